# Optimizing an MI355X kernel written in HIP

```python
import jax
import jax.numpy as jnp
from jax import lax

D_MODEL = 1024
BATCH = 2
SEQ = 8192
DEPTH = 4

ATTN_HEADS = 8
HEAD_DIM = 64
ATTN_WIDTH = ATTN_HEADS * HEAD_DIM
POOL_WINDOWS = (2, 4, 8, 16)
POOL_GROUPS = len(POOL_WINDOWS)
POOL_GROUP_DIM = 64
POOL_WIDTH = POOL_GROUPS * POOL_GROUP_DIM
HGRN_HEADS = 4
HGRN_HEAD_DIM = 64
HGRN_WIDTH = HGRN_HEADS * HGRN_HEAD_DIM
MIX_WIDTH = ATTN_WIDTH + POOL_WIDTH + HGRN_WIDTH
SPLIT_SIZES = (ATTN_WIDTH, ATTN_WIDTH, ATTN_WIDTH, POOL_WIDTH, HGRN_WIDTH, HGRN_WIDTH, HGRN_WIDTH, HGRN_WIDTH)
IN_WIDTH = sum(SPLIT_SIZES)
D_FF = 2816
MOBA_BLOCK = 256
MOBA_TOPK = 3
MOBA_Q_CHUNK = 64
HGRN_CHUNK = 64
ROPE_THETA = 10000.0
EPS = 1e-6
NEG_INF = -1e30
LB_FLOOR = 1e-20

kernel_name = 'hybrid_moba_pool_hgrn2_macaron'


def rms_norm(x, gain):
    x32 = x.astype(jnp.float32)
    y = x32 * lax.rsqrt(jnp.mean(x32 * x32, axis=-1, keepdims=True) + EPS)
    return (y * gain.astype(jnp.float32)).astype(x.dtype)


def swiglu(h, w_gate, w_up, w_down):
    return (jax.nn.silu(h @ w_gate) * (h @ w_up)) @ w_down


def apply_rope(x, pos):
    half = x.shape[-1] // 2
    inv_freq = ROPE_THETA ** (-jnp.arange(half, dtype=jnp.float32) / half)
    ang = pos.astype(jnp.float32)[:, None] * inv_freq[None, :]
    cos, sin = jnp.cos(ang), jnp.sin(ang)
    x32 = x.astype(jnp.float32)
    x1, x2 = x32[..., :half], x32[..., half:]
    return jnp.concatenate([x1 * cos - x2 * sin, x2 * cos + x1 * sin], axis=-1).astype(x.dtype)


def moba_attention(q, k, v):
    b, h, s, dh = q.shape
    nb = -(-s // MOBA_BLOCK)
    pad = nb * MOBA_BLOCK - s
    widths = ((0, 0), (0, 0), (0, pad), (0, 0))
    k_blocks = jnp.pad(k, widths).reshape(b, h, nb, MOBA_BLOCK, dh)
    v_blocks = jnp.pad(v, widths).reshape(b, h, nb, MOBA_BLOCK, dh)
    k_mean = jnp.mean(k_blocks.astype(jnp.float32), axis=3)
    n_sel = min(MOBA_TOPK, nb - 1)
    scale = dh ** -0.5
    n_chunks = s // MOBA_Q_CHUNK
    q_chunks = q.reshape(b, h, n_chunks, MOBA_Q_CHUNK, dh).transpose(2, 0, 1, 3, 4)
    b_idx = jnp.arange(b)[:, None, None, None]
    h_idx = jnp.arange(h)[None, :, None, None]
    key_off = jnp.arange(MOBA_BLOCK)
    q_off = jnp.arange(MOBA_Q_CHUNK)
    blk_ids = jnp.arange(nb)

    def chunk(args):
        q_c, c = args
        q_pos = c * MOBA_Q_CHUNK + q_off
        own = (c * MOBA_Q_CHUNK) // MOBA_BLOCK
        k_own = lax.dynamic_index_in_dim(k_blocks, own, axis=2, keepdims=False)
        v_own = lax.dynamic_index_in_dim(v_blocks, own, axis=2, keepdims=False)
        s_own = jnp.einsum('bhqd,bhkd->bhqk', q_c, k_own).astype(jnp.float32) * scale
        s_own = jnp.where(own * MOBA_BLOCK + key_off[None, :] <= q_pos[:, None], s_own, NEG_INF)
        if n_sel == 0:
            p = jax.nn.softmax(s_own, axis=-1).astype(v.dtype)
            return jnp.einsum('bhqk,bhkd->bhqd', p, v_own)
        gate = jnp.einsum('bhqd,bhnd->bhqn', q_c.astype(jnp.float32), k_mean)
        gate = jnp.where(blk_ids < own, gate, NEG_INF)
        _, sel = lax.top_k(gate, n_sel)
        sel_ok = jnp.arange(n_sel) < own
        k_sel = k_blocks[b_idx, h_idx, sel]
        v_sel = v_blocks[b_idx, h_idx, sel]
        s_sel = jnp.einsum('bhqd,bhqnkd->bhqnk', q_c, k_sel).astype(jnp.float32) * scale
        s_sel = jnp.where(sel_ok[:, None], s_sel, NEG_INF)
        n_keys = n_sel * MOBA_BLOCK
        scores = jnp.concatenate([s_sel.reshape(b, h, MOBA_Q_CHUNK, n_keys), s_own], axis=-1)
        p = jax.nn.softmax(scores, axis=-1).astype(v.dtype)
        p_sel = p[..., :n_keys].reshape(b, h, MOBA_Q_CHUNK, n_sel, MOBA_BLOCK)
        out = jnp.einsum('bhqnk,bhqnkd->bhqd', p_sel, v_sel)
        return out + jnp.einsum('bhqk,bhkd->bhqd', p[..., n_keys:], v_own)

    out = lax.map(chunk, (q_chunks, jnp.arange(n_chunks)))
    return out.transpose(1, 2, 0, 3, 4).reshape(b, h, s, dh)


def multiscale_pool(u, pool_w, pool_scale):
    b, s, _ = u.shape
    u32 = u.astype(jnp.float32)
    csum = jnp.pad(jnp.cumsum(u32, axis=1), ((0, 0), (1, 0), (0, 0)))
    count = jnp.arange(1, s + 1, dtype=jnp.float32)
    diffs = []
    for g, w in enumerate(POOL_WINDOWS):
        sl = slice(g * POOL_GROUP_DIM, (g + 1) * POOL_GROUP_DIM)
        cg = csum[..., sl]
        lo = jnp.pad(cg[:, :s + 1 - w], ((0, 0), (w - 1, 0), (0, 0)))
        mean = (cg[:, 1:] - lo) / jnp.minimum(count, float(w))[None, :, None]
        diffs.append(mean - u32[..., sl])
    d = jnp.stack(diffs, axis=2)
    y = jnp.einsum('bsgc,gce->bsge', d, pool_w.astype(jnp.float32)).reshape(b, s, POOL_WIDTH)
    return (y * pool_scale.astype(jnp.float32)).astype(u.dtype)


def hgrn2(q, f_logit, i, gate, lower_bound, out_norm):
    b, s, _ = q.shape
    n_c = s // HGRN_CHUNK
    z = f_logit.astype(jnp.float32)
    lb = lower_bound.astype(jnp.float32)
    log_f = jnp.logaddexp(jnp.log(jnp.maximum(lb, LB_FLOOR)), jnp.log1p(-lb) + jax.nn.log_sigmoid(z))
    key = (1.0 - lb) * jax.nn.sigmoid(-z)
    query = jax.nn.silu(q.astype(jnp.float32)) * HGRN_HEAD_DIM ** -0.5
    value = i.astype(jnp.float32)

    def chunks(t):
        return t.reshape(b, n_c, HGRN_CHUNK, HGRN_HEADS, HGRN_HEAD_DIM).transpose(1, 0, 3, 2, 4)

    causal = jnp.tril(jnp.ones((HGRN_CHUNK, HGRN_CHUNK), dtype=bool))[:, :, None]

    def step(state, inp):
        q_c, k_c, v_c, g_c = inp
        cum = jnp.cumsum(g_c, axis=2)
        last = cum[:, :, -1]
        o_inter = jnp.einsum('bhtk,bhkv->bhtv', q_c * jnp.exp(cum), state)
        diff = cum[:, :, :, None, :] - cum[:, :, None, :, :]
        decay = jnp.where(causal, jnp.exp(jnp.minimum(diff, 0.0)), 0.0)
        scores = jnp.einsum('bhtk,bhsk,bhtsk->bhts', q_c, k_c, decay)
        o_intra = jnp.einsum('bhts,bhsv->bhtv', scores, v_c)
        k_dec = k_c * jnp.exp(last[:, :, None, :] - cum)
        state = jnp.exp(last)[..., None] * state + jnp.einsum('bhsk,bhsv->bhkv', k_dec, v_c)
        return state, o_inter + o_intra

    state0 = jnp.zeros((b, HGRN_HEADS, HGRN_HEAD_DIM, HGRN_HEAD_DIM), jnp.float32)
    _, o = lax.scan(step, state0, (chunks(query), chunks(key), chunks(value), chunks(log_f)))
    o = o.transpose(1, 0, 3, 2, 4).reshape(b, s, HGRN_HEADS, HGRN_HEAD_DIM)
    g = gate.astype(jnp.float32).reshape(b, s, HGRN_HEADS, HGRN_HEAD_DIM)
    y = rms_norm(o, out_norm) * jax.nn.silu(g)
    return y.reshape(b, s, HGRN_WIDTH).astype(q.dtype)


def token_mixing(h, w_in, q_norm, k_norm, pool_w, pool_scale, lower_bound, hgrn_out_norm, w_out, pos):
    b, s, _ = h.shape
    proj = h @ w_in
    offsets = []
    acc = 0
    for sz in SPLIT_SIZES[:-1]:
        acc += sz
        offsets.append(acc)
    q_a, k_a, v_a, u_p, q_h, f_h, i_h, g_h = jnp.split(proj, offsets, axis=-1)

    def heads(t):
        return t.reshape(b, s, ATTN_HEADS, HEAD_DIM).transpose(0, 2, 1, 3)

    q = apply_rope(rms_norm(heads(q_a), q_norm), pos)
    k = apply_rope(rms_norm(heads(k_a), k_norm), pos)
    y_attn = moba_attention(q, k, heads(v_a)).transpose(0, 2, 1, 3).reshape(b, s, ATTN_WIDTH)
    y_pool = multiscale_pool(u_p, pool_w, pool_scale)
    y_hgrn = hgrn2(q_h, f_h, i_h, g_h, lower_bound, hgrn_out_norm)
    y = jnp.concatenate([y_attn, y_pool, y_hgrn], axis=-1)
    return y @ w_out


def setup_inputs(seed: int = 0) -> dict:
    key = jax.random.key(seed)
    ks = jax.random.split(key, 18)
    f32 = jnp.float32

    def normal(k, shape, scale):
        return jax.random.normal(k, shape, f32) * scale

    def gain(k, shape):
        return 1.0 + 0.05 * jax.random.normal(k, shape, f32)

    return {
        'x': normal(ks[0], (BATCH, SEQ, D_MODEL), 1.0),
        'ffn1_norm': gain(ks[1], (DEPTH, D_MODEL)),
        'ffn1_w_gate': normal(ks[2], (DEPTH, D_MODEL, D_FF), D_MODEL ** -0.5),
        'ffn1_w_up': normal(ks[3], (DEPTH, D_MODEL, D_FF), D_MODEL ** -0.5),
        'ffn1_w_down': normal(ks[4], (DEPTH, D_FF, D_MODEL), D_FF ** -0.5),
        'mix_norm': gain(ks[5], (DEPTH, D_MODEL)),
        'w_in': normal(ks[6], (DEPTH, D_MODEL, IN_WIDTH), D_MODEL ** -0.5),
        'q_norm': gain(ks[7], (DEPTH, HEAD_DIM)),
        'k_norm': gain(ks[8], (DEPTH, HEAD_DIM)),
        'pool_w': normal(ks[9], (DEPTH, POOL_GROUPS, POOL_GROUP_DIM, POOL_GROUP_DIM), POOL_GROUP_DIM ** -0.5),
        'pool_scale': gain(ks[10], (DEPTH, POOL_WIDTH)),
        'hgrn_lb': normal(ks[11], (DEPTH, HGRN_WIDTH), 0.5),
        'hgrn_out_norm': gain(ks[12], (DEPTH, HGRN_HEAD_DIM)),
        'w_out': normal(ks[13], (DEPTH, MIX_WIDTH, D_MODEL), MIX_WIDTH ** -0.5),
        'ffn2_norm': gain(ks[14], (DEPTH, D_MODEL)),
        'ffn2_w_gate': normal(ks[15], (DEPTH, D_MODEL, D_FF), D_MODEL ** -0.5),
        'ffn2_w_up': normal(ks[16], (DEPTH, D_MODEL, D_FF), D_MODEL ** -0.5),
        'ffn2_w_down': normal(ks[17], (DEPTH, D_FF, D_MODEL), D_FF ** -0.5),
    }


def reference(x, ffn1_norm, ffn1_w_gate, ffn1_w_up, ffn1_w_down, mix_norm, w_in, q_norm, k_norm,
              pool_w, pool_scale, hgrn_lb, hgrn_out_norm, w_out, ffn2_norm, ffn2_w_gate, ffn2_w_up,
              ffn2_w_down):
    pos = jnp.arange(x.shape[1])
    lb_soft = jax.nn.softmax(hgrn_lb.astype(jnp.float32), axis=0)
    lower_bounds = jnp.concatenate([jnp.zeros_like(lb_soft[:1]), jnp.cumsum(lb_soft[:-1], axis=0)], axis=0)
    for l in range(DEPTH):
        x = x + 0.5 * swiglu(rms_norm(x, ffn1_norm[l]), ffn1_w_gate[l], ffn1_w_up[l], ffn1_w_down[l])
        x = x + token_mixing(rms_norm(x, mix_norm[l]), w_in[l], q_norm[l], k_norm[l], pool_w[l],
                             pool_scale[l], lower_bounds[l], hgrn_out_norm[l], w_out[l], pos)
        x = x + 0.5 * swiglu(rms_norm(x, ffn2_norm[l]), ffn2_w_gate[l], ffn2_w_up[l], ffn2_w_down[l])
    return x
```

```cpp
#include <hip/hip_runtime.h>
#include <hip/hip_cooperative_groups.h>
#include <cstdio>
#include <cstdint>
namespace cg = cooperative_groups;
#define MK_MULTI 0
#define DBG_WC_ALWAYS
namespace pg8 {
#define PG8_LAS __attribute__((address_space(3)))
typedef unsigned short bf16_t;
typedef short bf16x8 __attribute__((ext_vector_type(8)));
typedef float f32x4 __attribute__((ext_vector_type(4)));
typedef unsigned u32x4 __attribute__((ext_vector_type(4)));
constexpr int BM = 256, BK = 64, HALF = 128, HTB = HALF * BK * 2  , STAGE_BYTES = 8 * HTB, NXCD = 8, WGM = 8;

__host__ __device__ __forceinline__ int lds_byte(int r, int c) { const int st = (r >> 4) * 2 + (c >> 5), rr = r & 15, cc = c & 31, ob = rr * 64 + cc * 2; return st * 1024 + (ob ^ (((ob >> 9) & 1) << 5)); }
__host__ __device__ __forceinline__ void stage_rc(int b, int& R, int& C) { const int st = b / 1024, sb = b % 1024, swz = sb ^ (((sb >> 9) & 1) << 5); R = (st >> 1) * 16 + swz / 64; C = (st & 1) * 32 + (swz % 64) / 2; }
__host__ __device__ __forceinline__ int perm32(int rho) { const int n = rho >> 4, i = rho & 15; return 8 * (i >> 2) + 4 * n + (i & 3); }

struct Unit { int pm, pn; };
struct Gemm { const bf16_t* A; const bf16_t* Bt; int M, N, K; };

struct StaticOrder {
    int nM, nN, nwg, G, c;
    __host__ __device__ void init(int M, int N, int G_, int c_) { nM = M / BM; nN = N / BM; nwg = nM * nN; G = G_; c = c_; }
    __host__ __device__ bool next(int i, Unit& u) const {
        const long L = (long)i * G + c; if (L >= nwg) return false;
        int wgid = (int)L; { const int q = nwg / NXCD, r = nwg % NXCD, xcd = wgid % NXCD, off = wgid / NXCD; wgid = (xcd < r ? xcd * (q + 1) : r * (q + 1) + (xcd - r) * q) + off; }
        const int nig = WGM * nN, gid = wgid / nig, fm = gid * WGM, gsz = (nM - fm) < WGM ? (nM - fm) : WGM;
        u.pm = fm + ((wgid % nig) % gsz); u.pn = (wgid % nig) / gsz; return true;
    }
    __device__ __forceinline__ void a_ready(const Unit&) const {}
    __device__ __forceinline__ void done(const Unit&) const {}
};

__device__ __forceinline__ unsigned cvt_pk_bf16(float lo, float hi) { unsigned r; asm volatile("v_cvt_pk_bf16_f32 %0, %1, %2" : "=v"(r) : "v"(lo), "v"(hi)); return r; }
typedef float f32x2 __attribute__((ext_vector_type(2)));
typedef unsigned u32x2 __attribute__((ext_vector_type(2)));
typedef __bf16 bf16x2_t __attribute__((ext_vector_type(2)));
__device__ __forceinline__ unsigned cvtpk(float lo, float hi) { f32x2 v = {lo, hi}; bf16x2_t b = __builtin_convertvector(v, bf16x2_t); return __builtin_bit_cast(unsigned, b); }
__device__ __forceinline__ float row_rstd(const float* stats, int row) {
    const f32x4* p = (const f32x4*)(stats + (size_t)row * 16);
    const f32x4 a = p[0], b = p[1], c = p[2], d = p[3];
    const float s = ((a[0] + a[1]) + (a[2] + a[3])) + ((b[0] + b[1]) + (b[2] + b[3])) + ((c[0] + c[1]) + (c[2] + c[3])) + ((d[0] + d[1]) + (d[2] + d[3]));
    return rsqrtf(s * (1.0f / 1024.0f) + 1e-6f);
}
__device__ __forceinline__ float silu_f(float g) { return g * __builtin_amdgcn_rcpf(1.0f + __expf(-g)); }

struct EpiSwiGLU {
    static constexpr bool PERM = true, AFTER_DRAIN = false;
    bf16_t* H; const float* stats; int ldh;
    __device__ __forceinline__ void operator()(const f32x4 (&acc)[2][2][4][2], const Unit& u, int wr, int wc, int fr, int fq) const {
        asm volatile("" : "+v"(fr), "+v"(fq));
        const int row0 = u.pm * BM + wr * 64 + fr, col0 = u.pn * HALF + wc * 32 + 8 * fq;
#pragma unroll
        for (int ai = 0; ai < 2; ++ai)
#pragma unroll
            for (int m = 0; m < 4; ++m) {
                const int row = row0 + ai * HALF + m * 16;
                const float rs = row_rstd(stats, row);
                float h[8];
#pragma unroll
                for (int n = 0; n < 2; ++n)
#pragma unroll
                    for (int i = 0; i < 4; ++i) { const float g = acc[ai][0][m][n][i] * rs, up = acc[ai][1][m][n][i] * rs; h[4 * n + i] = silu_f(g) * up; }
                u32x4 w; w.x = cvtpk(h[0], h[1]); w.y = cvtpk(h[2], h[3]); w.z = cvtpk(h[4], h[5]); w.w = cvtpk(h[6], h[7]);
                *(u32x4*)(H + (size_t)row * ldh + col0) = w;
            }
    }
};

struct EpiResid {
    static constexpr bool PERM = true, AFTER_DRAIN = false;
    float* X; bf16_t* XB; float* stats; float scale;
    __device__ __forceinline__ void operator()(const f32x4 (&acc)[2][2][4][2], const Unit& u, int wr, int wc, int fr, int fq) const {
        asm volatile("" : "+v"(fr), "+v"(fq));
        const int row0 = u.pm * BM + wr * 64 + fr, col0 = u.pn * BM + wc * 32 + 8 * fq;
#pragma unroll
        for (int ai = 0; ai < 2; ++ai)
#pragma unroll
            for (int m = 0; m < 4; ++m) {
                const int row = row0 + ai * HALF + m * 16; float ss = 0.f;
#pragma unroll
                for (int bj = 0; bj < 2; ++bj) {
                    float* xp = X + (size_t)row * 1024 + col0 + bj * HALF;
                    f32x4 x0 = *(const f32x4*)xp, x1 = *(const f32x4*)(xp + 4);
                    x0 = x0 + acc[ai][bj][m][0] * scale; x1 = x1 + acc[ai][bj][m][1] * scale;
                    *(f32x4*)xp = x0; *(f32x4*)(xp + 4) = x1;
                    ss += (x0[0] * x0[0] + x0[1] * x0[1]) + (x0[2] * x0[2] + x0[3] * x0[3]) + (x1[0] * x1[0] + x1[1] * x1[1]) + (x1[2] * x1[2] + x1[3] * x1[3]);
                    u32x4 w; w.x = cvtpk(x0[0], x0[1]); w.y = cvtpk(x0[2], x0[3]); w.z = cvtpk(x1[0], x1[1]); w.w = cvtpk(x1[2], x1[3]);
                    *(u32x4*)(XB + (size_t)row * 1024 + col0 + bj * HALF) = w;
                }
                ss += __shfl_xor(ss, 16); ss += __shfl_xor(ss, 32);
                if (fq == 0) stats[(size_t)row * 16 + u.pn * 4 + wc] = ss;
            }
    }
};

struct EpiProj {
    static constexpr bool PERM = true, AFTER_DRAIN = false;
    bf16_t* Q; bf16_t* Kb; bf16_t* Vb; bf16_t* U5; float* kmp; const float* stats; const float* ropeC; const float* ropeS; const float* qn; const float* kn;
    __device__ __forceinline__ void operator()(const f32x4 (&acc)[2][2][4][2], const Unit& u, int wr, int wc, int fr, int fq) const {
        asm volatile("" : "+v"(fr), "+v"(fq));
        const int row0 = u.pm * BM + wr * 64 + fr;
        const int pn = u.pn;
        if (pn >= 6) {
            bf16_t* O = U5 + (size_t)(pn - 6) * (16384 * 256);
            const int col0 = wc * 32 + 8 * fq;
#pragma unroll
            for (int ai = 0; ai < 2; ++ai)
#pragma unroll
                for (int m = 0; m < 4; ++m) {
                    const int row = row0 + ai * HALF + m * 16; const float rs = row_rstd(stats, row);
#pragma unroll
                    for (int bj = 0; bj < 2; ++bj) {
                        const f32x4 v0 = acc[ai][bj][m][0] * rs, v1 = acc[ai][bj][m][1] * rs;
                        u32x4 w; w.x = cvtpk(v0[0], v0[1]); w.y = cvtpk(v0[2], v0[3]); w.z = cvtpk(v1[0], v1[1]); w.w = cvtpk(v1[2], v1[3]);
                        *(u32x4*)(O + (size_t)row * 256 + col0 + bj * HALF) = w;
                    }
                }
            return;
        }
        const int head = (pn & 1) * 4 + wc, b = u.pm >> 5, j = u.pm & 31;
        const size_t bh = (size_t)(b * 8 + head);
        if (pn >= 4) {
            bf16_t* vb = Vb + (bh * 32 + j) * 16384;
#pragma unroll
            for (int ai = 0; ai < 2; ++ai)
#pragma unroll
                for (int m = 0; m < 4; ++m) {
                    const int row = row0 + ai * HALF + m * 16; const float rs = row_rstd(stats, row);
                    const int kk = ai * HALF + wr * 64 + m * 16 + fr;
                    const int kg = kk >> 5, w = kk & 31, st = w >> 4, w16 = w & 15, hh = (w16 >> 2) & 1, jj = 4 * (w16 >> 3) + (w16 & 3);
#pragma unroll
                    for (int bj = 0; bj < 2; ++bj)
#pragma unroll
                        for (int n = 0; n < 2; ++n) {
                            const unsigned p0 = cvtpk(acc[ai][bj][m][n][0] * rs, acc[ai][bj][m][n][1] * rs), p1 = cvtpk(acc[ai][bj][m][n][2] * rs, acc[ai][bj][m][n][3] * rs);
#pragma unroll
                            for (int i = 0; i < 4; ++i) {
                                const int r = 8 * fq + 4 * n + i;
                                const unsigned pv = (i < 2) ? p0 : p1;
                                vb[((((kg * 2 + st) * 2 + bj) * 32 + r) * 2 + hh) * 8 + jj] = (bf16_t)((i & 1) ? (pv >> 16) : (pv & 0xffffu));
                            }
                        }
                }
            return;
        }
        const bool isk = pn >= 2;
        const float* gn = isk ? kn : qn;
        float ksum[16];
#pragma unroll
        for (int e = 0; e < 16; ++e) ksum[e] = 0.f;
#pragma unroll
        for (int ai = 0; ai < 2; ++ai)
#pragma unroll
            for (int m = 0; m < 4; ++m) {
                const int row = row0 + ai * HALF + m * 16; const float rs = row_rstd(stats, row);
                const int t = row & 8191, kk = t & 255;
                float v0[8], v1[8]; float ss = 0.f;
#pragma unroll
                for (int n = 0; n < 2; ++n)
#pragma unroll
                    for (int i = 0; i < 4; ++i) { v0[4 * n + i] = acc[ai][0][m][n][i] * rs; v1[4 * n + i] = acc[ai][1][m][n][i] * rs; ss += v0[4 * n + i] * v0[4 * n + i] + v1[4 * n + i] * v1[4 * n + i]; }
                ss += __shfl_xor(ss, 16); ss += __shfl_xor(ss, 32);
                const float rn = rsqrtf(ss * (1.0f / 64.0f) + 1e-6f);
                const f32x4 c0 = *(const f32x4*)(ropeC + t * 32 + 8 * fq), c1 = *(const f32x4*)(ropeC + t * 32 + 8 * fq + 4);
                const f32x4 s0 = *(const f32x4*)(ropeS + t * 32 + 8 * fq), s1 = *(const f32x4*)(ropeS + t * 32 + 8 * fq + 4);
                const f32x4 ga0 = *(const f32x4*)(gn + 8 * fq), ga1 = *(const f32x4*)(gn + 8 * fq + 4), gb0 = *(const f32x4*)(gn + 32 + 8 * fq), gb1 = *(const f32x4*)(gn + 36 + 8 * fq);
                float o0[8], o1[8];
#pragma unroll
                for (int e = 0; e < 8; ++e) {
                    const float x1 = v0[e] * rn * (e < 4 ? ga0[e & 3] : ga1[e & 3]), x2 = v1[e] * rn * (e < 4 ? gb0[e & 3] : gb1[e & 3]);
                    const float cs = e < 4 ? c0[e & 3] : c1[e & 3], sn = e < 4 ? s0[e & 3] : s1[e & 3];
                    o0[e] = x1 * cs - x2 * sn; o1[e] = x2 * cs + x1 * sn;
                }
                u32x4 w0, w1;
                w0.x = cvtpk(o0[0], o0[1]); w0.y = cvtpk(o0[2], o0[3]); w0.z = cvtpk(o0[4], o0[5]); w0.w = cvtpk(o0[6], o0[7]);
                w1.x = cvtpk(o1[0], o1[1]); w1.y = cvtpk(o1[2], o1[3]); w1.z = cvtpk(o1[4], o1[5]); w1.w = cvtpk(o1[6], o1[7]);
                if (!isk) {
                    bf16_t* qp = Q + (bh * 8192 + t) * 64 + 8 * fq;
                    *(u32x4*)qp = w0; *(u32x4*)(qp + 32) = w1;
                } else {
                    bf16_t* kb = Kb + (bh * 32 + j) * 16384;
                    const int kg = kk >> 5, r = kk & 31, hq = fq & 1, ksl = fq >> 1;
                    *(u32x4*)(kb + (((kg * 4 + ksl) * 32 + r) * 2 + hq) * 8) = w0;
                    *(u32x4*)(kb + (((kg * 4 + 2 + ksl) * 32 + r) * 2 + hq) * 8) = w1;
#pragma unroll
                    for (int e = 0; e < 8; ++e) { ksum[e] += o0[e]; ksum[8 + e] += o1[e]; }
                }
                asm volatile("" ::: "memory");
            }
        if (isk) {
#pragma unroll
            for (int e = 0; e < 16; ++e) { float s = ksum[e]; s += __shfl_xor(s, 1); s += __shfl_xor(s, 2); s += __shfl_xor(s, 4); s += __shfl_xor(s, 8); ksum[e] = s; }
            if (fr == 0) {
                float* kp = kmp + ((size_t)(u.pm * 2 + wr) * 512) + head * 64 + 8 * fq;
                *(f32x4*)kp = (f32x4){ksum[0], ksum[1], ksum[2], ksum[3]}; *(f32x4*)(kp + 4) = (f32x4){ksum[4], ksum[5], ksum[6], ksum[7]};
                *(f32x4*)(kp + 32) = (f32x4){ksum[8], ksum[9], ksum[10], ksum[11]}; *(f32x4*)(kp + 36) = (f32x4){ksum[12], ksum[13], ksum[14], ksum[15]};
            }
        }
    }
};

template <class Epi, class Sched, bool ALIGN_EPI = false, bool SP2 = false>
__device__ __forceinline__ void gemm_phase(PG8_LAS unsigned char* lds, const Gemm g, const Sched& S, const Epi& E) {
    int tid_v = threadIdx.x; asm volatile("" : "+v"(tid_v));
    const int tid = tid_v, wid = __builtin_amdgcn_readfirstlane(tid >> 6), lane = tid & 63, wr = wid >> 2, wc = wid & 3, fr = lane & 15, fq = lane >> 4;
    const int K = g.K, nt = K / BK;
    unsigned voffA[2], voffB[2];
#pragma unroll
    for (int i = 0; i < 2; ++i) { int R, C; stage_rc(tid * 16 + i * 8192, R, C); const int Rb = Epi::PERM ? ((R & ~31) + perm32(R & 31)) : R;
        voffA[i] = (unsigned)(R * K + C) * 2u; voffB[i] = (unsigned)(Rb * K + C) * 2u; }
    const size_t kstep = (size_t)(BK * 2);
    const size_t hstep = (size_t)HALF * K * 2;
    const size_t tstep = 2 * hstep;
    const unsigned ldsw = (unsigned)wid * 1024u;
    const int aoff = lds_byte(wr * 64 + fr, fq * 8), boff = lds_byte(wc * 32 + fr, fq * 8);
#define PG8_SA(b, h) (((b) * 2 + (h)) * HTB)
#define PG8_SB(b, h) ((4 + (b) * 2 + (h)) * HTB)
#define PG8_STAGE(bufoff, gbase, voff) do { _Pragma("unroll") for (int _i = 0; _i < 2; ++_i) \
        __builtin_amdgcn_global_load_lds((const unsigned*)((const char*)(gbase) + (voff)[_i]), (PG8_LAS unsigned*)(lds + (bufoff) + ldsw + _i * 8192), 16, 0, 0); } while (0)
#define PG8_LDA(dst, b, h) do { _Pragma("unroll") for (int m = 0; m < 4; ++m) _Pragma("unroll") for (int k = 0; k < 2; ++k) dst[m][k] = *(const PG8_LAS bf16x8*)(lds + PG8_SA(b, h) + aoff + m * 2048 + k * 1024); } while (0)
#define PG8_LDB(dst, b, h) do { _Pragma("unroll") for (int n = 0; n < 2; ++n) _Pragma("unroll") for (int k = 0; k < 2; ++k) dst[n][k] = *(const PG8_LAS bf16x8*)(lds + PG8_SB(b, h) + boff + n * 2048 + k * 1024); } while (0)
#define PG8_MMA(ai, bj, At, Bt) do { __builtin_amdgcn_s_setprio(1); _Pragma("unroll") for (int m = 0; m < 4; ++m) _Pragma("unroll") for (int n = 0; n < 2; ++n) _Pragma("unroll") for (int k = 0; k < 2; ++k) \
        acc[ai][bj][m][n] = __builtin_amdgcn_mfma_f32_16x16x32_bf16(Bt[n][k], At[m][k], acc[ai][bj][m][n], 0, 0, 0); __builtin_amdgcn_s_setprio(0); } while (0)
#define PG8_WAIT_V(n) asm volatile("s_waitcnt vmcnt(" #n ")" ::: "memory")
#define PG8_WAIT_L(n) asm volatile("s_waitcnt lgkmcnt(" #n ")" ::: "memory")
#define PG8_BAR __builtin_amdgcn_s_barrier()
#define PG8_SCHED __builtin_amdgcn_sched_barrier(0)
    Unit cur, nxt; int ui = 0;
    if (!S.next(0, cur)) return;
    f32x4 acc[2][2][4][2];
#pragma unroll
    for (int a = 0; a < 2; ++a)
#pragma unroll
        for (int b = 0; b < 2; ++b)
#pragma unroll
            for (int m = 0; m < 4; ++m)
#pragma unroll
                for (int n = 0; n < 2; ++n) acc[a][b][m][n] = (f32x4){0.f, 0.f, 0.f, 0.f};
    bf16x8 At[4][2], B0[2][2], B1[2][2];
    const char* cA = (const char*)g.A + (size_t)cur.pm * tstep; const char* cB = (const char*)g.Bt + (size_t)cur.pn * tstep;
    S.a_ready(cur);
    if constexpr (SP2) {
        PG8_STAGE(PG8_SB(0, 0), cB, voffB); PG8_STAGE(PG8_SB(0, 1), cB + hstep, voffB); PG8_STAGE(PG8_SA(0, 0), cA, voffA); PG8_STAGE(PG8_SA(0, 1), cA + hstep, voffA);
        if (wr == 1) PG8_BAR;
        PG8_WAIT_V(2); PG8_BAR;
        PG8_STAGE(PG8_SB(1, 0), cB + kstep, voffB); PG8_STAGE(PG8_SA(1, 0), cA + kstep, voffA); PG8_STAGE(PG8_SB(1, 1), cB + hstep + kstep, voffB);
        PG8_WAIT_V(6); PG8_BAR;
    } else {
        PG8_STAGE(PG8_SB(0, 0), cB, voffB); PG8_STAGE(PG8_SA(0, 0), cA, voffA); PG8_STAGE(PG8_SB(0, 1), cB + hstep, voffB); PG8_STAGE(PG8_SA(0, 1), cA + hstep, voffA);
        if (wr == 1) PG8_BAR;
        PG8_WAIT_V(4); PG8_BAR;
        PG8_STAGE(PG8_SB(1, 0), cB + kstep, voffB); PG8_STAGE(PG8_SA(1, 0), cA + kstep, voffA); PG8_STAGE(PG8_SB(1, 1), cB + hstep + kstep, voffB);
        PG8_WAIT_V(6); PG8_BAR;
    }
    for (;;) {
        const bool has_next = S.next(ui + 1, nxt);
        const char* nA = has_next ? (const char*)g.A + (size_t)nxt.pm * tstep : cA; const char* nB = has_next ? (const char*)g.Bt + (size_t)nxt.pn * tstep : cB;
        for (int t = 0; t < nt; t += 2) {
            const bool last = (t == nt - 2);
            const char* a1 = cA + (size_t)(t + 1) * kstep;
            const char* a2 = last ? nA : cA + (size_t)(t + 2) * kstep; const char* b2 = last ? nB : cB + (size_t)(t + 2) * kstep;
            const char* a3 = a2 + kstep; const char* b3 = b2 + kstep;
            if (last && has_next) S.a_ready(nxt);
            if constexpr (SP2) {
            PG8_LDB(B0, 0, 0); PG8_LDB(B1, 0, 1); PG8_SCHED; PG8_LDA(At, 0, 0); PG8_STAGE(PG8_SA(1, 1), a1 + hstep, voffA);
            PG8_WAIT_V(8); PG8_WAIT_L(0); PG8_BAR; PG8_MMA(0, 0, At, B0); PG8_MMA(0, 1, At, B1); PG8_BAR; PG8_SCHED;
            PG8_LDA(At, 0, 1); PG8_STAGE(PG8_SB(0, 0), b2, voffB); PG8_STAGE(PG8_SB(0, 1), b2 + hstep, voffB); PG8_STAGE(PG8_SA(0, 0), a2, voffA);
            PG8_WAIT_V(8); PG8_WAIT_L(0); PG8_BAR; PG8_MMA(1, 0, At, B0); PG8_MMA(1, 1, At, B1); PG8_BAR; PG8_SCHED;
            PG8_LDB(B0, 1, 0); PG8_LDB(B1, 1, 1); PG8_SCHED; PG8_LDA(At, 1, 0); PG8_STAGE(PG8_SA(0, 1), a2 + hstep, voffA);
            PG8_WAIT_V(8); PG8_WAIT_L(0); PG8_BAR; PG8_MMA(0, 0, At, B0); PG8_MMA(0, 1, At, B1); PG8_BAR; PG8_SCHED;
            PG8_LDA(At, 1, 1); PG8_STAGE(PG8_SB(1, 0), b3, voffB); PG8_STAGE(PG8_SB(1, 1), b3 + hstep, voffB); PG8_STAGE(PG8_SA(1, 0), a3, voffA);
            PG8_WAIT_V(8); PG8_WAIT_L(0); PG8_BAR; PG8_MMA(1, 0, At, B0); PG8_MMA(1, 1, At, B1); PG8_BAR; PG8_SCHED;
            } else {
            PG8_LDB(B0, 0, 0); PG8_SCHED; PG8_LDA(At, 0, 0); PG8_STAGE(PG8_SA(1, 1), a1 + hstep, voffA);
            PG8_WAIT_L(8); PG8_BAR; PG8_WAIT_L(0); PG8_MMA(0, 0, At, B0); PG8_BAR; PG8_SCHED;
            PG8_LDB(B1, 0, 1); PG8_STAGE(PG8_SB(0, 0), b2, voffB);
            PG8_BAR; PG8_WAIT_L(0); PG8_MMA(0, 1, At, B1); PG8_BAR;
            PG8_LDA(At, 0, 1); PG8_STAGE(PG8_SA(0, 0), a2, voffA);
            PG8_BAR; PG8_WAIT_L(0); PG8_MMA(1, 0, At, B0); PG8_BAR; PG8_SCHED;
            PG8_STAGE(PG8_SB(0, 1), b2 + hstep, voffB);
            PG8_WAIT_V(6); PG8_BAR; PG8_MMA(1, 1, At, B1); PG8_BAR;
            PG8_LDB(B0, 1, 0); PG8_SCHED; PG8_LDA(At, 1, 0); PG8_STAGE(PG8_SA(0, 1), a2 + hstep, voffA);
            PG8_WAIT_L(8); PG8_BAR; PG8_WAIT_L(0); PG8_MMA(0, 0, At, B0); PG8_BAR; PG8_SCHED;
            PG8_LDB(B1, 1, 1); PG8_STAGE(PG8_SB(1, 0), b3, voffB);
            PG8_BAR; PG8_WAIT_L(0); PG8_MMA(0, 1, At, B1); PG8_BAR;
            PG8_LDA(At, 1, 1); PG8_STAGE(PG8_SA(1, 0), a3, voffA);
            PG8_BAR; PG8_WAIT_L(0); PG8_MMA(1, 0, At, B0); PG8_BAR; PG8_SCHED;
            PG8_STAGE(PG8_SB(1, 1), b3 + hstep, voffB);
            PG8_WAIT_V(6); PG8_BAR; PG8_MMA(1, 1, At, B1); PG8_BAR;
            }
        }
        if constexpr (ALIGN_EPI) { if (wr == 0) PG8_BAR; }
        if constexpr (!Epi::AFTER_DRAIN) { E(acc, cur, wr, wc, fr, fq); S.done(cur); }
        if (!has_next) break;
#pragma unroll
        for (int a = 0; a < 2; ++a)
#pragma unroll
            for (int b = 0; b < 2; ++b)
#pragma unroll
                for (int m = 0; m < 4; ++m)
#pragma unroll
                    for (int n = 0; n < 2; ++n) acc[a][b][m][n] = (f32x4){0.f, 0.f, 0.f, 0.f};
        cur = nxt; cA = nA; cB = nB; ++ui;
        if constexpr (ALIGN_EPI) { if (wr == 1) PG8_BAR; }
    }
    PG8_WAIT_V(0);
    if constexpr (!ALIGN_EPI) { if (wr == 0) PG8_BAR; }
    PG8_BAR;
    if constexpr (Epi::AFTER_DRAIN) { E.fused(acc, cur, wr, wc, fr, fq, lds, wid, lane); S.done(cur); }
#undef PG8_SA
#undef PG8_SB
#undef PG8_STAGE
#undef PG8_LDA
#undef PG8_LDB
#undef PG8_MMA
#undef PG8_WAIT_V
#undef PG8_WAIT_L
#undef PG8_BAR
#undef PG8_SCHED
}
}

#ifndef PG8_SP2
#define PG8_SP2 true
#endif
#ifndef PG8_ALIGN
#define PG8_ALIGN true
#endif

#define DI __device__ __forceinline__
typedef unsigned short bf16;
typedef short bf16x8 __attribute__((ext_vector_type(8)));
typedef float f32x4 __attribute__((ext_vector_type(4)));
typedef float f32x16 __attribute__((ext_vector_type(16)));
typedef unsigned u32x4 __attribute__((ext_vector_type(4)));
typedef unsigned u32x2 __attribute__((ext_vector_type(2)));
#define MFMA32(a, b, c) __builtin_amdgcn_mfma_f32_32x32x16_bf16((a), (b), (c), 0, 0, 0)

constexpr int NWAVES = 8, NTHR = 512;
constexpr int M = 16384, D = 1024, FF = 2816, INW = 2816, SEQ = 8192, DEPTH = 4;
constexpr int LDS_BYTES = 147456;
constexpr size_t MiB = 1u << 20;
constexpr size_t WS_CTL = 0;
constexpr size_t WS_STATS = 1 * MiB;
constexpr size_t WS_KMP = 2 * MiB;
constexpr size_t WS_DEC = 2 * MiB + 512 * 1024;
constexpr size_t WS_ROPEC = 3 * MiB, WS_ROPES = 4 * MiB;
constexpr size_t WS_W = 5 * MiB, WSZ = 42467328;
constexpr size_t W_GU1 = 0, W_D1 = 11534336, W_IN = 17301504, W_OUT = 23068672, W_GU2 = 25165824, W_D2 = 36700160;
constexpr size_t WS_XB = 86 * MiB;
constexpr size_t WS_R = 118 * MiB;
constexpr size_t R_HID = 0;
constexpr size_t R_Q = 0, R_K = 16 * MiB, R_V = 32 * MiB, R_U5 = 48 * MiB  , R_Y = 88 * MiB, R_PO = 120 * MiB, R_PML = 168 * MiB,
                 R_LIST = 172 * MiB  , R_ALOC = 188 * MiB, R_OINTRA = 204 * MiB, R_QDEC = 220 * MiB, R_SP = 228 * MiB, R_END = 236 * MiB;
constexpr size_t WS_END = WS_R + R_END;

DI float bf2f(unsigned short b) { return __uint_as_float((unsigned)b << 16); }
DI unsigned cvtpk(float lo, float hi) { return pg8::cvtpk(lo, hi); }
DI float wave_sum(float v) {
#pragma unroll
    for (int o = 1; o < 64; o <<= 1) v += __shfl_xor(v, o);
    return v;
}
DI void st_sc1(unsigned* p, unsigned v) { __hip_atomic_store(p, v, __ATOMIC_RELAXED, __HIP_MEMORY_SCOPE_AGENT); }
DI unsigned ld_sc1(const unsigned* p) { return __hip_atomic_load(p, __ATOMIC_RELAXED, __HIP_MEMORY_SCOPE_AGENT); }
DI float ld_sc1f(const float* p) { return __uint_as_float(__hip_atomic_load((const unsigned*)p, __ATOMIC_RELAXED, __HIP_MEMORY_SCOPE_AGENT)); }
DI int crow(int reg, int h) { return (reg & 3) + 8 * (reg >> 2) + 4 * h; }
DI bf16x8 pack8(const f32x16& x, int s) {
    u32x4 p; p.x = cvtpk(x[8 * s], x[8 * s + 1]); p.y = cvtpk(x[8 * s + 2], x[8 * s + 3]); p.z = cvtpk(x[8 * s + 4], x[8 * s + 5]); p.w = cvtpk(x[8 * s + 6], x[8 * s + 7]);
    return __builtin_bit_cast(bf16x8, p);
}
DI f32x16 zero16() { f32x16 z;
#pragma unroll
    for (int i = 0; i < 16; ++i) z[i] = 0.f; return z; }

struct Args { const float* in[18]; float* out; unsigned char* ws; int ph_lo, ph_hi; };
typedef const float* cfp_t;
typedef const __attribute__((address_space(4))) unsigned char* kptr_t;
struct Ctx { kptr_t kp; unsigned char* ws; float* out;
    DI const float* in(int i) const { return *(const __attribute__((address_space(4))) cfp_t*)(kp + 8 * i); } };
enum { I_X = 0, I_F1N, I_F1G, I_F1U, I_F1D, I_MIXN, I_WIN, I_QN, I_KN, I_PW, I_PS, I_LB, I_HON, I_WOUT, I_F2N, I_F2G, I_F2U, I_F2D };

DI void wconv_tile(const float* W, int ld, int srccol, const float* gain, bf16* WT, int K, int nrow0, int k0, float* scr, int lane) {
    asm volatile("" : "+v"(lane));
#pragma unroll 8
    for (int i = 0; i < 32; ++i) { const int kk = 2 * i + (lane >> 5); float v = W[(size_t)(k0 + kk) * ld + srccol + (lane & 31)]; if (gain) v *= gain[k0 + kk]; scr[kk * 33 + (lane & 31)] = v; }
    asm volatile("s_waitcnt lgkmcnt(0)" ::: "memory");
    const int c = lane & 7;
#pragma unroll
    for (int j = 0; j < 4; ++j) { const int n = (lane >> 3) + 8 * j; const float* s = scr + (8 * c) * 33 + n;
        u32x4 o; o.x = cvtpk(s[0 * 33], s[1 * 33]); o.y = cvtpk(s[2 * 33], s[3 * 33]); o.z = cvtpk(s[4 * 33], s[5 * 33]); o.w = cvtpk(s[6 * 33], s[7 * 33]);
        *(u32x4*)(WT + (size_t)(nrow0 + n) * K + k0 + 8 * c) = o; }
    asm volatile("s_waitcnt lgkmcnt(0)" ::: "memory");
}
constexpr int WC_I0 = 2816, WC_I1 = 1408, WC_I2 = 1408, WC_I3 = 512, WC_I4 = 2816, WC_I5 = 1408, WC_ITEMS = WC_I0 + WC_I1 + WC_I2 + WC_I3 + WC_I4 + WC_I5;
DI void wconv_item(const Ctx& a, int L, int item, float* scr, int lane) {
    unsigned char* wb = a.ws + WS_W + (size_t)(L & 1) * WSZ;
    int r = item;
    if (r < WC_I0 || (r >= WC_I0 + WC_I1 + WC_I2 + WC_I3 && r < WC_I0 + WC_I1 + WC_I2 + WC_I3 + WC_I4)) {
        const bool second = r >= WC_I0; if (second) r -= WC_I0 + WC_I1 + WC_I2 + WC_I3;
        const int kb = r / 176, nb = r % 176, n0 = nb * 32, pn = n0 >> 8, c = n0 & 255, bj = c >> 7, col = 128 * pn + (c & 127);
        const float* src = a.in(second ? (bj ? I_F2U : I_F2G) : (bj ? I_F1U : I_F1G)) + (size_t)L * D * FF;
        const float* gain = a.in(second ? I_F2N : I_F1N) + L * D;
        wconv_tile(src, FF, col, gain, (bf16*)(wb + (second ? W_GU2 : W_GU1)), D, n0, kb * 64, scr, lane); return;
    }
    r -= WC_I0;
    if (r < WC_I1) { const int kb = r / 32, nb = r % 32; wconv_tile(a.in(I_F1D) + (size_t)L * FF * D, D, nb * 32, nullptr, (bf16*)(wb + W_D1), FF, nb * 32, kb * 64, scr, lane); return; }
    r -= WC_I1;
    if (r < WC_I2) { const int kb = r / 88, nb = r % 88, n0 = nb * 32, pn = n0 >> 8, c = n0 & 255;
        const int col = pn < 6 ? (pn >> 1) * 512 + 64 * ((pn & 1) * 4 + ((c >> 5) & 3)) + 32 * (c >> 7) : n0;
        wconv_tile(a.in(I_WIN) + (size_t)L * D * INW, INW, col, a.in(I_MIXN) + L * D, (bf16*)(wb + W_IN), D, n0, kb * 64, scr, lane); return; }
    r -= WC_I2;
    if (r < WC_I3) { const int kb = r / 32, nb = r % 32; wconv_tile(a.in(I_WOUT) + (size_t)L * D * D, D, nb * 32, nullptr, (bf16*)(wb + W_OUT), D, nb * 32, kb * 64, scr, lane); return; }
    r -= WC_I3 + WC_I4;
    { const int kb = r / 32, nb = r % 32; wconv_tile(a.in(I_F2D) + (size_t)L * FF * D, D, nb * 32, nullptr, (bf16*)(wb + W_D2), FF, nb * 32, kb * 64, scr, lane); }
}

DI void phase_p0(const Ctx& a, unsigned char* lds, int gw, int NGW, int wave, int lane) {
    const float* x = a.in(I_X); float* out = a.out; bf16* xb = (bf16*)(a.ws + WS_XB); float* stats = (float*)(a.ws + WS_STATS);
    for (int m = gw; m < M; m += NGW) {
        const f32x4* xr = (const f32x4*)(x + (size_t)m * D) + lane; f32x4 v[4]; float s = 0.f;
#pragma unroll
        for (int j = 0; j < 4; ++j) { v[j] = xr[64 * j]; s += (v[j][0] * v[j][0] + v[j][1] * v[j][1]) + (v[j][2] * v[j][2] + v[j][3] * v[j][3]); }
        s = wave_sum(s);
        f32x4* orow = (f32x4*)(out + (size_t)m * D) + lane; u32x2* brow = (u32x2*)(xb + (size_t)m * D) + lane;
#pragma unroll
        for (int j = 0; j < 4; ++j) { orow[64 * j] = v[j]; u32x2 w; w.x = cvtpk(v[j][0], v[j][1]); w.y = cvtpk(v[j][2], v[j][3]); brow[64 * j] = w; }
        if (lane < 16) stats[(size_t)m * 16 + lane] = (lane == 0) ? s : 0.f;
    }
    { unsigned* cz = (unsigned*)(a.ws + WS_CTL); for (int i = gw * 64 + lane; i < DEPTH * 512; i += NGW * 64) st_sc1(cz + i, 0u); }
    float* rc = (float*)(a.ws + WS_ROPEC); float* rs = (float*)(a.ws + WS_ROPES);
    for (int e = gw * 64 + lane; e < SEQ * 32; e += NGW * 64) {
        const int t = e >> 5, i = e & 31;
        double c = 0.15915494309189535;
        for (int k = 0; k < i; ++k) c *= 0.74989420933245582;
        const float chi = (float)c, clo = (float)(c - (double)chi), tf = (float)t;
        const float p = tf * chi, pe = fmaf(tf, chi, -p);
        float fr = __builtin_amdgcn_fractf(p) + (pe + tf * clo);
        rc[e] = __builtin_amdgcn_cosf(fr); rs[e] = __builtin_amdgcn_sinf(fr);
    }
    float* scr = (float*)(lds + wave * 16384);
    for (int it = gw; it < WC_ITEMS; it += NGW) wconv_item(a, 0, it, scr, lane);
}

template <bool DIAG>
DI void attn_core(const bf16* qrow, const bf16* kblk, const bf16* vblk, int nkg, int r, int h, float& m_out, float& l_out, f32x16 (&ot)[2]) {
    bf16x8 qf[4];
#pragma unroll
    for (int ks = 0; ks < 4; ++ks) qf[ks] = *(const bf16x8*)(qrow + 16 * ks + 8 * h);
    f32x16 st[8];
    const int lo = (r * 2 + h) * 8;
#pragma unroll
    for (int kg = 0; kg < 8; ++kg) {
        f32x16 acc = zero16();
        if (!DIAG || kg < nkg) {
#pragma unroll
            for (int ks = 0; ks < 4; ++ks) { const bf16x8 kf = *(const bf16x8*)(kblk + (kg * 4 + ks) * 512 + lo); acc = MFMA32(kf, qf[ks], acc); }
            if (DIAG && kg == nkg - 1) {
#pragma unroll
                for (int i = 0; i < 16; ++i) if (crow(i, h) > r) acc[i] = -INFINITY;
            }
        } else {
#pragma unroll
            for (int i = 0; i < 16; ++i) acc[i] = -INFINITY;
        }
        st[kg] = acc;
    }
    float mx = -INFINITY;
#pragma unroll
    for (int kg = 0; kg < 8; ++kg)
#pragma unroll
        for (int i = 0; i < 16; ++i) mx = fmaxf(mx, st[kg][i]);
    mx = fmaxf(mx, __shfl_xor(mx, 32));
    const float c = 0.125f * 1.4426950408889634f; const float mc = mx * c;
    float l = 0.f;
#pragma unroll
    for (int kg = 0; kg < 8; ++kg)
#pragma unroll
        for (int i = 0; i < 16; ++i) { const float p = __builtin_amdgcn_exp2f(st[kg][i] * c - mc); st[kg][i] = p; l += p; }
    l += __shfl_xor(l, 32);
    ot[0] = zero16(); ot[1] = zero16();
#pragma unroll
    for (int kg = 0; kg < 8; ++kg) {
        if (!DIAG || kg < nkg) {
#pragma unroll
            for (int s2 = 0; s2 < 2; ++s2) {
                const bf16x8 pf = pack8(st[kg], s2);
#pragma unroll
                for (int md = 0; md < 2; ++md) { const bf16x8 vf = *(const bf16x8*)(vblk + ((kg * 2 + s2) * 2 + md) * 512 + lo); ot[md] = MFMA32(vf, pf, ot[md]); }
            }
        }
    }
    m_out = mx * 0.125f; l_out = l;
}

DI void topk_unit(const Ctx& a, int L, int unit, int lane) {
    asm volatile("" : "+v"(lane));
    const int b = unit >> 10, hd = (unit >> 7) & 7, c = unit & 127, own = c >> 2;
    if (own == 0) return;
    const bf16* Q = (const bf16*)(a.ws + WS_R + R_Q); const float* kmp = (const float*)(a.ws + WS_KMP);
    unsigned* cnt = (unsigned*)(a.ws + WS_CTL) + L * 512; unsigned* lists = (unsigned*)(a.ws + WS_R + R_LIST);
    const int t = c * 64 + lane; const size_t bh = (size_t)(b * 8 + hd);
    float q[64];
    { const u32x4* qp = (const u32x4*)(Q + (bh * SEQ + t) * 64);
#pragma unroll
      for (int i = 0; i < 8; ++i) { const u32x4 w = qp[i];
          q[8 * i + 0] = __uint_as_float(w.x << 16); q[8 * i + 1] = __uint_as_float(w.x & 0xffff0000u); q[8 * i + 2] = __uint_as_float(w.y << 16); q[8 * i + 3] = __uint_as_float(w.y & 0xffff0000u);
          q[8 * i + 4] = __uint_as_float(w.z << 16); q[8 * i + 5] = __uint_as_float(w.z & 0xffff0000u); q[8 * i + 6] = __uint_as_float(w.w << 16); q[8 * i + 7] = __uint_as_float(w.w & 0xffff0000u); } }
    float g0 = -INFINITY, g1 = -INFINITY, g2 = -INFINITY; int i0 = 0, i1 = 0, i2 = 0;
    for (int j = 0; j < own; ++j) {
        const float* p0 = kmp + (size_t)((b * 32 + j) * 2) * 512 + hd * 64; const float* p1 = p0 + 512;
        float g = 0.f;
#pragma unroll
        for (int d = 0; d < 64; d += 4) { const f32x4 x0 = *(const f32x4*)(p0 + d), x1 = *(const f32x4*)(p1 + d);
            g += q[d] * (x0[0] + x1[0]) + q[d + 1] * (x0[1] + x1[1]) + q[d + 2] * (x0[2] + x1[2]) + q[d + 3] * (x0[3] + x1[3]); }
#ifdef DBG_FIXED_SEL
        g = -(float)j;
#endif
        if (g > g0) { g2 = g1; i2 = i1; g1 = g0; i1 = i0; g0 = g; i0 = j; }
        else if (g > g1) { g2 = g1; i2 = i1; g1 = g; i1 = j; }
        else if (g > g2) { g2 = g; i2 = j; }
    }
    const int nsel = own < 3 ? own : 3;
#pragma unroll
    for (int s = 0; s < 3; ++s) {
        if (s < nsel) { const int j = s == 0 ? i0 : (s == 1 ? i1 : i2); const int li = (int)bh * 32 + j;
            const unsigned pos = atomicAdd(cnt + li, 1u); st_sc1(lists + (size_t)li * 8192 + pos, (unsigned)(t | (s << 13))); }
    }
}

DI void pool_unit(const Ctx& a, int L, int unit, int lane) {
    asm volatile("" : "+v"(lane));
    const int tile = unit >> 2, g = unit & 3, w = 2 << g, r = lane & 31, h = lane >> 5;
    const bf16* U = (const bf16*)(a.ws + WS_R + R_U5); bf16* Y = (bf16*)(a.ws + WS_R + R_Y);
    const float* pw = a.in(I_PW) + (size_t)(L * 4 + g) * 4096; const float* ps = a.in(I_PS) + L * 256 + g * 64;
    const float* pwl = pw + (8 * h) * 64 + r;
    bf16x8 wf[2][4];
#pragma unroll
    for (int me = 0; me < 2; ++me)
#pragma unroll
        for (int ks = 0; ks < 4; ++ks) { float f[8];
#pragma unroll
            for (int j = 0; j < 8; ++j) f[j] = pwl[(16 * ks + j) * 64 + 32 * me];
            u32x4 p; p.x = cvtpk(f[0], f[1]); p.y = cvtpk(f[2], f[3]); p.z = cvtpk(f[4], f[5]); p.w = cvtpk(f[6], f[7]); wf[me][ks] = __builtin_bit_cast(bf16x8, p); }
#pragma unroll 1
    for (int nt = 0; nt < 4; ++nt) {
        const int m = tile * 128 + nt * 32 + r, tpos = m & (SEQ - 1);
        const int cntw = tpos + 1 < w ? tpos + 1 : w; const float invc = 1.0f / (float)cntw;
        f32x16 acc[2]; acc[0] = zero16(); acc[1] = zero16();
#pragma unroll
        for (int ks = 0; ks < 4; ++ks) {
            const bf16* up = U + (size_t)m * 256 + g * 64 + 16 * ks + 8 * h;
            float sum[8], self[8];
            { const u32x4 wv = *(const u32x4*)up;
              self[0] = __uint_as_float(wv.x << 16); self[1] = __uint_as_float(wv.x & 0xffff0000u); self[2] = __uint_as_float(wv.y << 16); self[3] = __uint_as_float(wv.y & 0xffff0000u);
              self[4] = __uint_as_float(wv.z << 16); self[5] = __uint_as_float(wv.z & 0xffff0000u); self[6] = __uint_as_float(wv.w << 16); self[7] = __uint_as_float(wv.w & 0xffff0000u); }
#pragma unroll
            for (int j = 0; j < 8; ++j) sum[j] = self[j];
#pragma unroll 1
            for (int i = 1; i < cntw; ++i) { const u32x4 wv = *(const u32x4*)(up - (size_t)i * 256);
                sum[0] += __uint_as_float(wv.x << 16); sum[1] += __uint_as_float(wv.x & 0xffff0000u); sum[2] += __uint_as_float(wv.y << 16); sum[3] += __uint_as_float(wv.y & 0xffff0000u);
                sum[4] += __uint_as_float(wv.z << 16); sum[5] += __uint_as_float(wv.z & 0xffff0000u); sum[6] += __uint_as_float(wv.w << 16); sum[7] += __uint_as_float(wv.w & 0xffff0000u); }
            u32x4 p; p.x = cvtpk(sum[0] * invc - self[0], sum[1] * invc - self[1]); p.y = cvtpk(sum[2] * invc - self[2], sum[3] * invc - self[3]);
            p.z = cvtpk(sum[4] * invc - self[4], sum[5] * invc - self[5]); p.w = cvtpk(sum[6] * invc - self[6], sum[7] * invc - self[7]);
            const bf16x8 df = __builtin_bit_cast(bf16x8, p);
            acc[0] = MFMA32(wf[0][ks], df, acc[0]); acc[1] = MFMA32(wf[1][ks], df, acc[1]);
        }
#pragma unroll
        for (int me = 0; me < 2; ++me)
#pragma unroll
            for (int gq = 0; gq < 4; ++gq) { const int e0 = 32 * me + 8 * gq + 4 * h; const f32x4 sc = *(const f32x4*)(ps + e0);
                u32x2 o; o.x = cvtpk(acc[me][4 * gq] * sc[0], acc[me][4 * gq + 1] * sc[1]); o.y = cvtpk(acc[me][4 * gq + 2] * sc[2], acc[me][4 * gq + 3] * sc[3]);
                *(u32x2*)(Y + (size_t)m * 1024 + 512 + g * 64 + e0) = o; }
    }
}

DI void h1_unit(const Ctx& a, int L, int unit, unsigned char* sm, int lane) {
    asm volatile("" : "+v"(lane));
    const int b = unit >> 9, hh = (unit >> 7) & 3, n = unit & 127, r = lane & 31, h = lane >> 5;
    const int row0 = b * SEQ + n * 64, ch = hh * 64 + lane;
    const bf16* QH = (const bf16*)(a.ws + WS_R + R_U5) + (size_t)1 * M * 256; const bf16* FH = QH + (size_t)M * 256; const bf16* IH = FH + (size_t)M * 256;
    bf16* QDEC = (bf16*)(a.ws + WS_R + R_QDEC); float* ALOC = (float*)(a.ws + WS_R + R_ALOC); float* OINTRA = (float*)(a.ws + WS_R + R_OINTRA); float* DEC = (float*)(a.ws + WS_DEC);
    bf16* KD = (bf16*)sm; bf16* IT = (bf16*)(sm + 8192); bf16* Am = (bf16*)(sm + 16384); bf16* Bm = (bf16*)(sm + 24576);
    float lb;
    { const float* lp = a.in(I_LB) + ch; const float x0 = lp[0], x1 = lp[256], x2 = lp[512], x3 = lp[768];
      const float mx = fmaxf(fmaxf(x0, x1), fmaxf(x2, x3)); const float e0 = __expf(x0 - mx), e1 = __expf(x1 - mx), e2 = __expf(x2 - mx), e3 = __expf(x3 - mx);
      const float inv = 1.0f / (e0 + e1 + e2 + e3); float acc = 0.f; if (L > 0) acc += e0; if (L > 1) acc += e1; if (L > 2) acc += e2; lb = acc * inv; }
    const float loglb = __logf(fmaxf(lb, 1e-20f)), l1m = __logf(1.0f - lb), oml = 1.0f - lb;
    float cum = 0.f, ref = 0.f;
#ifndef H1_NO_P1
#pragma unroll 2
    for (int s = 0; s < 64; ++s) {
        const float z = bf2f(FH[(size_t)(row0 + s) * 256 + ch]);
        const float ls = fminf(z, 0.f) - __logf(1.0f + __expf(-fabsf(z)));
        const float bb = l1m + ls, hi = fmaxf(loglb, bb), df = fabsf(loglb - bb);
        cum += hi + __logf(1.0f + __expf(-df));
        asm volatile("" : "+v"(cum));
        if (s == 31) ref = cum;
    }
#endif
    const float last = cum;
    DEC[unit * 64 + lane] = __expf(last);
    cum = 0.f;
#ifndef H1_NO_P2
#pragma unroll 1
    for (int s8 = 0; s8 < 8; ++s8) {
        unsigned kp[4], ip[4]; float kd8[8]; unsigned short i8[8];
#pragma unroll
        for (int j = 0; j < 8; ++j) {
            const int s = s8 * 8 + j; const size_t gi = (size_t)(row0 + s) * 256 + ch;
            const float z = bf2f(FH[gi]), qv = bf2f(QH[gi]); i8[j] = IH[gi];
            const float ls = fminf(z, 0.f) - __logf(1.0f + __expf(-fabsf(z)));
            const float bb = l1m + ls, hi = fmaxf(loglb, bb), df = fabsf(loglb - bb);
            cum += hi + __logf(1.0f + __expf(-df));
            const float key = oml * __builtin_amdgcn_rcpf(1.0f + __expf(z));
            const float qs = qv * __builtin_amdgcn_rcpf(1.0f + __expf(-qv)) * 0.125f;
            const float av = qs * __expf(fminf(cum - ref, 80.f)), bv = key * __expf(fminf(ref - cum, 80.f)), qd = qs * __expf(cum);
            kd8[j] = key * __expf(last - cum);
#ifndef H1_NO_AB
            Am[s * 64 + lane] = (bf16)(cvtpk(av, 0.f) & 0xffffu); Bm[s * 64 + lane] = (bf16)(cvtpk(bv, 0.f) & 0xffffu);
#endif
#ifndef H1_NO_QD
            QDEC[gi] = (bf16)(cvtpk(qd, 0.f) & 0xffffu);
#endif
        }
#pragma unroll
        for (int j = 0; j < 4; ++j) { kp[j] = cvtpk(kd8[2 * j], kd8[2 * j + 1]); ip[j] = (unsigned)i8[2 * j] | ((unsigned)i8[2 * j + 1] << 16); }
        *(u32x4*)(KD + lane * 64 + s8 * 8) = (u32x4){kp[0], kp[1], kp[2], kp[3]};
        *(u32x4*)(IT + lane * 64 + s8 * 8) = (u32x4){ip[0], ip[1], ip[2], ip[3]};
    }
#endif
    asm volatile("s_waitcnt lgkmcnt(0)" ::: "memory");
#ifndef H1_NO_MM
    bf16x8 itf[2][2][2];
#pragma unroll
    for (int mv = 0; mv < 2; ++mv)
#pragma unroll
        for (int ms = 0; ms < 2; ++ms)
#pragma unroll
            for (int st = 0; st < 2; ++st) { const bf16* p = IT + (32 * mv + r) * 64 + 32 * ms + 16 * st + 4 * h; const u32x2 x0 = *(const u32x2*)p, x1 = *(const u32x2*)(p + 8);
                itf[mv][ms][st] = __builtin_bit_cast(bf16x8, ((u32x4){x0.x, x0.y, x1.x, x1.y})); }
    float* alb = ALOC + (size_t)unit * 4096 + (4 * h) * 64 + r;
#pragma unroll
    for (int nk = 0; nk < 2; ++nk) {
        bf16x8 kdf[2][2];
#pragma unroll
        for (int ms = 0; ms < 2; ++ms)
#pragma unroll
            for (int st = 0; st < 2; ++st) { const bf16* p = KD + (32 * nk + r) * 64 + 32 * ms + 16 * st + 4 * h; const u32x2 x0 = *(const u32x2*)p, x1 = *(const u32x2*)(p + 8);
                kdf[ms][st] = __builtin_bit_cast(bf16x8, ((u32x4){x0.x, x0.y, x1.x, x1.y})); }
#pragma unroll
        for (int mv = 0; mv < 2; ++mv) {
            f32x16 acc = zero16();
#pragma unroll
            for (int ms = 0; ms < 2; ++ms)
#pragma unroll
                for (int st = 0; st < 2; ++st) acc = MFMA32(itf[mv][ms][st], kdf[ms][st], acc);
#pragma unroll
            for (int i = 0; i < 16; ++i) alb[(32 * mv + (i & 3) + 8 * (i >> 2)) * 64 + 32 * nk] = acc[i];
        }
    }
#pragma unroll
    for (int nt = 0; nt < 2; ++nt) {
        bf16x8 af[4];
#pragma unroll
        for (int ks = 0; ks < 4; ++ks) af[ks] = *(const bf16x8*)(Am + (32 * nt + r) * 64 + 16 * ks + 8 * h);
        f32x16 oi[2]; oi[0] = zero16(); oi[1] = zero16();
#pragma unroll
        for (int ms = 0; ms < 2; ++ms) {
            if (ms <= nt) {
                f32x16 sacc = zero16();
#pragma unroll
                for (int ks = 0; ks < 4; ++ks) { const bf16x8 bf_ = *(const bf16x8*)(Bm + (32 * ms + r) * 64 + 16 * ks + 8 * h); sacc = MFMA32(bf_, af[ks], sacc); }
                if (ms == nt) {
#pragma unroll
                    for (int i = 0; i < 16; ++i) if (crow(i, h) > r) sacc[i] = 0.f;
                }
#pragma unroll
                for (int st = 0; st < 2; ++st) { const bf16x8 pf = pack8(sacc, st); oi[0] = MFMA32(itf[0][ms][st], pf, oi[0]); oi[1] = MFMA32(itf[1][ms][st], pf, oi[1]); }
            }
        }
        const size_t orow = (size_t)(row0 + 32 * nt + r) * 256 + hh * 64;
#pragma unroll
        for (int mv = 0; mv < 2; ++mv)
#pragma unroll
            for (int gq = 0; gq < 4; ++gq) *(f32x4*)(OINTRA + orow + 32 * mv + 8 * gq + 4 * h) = (f32x4){oi[mv][4 * gq], oi[mv][4 * gq + 1], oi[mv][4 * gq + 2], oi[mv][4 * gq + 3]};
    }
#endif
    asm volatile("s_waitcnt lgkmcnt(0)" ::: "memory");
}

DI void phase_t(const Ctx& a, int L, unsigned char* lds, int gw, int NGW, int wave, int lane) {
#ifndef NO_POOL
    for (int u = gw; u < 2048; u += NGW) pool_unit(a, L, u, lane);
#endif
#ifndef NO_WC
#ifdef DBG_WC_ALWAYS
    { float* scr = (float*)(lds + wave * 16384); for (int it = gw; it < WC_ITEMS; it += NGW) wconv_item(a, (L + 1) & 3, it, scr, lane); }
#else
    if (L + 1 < DEPTH) { float* scr = (float*)(lds + wave * 16384); for (int it = gw; it < WC_ITEMS; it += NGW) wconv_item(a, L + 1, it, scr, lane); }
#endif
#endif
    __syncthreads();
#ifndef NO_H1
    if (wave < 4) { const int hw = (gw >> 3) * 4 + wave, NHW = (NGW >> 3) * 4; for (int u = hw; u < 1024; u += NHW) h1_unit(a, L, u, lds + wave * 32768, lane); }
#endif
}

DI void attn_unit(const Ctx& a, int bh, int qb, unsigned char* lds, int tid, int wave, int lane) {
    asm volatile("" : "+v"(lane), "+v"(tid));
    const int r = lane & 31, h = lane >> 5, b = bh >> 3, hd = bh & 7, own = qb, nsel = own < 3 ? own : 3;
    const bf16* Q = (const bf16*)(a.ws + WS_R + R_Q); const bf16* Kb = (const bf16*)(a.ws + WS_R + R_K); const bf16* Vb = (const bf16*)(a.ws + WS_R + R_V);
    const float* kmp = (const float*)(a.ws + WS_KMP); bf16* Y = (bf16*)(a.ws + WS_R + R_Y);
    unsigned char* part = lds;
    unsigned short* llist = (unsigned short*)(lds + 104448);
    int* lcnt = (int*)(lds + 120832); int* itab = lcnt + 32;
    const size_t qbase = ((size_t)bh * SEQ + (size_t)qb * 256) * 64;
    if (own > 0) {
        if (tid < 32) lcnt[tid] = 0;
        __syncthreads();
        if (tid < 256) {
            float q[64];
            { const u32x4* qp = (const u32x4*)(Q + qbase + (size_t)tid * 64);
#pragma unroll
              for (int i = 0; i < 8; ++i) { const u32x4 w = qp[i];
                  q[8 * i + 0] = __uint_as_float(w.x << 16); q[8 * i + 1] = __uint_as_float(w.x & 0xffff0000u); q[8 * i + 2] = __uint_as_float(w.y << 16); q[8 * i + 3] = __uint_as_float(w.y & 0xffff0000u);
                  q[8 * i + 4] = __uint_as_float(w.z << 16); q[8 * i + 5] = __uint_as_float(w.z & 0xffff0000u); q[8 * i + 6] = __uint_as_float(w.w << 16); q[8 * i + 7] = __uint_as_float(w.w & 0xffff0000u); } }
            float g0 = -INFINITY, g1 = -INFINITY, g2 = -INFINITY; int i0 = 0, i1 = 0, i2 = 0;
            for (int j = 0; j < own; ++j) {
                const float* p0 = kmp + (size_t)((b * 32 + j) * 2) * 512 + hd * 64; const float* p1 = p0 + 512;
                float g = 0.f;
#pragma unroll
                for (int d = 0; d < 64; d += 4) { const f32x4 x0 = *(const f32x4*)(p0 + d), x1 = *(const f32x4*)(p1 + d);
                    g += q[d] * (x0[0] + x1[0]) + q[d + 1] * (x0[1] + x1[1]) + q[d + 2] * (x0[2] + x1[2]) + q[d + 3] * (x0[3] + x1[3]); }
                if (g > g0) { g2 = g1; i2 = i1; g1 = g0; i1 = i0; g0 = g; i0 = j; }
                else if (g > g1) { g2 = g1; i2 = i1; g1 = g; i1 = j; }
                else if (g > g2) { g2 = g; i2 = j; }
            }
#pragma unroll
            for (int s = 0; s < 3; ++s) {
                if (s < nsel) { const int j = s == 0 ? i0 : (s == 1 ? i1 : i2); const int pos = atomicAdd(lcnt + j, 1); llist[j * 256 + pos] = (unsigned short)(tid | (s << 8)); }
            }
        }
        __syncthreads();
        if (tid == 0) { int n = 0; for (int j = 0; j < own; ++j) { const int ng = (lcnt[j] + 31) >> 5; for (int g = 0; g < ng; ++g) itab[n++] = j | (g << 8); } itab[64] = n; }
        __syncthreads();
        const int nitems = __builtin_amdgcn_readfirstlane(itab[64]);
        for (int it = wave; it < nitems; it += NWAVES) {
            const int ent = __builtin_amdgcn_readfirstlane(itab[it]); const int j = ent & 255, g = ent >> 8, n = __builtin_amdgcn_readfirstlane(lcnt[j]);
            const int idx = g * 32 + r; const bool valid = idx < n;
            const unsigned e = llist[j * 256 + (valid ? idx : 0)];
            const int qi = e & 255, slot = e >> 8;
            float mo, lo_; f32x16 ot[2];
            attn_core<false>(Q + qbase + (size_t)qi * 64, Kb + ((size_t)bh * 32 + j) * 16384, Vb + ((size_t)bh * 32 + j) * 16384, 8, r, h, mo, lo_, ot);
            if (valid) {
                unsigned char* rec = part + (qi * 3 + slot) * 136; const float inv = 1.0f / lo_;
#pragma unroll
                for (int md = 0; md < 2; ++md)
#pragma unroll
                    for (int gq = 0; gq < 4; ++gq) { u32x2 o; o.x = cvtpk(ot[md][4 * gq] * inv, ot[md][4 * gq + 1] * inv); o.y = cvtpk(ot[md][4 * gq + 2] * inv, ot[md][4 * gq + 3] * inv);
                        *(u32x2*)(rec + 2 * (32 * md + 8 * gq + 4 * h)) = o; }
                if (h == 0) { *(float*)(rec + 128) = mo; *(float*)(rec + 132) = lo_; }
            }
        }
        __syncthreads();
    }
    {
        const int ql = 32 * wave + r, t = qb * 256 + ql;
        float m0, l0; f32x16 ot[2];
        attn_core<true>(Q + qbase + (size_t)ql * 64, Kb + ((size_t)bh * 32 + qb) * 16384, Vb + ((size_t)bh * 32 + qb) * 16384, wave + 1, r, h, m0, l0, ot);
        float ms[3], ls[3]; float mx = m0;
#pragma unroll
        for (int s = 0; s < 3; ++s) { ms[s] = -INFINITY; ls[s] = 0.f; if (s < nsel) { const unsigned char* rec = part + (ql * 3 + s) * 136; ms[s] = *(const float*)(rec + 128); ls[s] = *(const float*)(rec + 132); mx = fmaxf(mx, ms[s]); } }
        const float w0 = __expf(m0 - mx); float den = w0 * l0;
#pragma unroll
        for (int md = 0; md < 2; ++md)
#pragma unroll
            for (int i = 0; i < 16; ++i) ot[md][i] *= w0;
#pragma unroll
        for (int s = 0; s < 3; ++s) {
            if (s < nsel) {
                const unsigned char* rec = part + (ql * 3 + s) * 136; const float ws_ = __expf(ms[s] - mx) * ls[s]; den += ws_;
#pragma unroll
                for (int md = 0; md < 2; ++md)
#pragma unroll
                    for (int gq = 0; gq < 4; ++gq) { const u32x2 w = *(const u32x2*)(rec + 2 * (32 * md + 8 * gq + 4 * h));
                        ot[md][4 * gq] += ws_ * __uint_as_float(w.x << 16); ot[md][4 * gq + 1] += ws_ * __uint_as_float(w.x & 0xffff0000u);
                        ot[md][4 * gq + 2] += ws_ * __uint_as_float(w.y << 16); ot[md][4 * gq + 3] += ws_ * __uint_as_float(w.y & 0xffff0000u); }
            }
        }
        float inv = 1.0f / den; const size_t yrow = (size_t)(b * SEQ + t) * 1024 + hd * 64;
#ifdef DBG_AMP_ATTN
        inv *= 64.f;
#endif
#pragma unroll
        for (int md = 0; md < 2; ++md)
#pragma unroll
            for (int gq = 0; gq < 4; ++gq) { u32x2 o; o.x = cvtpk(ot[md][4 * gq] * inv, ot[md][4 * gq + 1] * inv); o.y = cvtpk(ot[md][4 * gq + 2] * inv, ot[md][4 * gq + 3] * inv);
                *(u32x2*)(Y + yrow + 32 * md + 8 * gq + 4 * h) = o; }
    }
    __syncthreads();
}

DI void phase_a(const Ctx& a, int L, unsigned char* lds, int gw, int NGW, int tid, int wave, int lane) {
    if ((gw & 3) == 0 && (gw >> 2) < 512) {
        const int chunk = gw >> 2, bhh = chunk >> 6, e = (chunk & 63) * 64 + lane, k = e & 63;
        const float* ALOC = (const float*)(a.ws + WS_R + R_ALOC); const float* DEC = (const float*)(a.ws + WS_DEC); bf16* SP = (bf16*)(a.ws + WS_R + R_SP);
        float st = 0.f;
#pragma unroll 8
        for (int n = 0; n < 128; ++n) { const int item = bhh * 128 + n; const float av = ALOC[(size_t)item * 4096 + e], dv = DEC[item * 64 + k];
            SP[(size_t)item * 4096 + e] = (bf16)(cvtpk(st, 0.f) & 0xffffu); st = dv * st + av; }
    }
    const int G = NGW / NWAVES, blk = gw / NWAVES;
    for (int u = blk; u < 512; u += G) {
        const int v = u & 255, bh = v >> 4, qb = (u < 256) ? (v & 15) : 31 - (v & 15);
        attn_unit(a, bh, qb, lds, tid, wave, lane);
    }
}

DI void own_unit(const Ctx& a, int bhi, int qg, int lane) {
    asm volatile("" : "+v"(lane));
    const int r = lane & 31, h = lane >> 5, t0 = qg * 32, j = t0 >> 8, nkg = ((t0 & 255) >> 5) + 1, t = t0 + r;
    const int b = bhi >> 3, hd = bhi & 7; const size_t bh = (size_t)bhi;
    const bf16* Q = (const bf16*)(a.ws + WS_R + R_Q); const bf16* Kb = (const bf16*)(a.ws + WS_R + R_K); const bf16* Vb = (const bf16*)(a.ws + WS_R + R_V);
    const bf16* PO = (const bf16*)(a.ws + WS_R + R_PO); const float* PML = (const float*)(a.ws + WS_R + R_PML); bf16* Y = (bf16*)(a.ws + WS_R + R_Y);
    float m0, l0; f32x16 ot[2];
    attn_core<true>(Q + (bh * SEQ + t) * 64, Kb + (bh * 32 + j) * 16384, Vb + (bh * 32 + j) * 16384, nkg, r, h, m0, l0, ot);
#ifdef DBG_OWN_ONLY
    const int nsel = 0;
#else
    const int nsel = j < 3 ? j : 3;
#endif
    const size_t pi = (bh * SEQ + t) * 3;
    float ms[3], ls[3]; float mx = m0;
#pragma unroll
    for (int s = 0; s < 3; ++s) { ms[s] = -INFINITY; ls[s] = 0.f; if (s < nsel) { ms[s] = ld_sc1f(PML + (pi + s) * 2); ls[s] = ld_sc1f(PML + (pi + s) * 2 + 1); mx = fmaxf(mx, ms[s]); } }
    const float w0 = __expf(m0 - mx); float den = w0 * l0;
#pragma unroll
    for (int md = 0; md < 2; ++md)
#pragma unroll
        for (int i = 0; i < 16; ++i) ot[md][i] *= w0;
#pragma unroll
    for (int s = 0; s < 3; ++s) {
        if (s < nsel) {
            const float ws_ = __expf(ms[s] - mx) * ls[s]; den += ws_;
#pragma unroll
            for (int md = 0; md < 2; ++md)
#pragma unroll
                for (int gq = 0; gq < 4; ++gq) { const u32x2 w = *(const u32x2*)(PO + (pi + s) * 64 + 32 * md + 8 * gq + 4 * h);
                    ot[md][4 * gq] += ws_ * __uint_as_float(w.x << 16); ot[md][4 * gq + 1] += ws_ * __uint_as_float(w.x & 0xffff0000u);
                    ot[md][4 * gq + 2] += ws_ * __uint_as_float(w.y << 16); ot[md][4 * gq + 3] += ws_ * __uint_as_float(w.y & 0xffff0000u); }
        }
    }
    float inv = 1.0f / den; const size_t yrow = (size_t)(b * SEQ + t) * 1024 + hd * 64;
#ifdef DBG_ZERO_ATTN
    inv = 0.f;
#endif
#pragma unroll
    for (int md = 0; md < 2; ++md)
#pragma unroll
        for (int gq = 0; gq < 4; ++gq) { u32x2 o; o.x = cvtpk(ot[md][4 * gq] * inv, ot[md][4 * gq + 1] * inv); o.y = cvtpk(ot[md][4 * gq + 2] * inv, ot[md][4 * gq + 3] * inv);
            *(u32x2*)(Y + yrow + 32 * md + 8 * gq + 4 * h) = o; }
}

DI void h3_unit(const Ctx& a, int L, int unit, int lane) {
    asm volatile("" : "+v"(lane));
    const int b = unit >> 9, hh = (unit >> 7) & 3, n = unit & 127, r = lane & 31, h = lane >> 5;
    const int row0 = b * SEQ + n * 64;
    const bf16* SP = (const bf16*)(a.ws + WS_R + R_SP) + (size_t)unit * 4096; const bf16* QDEC = (const bf16*)(a.ws + WS_R + R_QDEC);
    const float* OINTRA = (const float*)(a.ws + WS_R + R_OINTRA); const bf16* GH = (const bf16*)(a.ws + WS_R + R_U5) + (size_t)4 * M * 256; bf16* Y = (bf16*)(a.ws + WS_R + R_Y);
    const float* on = a.in(I_HON) + L * 64;
    bf16x8 sf[2][4];
#pragma unroll
    for (int mv = 0; mv < 2; ++mv)
#pragma unroll
        for (int ks = 0; ks < 4; ++ks) sf[mv][ks] = *(const bf16x8*)(SP + (32 * mv + r) * 64 + 16 * ks + 8 * h);
#pragma unroll
    for (int nt = 0; nt < 2; ++nt) {
        const size_t trow = (size_t)(row0 + 32 * nt + r) * 256 + hh * 64;
        f32x16 o[2]; o[0] = zero16(); o[1] = zero16();
#pragma unroll
        for (int ks = 0; ks < 4; ++ks) { const bf16x8 qf = *(const bf16x8*)(QDEC + trow + 16 * ks + 8 * h); o[0] = MFMA32(sf[0][ks], qf, o[0]); o[1] = MFMA32(sf[1][ks], qf, o[1]); }
        float ss = 0.f;
#pragma unroll
        for (int mv = 0; mv < 2; ++mv)
#pragma unroll
            for (int gq = 0; gq < 4; ++gq) { const f32x4 x = *(const f32x4*)(OINTRA + trow + 32 * mv + 8 * gq + 4 * h);
#pragma unroll
                for (int i = 0; i < 4; ++i) { o[mv][4 * gq + i] += x[i]; ss += o[mv][4 * gq + i] * o[mv][4 * gq + i]; } }
        ss += __shfl_xor(ss, 32);
        float rn = rsqrtf(ss * (1.0f / 64.0f) + 1e-6f);
#ifdef DBG_ZERO_HGRN
        rn = 0.f;
#endif
#ifdef DBG_AMP_HGRN
        rn *= 16.f;
#endif
        const size_t yrow = (size_t)(row0 + 32 * nt + r) * 1024 + 768 + hh * 64;
#pragma unroll
        for (int mv = 0; mv < 2; ++mv)
#pragma unroll
            for (int gq = 0; gq < 4; ++gq) { const int v0 = 32 * mv + 8 * gq + 4 * h; const f32x4 gn = *(const f32x4*)(on + v0); const u32x2 gw_ = *(const u32x2*)(GH + trow + v0);
                const float g0 = __uint_as_float(gw_.x << 16), g1 = __uint_as_float(gw_.x & 0xffff0000u), g2 = __uint_as_float(gw_.y << 16), g3 = __uint_as_float(gw_.y & 0xffff0000u);
                u32x2 w; w.x = cvtpk(o[mv][4 * gq] * rn * gn[0] * pg8::silu_f(g0), o[mv][4 * gq + 1] * rn * gn[1] * pg8::silu_f(g1));
                w.y = cvtpk(o[mv][4 * gq + 2] * rn * gn[2] * pg8::silu_f(g2), o[mv][4 * gq + 3] * rn * gn[3] * pg8::silu_f(g3));
                *(u32x2*)(Y + yrow + v0) = w; }
    }
}

DI void phase_c(const Ctx& a, int L, int gw, int NGW, int lane) {
    for (int u = gw; u < 1024; u += NGW) h3_unit(a, L, u, lane);
}

template <int MASK> __global__ void __launch_bounds__(NTHR, 2) mk_fwd(Args args) {
    extern __shared__ __attribute__((aligned(16))) unsigned char lds[];
    const int G = gridDim.x, NGW = G * NWAVES;
    cg::grid_group grid = cg::this_grid();
    const int ph_lo = args.ph_lo, ph_hi = args.ph_hi;
    for (int ph = ph_lo; ph < ph_hi; ++ph) {
        if (ph > ph_lo) grid.sync();
        int tid_v = threadIdx.x; asm volatile("" : "+v"(tid_v));
        const int tid = tid_v, lane = tid & 63, wave = __builtin_amdgcn_readfirstlane(tid >> 6), gw = blockIdx.x * NWAVES + wave;
        kptr_t kp = (kptr_t)__builtin_amdgcn_kernarg_segment_ptr();
        asm volatile("" : "+s"(kp));
        Ctx a; a.kp = kp; a.out = *(float* const __attribute__((address_space(4)))*)(kp + 144); a.ws = *(unsigned char* const __attribute__((address_space(4)))*)(kp + 152);
        unsigned char* ws = a.ws;
        float* stats = (float*)(ws + WS_STATS); bf16* xb = (bf16*)(ws + WS_XB); bf16* hid = (bf16*)(ws + WS_R + R_HID);
        if (ph == 0) {
if constexpr (MASK & 1) phase_p0(a, lds, gw, NGW, wave, lane);
 __syncthreads(); continue; }
        const int L = (ph - 1) / 9, sub = (ph - 1) % 9;
        unsigned char* wb = ws + WS_W + (size_t)(L & 1) * WSZ;
        if (sub == 0 || sub == 7) {
            pg8::Gemm g{xb, (const bf16*)(wb + (sub == 0 ? W_GU1 : W_GU2)), M, 2 * FF, D}; pg8::StaticOrder S; S.init(M, 2 * FF, G, (int)blockIdx.x);
            pg8::EpiSwiGLU E{hid, stats, FF};
            if constexpr (MASK & 2) pg8::gemm_phase<pg8::EpiSwiGLU, pg8::StaticOrder, PG8_ALIGN, PG8_SP2>((PG8_LAS unsigned char*)lds, g, S, E);
        } else if (sub == 1 || sub == 6 || sub == 8) {
            const bf16* A = sub == 6 ? (const bf16*)(ws + WS_R + R_Y) : hid; const int K = sub == 6 ? D : FF;
            const bf16* Bt = (const bf16*)(wb + (sub == 1 ? W_D1 : (sub == 6 ? W_OUT : W_D2)));
            pg8::Gemm g{A, Bt, M, D, K}; pg8::StaticOrder S; S.init(M, D, G, (int)blockIdx.x);
            pg8::EpiResid E{a.out, xb, stats, sub == 6 ? 1.0f : 0.5f};
            if constexpr (MASK & 4) pg8::gemm_phase<pg8::EpiResid, pg8::StaticOrder, PG8_ALIGN, PG8_SP2>((PG8_LAS unsigned char*)lds, g, S, E);
        } else if (sub == 2) {
            pg8::Gemm g{xb, (const bf16*)(wb + W_IN), M, INW, D}; pg8::StaticOrder S; S.init(M, INW, G, (int)blockIdx.x);
            pg8::EpiProj E{(bf16*)(ws + WS_R + R_Q), (bf16*)(ws + WS_R + R_K), (bf16*)(ws + WS_R + R_V), (bf16*)(ws + WS_R + R_U5), (float*)(ws + WS_KMP), stats,
                           (const float*)(ws + WS_ROPEC), (const float*)(ws + WS_ROPES), a.in(I_QN) + L * 64, a.in(I_KN) + L * 64};
            if constexpr (MASK & 8) pg8::gemm_phase<pg8::EpiProj, pg8::StaticOrder, PG8_ALIGN, PG8_SP2>((PG8_LAS unsigned char*)lds, g, S, E);
        } else if (sub == 3) {
if constexpr (MASK & 16) phase_t(a, L, lds, gw, NGW, wave, lane);
 __syncthreads(); }
        else if (sub == 4) {
if constexpr (MASK & 32) phase_a(a, L, lds, gw, NGW, tid, wave, lane);
 __syncthreads(); }
        else {
if constexpr (MASK & 64) phase_c(a, L, gw, NGW, lane);
 __syncthreads(); }
    }
}

#ifndef MK_MULTI
#define MK_MULTI 0
#define DBG_WC_ALWAYS
#endif
#ifndef DBG_NPH
#define DBG_NPH (1 + 9 * DEPTH)
#endif
constexpr int N_PHASES = DBG_NPH;
static int phase_mask(int ph) { if (ph == 0) return 1; const int sub = (ph - 1) % 9; const int m[9] = {2, 4, 8, 16, 32, 64, 4, 2, 4}; return m[sub]; }
template <int MASK> static bool setup_one(int& per_cu) {
    if (hipFuncSetAttribute((const void*)mk_fwd<MASK>, hipFuncAttributeMaxDynamicSharedMemorySize, LDS_BYTES) != hipSuccess) return false;
    if (hipOccupancyMaxActiveBlocksPerMultiprocessor(&per_cu, (const void*)mk_fwd<MASK>, NTHR, LDS_BYTES) != hipSuccess) per_cu = 1;
    (void)hipGetLastError(); return true;
}
template <int MASK> static void launch_one(const Args& a, int grid, hipStream_t stream) { hipLaunchKernelGGL(mk_fwd<MASK>, dim3(grid), dim3(NTHR), LDS_BYTES, stream, a); }
extern "C" void kernel_launch(void* const* d_in, const int* in_sizes, int n_in, void* d_out, int out_size, void* d_ws, size_t ws_size, hipStream_t stream) {
    static int grid = 0;
    if (grid == 0) {
        if (n_in != 18 || in_sizes[0] != M * D || out_size != M * D || ws_size < WS_END) { fprintf(stderr, "kernel_launch: unexpected shapes / workspace (n_in %d, ws %zu < %zu)\n", n_in, ws_size, (size_t)WS_END); grid = -1; return; }
        int dev = 0, cus = 0, per_cu = 0; bool ok = true;
        (void)hipGetDevice(&dev); (void)hipDeviceGetAttribute(&cus, hipDeviceAttributeMultiprocessorCount, dev);
#if MK_MULTI
        ok = setup_one<1>(per_cu) && setup_one<2>(per_cu) && setup_one<4>(per_cu) && setup_one<8>(per_cu) && setup_one<16>(per_cu) && setup_one<32>(per_cu) && setup_one<64>(per_cu);
#else
        ok = setup_one<127>(per_cu);
#endif
        if (!ok) { fprintf(stderr, "kernel_launch: hipFuncSetAttribute failed\n"); grid = -1; return; }
        grid = cus;
    }
    if (grid < 0) return;
    Args a{};
    for (int i = 0; i < 18; ++i) a.in[i] = (const float*)d_in[i];
    a.out = (float*)d_out; a.ws = (unsigned char*)d_ws;
#if MK_MULTI
    for (int ph = 0; ph < N_PHASES; ++ph) { a.ph_lo = ph; a.ph_hi = ph + 1;
        switch (phase_mask(ph)) { case 1: launch_one<1>(a, grid, stream); break; case 2: launch_one<2>(a, grid, stream); break; case 4: launch_one<4>(a, grid, stream); break; case 8: launch_one<8>(a, grid, stream); break;
                                  case 16: launch_one<16>(a, grid, stream); break; case 32: launch_one<32>(a, grid, stream); break; default: launch_one<64>(a, grid, stream); break; } }
#else
    a.ph_lo = 0; a.ph_hi = N_PHASES;
    void* args[] = {&a};
    hipError_t e = hipLaunchCooperativeKernel((const void*)mk_fwd<127>, dim3(grid), dim3(NTHR), args, LDS_BYTES, stream);
    if (e != hipSuccess) fprintf(stderr, "cooperative launch failed: %s (grid %d)\n", hipGetErrorString(e), grid);
#endif
}
```

```cpp
#include <hip/hip_runtime.h>
#include <hip/hip_cooperative_groups.h>
#include <cstdio>
#include <cstdint>
namespace cg = cooperative_groups;
#define MK_MULTI 0
#define DBG_WC_ALWAYS
namespace pg8 {
#define PG8_LAS __attribute__((address_space(3)))
typedef unsigned short bf16_t;
typedef short bf16x8 __attribute__((ext_vector_type(8)));
typedef float f32x4 __attribute__((ext_vector_type(4)));
typedef unsigned u32x4 __attribute__((ext_vector_type(4)));
constexpr int BM = 256, BK = 64, HALF = 128, HTB = HALF * BK * 2  , STAGE_BYTES = 8 * HTB, NXCD = 8, WGM = 8;

__host__ __device__ __forceinline__ int lds_byte(int r, int c) { const int st = (r >> 4) * 2 + (c >> 5), rr = r & 15, cc = c & 31, ob = rr * 64 + cc * 2; return st * 1024 + (ob ^ (((ob >> 9) & 1) << 5)); }
__host__ __device__ __forceinline__ void stage_rc(int b, int& R, int& C) { const int st = b / 1024, sb = b % 1024, swz = sb ^ (((sb >> 9) & 1) << 5); R = (st >> 1) * 16 + swz / 64; C = (st & 1) * 32 + (swz % 64) / 2; }
__host__ __device__ __forceinline__ int perm32(int rho) { const int n = rho >> 4, i = rho & 15; return 8 * (i >> 2) + 4 * n + (i & 3); }

struct Unit { int pm, pn; };
struct Gemm { const bf16_t* A; const bf16_t* Bt; int M, N, K; };

struct StaticOrder {
    int nM, nN, nwg, G, c;
    __host__ __device__ void init(int M, int N, int G_, int c_) { nM = M / BM; nN = N / BM; nwg = nM * nN; G = G_; c = c_; }
    __host__ __device__ bool next(int i, Unit& u) const {
        const long L = (long)i * G + c; if (L >= nwg) return false;
        int wgid = (int)L; { const int q = nwg / NXCD, r = nwg % NXCD, xcd = wgid % NXCD, off = wgid / NXCD; wgid = (xcd < r ? xcd * (q + 1) : r * (q + 1) + (xcd - r) * q) + off; }
        const int nig = WGM * nN, gid = wgid / nig, fm = gid * WGM, gsz = (nM - fm) < WGM ? (nM - fm) : WGM;
        u.pm = fm + ((wgid % nig) % gsz); u.pn = (wgid % nig) / gsz; return true;
    }
    __device__ __forceinline__ void a_ready(const Unit&) const {}
    __device__ __forceinline__ void done(const Unit&) const {}
};

__device__ __forceinline__ unsigned cvt_pk_bf16(float lo, float hi) { unsigned r; asm volatile("v_cvt_pk_bf16_f32 %0, %1, %2" : "=v"(r) : "v"(lo), "v"(hi)); return r; }
typedef float f32x2 __attribute__((ext_vector_type(2)));
typedef unsigned u32x2 __attribute__((ext_vector_type(2)));
typedef __bf16 bf16x2_t __attribute__((ext_vector_type(2)));
__device__ __forceinline__ unsigned cvtpk(float lo, float hi) { f32x2 v = {lo, hi}; bf16x2_t b = __builtin_convertvector(v, bf16x2_t); return __builtin_bit_cast(unsigned, b); }
__device__ __forceinline__ float row_rstd(const float* stats, int row) {
    const f32x4* p = (const f32x4*)(stats + (size_t)row * 16);
    const f32x4 a = p[0], b = p[1], c = p[2], d = p[3];
    const float s = ((a[0] + a[1]) + (a[2] + a[3])) + ((b[0] + b[1]) + (b[2] + b[3])) + ((c[0] + c[1]) + (c[2] + c[3])) + ((d[0] + d[1]) + (d[2] + d[3]));
    return rsqrtf(s * (1.0f / 1024.0f) + 1e-6f);
}
__device__ __forceinline__ float silu_f(float g) { return g * __builtin_amdgcn_rcpf(1.0f + __expf(-g)); }

struct EpiSwiGLU {
    static constexpr bool PERM = true, AFTER_DRAIN = false;
    bf16_t* H; const float* stats; int ldh;
    __device__ __forceinline__ void operator()(const f32x4 (&acc)[2][2][4][2], const Unit& u, int wr, int wc, int fr, int fq) const {
        asm volatile("" : "+v"(fr), "+v"(fq));
        const int row0 = u.pm * BM + wr * 64 + fr, col0 = u.pn * HALF + wc * 32 + 8 * fq;
#pragma unroll
        for (int ai = 0; ai < 2; ++ai)
#pragma unroll
            for (int m = 0; m < 4; ++m) {
                const int row = row0 + ai * HALF + m * 16;
                const float rs = row_rstd(stats, row);
                float h[8];
#pragma unroll
                for (int n = 0; n < 2; ++n)
#pragma unroll
                    for (int i = 0; i < 4; ++i) { const float g = acc[ai][0][m][n][i] * rs, up = acc[ai][1][m][n][i] * rs; h[4 * n + i] = silu_f(g) * up; }
                u32x4 w; w.x = cvtpk(h[0], h[1]); w.y = cvtpk(h[2], h[3]); w.z = cvtpk(h[4], h[5]); w.w = cvtpk(h[6], h[7]);
                *(u32x4*)(H + (size_t)row * ldh + col0) = w;
            }
    }
};

struct EpiResid {
    static constexpr bool PERM = true, AFTER_DRAIN = false;
    float* X; bf16_t* XB; float* stats; float scale;
    __device__ __forceinline__ void operator()(const f32x4 (&acc)[2][2][4][2], const Unit& u, int wr, int wc, int fr, int fq) const {
        asm volatile("" : "+v"(fr), "+v"(fq));
        const int row0 = u.pm * BM + wr * 64 + fr, col0 = u.pn * BM + wc * 32 + 8 * fq;
#pragma unroll
        for (int ai = 0; ai < 2; ++ai)
#pragma unroll
            for (int m = 0; m < 4; ++m) {
                const int row = row0 + ai * HALF + m * 16; float ss = 0.f;
#pragma unroll
                for (int bj = 0; bj < 2; ++bj) {
                    float* xp = X + (size_t)row * 1024 + col0 + bj * HALF;
                    f32x4 x0 = *(const f32x4*)xp, x1 = *(const f32x4*)(xp + 4);
                    x0 = x0 + acc[ai][bj][m][0] * scale; x1 = x1 + acc[ai][bj][m][1] * scale;
                    *(f32x4*)xp = x0; *(f32x4*)(xp + 4) = x1;
                    ss += (x0[0] * x0[0] + x0[1] * x0[1]) + (x0[2] * x0[2] + x0[3] * x0[3]) + (x1[0] * x1[0] + x1[1] * x1[1]) + (x1[2] * x1[2] + x1[3] * x1[3]);
                    u32x4 w; w.x = cvtpk(x0[0], x0[1]); w.y = cvtpk(x0[2], x0[3]); w.z = cvtpk(x1[0], x1[1]); w.w = cvtpk(x1[2], x1[3]);
                    *(u32x4*)(XB + (size_t)row * 1024 + col0 + bj * HALF) = w;
                }
                ss += __shfl_xor(ss, 16); ss += __shfl_xor(ss, 32);
                if (fq == 0) stats[(size_t)row * 16 + u.pn * 4 + wc] = ss;
            }
    }
};

struct EpiProj {
    static constexpr bool PERM = true, AFTER_DRAIN = false;
    bf16_t* Q; bf16_t* Kb; bf16_t* Vb; bf16_t* U5; float* kmp; const float* stats; const float* ropeC; const float* ropeS; const float* qn; const float* kn;
    __device__ __forceinline__ void operator()(const f32x4 (&acc)[2][2][4][2], const Unit& u, int wr, int wc, int fr, int fq) const {
        asm volatile("" : "+v"(fr), "+v"(fq));
        const int row0 = u.pm * BM + wr * 64 + fr;
        const int pn = u.pn;
        if (pn >= 6) {
            bf16_t* O = U5 + (size_t)(pn - 6) * (16384 * 256);
            const int col0 = wc * 32 + 8 * fq;
#pragma unroll
            for (int ai = 0; ai < 2; ++ai)
#pragma unroll
                for (int m = 0; m < 4; ++m) {
                    const int row = row0 + ai * HALF + m * 16; const float rs = row_rstd(stats, row);
#pragma unroll
                    for (int bj = 0; bj < 2; ++bj) {
                        const f32x4 v0 = acc[ai][bj][m][0] * rs, v1 = acc[ai][bj][m][1] * rs;
                        u32x4 w; w.x = cvtpk(v0[0], v0[1]); w.y = cvtpk(v0[2], v0[3]); w.z = cvtpk(v1[0], v1[1]); w.w = cvtpk(v1[2], v1[3]);
                        *(u32x4*)(O + (size_t)row * 256 + col0 + bj * HALF) = w;
                    }
                }
            return;
        }
        const int head = (pn & 1) * 4 + wc, b = u.pm >> 5, j = u.pm & 31;
        const size_t bh = (size_t)(b * 8 + head);
        if (pn >= 4) {
            bf16_t* vb = Vb + (bh * 32 + j) * 16384;
#pragma unroll
            for (int ai = 0; ai < 2; ++ai)
#pragma unroll
                for (int m = 0; m < 4; ++m) {
                    const int row = row0 + ai * HALF + m * 16; const float rs = row_rstd(stats, row);
                    const int kk = ai * HALF + wr * 64 + m * 16 + fr;
                    const int kg = kk >> 5, w = kk & 31, st = w >> 4, w16 = w & 15, hh = (w16 >> 2) & 1, jj = 4 * (w16 >> 3) + (w16 & 3);
#pragma unroll
                    for (int bj = 0; bj < 2; ++bj)
#pragma unroll
                        for (int n = 0; n < 2; ++n) {
                            const unsigned p0 = cvtpk(acc[ai][bj][m][n][0] * rs, acc[ai][bj][m][n][1] * rs), p1 = cvtpk(acc[ai][bj][m][n][2] * rs, acc[ai][bj][m][n][3] * rs);
#pragma unroll
                            for (int i = 0; i < 4; ++i) {
                                const int r = 8 * fq + 4 * n + i;
                                const unsigned pv = (i < 2) ? p0 : p1;
                                vb[((((kg * 2 + st) * 2 + bj) * 32 + r) * 2 + hh) * 8 + jj] = (bf16_t)((i & 1) ? (pv >> 16) : (pv & 0xffffu));
                            }
                        }
                }
            return;
        }
        const bool isk = pn >= 2;
        const float* gn = isk ? kn : qn;
        float ksum[16];
#pragma unroll
        for (int e = 0; e < 16; ++e) ksum[e] = 0.f;
#pragma unroll
        for (int ai = 0; ai < 2; ++ai)
#pragma unroll
            for (int m = 0; m < 4; ++m) {
                const int row = row0 + ai * HALF + m * 16; const float rs = row_rstd(stats, row);
                const int t = row & 8191, kk = t & 255;
                float v0[8], v1[8]; float ss = 0.f;
#pragma unroll
                for (int n = 0; n < 2; ++n)
#pragma unroll
                    for (int i = 0; i < 4; ++i) { v0[4 * n + i] = acc[ai][0][m][n][i] * rs; v1[4 * n + i] = acc[ai][1][m][n][i] * rs; ss += v0[4 * n + i] * v0[4 * n + i] + v1[4 * n + i] * v1[4 * n + i]; }
                ss += __shfl_xor(ss, 16); ss += __shfl_xor(ss, 32);
                const float rn = rsqrtf(ss * (1.0f / 64.0f) + 1e-6f);
                const f32x4 c0 = *(const f32x4*)(ropeC + t * 32 + 8 * fq), c1 = *(const f32x4*)(ropeC + t * 32 + 8 * fq + 4);
                const f32x4 s0 = *(const f32x4*)(ropeS + t * 32 + 8 * fq), s1 = *(const f32x4*)(ropeS + t * 32 + 8 * fq + 4);
                const f32x4 ga0 = *(const f32x4*)(gn + 8 * fq), ga1 = *(const f32x4*)(gn + 8 * fq + 4), gb0 = *(const f32x4*)(gn + 32 + 8 * fq), gb1 = *(const f32x4*)(gn + 36 + 8 * fq);
                float o0[8], o1[8];
#pragma unroll
                for (int e = 0; e < 8; ++e) {
                    const float x1 = v0[e] * rn * (e < 4 ? ga0[e & 3] : ga1[e & 3]), x2 = v1[e] * rn * (e < 4 ? gb0[e & 3] : gb1[e & 3]);
                    const float cs = e < 4 ? c0[e & 3] : c1[e & 3], sn = e < 4 ? s0[e & 3] : s1[e & 3];
                    o0[e] = x1 * cs - x2 * sn; o1[e] = x2 * cs + x1 * sn;
                }
                u32x4 w0, w1;
                w0.x = cvtpk(o0[0], o0[1]); w0.y = cvtpk(o0[2], o0[3]); w0.z = cvtpk(o0[4], o0[5]); w0.w = cvtpk(o0[6], o0[7]);
                w1.x = cvtpk(o1[0], o1[1]); w1.y = cvtpk(o1[2], o1[3]); w1.z = cvtpk(o1[4], o1[5]); w1.w = cvtpk(o1[6], o1[7]);
                if (!isk) {
                    bf16_t* qp = Q + (bh * 8192 + t) * 64 + 8 * fq;
                    *(u32x4*)qp = w0; *(u32x4*)(qp + 32) = w1;
                } else {
                    bf16_t* kb = Kb + (bh * 32 + j) * 16384;
                    const int kg = kk >> 5, r = kk & 31, hq = fq & 1, ksl = fq >> 1;
                    *(u32x4*)(kb + (((kg * 4 + ksl) * 32 + r) * 2 + hq) * 8) = w0;
                    *(u32x4*)(kb + (((kg * 4 + 2 + ksl) * 32 + r) * 2 + hq) * 8) = w1;
#pragma unroll
                    for (int e = 0; e < 8; ++e) { ksum[e] += o0[e]; ksum[8 + e] += o1[e]; }
                }
                asm volatile("" ::: "memory");
            }
        if (isk) {
#pragma unroll
            for (int e = 0; e < 16; ++e) { float s = ksum[e]; s += __shfl_xor(s, 1); s += __shfl_xor(s, 2); s += __shfl_xor(s, 4); s += __shfl_xor(s, 8); ksum[e] = s; }
            if (fr == 0) {
                float* kp = kmp + ((size_t)(u.pm * 2 + wr) * 512) + head * 64 + 8 * fq;
                *(f32x4*)kp = (f32x4){ksum[0], ksum[1], ksum[2], ksum[3]}; *(f32x4*)(kp + 4) = (f32x4){ksum[4], ksum[5], ksum[6], ksum[7]};
                *(f32x4*)(kp + 32) = (f32x4){ksum[8], ksum[9], ksum[10], ksum[11]}; *(f32x4*)(kp + 36) = (f32x4){ksum[12], ksum[13], ksum[14], ksum[15]};
            }
        }
    }
};

template <class Epi, class Sched, bool ALIGN_EPI = false, bool SP2 = false>
__device__ __forceinline__ void gemm_phase(PG8_LAS unsigned char* lds, const Gemm g, const Sched& S, const Epi& E) {
    int tid_v = threadIdx.x; asm volatile("" : "+v"(tid_v));
    const int tid = tid_v, wid = __builtin_amdgcn_readfirstlane(tid >> 6), lane = tid & 63, wr = wid >> 2, wc = wid & 3, fr = lane & 15, fq = lane >> 4;
    const int K = g.K, nt = K / BK;
    unsigned voffA[2], voffB[2];
#pragma unroll
    for (int i = 0; i < 2; ++i) { int R, C; stage_rc(tid * 16 + i * 8192, R, C); const int Rb = Epi::PERM ? ((R & ~31) + perm32(R & 31)) : R;
        voffA[i] = (unsigned)(R * K + C) * 2u; voffB[i] = (unsigned)(Rb * K + C) * 2u; }
    const size_t kstep = (size_t)(BK * 2);
    const size_t hstep = (size_t)HALF * K * 2;
    const size_t tstep = 2 * hstep;
    const unsigned ldsw = (unsigned)wid * 1024u;
    const int aoff = lds_byte(wr * 64 + fr, fq * 8), boff = lds_byte(wc * 32 + fr, fq * 8);
#define PG8_SA(b, h) (((b) * 2 + (h)) * HTB)
#define PG8_SB(b, h) ((4 + (b) * 2 + (h)) * HTB)
#define PG8_STAGE(bufoff, gbase, voff) do { _Pragma("unroll") for (int _i = 0; _i < 2; ++_i) \
        __builtin_amdgcn_global_load_lds((const unsigned*)((const char*)(gbase) + (voff)[_i]), (PG8_LAS unsigned*)(lds + (bufoff) + ldsw + _i * 8192), 16, 0, 0); } while (0)
#define PG8_LDA(dst, b, h) do { _Pragma("unroll") for (int m = 0; m < 4; ++m) _Pragma("unroll") for (int k = 0; k < 2; ++k) dst[m][k] = *(const PG8_LAS bf16x8*)(lds + PG8_SA(b, h) + aoff + m * 2048 + k * 1024); } while (0)
#define PG8_LDB(dst, b, h) do { _Pragma("unroll") for (int n = 0; n < 2; ++n) _Pragma("unroll") for (int k = 0; k < 2; ++k) dst[n][k] = *(const PG8_LAS bf16x8*)(lds + PG8_SB(b, h) + boff + n * 2048 + k * 1024); } while (0)
#define PG8_MMA(ai, bj, At, Bt) do { __builtin_amdgcn_s_setprio(1); _Pragma("unroll") for (int m = 0; m < 4; ++m) _Pragma("unroll") for (int n = 0; n < 2; ++n) _Pragma("unroll") for (int k = 0; k < 2; ++k) \
        acc[ai][bj][m][n] = __builtin_amdgcn_mfma_f32_16x16x32_bf16(Bt[n][k], At[m][k], acc[ai][bj][m][n], 0, 0, 0); __builtin_amdgcn_s_setprio(0); } while (0)
#define PG8_WAIT_V(n) asm volatile("s_waitcnt vmcnt(" #n ")" ::: "memory")
#define PG8_WAIT_L(n) asm volatile("s_waitcnt lgkmcnt(" #n ")" ::: "memory")
#define PG8_BAR __builtin_amdgcn_s_barrier()
#define PG8_SCHED __builtin_amdgcn_sched_barrier(0)
    Unit cur, nxt; int ui = 0;
    if (!S.next(0, cur)) return;
    f32x4 acc[2][2][4][2];
#pragma unroll
    for (int a = 0; a < 2; ++a)
#pragma unroll
        for (int b = 0; b < 2; ++b)
#pragma unroll
            for (int m = 0; m < 4; ++m)
#pragma unroll
                for (int n = 0; n < 2; ++n) acc[a][b][m][n] = (f32x4){0.f, 0.f, 0.f, 0.f};
    bf16x8 At[4][2], B0[2][2], B1[2][2];
    const char* cA = (const char*)g.A + (size_t)cur.pm * tstep; const char* cB = (const char*)g.Bt + (size_t)cur.pn * tstep;
    S.a_ready(cur);
    if constexpr (SP2) {
        PG8_STAGE(PG8_SB(0, 0), cB, voffB); PG8_STAGE(PG8_SB(0, 1), cB + hstep, voffB); PG8_STAGE(PG8_SA(0, 0), cA, voffA); PG8_STAGE(PG8_SA(0, 1), cA + hstep, voffA);
        if (wr == 1) PG8_BAR;
        PG8_WAIT_V(2); PG8_BAR;
        PG8_STAGE(PG8_SB(1, 0), cB + kstep, voffB); PG8_STAGE(PG8_SA(1, 0), cA + kstep, voffA); PG8_STAGE(PG8_SB(1, 1), cB + hstep + kstep, voffB);
        PG8_WAIT_V(6); PG8_BAR;
    } else {
        PG8_STAGE(PG8_SB(0, 0), cB, voffB); PG8_STAGE(PG8_SA(0, 0), cA, voffA); PG8_STAGE(PG8_SB(0, 1), cB + hstep, voffB); PG8_STAGE(PG8_SA(0, 1), cA + hstep, voffA);
        if (wr == 1) PG8_BAR;
        PG8_WAIT_V(4); PG8_BAR;
        PG8_STAGE(PG8_SB(1, 0), cB + kstep, voffB); PG8_STAGE(PG8_SA(1, 0), cA + kstep, voffA); PG8_STAGE(PG8_SB(1, 1), cB + hstep + kstep, voffB);
        PG8_WAIT_V(6); PG8_BAR;
    }
    for (;;) {
        const bool has_next = S.next(ui + 1, nxt);
        const char* nA = has_next ? (const char*)g.A + (size_t)nxt.pm * tstep : cA; const char* nB = has_next ? (const char*)g.Bt + (size_t)nxt.pn * tstep : cB;
        for (int t = 0; t < nt; t += 2) {
            const bool last = (t == nt - 2);
            const char* a1 = cA + (size_t)(t + 1) * kstep;
            const char* a2 = last ? nA : cA + (size_t)(t + 2) * kstep; const char* b2 = last ? nB : cB + (size_t)(t + 2) * kstep;
            const char* a3 = a2 + kstep; const char* b3 = b2 + kstep;
            if (last && has_next) S.a_ready(nxt);
            if constexpr (SP2) {
            PG8_LDB(B0, 0, 0); PG8_LDB(B1, 0, 1); PG8_SCHED; PG8_LDA(At, 0, 0); PG8_STAGE(PG8_SA(1, 1), a1 + hstep, voffA);
            PG8_WAIT_V(8); PG8_WAIT_L(0); PG8_BAR; PG8_MMA(0, 0, At, B0); PG8_MMA(0, 1, At, B1); PG8_BAR; PG8_SCHED;
            PG8_LDA(At, 0, 1); PG8_STAGE(PG8_SB(0, 0), b2, voffB); PG8_STAGE(PG8_SB(0, 1), b2 + hstep, voffB); PG8_STAGE(PG8_SA(0, 0), a2, voffA);
            PG8_WAIT_V(8); PG8_WAIT_L(0); PG8_BAR; PG8_MMA(1, 0, At, B0); PG8_MMA(1, 1, At, B1); PG8_BAR; PG8_SCHED;
            PG8_LDB(B0, 1, 0); PG8_LDB(B1, 1, 1); PG8_SCHED; PG8_LDA(At, 1, 0); PG8_STAGE(PG8_SA(0, 1), a2 + hstep, voffA);
            PG8_WAIT_V(8); PG8_WAIT_L(0); PG8_BAR; PG8_MMA(0, 0, At, B0); PG8_MMA(0, 1, At, B1); PG8_BAR; PG8_SCHED;
            PG8_LDA(At, 1, 1); PG8_STAGE(PG8_SB(1, 0), b3, voffB); PG8_STAGE(PG8_SB(1, 1), b3 + hstep, voffB); PG8_STAGE(PG8_SA(1, 0), a3, voffA);
            PG8_WAIT_V(8); PG8_WAIT_L(0); PG8_BAR; PG8_MMA(1, 0, At, B0); PG8_MMA(1, 1, At, B1); PG8_BAR; PG8_SCHED;
            } else {
            PG8_LDB(B0, 0, 0); PG8_SCHED; PG8_LDA(At, 0, 0); PG8_STAGE(PG8_SA(1, 1), a1 + hstep, voffA);
            PG8_WAIT_L(8); PG8_BAR; PG8_WAIT_L(0); PG8_MMA(0, 0, At, B0); PG8_BAR; PG8_SCHED;
            PG8_LDB(B1, 0, 1); PG8_STAGE(PG8_SB(0, 0), b2, voffB);
            PG8_BAR; PG8_WAIT_L(0); PG8_MMA(0, 1, At, B1); PG8_BAR;
            PG8_LDA(At, 0, 1); PG8_STAGE(PG8_SA(0, 0), a2, voffA);
            PG8_BAR; PG8_WAIT_L(0); PG8_MMA(1, 0, At, B0); PG8_BAR; PG8_SCHED;
            PG8_STAGE(PG8_SB(0, 1), b2 + hstep, voffB);
            PG8_WAIT_V(6); PG8_BAR; PG8_MMA(1, 1, At, B1); PG8_BAR;
            PG8_LDB(B0, 1, 0); PG8_SCHED; PG8_LDA(At, 1, 0); PG8_STAGE(PG8_SA(0, 1), a2 + hstep, voffA);
            PG8_WAIT_L(8); PG8_BAR; PG8_WAIT_L(0); PG8_MMA(0, 0, At, B0); PG8_BAR; PG8_SCHED;
            PG8_LDB(B1, 1, 1); PG8_STAGE(PG8_SB(1, 0), b3, voffB);
            PG8_BAR; PG8_WAIT_L(0); PG8_MMA(0, 1, At, B1); PG8_BAR;
            PG8_LDA(At, 1, 1); PG8_STAGE(PG8_SA(1, 0), a3, voffA);
            PG8_BAR; PG8_WAIT_L(0); PG8_MMA(1, 0, At, B0); PG8_BAR; PG8_SCHED;
            PG8_STAGE(PG8_SB(1, 1), b3 + hstep, voffB);
            PG8_WAIT_V(6); PG8_BAR; PG8_MMA(1, 1, At, B1); PG8_BAR;
            }
        }
        if constexpr (ALIGN_EPI) { if (wr == 0) PG8_BAR; }
        if constexpr (!Epi::AFTER_DRAIN) { E(acc, cur, wr, wc, fr, fq); S.done(cur); }
        if (!has_next) break;
#pragma unroll
        for (int a = 0; a < 2; ++a)
#pragma unroll
            for (int b = 0; b < 2; ++b)
#pragma unroll
                for (int m = 0; m < 4; ++m)
#pragma unroll
                    for (int n = 0; n < 2; ++n) acc[a][b][m][n] = (f32x4){0.f, 0.f, 0.f, 0.f};
        cur = nxt; cA = nA; cB = nB; ++ui;
        if constexpr (ALIGN_EPI) { if (wr == 1) PG8_BAR; }
    }
    PG8_WAIT_V(0);
    if constexpr (!ALIGN_EPI) { if (wr == 0) PG8_BAR; }
    PG8_BAR;
    if constexpr (Epi::AFTER_DRAIN) { E.fused(acc, cur, wr, wc, fr, fq, lds, wid, lane); S.done(cur); }
#undef PG8_SA
#undef PG8_SB
#undef PG8_STAGE
#undef PG8_LDA
#undef PG8_LDB
#undef PG8_MMA
#undef PG8_WAIT_V
#undef PG8_WAIT_L
#undef PG8_BAR
#undef PG8_SCHED
}
}

#ifndef PG8_SP2
#define PG8_SP2 true
#endif
#ifndef PG8_ALIGN
#define PG8_ALIGN true
#endif

#define DI __device__ __forceinline__
typedef unsigned short bf16;
typedef short bf16x8 __attribute__((ext_vector_type(8)));
typedef float f32x4 __attribute__((ext_vector_type(4)));
typedef float f32x16 __attribute__((ext_vector_type(16)));
typedef unsigned u32x4 __attribute__((ext_vector_type(4)));
typedef unsigned u32x2 __attribute__((ext_vector_type(2)));
#define MFMA32(a, b, c) __builtin_amdgcn_mfma_f32_32x32x16_bf16((a), (b), (c), 0, 0, 0)

constexpr int NWAVES = 8, NTHR = 512;
constexpr int M = 16384, D = 1024, FF = 2816, INW = 2816, SEQ = 8192, DEPTH = 4;
constexpr int LDS_BYTES = 147456;
constexpr size_t MiB = 1u << 20;
constexpr size_t WS_CTL = 0;
constexpr size_t WS_STATS = 1 * MiB;
constexpr size_t WS_KMP = 2 * MiB;
constexpr size_t WS_DEC = 2 * MiB + 512 * 1024;
constexpr size_t WS_ROPEC = 3 * MiB, WS_ROPES = 4 * MiB;
constexpr size_t WS_W = 5 * MiB, WSZ = 42467328;
constexpr size_t W_GU1 = 0, W_D1 = 11534336, W_IN = 17301504, W_OUT = 23068672, W_GU2 = 25165824, W_D2 = 36700160;
constexpr size_t WS_XB = 86 * MiB;
constexpr size_t WS_R = 118 * MiB;
constexpr size_t R_HID = 0;
constexpr size_t R_Q = 0, R_K = 16 * MiB, R_V = 32 * MiB, R_U5 = 48 * MiB  , R_Y = 88 * MiB, R_PO = 120 * MiB, R_PML = 168 * MiB,
                 R_LIST = 172 * MiB  , R_ALOC = 188 * MiB, R_OINTRA = 204 * MiB, R_QDEC = 220 * MiB, R_SP = 228 * MiB, R_END = 236 * MiB;
constexpr size_t WS_END = WS_R + R_END;

DI float bf2f(unsigned short b) { return __uint_as_float((unsigned)b << 16); }
DI unsigned cvtpk(float lo, float hi) { return pg8::cvtpk(lo, hi); }
DI float wave_sum(float v) {
#pragma unroll
    for (int o = 1; o < 64; o <<= 1) v += __shfl_xor(v, o);
    return v;
}
DI void st_sc1(unsigned* p, unsigned v) { __hip_atomic_store(p, v, __ATOMIC_RELAXED, __HIP_MEMORY_SCOPE_AGENT); }
DI unsigned ld_sc1(const unsigned* p) { return __hip_atomic_load(p, __ATOMIC_RELAXED, __HIP_MEMORY_SCOPE_AGENT); }
DI float ld_sc1f(const float* p) { return __uint_as_float(__hip_atomic_load((const unsigned*)p, __ATOMIC_RELAXED, __HIP_MEMORY_SCOPE_AGENT)); }
DI int crow(int reg, int h) { return (reg & 3) + 8 * (reg >> 2) + 4 * h; }
DI bf16x8 pack8(const f32x16& x, int s) {
    u32x4 p; p.x = cvtpk(x[8 * s], x[8 * s + 1]); p.y = cvtpk(x[8 * s + 2], x[8 * s + 3]); p.z = cvtpk(x[8 * s + 4], x[8 * s + 5]); p.w = cvtpk(x[8 * s + 6], x[8 * s + 7]);
    return __builtin_bit_cast(bf16x8, p);
}
DI f32x16 zero16() { f32x16 z;
#pragma unroll
    for (int i = 0; i < 16; ++i) z[i] = 0.f; return z; }

struct Args { const float* in[18]; float* out; unsigned char* ws; int ph_lo, ph_hi; };
typedef const float* cfp_t;
typedef const __attribute__((address_space(4))) unsigned char* kptr_t;
struct Ctx { kptr_t kp; unsigned char* ws; float* out;
    DI const float* in(int i) const { return *(const __attribute__((address_space(4))) cfp_t*)(kp + 8 * i); } };
enum { I_X = 0, I_F1N, I_F1G, I_F1U, I_F1D, I_MIXN, I_WIN, I_QN, I_KN, I_PW, I_PS, I_LB, I_HON, I_WOUT, I_F2N, I_F2G, I_F2U, I_F2D };

DI void wconv_tile(const float* W, int ld, int srccol, const float* gain, bf16* WT, int K, int nrow0, int k0, float* scr, int lane) {
    asm volatile("" : "+v"(lane));
#pragma unroll 8
    for (int i = 0; i < 32; ++i) { const int kk = 2 * i + (lane >> 5); float v = W[(size_t)(k0 + kk) * ld + srccol + (lane & 31)]; if (gain) v *= gain[k0 + kk]; scr[kk * 33 + (lane & 31)] = v; }
    asm volatile("s_waitcnt lgkmcnt(0)" ::: "memory");
    const int c = lane & 7;
#pragma unroll
    for (int j = 0; j < 4; ++j) { const int n = (lane >> 3) + 8 * j; const float* s = scr + (8 * c) * 33 + n;
        u32x4 o; o.x = cvtpk(s[0 * 33], s[1 * 33]); o.y = cvtpk(s[2 * 33], s[3 * 33]); o.z = cvtpk(s[4 * 33], s[5 * 33]); o.w = cvtpk(s[6 * 33], s[7 * 33]);
        *(u32x4*)(WT + (size_t)(nrow0 + n) * K + k0 + 8 * c) = o; }
    asm volatile("s_waitcnt lgkmcnt(0)" ::: "memory");
}
constexpr int WC_I0 = 2816, WC_I1 = 1408, WC_I2 = 1408, WC_I3 = 512, WC_I4 = 2816, WC_I5 = 1408, WC_ITEMS = WC_I0 + WC_I1 + WC_I2 + WC_I3 + WC_I4 + WC_I5;
DI void wconv_item(const Ctx& a, int L, int item, float* scr, int lane) {
    unsigned char* wb = a.ws + WS_W + (size_t)(L & 1) * WSZ;
    int r = item;
    if (r < WC_I0 || (r >= WC_I0 + WC_I1 + WC_I2 + WC_I3 && r < WC_I0 + WC_I1 + WC_I2 + WC_I3 + WC_I4)) {
        const bool second = r >= WC_I0; if (second) r -= WC_I0 + WC_I1 + WC_I2 + WC_I3;
        const int kb = r / 176, nb = r % 176, n0 = nb * 32, pn = n0 >> 8, c = n0 & 255, bj = c >> 7, col = 128 * pn + (c & 127);
        const float* src = a.in(second ? (bj ? I_F2U : I_F2G) : (bj ? I_F1U : I_F1G)) + (size_t)L * D * FF;
        const float* gain = a.in(second ? I_F2N : I_F1N) + L * D;
        wconv_tile(src, FF, col, gain, (bf16*)(wb + (second ? W_GU2 : W_GU1)), D, n0, kb * 64, scr, lane); return;
    }
    r -= WC_I0;
    if (r < WC_I1) { const int kb = r / 32, nb = r % 32; wconv_tile(a.in(I_F1D) + (size_t)L * FF * D, D, nb * 32, nullptr, (bf16*)(wb + W_D1), FF, nb * 32, kb * 64, scr, lane); return; }
    r -= WC_I1;
    if (r < WC_I2) { const int kb = r / 88, nb = r % 88, n0 = nb * 32, pn = n0 >> 8, c = n0 & 255;
        const int col = pn < 6 ? (pn >> 1) * 512 + 64 * ((pn & 1) * 4 + ((c >> 5) & 3)) + 32 * (c >> 7) : n0;
        wconv_tile(a.in(I_WIN) + (size_t)L * D * INW, INW, col, a.in(I_MIXN) + L * D, (bf16*)(wb + W_IN), D, n0, kb * 64, scr, lane); return; }
    r -= WC_I2;
    if (r < WC_I3) { const int kb = r / 32, nb = r % 32; wconv_tile(a.in(I_WOUT) + (size_t)L * D * D, D, nb * 32, nullptr, (bf16*)(wb + W_OUT), D, nb * 32, kb * 64, scr, lane); return; }
    r -= WC_I3 + WC_I4;
    { const int kb = r / 32, nb = r % 32; wconv_tile(a.in(I_F2D) + (size_t)L * FF * D, D, nb * 32, nullptr, (bf16*)(wb + W_D2), FF, nb * 32, kb * 64, scr, lane); }
}

DI void phase_p0(const Ctx& a, unsigned char* lds, int gw, int NGW, int wave, int lane) {
    const float* x = a.in(I_X); float* out = a.out; bf16* xb = (bf16*)(a.ws + WS_XB); float* stats = (float*)(a.ws + WS_STATS);
    for (int m = gw; m < M; m += NGW) {
        const f32x4* xr = (const f32x4*)(x + (size_t)m * D) + lane; f32x4 v[4]; float s = 0.f;
#pragma unroll
        for (int j = 0; j < 4; ++j) { v[j] = xr[64 * j]; s += (v[j][0] * v[j][0] + v[j][1] * v[j][1]) + (v[j][2] * v[j][2] + v[j][3] * v[j][3]); }
        s = wave_sum(s);
        f32x4* orow = (f32x4*)(out + (size_t)m * D) + lane; u32x2* brow = (u32x2*)(xb + (size_t)m * D) + lane;
#pragma unroll
        for (int j = 0; j < 4; ++j) { orow[64 * j] = v[j]; u32x2 w; w.x = cvtpk(v[j][0], v[j][1]); w.y = cvtpk(v[j][2], v[j][3]); brow[64 * j] = w; }
        if (lane < 16) stats[(size_t)m * 16 + lane] = (lane == 0) ? s : 0.f;
    }
    { unsigned* cz = (unsigned*)(a.ws + WS_CTL + 65536); for (int i = gw * 64 + lane; i < 3456; i += NGW * 64) cz[i] = 0u; }
    float* rc = (float*)(a.ws + WS_ROPEC); float* rs = (float*)(a.ws + WS_ROPES);
    for (int e = gw * 64 + lane; e < SEQ * 32; e += NGW * 64) {
        const int t = e >> 5, i = e & 31;
        double c = 0.15915494309189535;
        for (int k = 0; k < i; ++k) c *= 0.74989420933245582;
        const float chi = (float)c, clo = (float)(c - (double)chi), tf = (float)t;
        const float p = tf * chi, pe = fmaf(tf, chi, -p);
        float fr = __builtin_amdgcn_fractf(p) + (pe + tf * clo);
        rc[e] = __builtin_amdgcn_cosf(fr); rs[e] = __builtin_amdgcn_sinf(fr);
    }
    float* scr = (float*)(lds + wave * 16384);
    for (int it = gw; it < WC_ITEMS; it += NGW) wconv_item(a, 0, it, scr, lane);
}

template <bool DIAG>
DI void attn_core(const bf16* qrow, const bf16* kblk, const bf16* vblk, int nkg, int r, int h, float& m_out, float& l_out, f32x16 (&ot)[2]) {
    bf16x8 qf[4];
#pragma unroll
    for (int ks = 0; ks < 4; ++ks) qf[ks] = *(const bf16x8*)(qrow + 16 * ks + 8 * h);
    f32x16 st[8];
    const int lo = (r * 2 + h) * 8;
#pragma unroll
    for (int kg = 0; kg < 8; ++kg) {
        f32x16 acc = zero16();
        if (!DIAG || kg < nkg) {
#pragma unroll
            for (int ks = 0; ks < 4; ++ks) { const bf16x8 kf = *(const bf16x8*)(kblk + (kg * 4 + ks) * 512 + lo); acc = MFMA32(kf, qf[ks], acc); }
            if (DIAG && kg == nkg - 1) {
#pragma unroll
                for (int i = 0; i < 16; ++i) if (crow(i, h) > r) acc[i] = -INFINITY;
            }
        } else {
#pragma unroll
            for (int i = 0; i < 16; ++i) acc[i] = -INFINITY;
        }
        st[kg] = acc;
    }
    float mx = -INFINITY;
#pragma unroll
    for (int kg = 0; kg < 8; ++kg)
#pragma unroll
        for (int i = 0; i < 16; ++i) mx = fmaxf(mx, st[kg][i]);
    mx = fmaxf(mx, __shfl_xor(mx, 32));
    const float c = 0.125f * 1.4426950408889634f; const float mc = mx * c;
    float l = 0.f;
#pragma unroll
    for (int kg = 0; kg < 8; ++kg)
#pragma unroll
        for (int i = 0; i < 16; ++i) { const float p = __builtin_amdgcn_exp2f(st[kg][i] * c - mc); st[kg][i] = p; l += p; }
    l += __shfl_xor(l, 32);
    ot[0] = zero16(); ot[1] = zero16();
#pragma unroll
    for (int kg = 0; kg < 8; ++kg) {
        if (!DIAG || kg < nkg) {
#pragma unroll
            for (int s2 = 0; s2 < 2; ++s2) {
                const bf16x8 pf = pack8(st[kg], s2);
#pragma unroll
                for (int md = 0; md < 2; ++md) { const bf16x8 vf = *(const bf16x8*)(vblk + ((kg * 2 + s2) * 2 + md) * 512 + lo); ot[md] = MFMA32(vf, pf, ot[md]); }
            }
        }
    }
    m_out = mx * 0.125f; l_out = l;
}

DI void topk_unit(const Ctx& a, int L, int unit, int lane) {
    asm volatile("" : "+v"(lane));
    const int b = unit >> 10, hd = (unit >> 7) & 7, c = unit & 127, own = c >> 2;
    if (own == 0) return;
    const bf16* Q = (const bf16*)(a.ws + WS_R + R_Q); const float* kmp = (const float*)(a.ws + WS_KMP);
    unsigned* cnt = (unsigned*)(a.ws + WS_CTL) + L * 512; unsigned* lists = (unsigned*)(a.ws + WS_R + R_LIST);
    const int t = c * 64 + lane; const size_t bh = (size_t)(b * 8 + hd);
    float q[64];
    { const u32x4* qp = (const u32x4*)(Q + (bh * SEQ + t) * 64);
#pragma unroll
      for (int i = 0; i < 8; ++i) { const u32x4 w = qp[i];
          q[8 * i + 0] = __uint_as_float(w.x << 16); q[8 * i + 1] = __uint_as_float(w.x & 0xffff0000u); q[8 * i + 2] = __uint_as_float(w.y << 16); q[8 * i + 3] = __uint_as_float(w.y & 0xffff0000u);
          q[8 * i + 4] = __uint_as_float(w.z << 16); q[8 * i + 5] = __uint_as_float(w.z & 0xffff0000u); q[8 * i + 6] = __uint_as_float(w.w << 16); q[8 * i + 7] = __uint_as_float(w.w & 0xffff0000u); } }
    float g0 = -INFINITY, g1 = -INFINITY, g2 = -INFINITY; int i0 = 0, i1 = 0, i2 = 0;
    for (int j = 0; j < own; ++j) {
        const float* p0 = kmp + (size_t)((b * 32 + j) * 2) * 512 + hd * 64; const float* p1 = p0 + 512;
        float g = 0.f;
#pragma unroll
        for (int d = 0; d < 64; d += 4) { const f32x4 x0 = *(const f32x4*)(p0 + d), x1 = *(const f32x4*)(p1 + d);
            g += q[d] * (x0[0] + x1[0]) + q[d + 1] * (x0[1] + x1[1]) + q[d + 2] * (x0[2] + x1[2]) + q[d + 3] * (x0[3] + x1[3]); }
#ifdef DBG_FIXED_SEL
        g = -(float)j;
#endif
        if (g > g0) { g2 = g1; i2 = i1; g1 = g0; i1 = i0; g0 = g; i0 = j; }
        else if (g > g1) { g2 = g1; i2 = i1; g1 = g; i1 = j; }
        else if (g > g2) { g2 = g; i2 = j; }
    }
    const int nsel = own < 3 ? own : 3;
#pragma unroll
    for (int s = 0; s < 3; ++s) {
        if (s < nsel) { const int j = s == 0 ? i0 : (s == 1 ? i1 : i2); const int li = (int)bh * 32 + j;
            const unsigned pos = atomicAdd(cnt + li, 1u); st_sc1(lists + (size_t)li * 8192 + pos, (unsigned)(t | (s << 13))); }
    }
}

DI void pool_unit(const Ctx& a, int L, int unit, int lane) {
    asm volatile("" : "+v"(lane));
    const int tile = unit >> 2, g = unit & 3, w = 2 << g, r = lane & 31, h = lane >> 5;
    const bf16* U = (const bf16*)(a.ws + WS_R + R_U5); bf16* Y = (bf16*)(a.ws + WS_R + R_Y);
    const float* pw = a.in(I_PW) + (size_t)(L * 4 + g) * 4096; const float* ps = a.in(I_PS) + L * 256 + g * 64;
    const float* pwl = pw + (8 * h) * 64 + r;
    bf16x8 wf[2][4];
#pragma unroll
    for (int me = 0; me < 2; ++me)
#pragma unroll
        for (int ks = 0; ks < 4; ++ks) { float f[8];
#pragma unroll
            for (int j = 0; j < 8; ++j) f[j] = pwl[(16 * ks + j) * 64 + 32 * me];
            u32x4 p; p.x = cvtpk(f[0], f[1]); p.y = cvtpk(f[2], f[3]); p.z = cvtpk(f[4], f[5]); p.w = cvtpk(f[6], f[7]); wf[me][ks] = __builtin_bit_cast(bf16x8, p); }
#pragma unroll 1
    for (int nt = 0; nt < 4; ++nt) {
        const int m = tile * 128 + nt * 32 + r, tpos = m & (SEQ - 1);
        const int cntw = tpos + 1 < w ? tpos + 1 : w; const float invc = 1.0f / (float)cntw;
        f32x16 acc[2]; acc[0] = zero16(); acc[1] = zero16();
#pragma unroll
        for (int ks = 0; ks < 4; ++ks) {
            const bf16* up = U + (size_t)m * 256 + g * 64 + 16 * ks + 8 * h;
            float sum[8], self[8];
            { const u32x4 wv = *(const u32x4*)up;
              self[0] = __uint_as_float(wv.x << 16); self[1] = __uint_as_float(wv.x & 0xffff0000u); self[2] = __uint_as_float(wv.y << 16); self[3] = __uint_as_float(wv.y & 0xffff0000u);
              self[4] = __uint_as_float(wv.z << 16); self[5] = __uint_as_float(wv.z & 0xffff0000u); self[6] = __uint_as_float(wv.w << 16); self[7] = __uint_as_float(wv.w & 0xffff0000u); }
#pragma unroll
            for (int j = 0; j < 8; ++j) sum[j] = self[j];
#pragma unroll 1
            for (int i = 1; i < cntw; ++i) { const u32x4 wv = *(const u32x4*)(up - (size_t)i * 256);
                sum[0] += __uint_as_float(wv.x << 16); sum[1] += __uint_as_float(wv.x & 0xffff0000u); sum[2] += __uint_as_float(wv.y << 16); sum[3] += __uint_as_float(wv.y & 0xffff0000u);
                sum[4] += __uint_as_float(wv.z << 16); sum[5] += __uint_as_float(wv.z & 0xffff0000u); sum[6] += __uint_as_float(wv.w << 16); sum[7] += __uint_as_float(wv.w & 0xffff0000u); }
            u32x4 p; p.x = cvtpk(sum[0] * invc - self[0], sum[1] * invc - self[1]); p.y = cvtpk(sum[2] * invc - self[2], sum[3] * invc - self[3]);
            p.z = cvtpk(sum[4] * invc - self[4], sum[5] * invc - self[5]); p.w = cvtpk(sum[6] * invc - self[6], sum[7] * invc - self[7]);
            const bf16x8 df = __builtin_bit_cast(bf16x8, p);
            acc[0] = MFMA32(wf[0][ks], df, acc[0]); acc[1] = MFMA32(wf[1][ks], df, acc[1]);
        }
#pragma unroll
        for (int me = 0; me < 2; ++me)
#pragma unroll
            for (int gq = 0; gq < 4; ++gq) { const int e0 = 32 * me + 8 * gq + 4 * h; const f32x4 sc = *(const f32x4*)(ps + e0);
                u32x2 o; o.x = cvtpk(acc[me][4 * gq] * sc[0], acc[me][4 * gq + 1] * sc[1]); o.y = cvtpk(acc[me][4 * gq + 2] * sc[2], acc[me][4 * gq + 3] * sc[3]);
                *(u32x2*)(Y + (size_t)m * 1024 + 512 + g * 64 + e0) = o; }
    }
}

DI void h1_unit(const Ctx& a, int L, int unit, unsigned char* sm, int lane) {
    asm volatile("" : "+v"(lane));
    const int b = unit >> 9, hh = (unit >> 7) & 3, n = unit & 127, r = lane & 31, h = lane >> 5;
    const int row0 = b * SEQ + n * 64, ch = hh * 64 + lane;
    const bf16* QH = (const bf16*)(a.ws + WS_R + R_U5) + (size_t)1 * M * 256; const bf16* FH = QH + (size_t)M * 256; const bf16* IH = FH + (size_t)M * 256;
    bf16* QDEC = (bf16*)(a.ws + WS_R + R_QDEC); float* ALOC = (float*)(a.ws + WS_R + R_ALOC); float* OINTRA = (float*)(a.ws + WS_R + R_OINTRA); float* DEC = (float*)(a.ws + WS_DEC);
    bf16* KD = (bf16*)sm; bf16* IT = (bf16*)(sm + 8192); bf16* Am = (bf16*)(sm + 16384); bf16* Bm = (bf16*)(sm + 24576);
    float lb;
    { const float* lp = a.in(I_LB) + ch; const float x0 = lp[0], x1 = lp[256], x2 = lp[512], x3 = lp[768];
      const float mx = fmaxf(fmaxf(x0, x1), fmaxf(x2, x3)); const float e0 = __expf(x0 - mx), e1 = __expf(x1 - mx), e2 = __expf(x2 - mx), e3 = __expf(x3 - mx);
      const float inv = 1.0f / (e0 + e1 + e2 + e3); float acc = 0.f; if (L > 0) acc += e0; if (L > 1) acc += e1; if (L > 2) acc += e2; lb = acc * inv; }
    const float loglb = __logf(fmaxf(lb, 1e-20f)), l1m = __logf(1.0f - lb), oml = 1.0f - lb;
    float cum = 0.f, ref = 0.f;
#ifndef H1_NO_P1
#pragma unroll 2
    for (int s = 0; s < 64; ++s) {
        const float z = bf2f(FH[(size_t)(row0 + s) * 256 + ch]);
        const float ls = fminf(z, 0.f) - __logf(1.0f + __expf(-fabsf(z)));
        const float bb = l1m + ls, hi = fmaxf(loglb, bb), df = fabsf(loglb - bb);
        cum += hi + __logf(1.0f + __expf(-df));
        asm volatile("" : "+v"(cum));
        if (s == 31) ref = cum;
    }
#endif
    const float last = cum;
    DEC[unit * 64 + lane] = __expf(last);
    cum = 0.f;
#ifndef H1_NO_P2
#pragma unroll 1
    for (int s8 = 0; s8 < 8; ++s8) {
        unsigned kp[4], ip[4]; float kd8[8]; unsigned short i8[8];
#pragma unroll
        for (int j = 0; j < 8; ++j) {
            const int s = s8 * 8 + j; const size_t gi = (size_t)(row0 + s) * 256 + ch;
            const float z = bf2f(FH[gi]), qv = bf2f(QH[gi]); i8[j] = IH[gi];
            const float ls = fminf(z, 0.f) - __logf(1.0f + __expf(-fabsf(z)));
            const float bb = l1m + ls, hi = fmaxf(loglb, bb), df = fabsf(loglb - bb);
            cum += hi + __logf(1.0f + __expf(-df));
            const float key = oml * __builtin_amdgcn_rcpf(1.0f + __expf(z));
            const float qs = qv * __builtin_amdgcn_rcpf(1.0f + __expf(-qv)) * 0.125f;
            const float av = qs * __expf(fminf(cum - ref, 80.f)), bv = key * __expf(fminf(ref - cum, 80.f)), qd = qs * __expf(cum);
            kd8[j] = key * __expf(last - cum);
#ifndef H1_NO_AB
            Am[s * 64 + lane] = (bf16)(cvtpk(av, 0.f) & 0xffffu); Bm[s * 64 + lane] = (bf16)(cvtpk(bv, 0.f) & 0xffffu);
#endif
#ifndef H1_NO_QD
            QDEC[gi] = (bf16)(cvtpk(qd, 0.f) & 0xffffu);
#endif
        }
#pragma unroll
        for (int j = 0; j < 4; ++j) { kp[j] = cvtpk(kd8[2 * j], kd8[2 * j + 1]); ip[j] = (unsigned)i8[2 * j] | ((unsigned)i8[2 * j + 1] << 16); }
        *(u32x4*)(KD + lane * 64 + s8 * 8) = (u32x4){kp[0], kp[1], kp[2], kp[3]};
        *(u32x4*)(IT + lane * 64 + s8 * 8) = (u32x4){ip[0], ip[1], ip[2], ip[3]};
    }
#endif
    asm volatile("s_waitcnt lgkmcnt(0)" ::: "memory");
#ifndef H1_NO_MM
    bf16x8 itf[2][2][2];
#pragma unroll
    for (int mv = 0; mv < 2; ++mv)
#pragma unroll
        for (int ms = 0; ms < 2; ++ms)
#pragma unroll
            for (int st = 0; st < 2; ++st) { const bf16* p = IT + (32 * mv + r) * 64 + 32 * ms + 16 * st + 4 * h; const u32x2 x0 = *(const u32x2*)p, x1 = *(const u32x2*)(p + 8);
                itf[mv][ms][st] = __builtin_bit_cast(bf16x8, ((u32x4){x0.x, x0.y, x1.x, x1.y})); }
    float* alb = ALOC + (size_t)unit * 4096 + (4 * h) * 64 + r;
#pragma unroll
    for (int nk = 0; nk < 2; ++nk) {
        bf16x8 kdf[2][2];
#pragma unroll
        for (int ms = 0; ms < 2; ++ms)
#pragma unroll
            for (int st = 0; st < 2; ++st) { const bf16* p = KD + (32 * nk + r) * 64 + 32 * ms + 16 * st + 4 * h; const u32x2 x0 = *(const u32x2*)p, x1 = *(const u32x2*)(p + 8);
                kdf[ms][st] = __builtin_bit_cast(bf16x8, ((u32x4){x0.x, x0.y, x1.x, x1.y})); }
#pragma unroll
        for (int mv = 0; mv < 2; ++mv) {
            f32x16 acc = zero16();
#pragma unroll
            for (int ms = 0; ms < 2; ++ms)
#pragma unroll
                for (int st = 0; st < 2; ++st) acc = MFMA32(itf[mv][ms][st], kdf[ms][st], acc);
#pragma unroll
            for (int i = 0; i < 16; ++i) alb[(32 * mv + (i & 3) + 8 * (i >> 2)) * 64 + 32 * nk] = acc[i];
        }
    }
#pragma unroll
    for (int nt = 0; nt < 2; ++nt) {
        bf16x8 af[4];
#pragma unroll
        for (int ks = 0; ks < 4; ++ks) af[ks] = *(const bf16x8*)(Am + (32 * nt + r) * 64 + 16 * ks + 8 * h);
        f32x16 oi[2]; oi[0] = zero16(); oi[1] = zero16();
#pragma unroll
        for (int ms = 0; ms < 2; ++ms) {
            if (ms <= nt) {
                f32x16 sacc = zero16();
#pragma unroll
                for (int ks = 0; ks < 4; ++ks) { const bf16x8 bf_ = *(const bf16x8*)(Bm + (32 * ms + r) * 64 + 16 * ks + 8 * h); sacc = MFMA32(bf_, af[ks], sacc); }
                if (ms == nt) {
#pragma unroll
                    for (int i = 0; i < 16; ++i) if (crow(i, h) > r) sacc[i] = 0.f;
                }
#pragma unroll
                for (int st = 0; st < 2; ++st) { const bf16x8 pf = pack8(sacc, st); oi[0] = MFMA32(itf[0][ms][st], pf, oi[0]); oi[1] = MFMA32(itf[1][ms][st], pf, oi[1]); }
            }
        }
        const size_t orow = (size_t)(row0 + 32 * nt + r) * 256 + hh * 64;
#pragma unroll
        for (int mv = 0; mv < 2; ++mv)
#pragma unroll
            for (int gq = 0; gq < 4; ++gq) *(f32x4*)(OINTRA + orow + 32 * mv + 8 * gq + 4 * h) = (f32x4){oi[mv][4 * gq], oi[mv][4 * gq + 1], oi[mv][4 * gq + 2], oi[mv][4 * gq + 3]};
    }
#endif
    asm volatile("s_waitcnt lgkmcnt(0)" ::: "memory");
}

DI void phase_t(const Ctx& a, int L, unsigned char* lds, int gw, int NGW, int wave, int lane) {
#ifndef NO_POOL
    for (int u = gw; u < 2048; u += NGW) pool_unit(a, L, u, lane);
#endif
#ifndef NO_WC
#ifdef DBG_WC_ALWAYS
    { float* scr = (float*)(lds + wave * 16384); for (int it = gw; it < WC_ITEMS; it += NGW) wconv_item(a, (L + 1) & 3, it, scr, lane); }
#else
    if (L + 1 < DEPTH) { float* scr = (float*)(lds + wave * 16384); for (int it = gw; it < WC_ITEMS; it += NGW) wconv_item(a, L + 1, it, scr, lane); }
#endif
#endif
    __syncthreads();
#ifndef NO_H1
    if (wave < 4) { const int hw = (gw >> 3) * 4 + wave, NHW = (NGW >> 3) * 4; for (int u = hw; u < 1024; u += NHW) h1_unit(a, L, u, lds + wave * 32768, lane); }
#endif
}

DI void attn_unit(const Ctx& a, int bh, int qb, unsigned char* lds, int tid, int wave, int lane) {
    asm volatile("" : "+v"(lane), "+v"(tid));
    const int r = lane & 31, h = lane >> 5, b = bh >> 3, hd = bh & 7, own = qb, nsel = own < 3 ? own : 3;
    const bf16* Q = (const bf16*)(a.ws + WS_R + R_Q); const bf16* Kb = (const bf16*)(a.ws + WS_R + R_K); const bf16* Vb = (const bf16*)(a.ws + WS_R + R_V);
    const float* kmp = (const float*)(a.ws + WS_KMP); bf16* Y = (bf16*)(a.ws + WS_R + R_Y);
    unsigned char* part = lds;
    unsigned short* llist = (unsigned short*)(lds + 104448);
    int* lcnt = (int*)(lds + 120832); int* itab = lcnt + 32;
    const size_t qbase = ((size_t)bh * SEQ + (size_t)qb * 256) * 64;
    if (own > 0) {
        if (tid < 32) lcnt[tid] = 0;
        __syncthreads();
        if (tid < 256) {
            float q[64];
            { const u32x4* qp = (const u32x4*)(Q + qbase + (size_t)tid * 64);
#pragma unroll
              for (int i = 0; i < 8; ++i) { const u32x4 w = qp[i];
                  q[8 * i + 0] = __uint_as_float(w.x << 16); q[8 * i + 1] = __uint_as_float(w.x & 0xffff0000u); q[8 * i + 2] = __uint_as_float(w.y << 16); q[8 * i + 3] = __uint_as_float(w.y & 0xffff0000u);
                  q[8 * i + 4] = __uint_as_float(w.z << 16); q[8 * i + 5] = __uint_as_float(w.z & 0xffff0000u); q[8 * i + 6] = __uint_as_float(w.w << 16); q[8 * i + 7] = __uint_as_float(w.w & 0xffff0000u); } }
            float g0 = -INFINITY, g1 = -INFINITY, g2 = -INFINITY; int i0 = 0, i1 = 0, i2 = 0;
            for (int j = 0; j < own; ++j) {
                const float* p0 = kmp + (size_t)((b * 32 + j) * 2) * 512 + hd * 64; const float* p1 = p0 + 512;
                float g = 0.f;
#pragma unroll
                for (int d = 0; d < 64; d += 4) { const f32x4 x0 = *(const f32x4*)(p0 + d), x1 = *(const f32x4*)(p1 + d);
                    g += q[d] * (x0[0] + x1[0]) + q[d + 1] * (x0[1] + x1[1]) + q[d + 2] * (x0[2] + x1[2]) + q[d + 3] * (x0[3] + x1[3]); }
                if (g > g0) { g2 = g1; i2 = i1; g1 = g0; i1 = i0; g0 = g; i0 = j; }
                else if (g > g1) { g2 = g1; i2 = i1; g1 = g; i1 = j; }
                else if (g > g2) { g2 = g; i2 = j; }
            }
#pragma unroll
            for (int s = 0; s < 3; ++s) {
                if (s < nsel) { const int j = s == 0 ? i0 : (s == 1 ? i1 : i2); const int pos = atomicAdd(lcnt + j, 1); llist[j * 256 + pos] = (unsigned short)(tid | (s << 8)); }
            }
        }
        __syncthreads();
        if (tid == 0) { int n = 0; for (int j = 0; j < own; ++j) { const int ng = (lcnt[j] + 31) >> 5; for (int g = 0; g < ng; ++g) itab[n++] = j | (g << 8); } itab[64] = n; }
        __syncthreads();
        const int nitems = __builtin_amdgcn_readfirstlane(itab[64]);
        for (int it = wave; it < nitems; it += NWAVES) {
            const int ent = __builtin_amdgcn_readfirstlane(itab[it]); const int j = ent & 255, g = ent >> 8, n = __builtin_amdgcn_readfirstlane(lcnt[j]);
            const int idx = g * 32 + r; const bool valid = idx < n;
            const unsigned e = llist[j * 256 + (valid ? idx : 0)];
            const int qi = e & 255, slot = e >> 8;
            float mo, lo_; f32x16 ot[2];
            attn_core<false>(Q + qbase + (size_t)qi * 64, Kb + ((size_t)bh * 32 + j) * 16384, Vb + ((size_t)bh * 32 + j) * 16384, 8, r, h, mo, lo_, ot);
            if (valid) {
                unsigned char* rec = part + (qi * 3 + slot) * 136; const float inv = 1.0f / lo_;
#pragma unroll
                for (int md = 0; md < 2; ++md)
#pragma unroll
                    for (int gq = 0; gq < 4; ++gq) { u32x2 o; o.x = cvtpk(ot[md][4 * gq] * inv, ot[md][4 * gq + 1] * inv); o.y = cvtpk(ot[md][4 * gq + 2] * inv, ot[md][4 * gq + 3] * inv);
                        *(u32x2*)(rec + 2 * (32 * md + 8 * gq + 4 * h)) = o; }
                if (h == 0) { *(float*)(rec + 128) = mo; *(float*)(rec + 132) = lo_; }
            }
        }
        __syncthreads();
    }
    {
        const int ql = 32 * wave + r, t = qb * 256 + ql;
        float m0, l0; f32x16 ot[2];
        attn_core<true>(Q + qbase + (size_t)ql * 64, Kb + ((size_t)bh * 32 + qb) * 16384, Vb + ((size_t)bh * 32 + qb) * 16384, wave + 1, r, h, m0, l0, ot);
        float ms[3], ls[3]; float mx = m0;
#pragma unroll
        for (int s = 0; s < 3; ++s) { ms[s] = -INFINITY; ls[s] = 0.f; if (s < nsel) { const unsigned char* rec = part + (ql * 3 + s) * 136; ms[s] = *(const float*)(rec + 128); ls[s] = *(const float*)(rec + 132); mx = fmaxf(mx, ms[s]); } }
        const float w0 = __expf(m0 - mx); float den = w0 * l0;
#pragma unroll
        for (int md = 0; md < 2; ++md)
#pragma unroll
            for (int i = 0; i < 16; ++i) ot[md][i] *= w0;
#pragma unroll
        for (int s = 0; s < 3; ++s) {
            if (s < nsel) {
                const unsigned char* rec = part + (ql * 3 + s) * 136; const float ws_ = __expf(ms[s] - mx) * ls[s]; den += ws_;
#pragma unroll
                for (int md = 0; md < 2; ++md)
#pragma unroll
                    for (int gq = 0; gq < 4; ++gq) { const u32x2 w = *(const u32x2*)(rec + 2 * (32 * md + 8 * gq + 4 * h));
                        ot[md][4 * gq] += ws_ * __uint_as_float(w.x << 16); ot[md][4 * gq + 1] += ws_ * __uint_as_float(w.x & 0xffff0000u);
                        ot[md][4 * gq + 2] += ws_ * __uint_as_float(w.y << 16); ot[md][4 * gq + 3] += ws_ * __uint_as_float(w.y & 0xffff0000u); }
            }
        }
        float inv = 1.0f / den; const size_t yrow = (size_t)(b * SEQ + t) * 1024 + hd * 64;
#ifdef DBG_AMP_ATTN
        inv *= 64.f;
#endif
#pragma unroll
        for (int md = 0; md < 2; ++md)
#pragma unroll
            for (int gq = 0; gq < 4; ++gq) { u32x2 o; o.x = cvtpk(ot[md][4 * gq] * inv, ot[md][4 * gq + 1] * inv); o.y = cvtpk(ot[md][4 * gq + 2] * inv, ot[md][4 * gq + 3] * inv);
                *(u32x2*)(Y + yrow + 32 * md + 8 * gq + 4 * h) = o; }
    }
    __syncthreads();
}

DI void phase_a(const Ctx& a, int L, unsigned char* lds, int gw, int NGW, int tid, int wave, int lane) {
    if ((gw & 3) == 0 && (gw >> 2) < 512) {
        const int chunk = gw >> 2, bhh = chunk >> 6, e = (chunk & 63) * 64 + lane, k = e & 63;
        const float* ALOC = (const float*)(a.ws + WS_R + R_ALOC); const float* DEC = (const float*)(a.ws + WS_DEC); bf16* SP = (bf16*)(a.ws + WS_R + R_SP);
        float st = 0.f;
#pragma unroll 8
        for (int n = 0; n < 128; ++n) { const int item = bhh * 128 + n; const float av = ALOC[(size_t)item * 4096 + e], dv = DEC[item * 64 + k];
            SP[(size_t)item * 4096 + e] = (bf16)(cvtpk(st, 0.f) & 0xffffu); st = dv * st + av; }
    }
    const int G = NGW / NWAVES, blk = gw / NWAVES;
    for (int u = blk; u < 512; u += G) {
        const int v = u & 255, bh = v >> 4, qb = (u < 256) ? (v & 15) : 31 - (v & 15);
        attn_unit(a, bh, qb, lds, tid, wave, lane);
    }
}

DI void own_unit(const Ctx& a, int bhi, int qg, int lane) {
    asm volatile("" : "+v"(lane));
    const int r = lane & 31, h = lane >> 5, t0 = qg * 32, j = t0 >> 8, nkg = ((t0 & 255) >> 5) + 1, t = t0 + r;
    const int b = bhi >> 3, hd = bhi & 7; const size_t bh = (size_t)bhi;
    const bf16* Q = (const bf16*)(a.ws + WS_R + R_Q); const bf16* Kb = (const bf16*)(a.ws + WS_R + R_K); const bf16* Vb = (const bf16*)(a.ws + WS_R + R_V);
    const bf16* PO = (const bf16*)(a.ws + WS_R + R_PO); const float* PML = (const float*)(a.ws + WS_R + R_PML); bf16* Y = (bf16*)(a.ws + WS_R + R_Y);
    float m0, l0; f32x16 ot[2];
    attn_core<true>(Q + (bh * SEQ + t) * 64, Kb + (bh * 32 + j) * 16384, Vb + (bh * 32 + j) * 16384, nkg, r, h, m0, l0, ot);
#ifdef DBG_OWN_ONLY
    const int nsel = 0;
#else
    const int nsel = j < 3 ? j : 3;
#endif
    const size_t pi = (bh * SEQ + t) * 3;
    float ms[3], ls[3]; float mx = m0;
#pragma unroll
    for (int s = 0; s < 3; ++s) { ms[s] = -INFINITY; ls[s] = 0.f; if (s < nsel) { ms[s] = ld_sc1f(PML + (pi + s) * 2); ls[s] = ld_sc1f(PML + (pi + s) * 2 + 1); mx = fmaxf(mx, ms[s]); } }
    const float w0 = __expf(m0 - mx); float den = w0 * l0;
#pragma unroll
    for (int md = 0; md < 2; ++md)
#pragma unroll
        for (int i = 0; i < 16; ++i) ot[md][i] *= w0;
#pragma unroll
    for (int s = 0; s < 3; ++s) {
        if (s < nsel) {
            const float ws_ = __expf(ms[s] - mx) * ls[s]; den += ws_;
#pragma unroll
            for (int md = 0; md < 2; ++md)
#pragma unroll
                for (int gq = 0; gq < 4; ++gq) { const u32x2 w = *(const u32x2*)(PO + (pi + s) * 64 + 32 * md + 8 * gq + 4 * h);
                    ot[md][4 * gq] += ws_ * __uint_as_float(w.x << 16); ot[md][4 * gq + 1] += ws_ * __uint_as_float(w.x & 0xffff0000u);
                    ot[md][4 * gq + 2] += ws_ * __uint_as_float(w.y << 16); ot[md][4 * gq + 3] += ws_ * __uint_as_float(w.y & 0xffff0000u); }
        }
    }
    float inv = 1.0f / den; const size_t yrow = (size_t)(b * SEQ + t) * 1024 + hd * 64;
#ifdef DBG_ZERO_ATTN
    inv = 0.f;
#endif
#pragma unroll
    for (int md = 0; md < 2; ++md)
#pragma unroll
        for (int gq = 0; gq < 4; ++gq) { u32x2 o; o.x = cvtpk(ot[md][4 * gq] * inv, ot[md][4 * gq + 1] * inv); o.y = cvtpk(ot[md][4 * gq + 2] * inv, ot[md][4 * gq + 3] * inv);
            *(u32x2*)(Y + yrow + 32 * md + 8 * gq + 4 * h) = o; }
}

DI void h3_unit(const Ctx& a, int L, int unit, int lane) {
    asm volatile("" : "+v"(lane));
    const int b = unit >> 9, hh = (unit >> 7) & 3, n = unit & 127, r = lane & 31, h = lane >> 5;
    const int row0 = b * SEQ + n * 64;
    const bf16* SP = (const bf16*)(a.ws + WS_R + R_SP) + (size_t)unit * 4096; const bf16* QDEC = (const bf16*)(a.ws + WS_R + R_QDEC);
    const float* OINTRA = (const float*)(a.ws + WS_R + R_OINTRA); const bf16* GH = (const bf16*)(a.ws + WS_R + R_U5) + (size_t)4 * M * 256; bf16* Y = (bf16*)(a.ws + WS_R + R_Y);
    const float* on = a.in(I_HON) + L * 64;
    bf16x8 sf[2][4];
#pragma unroll
    for (int mv = 0; mv < 2; ++mv)
#pragma unroll
        for (int ks = 0; ks < 4; ++ks) sf[mv][ks] = *(const bf16x8*)(SP + (32 * mv + r) * 64 + 16 * ks + 8 * h);
#pragma unroll
    for (int nt = 0; nt < 2; ++nt) {
        const size_t trow = (size_t)(row0 + 32 * nt + r) * 256 + hh * 64;
        f32x16 o[2]; o[0] = zero16(); o[1] = zero16();
#pragma unroll
        for (int ks = 0; ks < 4; ++ks) { const bf16x8 qf = *(const bf16x8*)(QDEC + trow + 16 * ks + 8 * h); o[0] = MFMA32(sf[0][ks], qf, o[0]); o[1] = MFMA32(sf[1][ks], qf, o[1]); }
        float ss = 0.f;
#pragma unroll
        for (int mv = 0; mv < 2; ++mv)
#pragma unroll
            for (int gq = 0; gq < 4; ++gq) { const f32x4 x = *(const f32x4*)(OINTRA + trow + 32 * mv + 8 * gq + 4 * h);
#pragma unroll
                for (int i = 0; i < 4; ++i) { o[mv][4 * gq + i] += x[i]; ss += o[mv][4 * gq + i] * o[mv][4 * gq + i]; } }
        ss += __shfl_xor(ss, 32);
        float rn = rsqrtf(ss * (1.0f / 64.0f) + 1e-6f);
#ifdef DBG_ZERO_HGRN
        rn = 0.f;
#endif
#ifdef DBG_AMP_HGRN
        rn *= 16.f;
#endif
        const size_t yrow = (size_t)(row0 + 32 * nt + r) * 1024 + 768 + hh * 64;
#pragma unroll
        for (int mv = 0; mv < 2; ++mv)
#pragma unroll
            for (int gq = 0; gq < 4; ++gq) { const int v0 = 32 * mv + 8 * gq + 4 * h; const f32x4 gn = *(const f32x4*)(on + v0); const u32x2 gw_ = *(const u32x2*)(GH + trow + v0);
                const float g0 = __uint_as_float(gw_.x << 16), g1 = __uint_as_float(gw_.x & 0xffff0000u), g2 = __uint_as_float(gw_.y << 16), g3 = __uint_as_float(gw_.y & 0xffff0000u);
                u32x2 w; w.x = cvtpk(o[mv][4 * gq] * rn * gn[0] * pg8::silu_f(g0), o[mv][4 * gq + 1] * rn * gn[1] * pg8::silu_f(g1));
                w.y = cvtpk(o[mv][4 * gq + 2] * rn * gn[2] * pg8::silu_f(g2), o[mv][4 * gq + 3] * rn * gn[3] * pg8::silu_f(g3));
                *(u32x2*)(Y + yrow + v0) = w; }
    }
}

DI void phase_c(const Ctx& a, int L, int gw, int NGW, int lane) {
    for (int u = gw; u < 1024; u += NGW) h3_unit(a, L, u, lane);
}

#define LAS __attribute__((address_space(3)))
#define XB_TMO      128
#define XB_XCNT(j)  (256  + 64 * (j))
#define XB_XSUB(j)  (1280 + 64 * (j))
#define XB_XGEN(j)  (2304 + 64 * (j))
#define XB_TOP      3328
#define XB_TOPGEN   3392
#define XCD_BAR_WORDS 3456
#define XB_SPIN_CAP (1u << 18)

__device__ __forceinline__ unsigned xb_ld(unsigned* p)              { return __hip_atomic_load(p, __ATOMIC_RELAXED, __HIP_MEMORY_SCOPE_AGENT); }
__device__ __forceinline__ unsigned xb_add(unsigned* p, unsigned v) { return __hip_atomic_fetch_add(p, v, __ATOMIC_RELAXED, __HIP_MEMORY_SCOPE_AGENT); }
__device__ __forceinline__ unsigned xb_xcc_id() { return (unsigned)__builtin_amdgcn_s_getreg((3 << 11) | 20) & 0xFu; }
#define XB_SPIN(cond, bar) do { unsigned _sp = 0; while (cond) { __builtin_amdgcn_s_sleep(1); \
    if ((++_sp & 255u) == 0u) { if (xb_ld(&(bar)[XB_TMO])) break; if (_sp > XB_SPIN_CAP) { atomicAdd(&(bar)[XB_TMO], 1u); break; } } } } while (0)

struct XcdBarrier {
    unsigned* bar; unsigned x;
    volatile LAS unsigned* st;
};

__device__ __forceinline__ XcdBarrier xcd_barrier_post(unsigned* bar, volatile LAS unsigned* st) {
    XcdBarrier b; b.bar = bar; b.x = xb_xcc_id(); b.st = st;
    if (threadIdx.x == 0) (void)xb_add(&bar[XB_XCNT(b.x)], 1u);
    return b;
}
__device__ __forceinline__ void xcd_barrier_complete(unsigned* bar, unsigned x, unsigned& nloc, unsigned& nx) {
    const unsigned G = gridDim.x * gridDim.y * gridDim.z;
    unsigned sum, cnt, mine, sp = 0u;
    for (;;) {
        sum = 0u; cnt = 0u; mine = 0u;
#pragma unroll
        for (unsigned j = 0; j < 16; ++j) { const unsigned c = xb_ld(&bar[XB_XCNT(j)]); sum += c; cnt += (c > 0u) ? 1u : 0u; mine = (j == x) ? c : mine; }
        if (sum == G) break;
        __builtin_amdgcn_s_sleep(1);
        if ((++sp & 255u) == 0u) { if (xb_ld(&bar[XB_TMO])) break; if (sp > XB_SPIN_CAP) { atomicAdd(&bar[XB_TMO], 1u); break; } }
    }
    nloc = mine > 0u ? mine : 1u; nx = cnt > 0u ? cnt : 1u;
}

__device__ __forceinline__ void xcd_barrier(const XcdBarrier& b) {
    asm volatile("s_waitcnt vmcnt(0)" ::: "memory");
    __syncthreads();
    if (threadIdx.x == 0) {
        unsigned* bar = b.bar;
        __builtin_amdgcn_s_waitcnt(0);
        unsigned nloc = b.st[0], nx = b.st[1];
        if (nloc == 0u) { xcd_barrier_complete(bar, b.x, nloc, nx); b.st[0] = nloc; b.st[1] = nx; }
        const unsigned old = xb_add(&bar[XB_XSUB(b.x)], 1u);
        const unsigned gen = old / nloc;
        if (old + 1u == (gen + 1u) * nloc) {
            __builtin_amdgcn_fence(__ATOMIC_RELEASE, "agent");
            asm volatile("s_waitcnt vmcnt(0)" ::: "memory");
            const unsigned og = xb_add(&bar[XB_TOP], 1u);
            const unsigned tg = og / nx;
            if (og + 1u == (tg + 1u) * nx) xb_add(&bar[XB_TOPGEN], 1u);
            else XB_SPIN(xb_ld(&bar[XB_TOPGEN]) == tg, bar);
            __builtin_amdgcn_fence(__ATOMIC_ACQUIRE, "agent");
            xb_add(&bar[XB_XGEN(b.x)], 1u);
            asm volatile("s_waitcnt vmcnt(0)" ::: "memory");
        } else {
            XB_SPIN(xb_ld(&bar[XB_XGEN(b.x)]) == gen, bar);
            __builtin_amdgcn_fence(__ATOMIC_ACQUIRE, "agent");
            asm volatile("s_waitcnt vmcnt(0)" ::: "memory");
        }
    }
    __syncthreads();
}

template <int MASK> __global__ void __launch_bounds__(NTHR, 2) mk_fwd(Args args) {
    extern __shared__ __attribute__((aligned(16))) unsigned char lds[];
    const int G = gridDim.x, NGW = G * NWAVES;
    cg::grid_group grid = cg::this_grid();
    const int ph_lo = args.ph_lo, ph_hi = args.ph_hi;
    volatile LAS unsigned* bst = (volatile LAS unsigned*)((LAS unsigned char*)lds + 131072);
    if (threadIdx.x == 0) { bst[0] = 0u; bst[1] = 0u; }
    __syncthreads();
    XcdBarrier bar; bar.bar = nullptr; bar.x = 0; bar.st = bst;
    for (int ph = ph_lo; ph < ph_hi; ++ph) {
        if (ph > ph_lo) {
            if (ph == ph_lo + 1) {
                grid.sync();
                bar = xcd_barrier_post((unsigned*)(args.ws + WS_CTL + 65536), bst);
            } else xcd_barrier(bar);
        }
        int tid_v = threadIdx.x; asm volatile("" : "+v"(tid_v));
        const int tid = tid_v, lane = tid & 63, wave = __builtin_amdgcn_readfirstlane(tid >> 6), gw = blockIdx.x * NWAVES + wave;
        kptr_t kp = (kptr_t)__builtin_amdgcn_kernarg_segment_ptr();
        asm volatile("" : "+s"(kp));
        Ctx a; a.kp = kp; a.out = *(float* const __attribute__((address_space(4)))*)(kp + 144); a.ws = *(unsigned char* const __attribute__((address_space(4)))*)(kp + 152);
        unsigned char* ws = a.ws;
        float* stats = (float*)(ws + WS_STATS); bf16* xb = (bf16*)(ws + WS_XB); bf16* hid = (bf16*)(ws + WS_R + R_HID);
        if (ph == 0) {
if constexpr (MASK & 1) phase_p0(a, lds, gw, NGW, wave, lane);
 __syncthreads(); continue; }
        const int L = (ph - 1) / 9, sub = (ph - 1) % 9;
        unsigned char* wb = ws + WS_W + (size_t)(L & 1) * WSZ;
        if (sub == 0 || sub == 7) {
            pg8::Gemm g{xb, (const bf16*)(wb + (sub == 0 ? W_GU1 : W_GU2)), M, 2 * FF, D}; pg8::StaticOrder S; S.init(M, 2 * FF, G, (int)blockIdx.x);
            pg8::EpiSwiGLU E{hid, stats, FF};
            if constexpr (MASK & 2) pg8::gemm_phase<pg8::EpiSwiGLU, pg8::StaticOrder, PG8_ALIGN, PG8_SP2>((PG8_LAS unsigned char*)lds, g, S, E);
        } else if (sub == 1 || sub == 6 || sub == 8) {
            const bf16* A = sub == 6 ? (const bf16*)(ws + WS_R + R_Y) : hid; const int K = sub == 6 ? D : FF;
            const bf16* Bt = (const bf16*)(wb + (sub == 1 ? W_D1 : (sub == 6 ? W_OUT : W_D2)));
            pg8::Gemm g{A, Bt, M, D, K}; pg8::StaticOrder S; S.init(M, D, G, (int)blockIdx.x);
            pg8::EpiResid E{a.out, xb, stats, sub == 6 ? 1.0f : 0.5f};
            if constexpr (MASK & 4) pg8::gemm_phase<pg8::EpiResid, pg8::StaticOrder, PG8_ALIGN, PG8_SP2>((PG8_LAS unsigned char*)lds, g, S, E);
        } else if (sub == 2) {
            pg8::Gemm g{xb, (const bf16*)(wb + W_IN), M, INW, D}; pg8::StaticOrder S; S.init(M, INW, G, (int)blockIdx.x);
            pg8::EpiProj E{(bf16*)(ws + WS_R + R_Q), (bf16*)(ws + WS_R + R_K), (bf16*)(ws + WS_R + R_V), (bf16*)(ws + WS_R + R_U5), (float*)(ws + WS_KMP), stats,
                           (const float*)(ws + WS_ROPEC), (const float*)(ws + WS_ROPES), a.in(I_QN) + L * 64, a.in(I_KN) + L * 64};
            if constexpr (MASK & 8) pg8::gemm_phase<pg8::EpiProj, pg8::StaticOrder, PG8_ALIGN, PG8_SP2>((PG8_LAS unsigned char*)lds, g, S, E);
        } else if (sub == 3) {
if constexpr (MASK & 16) phase_t(a, L, lds, gw, NGW, wave, lane);
 __syncthreads(); }
        else if (sub == 4) {
if constexpr (MASK & 32) phase_a(a, L, lds, gw, NGW, tid, wave, lane);
 __syncthreads(); }
        else {
if constexpr (MASK & 64) phase_c(a, L, gw, NGW, lane);
 __syncthreads(); }
    }
}

#ifndef MK_MULTI
#define MK_MULTI 0
#define DBG_WC_ALWAYS
#endif
#ifndef DBG_NPH
#define DBG_NPH (1 + 9 * DEPTH)
#endif
constexpr int N_PHASES = DBG_NPH;
static int phase_mask(int ph) { if (ph == 0) return 1; const int sub = (ph - 1) % 9; const int m[9] = {2, 4, 8, 16, 32, 64, 4, 2, 4}; return m[sub]; }
template <int MASK> static bool setup_one(int& per_cu) {
    if (hipFuncSetAttribute((const void*)mk_fwd<MASK>, hipFuncAttributeMaxDynamicSharedMemorySize, LDS_BYTES) != hipSuccess) return false;
    if (hipOccupancyMaxActiveBlocksPerMultiprocessor(&per_cu, (const void*)mk_fwd<MASK>, NTHR, LDS_BYTES) != hipSuccess) per_cu = 1;
    (void)hipGetLastError(); return true;
}
template <int MASK> static void launch_one(const Args& a, int grid, hipStream_t stream) { hipLaunchKernelGGL(mk_fwd<MASK>, dim3(grid), dim3(NTHR), LDS_BYTES, stream, a); }
extern "C" void kernel_launch(void* const* d_in, const int* in_sizes, int n_in, void* d_out, int out_size, void* d_ws, size_t ws_size, hipStream_t stream) {
    static int grid = 0;
    if (grid == 0) {
        if (n_in != 18 || in_sizes[0] != M * D || out_size != M * D || ws_size < WS_END) { fprintf(stderr, "kernel_launch: unexpected shapes / workspace (n_in %d, ws %zu < %zu)\n", n_in, ws_size, (size_t)WS_END); grid = -1; return; }
        int dev = 0, cus = 0, per_cu = 0; bool ok = true;
        (void)hipGetDevice(&dev); (void)hipDeviceGetAttribute(&cus, hipDeviceAttributeMultiprocessorCount, dev);
#if MK_MULTI
        ok = setup_one<1>(per_cu) && setup_one<2>(per_cu) && setup_one<4>(per_cu) && setup_one<8>(per_cu) && setup_one<16>(per_cu) && setup_one<32>(per_cu) && setup_one<64>(per_cu);
#else
        ok = setup_one<127>(per_cu);
#endif
        if (!ok) { fprintf(stderr, "kernel_launch: hipFuncSetAttribute failed\n"); grid = -1; return; }
        grid = cus;
    }
    if (grid < 0) return;
    Args a{};
    for (int i = 0; i < 18; ++i) a.in[i] = (const float*)d_in[i];
    a.out = (float*)d_out; a.ws = (unsigned char*)d_ws;
#if MK_MULTI
    for (int ph = 0; ph < N_PHASES; ++ph) { a.ph_lo = ph; a.ph_hi = ph + 1;
        switch (phase_mask(ph)) { case 1: launch_one<1>(a, grid, stream); break; case 2: launch_one<2>(a, grid, stream); break; case 4: launch_one<4>(a, grid, stream); break; case 8: launch_one<8>(a, grid, stream); break;
                                  case 16: launch_one<16>(a, grid, stream); break; case 32: launch_one<32>(a, grid, stream); break; default: launch_one<64>(a, grid, stream); break; } }
#else
    a.ph_lo = 0; a.ph_hi = N_PHASES;
    void* args[] = {&a};
    hipError_t e = hipLaunchCooperativeKernel((const void*)mk_fwd<127>, dim3(grid), dim3(NTHR), args, LDS_BYTES, stream);
    if (e != hipSuccess) fprintf(stderr, "cooperative launch failed: %s (grid %d)\n", hipGetErrorString(e), grid);
#endif
}
```

```cpp
#include <hip/hip_runtime.h>
#include <hip/hip_cooperative_groups.h>
#include <cstdio>
#include <cstdint>
namespace cg = cooperative_groups;
#define MK_MULTI 0
#define DBG_WC_ALWAYS
namespace pg8 {
#define PG8_LAS __attribute__((address_space(3)))
typedef unsigned short bf16_t;
typedef short bf16x8 __attribute__((ext_vector_type(8)));
typedef float f32x4 __attribute__((ext_vector_type(4)));
typedef unsigned u32x4 __attribute__((ext_vector_type(4)));
constexpr int BM = 256, BK = 64, HALF = 128, HTB = HALF * BK * 2  , STAGE_BYTES = 8 * HTB, NXCD = 8, WGM = 8;

__host__ __device__ __forceinline__ int lds_byte(int r, int c) { const int st = (r >> 4) * 2 + (c >> 5), rr = r & 15, cc = c & 31, ob = rr * 64 + cc * 2; return st * 1024 + (ob ^ (((ob >> 9) & 1) << 5)); }
__host__ __device__ __forceinline__ void stage_rc(int b, int& R, int& C) { const int st = b / 1024, sb = b % 1024, swz = sb ^ (((sb >> 9) & 1) << 5); R = (st >> 1) * 16 + swz / 64; C = (st & 1) * 32 + (swz % 64) / 2; }
__host__ __device__ __forceinline__ int perm32(int rho) { const int n = rho >> 4, i = rho & 15; return 8 * (i >> 2) + 4 * n + (i & 3); }

struct Unit { int pm, pn; };
struct Gemm { const bf16_t* A; const bf16_t* Bt; int M, N, K; };

struct StaticOrder {
    int nM, nN, nwg, G, c;
    __host__ __device__ void init(int M, int N, int G_, int c_) { nM = M / BM; nN = N / BM; nwg = nM * nN; G = G_; c = c_; }
    __host__ __device__ bool next(int i, Unit& u) const {
        const long L = (long)i * G + c; if (L >= nwg) return false;
        int wgid = (int)L; { const int q = nwg / NXCD, r = nwg % NXCD, xcd = wgid % NXCD, off = wgid / NXCD; wgid = (xcd < r ? xcd * (q + 1) : r * (q + 1) + (xcd - r) * q) + off; }
        const int nig = WGM * nN, gid = wgid / nig, fm = gid * WGM, gsz = (nM - fm) < WGM ? (nM - fm) : WGM;
        u.pm = fm + ((wgid % nig) % gsz); u.pn = (wgid % nig) / gsz; return true;
    }
    __device__ __forceinline__ void a_ready(const Unit&) const {}
    __device__ __forceinline__ void done(const Unit&) const {}
};

__device__ __forceinline__ unsigned cvt_pk_bf16(float lo, float hi) { unsigned r; asm volatile("v_cvt_pk_bf16_f32 %0, %1, %2" : "=v"(r) : "v"(lo), "v"(hi)); return r; }
typedef float f32x2 __attribute__((ext_vector_type(2)));
typedef unsigned u32x2 __attribute__((ext_vector_type(2)));
typedef __bf16 bf16x2_t __attribute__((ext_vector_type(2)));
__device__ __forceinline__ unsigned cvtpk(float lo, float hi) { f32x2 v = {lo, hi}; bf16x2_t b = __builtin_convertvector(v, bf16x2_t); return __builtin_bit_cast(unsigned, b); }
__device__ __forceinline__ float row_rstd(const float* stats, int row) {
    const f32x4* p = (const f32x4*)(stats + (size_t)row * 16);
    const f32x4 a = p[0], b = p[1], c = p[2], d = p[3];
    const float s = ((a[0] + a[1]) + (a[2] + a[3])) + ((b[0] + b[1]) + (b[2] + b[3])) + ((c[0] + c[1]) + (c[2] + c[3])) + ((d[0] + d[1]) + (d[2] + d[3]));
    return rsqrtf(s * (1.0f / 1024.0f) + 1e-6f);
}
__device__ __forceinline__ float silu_f(float g) { return g * __builtin_amdgcn_rcpf(1.0f + __expf(-g)); }

struct EpiSwiGLU {
    static constexpr bool PERM = true, AFTER_DRAIN = false;
    bf16_t* H; const float* stats; int ldh;
    __device__ __forceinline__ void operator()(const f32x4 (&acc)[2][2][4][2], const Unit& u, int wr, int wc, int fr, int fq) const {
        asm volatile("" : "+v"(fr), "+v"(fq));
        const int row0 = u.pm * BM + wr * 64 + fr, col0 = u.pn * HALF + wc * 32 + 8 * fq;
#pragma unroll
        for (int ai = 0; ai < 2; ++ai)
#pragma unroll
            for (int m = 0; m < 4; ++m) {
                const int row = row0 + ai * HALF + m * 16;
                const float rs = row_rstd(stats, row);
                float h[8];
#pragma unroll
                for (int n = 0; n < 2; ++n)
#pragma unroll
                    for (int i = 0; i < 4; ++i) { const float g = acc[ai][0][m][n][i] * rs, up = acc[ai][1][m][n][i] * rs; h[4 * n + i] = silu_f(g) * up; }
                u32x4 w; w.x = cvtpk(h[0], h[1]); w.y = cvtpk(h[2], h[3]); w.z = cvtpk(h[4], h[5]); w.w = cvtpk(h[6], h[7]);
                *(u32x4*)(H + (size_t)row * ldh + col0) = w;
            }
    }
};

struct EpiResid {
    static constexpr bool PERM = true, AFTER_DRAIN = false;
    float* X; bf16_t* XB; float* stats; float scale;
    __device__ __forceinline__ void operator()(const f32x4 (&acc)[2][2][4][2], const Unit& u, int wr, int wc, int fr, int fq) const {
        asm volatile("" : "+v"(fr), "+v"(fq));
        const int row0 = u.pm * BM + wr * 64 + fr, col0 = u.pn * BM + wc * 32 + 8 * fq;
#pragma unroll
        for (int ai = 0; ai < 2; ++ai)
#pragma unroll
            for (int m = 0; m < 4; ++m) {
                const int row = row0 + ai * HALF + m * 16; float ss = 0.f;
#pragma unroll
                for (int bj = 0; bj < 2; ++bj) {
                    float* xp = X + (size_t)row * 1024 + col0 + bj * HALF;
                    f32x4 x0 = *(const f32x4*)xp, x1 = *(const f32x4*)(xp + 4);
                    x0 = x0 + acc[ai][bj][m][0] * scale; x1 = x1 + acc[ai][bj][m][1] * scale;
                    *(f32x4*)xp = x0; *(f32x4*)(xp + 4) = x1;
                    ss += (x0[0] * x0[0] + x0[1] * x0[1]) + (x0[2] * x0[2] + x0[3] * x0[3]) + (x1[0] * x1[0] + x1[1] * x1[1]) + (x1[2] * x1[2] + x1[3] * x1[3]);
                    u32x4 w; w.x = cvtpk(x0[0], x0[1]); w.y = cvtpk(x0[2], x0[3]); w.z = cvtpk(x1[0], x1[1]); w.w = cvtpk(x1[2], x1[3]);
                    *(u32x4*)(XB + (size_t)row * 1024 + col0 + bj * HALF) = w;
                }
                ss += __shfl_xor(ss, 16); ss += __shfl_xor(ss, 32);
                if (fq == 0) stats[(size_t)row * 16 + u.pn * 4 + wc] = ss;
            }
    }
};

struct EpiProj {
    static constexpr bool PERM = true, AFTER_DRAIN = false;
    bf16_t* Q; bf16_t* Kb; bf16_t* Vb; bf16_t* U5; float* kmp; const float* stats; const float* ropeC; const float* ropeS; const float* qn; const float* kn;
    __device__ __forceinline__ void operator()(const f32x4 (&acc)[2][2][4][2], const Unit& u, int wr, int wc, int fr, int fq) const {
        asm volatile("" : "+v"(fr), "+v"(fq));
        const int row0 = u.pm * BM + wr * 64 + fr;
        const int pn = u.pn;
        if (pn >= 6) {
            bf16_t* O = U5 + (size_t)(pn - 6) * (16384 * 256);
            const int col0 = wc * 32 + 8 * fq;
#pragma unroll
            for (int ai = 0; ai < 2; ++ai)
#pragma unroll
                for (int m = 0; m < 4; ++m) {
                    const int row = row0 + ai * HALF + m * 16; const float rs = row_rstd(stats, row);
#pragma unroll
                    for (int bj = 0; bj < 2; ++bj) {
                        const f32x4 v0 = acc[ai][bj][m][0] * rs, v1 = acc[ai][bj][m][1] * rs;
                        u32x4 w; w.x = cvtpk(v0[0], v0[1]); w.y = cvtpk(v0[2], v0[3]); w.z = cvtpk(v1[0], v1[1]); w.w = cvtpk(v1[2], v1[3]);
                        *(u32x4*)(O + (size_t)row * 256 + col0 + bj * HALF) = w;
                    }
                }
            return;
        }
        const int head = (pn & 1) * 4 + wc, b = u.pm >> 5, j = u.pm & 31;
        const size_t bh = (size_t)(b * 8 + head);
        if (pn >= 4) {
            bf16_t* vb = Vb + (bh * 32 + j) * 16384;
#pragma unroll
            for (int ai = 0; ai < 2; ++ai)
#pragma unroll
                for (int m = 0; m < 4; ++m) {
                    const int row = row0 + ai * HALF + m * 16; const float rs = row_rstd(stats, row);
                    const int kk = ai * HALF + wr * 64 + m * 16 + fr;
                    const int kg = kk >> 5, w = kk & 31, st = w >> 4, w16 = w & 15, hh = (w16 >> 2) & 1, jj = 4 * (w16 >> 3) + (w16 & 3);
#pragma unroll
                    for (int bj = 0; bj < 2; ++bj)
#pragma unroll
                        for (int n = 0; n < 2; ++n) {
                            const unsigned p0 = cvtpk(acc[ai][bj][m][n][0] * rs, acc[ai][bj][m][n][1] * rs), p1 = cvtpk(acc[ai][bj][m][n][2] * rs, acc[ai][bj][m][n][3] * rs);
#pragma unroll
                            for (int i = 0; i < 4; ++i) {
                                const int r = 8 * fq + 4 * n + i;
                                const unsigned pv = (i < 2) ? p0 : p1;
                                vb[((((kg * 2 + st) * 2 + bj) * 32 + r) * 2 + hh) * 8 + jj] = (bf16_t)((i & 1) ? (pv >> 16) : (pv & 0xffffu));
                            }
                        }
                }
            return;
        }
        const bool isk = pn >= 2;
        const float* gn = isk ? kn : qn;
        float ksum[16];
#pragma unroll
        for (int e = 0; e < 16; ++e) ksum[e] = 0.f;
#pragma unroll
        for (int ai = 0; ai < 2; ++ai)
#pragma unroll
            for (int m = 0; m < 4; ++m) {
                const int row = row0 + ai * HALF + m * 16; const float rs = row_rstd(stats, row);
                const int t = row & 8191, kk = t & 255;
                float v0[8], v1[8]; float ss = 0.f;
#pragma unroll
                for (int n = 0; n < 2; ++n)
#pragma unroll
                    for (int i = 0; i < 4; ++i) { v0[4 * n + i] = acc[ai][0][m][n][i] * rs; v1[4 * n + i] = acc[ai][1][m][n][i] * rs; ss += v0[4 * n + i] * v0[4 * n + i] + v1[4 * n + i] * v1[4 * n + i]; }
                ss += __shfl_xor(ss, 16); ss += __shfl_xor(ss, 32);
                const float rn = rsqrtf(ss * (1.0f / 64.0f) + 1e-6f);
                const f32x4 c0 = *(const f32x4*)(ropeC + t * 32 + 8 * fq), c1 = *(const f32x4*)(ropeC + t * 32 + 8 * fq + 4);
                const f32x4 s0 = *(const f32x4*)(ropeS + t * 32 + 8 * fq), s1 = *(const f32x4*)(ropeS + t * 32 + 8 * fq + 4);
                const f32x4 ga0 = *(const f32x4*)(gn + 8 * fq), ga1 = *(const f32x4*)(gn + 8 * fq + 4), gb0 = *(const f32x4*)(gn + 32 + 8 * fq), gb1 = *(const f32x4*)(gn + 36 + 8 * fq);
                float o0[8], o1[8];
#pragma unroll
                for (int e = 0; e < 8; ++e) {
                    const float x1 = v0[e] * rn * (e < 4 ? ga0[e & 3] : ga1[e & 3]), x2 = v1[e] * rn * (e < 4 ? gb0[e & 3] : gb1[e & 3]);
                    const float cs = e < 4 ? c0[e & 3] : c1[e & 3], sn = e < 4 ? s0[e & 3] : s1[e & 3];
                    o0[e] = x1 * cs - x2 * sn; o1[e] = x2 * cs + x1 * sn;
                }
                u32x4 w0, w1;
                w0.x = cvtpk(o0[0], o0[1]); w0.y = cvtpk(o0[2], o0[3]); w0.z = cvtpk(o0[4], o0[5]); w0.w = cvtpk(o0[6], o0[7]);
                w1.x = cvtpk(o1[0], o1[1]); w1.y = cvtpk(o1[2], o1[3]); w1.z = cvtpk(o1[4], o1[5]); w1.w = cvtpk(o1[6], o1[7]);
                if (!isk) {
                    bf16_t* qp = Q + (bh * 8192 + t) * 64 + 8 * fq;
                    *(u32x4*)qp = w0; *(u32x4*)(qp + 32) = w1;
                } else {
                    bf16_t* kb = Kb + (bh * 32 + j) * 16384;
                    const int kg = kk >> 5, r = kk & 31, hq = fq & 1, ksl = fq >> 1;
                    *(u32x4*)(kb + (((kg * 4 + ksl) * 32 + r) * 2 + hq) * 8) = w0;
                    *(u32x4*)(kb + (((kg * 4 + 2 + ksl) * 32 + r) * 2 + hq) * 8) = w1;
#pragma unroll
                    for (int e = 0; e < 8; ++e) { ksum[e] += o0[e]; ksum[8 + e] += o1[e]; }
                }
                asm volatile("" ::: "memory");
            }
        if (isk) {
#pragma unroll
            for (int e = 0; e < 16; ++e) { float s = ksum[e]; s += __shfl_xor(s, 1); s += __shfl_xor(s, 2); s += __shfl_xor(s, 4); s += __shfl_xor(s, 8); ksum[e] = s; }
            if (fr == 0) {
                float* kp = kmp + ((size_t)(u.pm * 2 + wr) * 512) + head * 64 + 8 * fq;
                *(f32x4*)kp = (f32x4){ksum[0], ksum[1], ksum[2], ksum[3]}; *(f32x4*)(kp + 4) = (f32x4){ksum[4], ksum[5], ksum[6], ksum[7]};
                *(f32x4*)(kp + 32) = (f32x4){ksum[8], ksum[9], ksum[10], ksum[11]}; *(f32x4*)(kp + 36) = (f32x4){ksum[12], ksum[13], ksum[14], ksum[15]};
            }
        }
    }
};

template <class Epi, class Sched, bool ALIGN_EPI = false, bool SP2 = false>
__device__ __forceinline__ void gemm_phase(PG8_LAS unsigned char* lds, const Gemm g, const Sched& S, const Epi& E) {
    int tid_v = threadIdx.x; asm volatile("" : "+v"(tid_v));
    const int tid = tid_v, wid = __builtin_amdgcn_readfirstlane(tid >> 6), lane = tid & 63, wr = wid >> 2, wc = wid & 3, fr = lane & 15, fq = lane >> 4;
    const int K = g.K, nt = K / BK;
    unsigned voffA[2], voffB[2];
#pragma unroll
    for (int i = 0; i < 2; ++i) { int R, C; stage_rc(tid * 16 + i * 8192, R, C); const int Rb = Epi::PERM ? ((R & ~31) + perm32(R & 31)) : R;
        voffA[i] = (unsigned)(R * K + C) * 2u; voffB[i] = (unsigned)(Rb * K + C) * 2u; }
    const size_t kstep = (size_t)(BK * 2);
    const size_t hstep = (size_t)HALF * K * 2;
    const size_t tstep = 2 * hstep;
    const unsigned ldsw = (unsigned)wid * 1024u;
    const int aoff = lds_byte(wr * 64 + fr, fq * 8), boff = lds_byte(wc * 32 + fr, fq * 8);
#define PG8_SA(b, h) (((b) * 2 + (h)) * HTB)
#define PG8_SB(b, h) ((4 + (b) * 2 + (h)) * HTB)
#define PG8_STAGE(bufoff, gbase, voff) do { _Pragma("unroll") for (int _i = 0; _i < 2; ++_i) \
        __builtin_amdgcn_global_load_lds((const unsigned*)((const char*)(gbase) + (voff)[_i]), (PG8_LAS unsigned*)(lds + (bufoff) + ldsw + _i * 8192), 16, 0, 0); } while (0)
#define PG8_LDA(dst, b, h) do { _Pragma("unroll") for (int m = 0; m < 4; ++m) _Pragma("unroll") for (int k = 0; k < 2; ++k) dst[m][k] = *(const PG8_LAS bf16x8*)(lds + PG8_SA(b, h) + aoff + m * 2048 + k * 1024); } while (0)
#define PG8_LDB(dst, b, h) do { _Pragma("unroll") for (int n = 0; n < 2; ++n) _Pragma("unroll") for (int k = 0; k < 2; ++k) dst[n][k] = *(const PG8_LAS bf16x8*)(lds + PG8_SB(b, h) + boff + n * 2048 + k * 1024); } while (0)
#define PG8_MMA(ai, bj, At, Bt) do { __builtin_amdgcn_s_setprio(1); _Pragma("unroll") for (int m = 0; m < 4; ++m) _Pragma("unroll") for (int n = 0; n < 2; ++n) _Pragma("unroll") for (int k = 0; k < 2; ++k) \
        acc[ai][bj][m][n] = __builtin_amdgcn_mfma_f32_16x16x32_bf16(Bt[n][k], At[m][k], acc[ai][bj][m][n], 0, 0, 0); __builtin_amdgcn_s_setprio(0); } while (0)
#define PG8_WAIT_V(n) asm volatile("s_waitcnt vmcnt(" #n ")" ::: "memory")
#define PG8_WAIT_L(n) asm volatile("s_waitcnt lgkmcnt(" #n ")" ::: "memory")
#define PG8_BAR __builtin_amdgcn_s_barrier()
#define PG8_SCHED __builtin_amdgcn_sched_barrier(0)
    Unit cur, nxt; int ui = 0;
    if (!S.next(0, cur)) return;
    f32x4 acc[2][2][4][2];
#pragma unroll
    for (int a = 0; a < 2; ++a)
#pragma unroll
        for (int b = 0; b < 2; ++b)
#pragma unroll
            for (int m = 0; m < 4; ++m)
#pragma unroll
                for (int n = 0; n < 2; ++n) acc[a][b][m][n] = (f32x4){0.f, 0.f, 0.f, 0.f};
    bf16x8 At[4][2], B0[2][2], B1[2][2];
    const char* cA = (const char*)g.A + (size_t)cur.pm * tstep; const char* cB = (const char*)g.Bt + (size_t)cur.pn * tstep;
    S.a_ready(cur);
    if constexpr (SP2) {
        PG8_STAGE(PG8_SB(0, 0), cB, voffB); PG8_STAGE(PG8_SB(0, 1), cB + hstep, voffB); PG8_STAGE(PG8_SA(0, 0), cA, voffA); PG8_STAGE(PG8_SA(0, 1), cA + hstep, voffA);
        if (wr == 1) PG8_BAR;
        PG8_WAIT_V(2); PG8_BAR;
        PG8_STAGE(PG8_SB(1, 0), cB + kstep, voffB); PG8_STAGE(PG8_SA(1, 0), cA + kstep, voffA); PG8_STAGE(PG8_SB(1, 1), cB + hstep + kstep, voffB);
        PG8_WAIT_V(6); PG8_BAR;
    } else {
        PG8_STAGE(PG8_SB(0, 0), cB, voffB); PG8_STAGE(PG8_SA(0, 0), cA, voffA); PG8_STAGE(PG8_SB(0, 1), cB + hstep, voffB); PG8_STAGE(PG8_SA(0, 1), cA + hstep, voffA);
        if (wr == 1) PG8_BAR;
        PG8_WAIT_V(4); PG8_BAR;
        PG8_STAGE(PG8_SB(1, 0), cB + kstep, voffB); PG8_STAGE(PG8_SA(1, 0), cA + kstep, voffA); PG8_STAGE(PG8_SB(1, 1), cB + hstep + kstep, voffB);
        PG8_WAIT_V(6); PG8_BAR;
    }
    for (;;) {
        const bool has_next = S.next(ui + 1, nxt);
        const char* nA = has_next ? (const char*)g.A + (size_t)nxt.pm * tstep : cA; const char* nB = has_next ? (const char*)g.Bt + (size_t)nxt.pn * tstep : cB;
        for (int t = 0; t < nt; t += 2) {
            const bool last = (t == nt - 2);
            const char* a1 = cA + (size_t)(t + 1) * kstep;
            const char* a2 = last ? nA : cA + (size_t)(t + 2) * kstep; const char* b2 = last ? nB : cB + (size_t)(t + 2) * kstep;
            const char* a3 = a2 + kstep; const char* b3 = b2 + kstep;
            if (last && has_next) S.a_ready(nxt);
            if constexpr (SP2) {
            PG8_LDB(B0, 0, 0); PG8_LDB(B1, 0, 1); PG8_SCHED; PG8_LDA(At, 0, 0); PG8_STAGE(PG8_SA(1, 1), a1 + hstep, voffA);
            PG8_WAIT_V(8); PG8_WAIT_L(0); PG8_BAR; PG8_MMA(0, 0, At, B0); PG8_MMA(0, 1, At, B1); PG8_BAR; PG8_SCHED;
            PG8_LDA(At, 0, 1); PG8_STAGE(PG8_SB(0, 0), b2, voffB); PG8_STAGE(PG8_SB(0, 1), b2 + hstep, voffB); PG8_STAGE(PG8_SA(0, 0), a2, voffA);
            PG8_WAIT_V(8); PG8_WAIT_L(0); PG8_BAR; PG8_MMA(1, 0, At, B0); PG8_MMA(1, 1, At, B1); PG8_BAR; PG8_SCHED;
            PG8_LDB(B0, 1, 0); PG8_LDB(B1, 1, 1); PG8_SCHED; PG8_LDA(At, 1, 0); PG8_STAGE(PG8_SA(0, 1), a2 + hstep, voffA);
            PG8_WAIT_V(8); PG8_WAIT_L(0); PG8_BAR; PG8_MMA(0, 0, At, B0); PG8_MMA(0, 1, At, B1); PG8_BAR; PG8_SCHED;
            PG8_LDA(At, 1, 1); PG8_STAGE(PG8_SB(1, 0), b3, voffB); PG8_STAGE(PG8_SB(1, 1), b3 + hstep, voffB); PG8_STAGE(PG8_SA(1, 0), a3, voffA);
            PG8_WAIT_V(8); PG8_WAIT_L(0); PG8_BAR; PG8_MMA(1, 0, At, B0); PG8_MMA(1, 1, At, B1); PG8_BAR; PG8_SCHED;
            } else {
            PG8_LDB(B0, 0, 0); PG8_SCHED; PG8_LDA(At, 0, 0); PG8_STAGE(PG8_SA(1, 1), a1 + hstep, voffA);
            PG8_WAIT_L(8); PG8_BAR; PG8_WAIT_L(0); PG8_MMA(0, 0, At, B0); PG8_BAR; PG8_SCHED;
            PG8_LDB(B1, 0, 1); PG8_STAGE(PG8_SB(0, 0), b2, voffB);
            PG8_BAR; PG8_WAIT_L(0); PG8_MMA(0, 1, At, B1); PG8_BAR;
            PG8_LDA(At, 0, 1); PG8_STAGE(PG8_SA(0, 0), a2, voffA);
            PG8_BAR; PG8_WAIT_L(0); PG8_MMA(1, 0, At, B0); PG8_BAR; PG8_SCHED;
            PG8_STAGE(PG8_SB(0, 1), b2 + hstep, voffB);
            PG8_WAIT_V(6); PG8_BAR; PG8_MMA(1, 1, At, B1); PG8_BAR;
            PG8_LDB(B0, 1, 0); PG8_SCHED; PG8_LDA(At, 1, 0); PG8_STAGE(PG8_SA(0, 1), a2 + hstep, voffA);
            PG8_WAIT_L(8); PG8_BAR; PG8_WAIT_L(0); PG8_MMA(0, 0, At, B0); PG8_BAR; PG8_SCHED;
            PG8_LDB(B1, 1, 1); PG8_STAGE(PG8_SB(1, 0), b3, voffB);
            PG8_BAR; PG8_WAIT_L(0); PG8_MMA(0, 1, At, B1); PG8_BAR;
            PG8_LDA(At, 1, 1); PG8_STAGE(PG8_SA(1, 0), a3, voffA);
            PG8_BAR; PG8_WAIT_L(0); PG8_MMA(1, 0, At, B0); PG8_BAR; PG8_SCHED;
            PG8_STAGE(PG8_SB(1, 1), b3 + hstep, voffB);
            PG8_WAIT_V(6); PG8_BAR; PG8_MMA(1, 1, At, B1); PG8_BAR;
            }
        }
        if constexpr (ALIGN_EPI) { if (wr == 0) PG8_BAR; }
        if constexpr (!Epi::AFTER_DRAIN) { E(acc, cur, wr, wc, fr, fq); S.done(cur); }
        if (!has_next) break;
#pragma unroll
        for (int a = 0; a < 2; ++a)
#pragma unroll
            for (int b = 0; b < 2; ++b)
#pragma unroll
                for (int m = 0; m < 4; ++m)
#pragma unroll
                    for (int n = 0; n < 2; ++n) acc[a][b][m][n] = (f32x4){0.f, 0.f, 0.f, 0.f};
        cur = nxt; cA = nA; cB = nB; ++ui;
        if constexpr (ALIGN_EPI) { if (wr == 1) PG8_BAR; }
    }
    PG8_WAIT_V(0);
    if constexpr (!ALIGN_EPI) { if (wr == 0) PG8_BAR; }
    PG8_BAR;
    if constexpr (Epi::AFTER_DRAIN) { E.fused(acc, cur, wr, wc, fr, fq, lds, wid, lane); S.done(cur); }
#undef PG8_SA
#undef PG8_SB
#undef PG8_STAGE
#undef PG8_LDA
#undef PG8_LDB
#undef PG8_MMA
#undef PG8_WAIT_V
#undef PG8_WAIT_L
#undef PG8_BAR
#undef PG8_SCHED
}
}

#ifndef PG8_SP2
#define PG8_SP2 true
#endif
#ifndef PG8_ALIGN
#define PG8_ALIGN true
#endif

#define DI __device__ __forceinline__
typedef unsigned short bf16;
typedef short bf16x8 __attribute__((ext_vector_type(8)));
typedef float f32x4 __attribute__((ext_vector_type(4)));
typedef float f32x16 __attribute__((ext_vector_type(16)));
typedef unsigned u32x4 __attribute__((ext_vector_type(4)));
typedef unsigned u32x2 __attribute__((ext_vector_type(2)));
#define MFMA32(a, b, c) __builtin_amdgcn_mfma_f32_32x32x16_bf16((a), (b), (c), 0, 0, 0)

constexpr int NWAVES = 8, NTHR = 512;
constexpr int M = 16384, D = 1024, FF = 2816, INW = 2816, SEQ = 8192, DEPTH = 4;
constexpr int LDS_BYTES = 147456;
constexpr size_t MiB = 1u << 20;
constexpr size_t WS_CTL = 0;
constexpr size_t WS_STATS = 1 * MiB;
constexpr size_t WS_KMP = 2 * MiB;
constexpr size_t WS_DEC = 2 * MiB + 512 * 1024;
constexpr size_t WS_ROPEC = 3 * MiB, WS_ROPES = 4 * MiB;
constexpr size_t WS_W = 5 * MiB, WSZ = 42467328;
constexpr size_t W_GU1 = 0, W_D1 = 11534336, W_IN = 17301504, W_OUT = 23068672, W_GU2 = 25165824, W_D2 = 36700160;
constexpr size_t WS_XB = 86 * MiB;
constexpr size_t WS_R = 118 * MiB;
constexpr size_t R_HID = 0;
constexpr size_t R_Q = 0, R_K = 16 * MiB, R_V = 32 * MiB, R_U5 = 48 * MiB  , R_Y = 88 * MiB, R_PO = 120 * MiB, R_PML = 168 * MiB,
                 R_LIST = 172 * MiB  , R_ALOC = 188 * MiB, R_OINTRA = 204 * MiB, R_QDEC = 220 * MiB, R_SP = 228 * MiB, R_END = 236 * MiB;
constexpr size_t WS_END = WS_R + R_END;

DI float bf2f(unsigned short b) { return __uint_as_float((unsigned)b << 16); }
DI unsigned cvtpk(float lo, float hi) { return pg8::cvtpk(lo, hi); }
DI float wave_sum(float v) {
#pragma unroll
    for (int o = 1; o < 64; o <<= 1) v += __shfl_xor(v, o);
    return v;
}
DI void st_sc1(unsigned* p, unsigned v) { __hip_atomic_store(p, v, __ATOMIC_RELAXED, __HIP_MEMORY_SCOPE_AGENT); }
DI unsigned ld_sc1(const unsigned* p) { return __hip_atomic_load(p, __ATOMIC_RELAXED, __HIP_MEMORY_SCOPE_AGENT); }
DI float ld_sc1f(const float* p) { return __uint_as_float(__hip_atomic_load((const unsigned*)p, __ATOMIC_RELAXED, __HIP_MEMORY_SCOPE_AGENT)); }
DI int crow(int reg, int h) { return (reg & 3) + 8 * (reg >> 2) + 4 * h; }
DI bf16x8 pack8(const f32x16& x, int s) {
    u32x4 p; p.x = cvtpk(x[8 * s], x[8 * s + 1]); p.y = cvtpk(x[8 * s + 2], x[8 * s + 3]); p.z = cvtpk(x[8 * s + 4], x[8 * s + 5]); p.w = cvtpk(x[8 * s + 6], x[8 * s + 7]);
    return __builtin_bit_cast(bf16x8, p);
}
DI f32x16 zero16() { f32x16 z;
#pragma unroll
    for (int i = 0; i < 16; ++i) z[i] = 0.f; return z; }

struct Args { const float* in[18]; float* out; unsigned char* ws; int ph_lo, ph_hi; };
typedef const float* cfp_t;
typedef const __attribute__((address_space(4))) unsigned char* kptr_t;
struct Ctx { kptr_t kp; unsigned char* ws; float* out;
    DI const float* in(int i) const { return *(const __attribute__((address_space(4))) cfp_t*)(kp + 8 * i); } };
enum { I_X = 0, I_F1N, I_F1G, I_F1U, I_F1D, I_MIXN, I_WIN, I_QN, I_KN, I_PW, I_PS, I_LB, I_HON, I_WOUT, I_F2N, I_F2G, I_F2U, I_F2D };

DI void wconv_tile(const float* W, int ld, int srccol, const float* gain, bf16* WT, int K, int nrow0, int k0, float* scr, int lane) {
    asm volatile("" : "+v"(lane));
#pragma unroll 8
    for (int i = 0; i < 32; ++i) { const int kk = 2 * i + (lane >> 5); float v = W[(size_t)(k0 + kk) * ld + srccol + (lane & 31)]; if (gain) v *= gain[k0 + kk]; scr[kk * 33 + (lane & 31)] = v; }
    asm volatile("s_waitcnt lgkmcnt(0)" ::: "memory");
    const int c = lane & 7;
#pragma unroll
    for (int j = 0; j < 4; ++j) { const int n = (lane >> 3) + 8 * j; const float* s = scr + (8 * c) * 33 + n;
        u32x4 o; o.x = cvtpk(s[0 * 33], s[1 * 33]); o.y = cvtpk(s[2 * 33], s[3 * 33]); o.z = cvtpk(s[4 * 33], s[5 * 33]); o.w = cvtpk(s[6 * 33], s[7 * 33]);
        *(u32x4*)(WT + (size_t)(nrow0 + n) * K + k0 + 8 * c) = o; }
    asm volatile("s_waitcnt lgkmcnt(0)" ::: "memory");
}
constexpr int WC_I0 = 2816, WC_I1 = 1408, WC_I2 = 1408, WC_I3 = 512, WC_I4 = 2816, WC_I5 = 1408, WC_ITEMS = WC_I0 + WC_I1 + WC_I2 + WC_I3 + WC_I4 + WC_I5;
DI void wconv_item(const Ctx& a, int L, int item, float* scr, int lane) {
    unsigned char* wb = a.ws + WS_W + (size_t)(L & 1) * WSZ;
    int r = item;
    if (r < WC_I0 || (r >= WC_I0 + WC_I1 + WC_I2 + WC_I3 && r < WC_I0 + WC_I1 + WC_I2 + WC_I3 + WC_I4)) {
        const bool second = r >= WC_I0; if (second) r -= WC_I0 + WC_I1 + WC_I2 + WC_I3;
        const int kb = r / 176, nb = r % 176, n0 = nb * 32, pn = n0 >> 8, c = n0 & 255, bj = c >> 7, col = 128 * pn + (c & 127);
        const float* src = a.in(second ? (bj ? I_F2U : I_F2G) : (bj ? I_F1U : I_F1G)) + (size_t)L * D * FF;
        const float* gain = a.in(second ? I_F2N : I_F1N) + L * D;
        wconv_tile(src, FF, col, gain, (bf16*)(wb + (second ? W_GU2 : W_GU1)), D, n0, kb * 64, scr, lane); return;
    }
    r -= WC_I0;
    if (r < WC_I1) { const int kb = r / 32, nb = r % 32; wconv_tile(a.in(I_F1D) + (size_t)L * FF * D, D, nb * 32, nullptr, (bf16*)(wb + W_D1), FF, nb * 32, kb * 64, scr, lane); return; }
    r -= WC_I1;
    if (r < WC_I2) { const int kb = r / 88, nb = r % 88, n0 = nb * 32, pn = n0 >> 8, c = n0 & 255;
        const int col = pn < 6 ? (pn >> 1) * 512 + 64 * ((pn & 1) * 4 + ((c >> 5) & 3)) + 32 * (c >> 7) : n0;
        wconv_tile(a.in(I_WIN) + (size_t)L * D * INW, INW, col, a.in(I_MIXN) + L * D, (bf16*)(wb + W_IN), D, n0, kb * 64, scr, lane); return; }
    r -= WC_I2;
    if (r < WC_I3) { const int kb = r / 32, nb = r % 32; wconv_tile(a.in(I_WOUT) + (size_t)L * D * D, D, nb * 32, nullptr, (bf16*)(wb + W_OUT), D, nb * 32, kb * 64, scr, lane); return; }
    r -= WC_I3 + WC_I4;
    { const int kb = r / 32, nb = r % 32; wconv_tile(a.in(I_F2D) + (size_t)L * FF * D, D, nb * 32, nullptr, (bf16*)(wb + W_D2), FF, nb * 32, kb * 64, scr, lane); }
}

DI void phase_p0(const Ctx& a, unsigned char* lds, int gw, int NGW, int wave, int lane) {
    const float* x = a.in(I_X); float* out = a.out; bf16* xb = (bf16*)(a.ws + WS_XB); float* stats = (float*)(a.ws + WS_STATS);
    for (int m = gw; m < M; m += NGW) {
        const f32x4* xr = (const f32x4*)(x + (size_t)m * D) + lane; f32x4 v[4]; float s = 0.f;
#pragma unroll
        for (int j = 0; j < 4; ++j) { v[j] = xr[64 * j]; s += (v[j][0] * v[j][0] + v[j][1] * v[j][1]) + (v[j][2] * v[j][2] + v[j][3] * v[j][3]); }
        s = wave_sum(s);
        f32x4* orow = (f32x4*)(out + (size_t)m * D) + lane; u32x2* brow = (u32x2*)(xb + (size_t)m * D) + lane;
#pragma unroll
        for (int j = 0; j < 4; ++j) { orow[64 * j] = v[j]; u32x2 w; w.x = cvtpk(v[j][0], v[j][1]); w.y = cvtpk(v[j][2], v[j][3]); brow[64 * j] = w; }
        if (lane < 16) stats[(size_t)m * 16 + lane] = (lane == 0) ? s : 0.f;
    }
    { unsigned* cz = (unsigned*)(a.ws + WS_CTL + 65536); for (int i = gw * 64 + lane; i < 3456; i += NGW * 64) cz[i] = 0u; }
    float* rc = (float*)(a.ws + WS_ROPEC); float* rs = (float*)(a.ws + WS_ROPES);
    for (int e = gw * 64 + lane; e < SEQ * 32; e += NGW * 64) {
        const int t = e >> 5, i = e & 31;
        double c = 0.15915494309189535;
        for (int k = 0; k < i; ++k) c *= 0.74989420933245582;
        const float chi = (float)c, clo = (float)(c - (double)chi), tf = (float)t;
        const float p = tf * chi, pe = fmaf(tf, chi, -p);
        float fr = __builtin_amdgcn_fractf(p) + (pe + tf * clo);
        rc[e] = __builtin_amdgcn_cosf(fr); rs[e] = __builtin_amdgcn_sinf(fr);
    }
    float* scr = (float*)(lds + wave * 16384);
    for (int it = gw; it < WC_ITEMS; it += NGW) wconv_item(a, 0, it, scr, lane);
}

template <bool DIAG>
DI void attn_core(const bf16* qrow, const bf16* kblk, const bf16* vblk, int nkg, int r, int h, float& m_out, float& l_out, f32x16 (&ot)[2]) {
    bf16x8 qf[4];
#pragma unroll
    for (int ks = 0; ks < 4; ++ks) qf[ks] = *(const bf16x8*)(qrow + 16 * ks + 8 * h);
    f32x16 st[8];
    const int lo = (r * 2 + h) * 8;
#pragma unroll
    for (int hf = 0; hf < 2; ++hf) {
        if (!DIAG || 4 * hf < nkg) {
            bf16x8 kf[16];
#pragma unroll
            for (int i = 0; i < 16; ++i) kf[i] = (!DIAG || 4 * hf + (i >> 2) < nkg) ? *(const bf16x8*)(kblk + ((4 * hf + (i >> 2)) * 4 + (i & 3)) * 512 + lo) : qf[0];
#pragma unroll
            for (int g = 0; g < 4; ++g) {
                const int kg = 4 * hf + g;
                f32x16 acc = zero16();
                if (!DIAG || kg < nkg) {
#pragma unroll
                    for (int ks = 0; ks < 4; ++ks) acc = MFMA32(kf[4 * g + ks], qf[ks], acc);
                    if (DIAG && kg == nkg - 1) {
#pragma unroll
                        for (int i = 0; i < 16; ++i) if (crow(i, h) > r) acc[i] = -INFINITY;
                    }
                } else {
#pragma unroll
                    for (int i = 0; i < 16; ++i) acc[i] = -INFINITY;
                }
                st[kg] = acc;
            }
        } else {
#pragma unroll
            for (int g = 0; g < 4; ++g)
#pragma unroll
                for (int i = 0; i < 16; ++i) st[4 * hf + g][i] = -INFINITY;
        }
    }
    float mx = -INFINITY;
#pragma unroll
    for (int kg = 0; kg < 8; ++kg)
#pragma unroll
        for (int i = 0; i < 16; ++i) mx = fmaxf(mx, st[kg][i]);
    mx = fmaxf(mx, __shfl_xor(mx, 32));
    const float c = 0.125f * 1.4426950408889634f; const float mc = mx * c;
    float l = 0.f;
#pragma unroll
    for (int kg = 0; kg < 8; ++kg)
#pragma unroll
        for (int i = 0; i < 16; ++i) { const float p = __builtin_amdgcn_exp2f(st[kg][i] * c - mc); st[kg][i] = p; l += p; }
    l += __shfl_xor(l, 32);
    ot[0] = zero16(); ot[1] = zero16();
#pragma unroll
    for (int pr = 0; pr < 4; ++pr) {
        if (!DIAG || 2 * pr < nkg) {
            bf16x8 vf[8];
#pragma unroll
            for (int i = 0; i < 8; ++i) vf[i] = (!DIAG || 2 * pr + (i >> 2) < nkg) ? *(const bf16x8*)(vblk + (((2 * pr + (i >> 2)) * 2 + ((i >> 1) & 1)) * 2 + (i & 1)) * 512 + lo) : qf[0];
#pragma unroll
            for (int g = 0; g < 2; ++g) {
                const int kg = 2 * pr + g;
                if (!DIAG || kg < nkg) {
#pragma unroll
                    for (int s2 = 0; s2 < 2; ++s2) { const bf16x8 pf = pack8(st[kg], s2); ot[0] = MFMA32(vf[4 * g + 2 * s2], pf, ot[0]); ot[1] = MFMA32(vf[4 * g + 2 * s2 + 1], pf, ot[1]); }
                }
            }
        }
    }
    m_out = mx * 0.125f; l_out = l;
}

DI void topk_unit(const Ctx& a, int L, int unit, int lane) {
    asm volatile("" : "+v"(lane));
    const int b = unit >> 10, hd = (unit >> 7) & 7, c = unit & 127, own = c >> 2;
    if (own == 0) return;
    const bf16* Q = (const bf16*)(a.ws + WS_R + R_Q); const float* kmp = (const float*)(a.ws + WS_KMP);
    unsigned* cnt = (unsigned*)(a.ws + WS_CTL) + L * 512; unsigned* lists = (unsigned*)(a.ws + WS_R + R_LIST);
    const int t = c * 64 + lane; const size_t bh = (size_t)(b * 8 + hd);
    float q[64];
    { const u32x4* qp = (const u32x4*)(Q + (bh * SEQ + t) * 64);
#pragma unroll
      for (int i = 0; i < 8; ++i) { const u32x4 w = qp[i];
          q[8 * i + 0] = __uint_as_float(w.x << 16); q[8 * i + 1] = __uint_as_float(w.x & 0xffff0000u); q[8 * i + 2] = __uint_as_float(w.y << 16); q[8 * i + 3] = __uint_as_float(w.y & 0xffff0000u);
          q[8 * i + 4] = __uint_as_float(w.z << 16); q[8 * i + 5] = __uint_as_float(w.z & 0xffff0000u); q[8 * i + 6] = __uint_as_float(w.w << 16); q[8 * i + 7] = __uint_as_float(w.w & 0xffff0000u); } }
    float g0 = -INFINITY, g1 = -INFINITY, g2 = -INFINITY; int i0 = 0, i1 = 0, i2 = 0;
    for (int j = 0; j < own; ++j) {
        const float* p0 = kmp + (size_t)((b * 32 + j) * 2) * 512 + hd * 64; const float* p1 = p0 + 512;
        float g = 0.f;
#pragma unroll
        for (int d = 0; d < 64; d += 4) { const f32x4 x0 = *(const f32x4*)(p0 + d), x1 = *(const f32x4*)(p1 + d);
            g += q[d] * (x0[0] + x1[0]) + q[d + 1] * (x0[1] + x1[1]) + q[d + 2] * (x0[2] + x1[2]) + q[d + 3] * (x0[3] + x1[3]); }
#ifdef DBG_FIXED_SEL
        g = -(float)j;
#endif
        if (g > g0) { g2 = g1; i2 = i1; g1 = g0; i1 = i0; g0 = g; i0 = j; }
        else if (g > g1) { g2 = g1; i2 = i1; g1 = g; i1 = j; }
        else if (g > g2) { g2 = g; i2 = j; }
    }
    const int nsel = own < 3 ? own : 3;
#pragma unroll
    for (int s = 0; s < 3; ++s) {
        if (s < nsel) { const int j = s == 0 ? i0 : (s == 1 ? i1 : i2); const int li = (int)bh * 32 + j;
            const unsigned pos = atomicAdd(cnt + li, 1u); st_sc1(lists + (size_t)li * 8192 + pos, (unsigned)(t | (s << 13))); }
    }
}

DI void pool_unit(const Ctx& a, int L, int unit, int lane) {
    asm volatile("" : "+v"(lane));
    const int tile = unit >> 2, g = unit & 3, w = 2 << g, r = lane & 31, h = lane >> 5;
    const bf16* U = (const bf16*)(a.ws + WS_R + R_U5); bf16* Y = (bf16*)(a.ws + WS_R + R_Y);
    const float* pw = a.in(I_PW) + (size_t)(L * 4 + g) * 4096; const float* ps = a.in(I_PS) + L * 256 + g * 64;
    const float* pwl = pw + (8 * h) * 64 + r;
    bf16x8 wf[2][4];
#pragma unroll
    for (int me = 0; me < 2; ++me)
#pragma unroll
        for (int ks = 0; ks < 4; ++ks) { float f[8];
#pragma unroll
            for (int j = 0; j < 8; ++j) f[j] = pwl[(16 * ks + j) * 64 + 32 * me];
            u32x4 p; p.x = cvtpk(f[0], f[1]); p.y = cvtpk(f[2], f[3]); p.z = cvtpk(f[4], f[5]); p.w = cvtpk(f[6], f[7]); wf[me][ks] = __builtin_bit_cast(bf16x8, p); }
#pragma unroll 1
    for (int nt = 0; nt < 4; ++nt) {
        const int m = tile * 128 + nt * 32 + r, tpos = m & (SEQ - 1);
        const int cntw = tpos + 1 < w ? tpos + 1 : w; const float invc = 1.0f / (float)cntw;
        f32x16 acc[2]; acc[0] = zero16(); acc[1] = zero16();
#pragma unroll
        for (int ks = 0; ks < 4; ++ks) {
            const bf16* up = U + (size_t)m * 256 + g * 64 + 16 * ks + 8 * h;
            float sum[8], self[8];
            { const u32x4 wv = *(const u32x4*)up;
              self[0] = __uint_as_float(wv.x << 16); self[1] = __uint_as_float(wv.x & 0xffff0000u); self[2] = __uint_as_float(wv.y << 16); self[3] = __uint_as_float(wv.y & 0xffff0000u);
              self[4] = __uint_as_float(wv.z << 16); self[5] = __uint_as_float(wv.z & 0xffff0000u); self[6] = __uint_as_float(wv.w << 16); self[7] = __uint_as_float(wv.w & 0xffff0000u); }
#pragma unroll
            for (int j = 0; j < 8; ++j) sum[j] = self[j];
#pragma unroll 8
            for (int i = 1; i < w; ++i) {
                const bool ok = i <= tpos; const u32x4 wv = *(const u32x4*)(up - (size_t)(ok ? i : 0) * 256); const float kf = ok ? 1.f : 0.f;
                sum[0] += kf * __uint_as_float(wv.x << 16); sum[1] += kf * __uint_as_float(wv.x & 0xffff0000u); sum[2] += kf * __uint_as_float(wv.y << 16); sum[3] += kf * __uint_as_float(wv.y & 0xffff0000u);
                sum[4] += kf * __uint_as_float(wv.z << 16); sum[5] += kf * __uint_as_float(wv.z & 0xffff0000u); sum[6] += kf * __uint_as_float(wv.w << 16); sum[7] += kf * __uint_as_float(wv.w & 0xffff0000u); }
            u32x4 p; p.x = cvtpk(sum[0] * invc - self[0], sum[1] * invc - self[1]); p.y = cvtpk(sum[2] * invc - self[2], sum[3] * invc - self[3]);
            p.z = cvtpk(sum[4] * invc - self[4], sum[5] * invc - self[5]); p.w = cvtpk(sum[6] * invc - self[6], sum[7] * invc - self[7]);
            const bf16x8 df = __builtin_bit_cast(bf16x8, p);
            acc[0] = MFMA32(wf[0][ks], df, acc[0]); acc[1] = MFMA32(wf[1][ks], df, acc[1]);
        }
#pragma unroll
        for (int me = 0; me < 2; ++me)
#pragma unroll
            for (int gq = 0; gq < 4; ++gq) { const int e0 = 32 * me + 8 * gq + 4 * h; const f32x4 sc = *(const f32x4*)(ps + e0);
                u32x2 o; o.x = cvtpk(acc[me][4 * gq] * sc[0], acc[me][4 * gq + 1] * sc[1]); o.y = cvtpk(acc[me][4 * gq + 2] * sc[2], acc[me][4 * gq + 3] * sc[3]);
                *(u32x2*)(Y + (size_t)m * 1024 + 512 + g * 64 + e0) = o; }
    }
}

DI void h1_unit(const Ctx& a, int L, int unit, unsigned char* sm, int lane) {
    asm volatile("" : "+v"(lane));
    const int b = unit >> 9, hh = (unit >> 7) & 3, n = unit & 127, r = lane & 31, h = lane >> 5;
    const int row0 = b * SEQ + n * 64, ch = hh * 64 + lane;
    const bf16* QH = (const bf16*)(a.ws + WS_R + R_U5) + (size_t)1 * M * 256; const bf16* FH = QH + (size_t)M * 256; const bf16* IH = FH + (size_t)M * 256;
    bf16* QDEC = (bf16*)(a.ws + WS_R + R_QDEC); float* ALOC = (float*)(a.ws + WS_R + R_ALOC); float* OINTRA = (float*)(a.ws + WS_R + R_OINTRA); float* DEC = (float*)(a.ws + WS_DEC);
    bf16* KD = (bf16*)sm; bf16* IT = (bf16*)(sm + 8192); bf16* Am = (bf16*)(sm + 16384); bf16* Bm = (bf16*)(sm + 24576);
    float lb;
    { const float* lp = a.in(I_LB) + ch; const float x0 = lp[0], x1 = lp[256], x2 = lp[512], x3 = lp[768];
      const float mx = fmaxf(fmaxf(x0, x1), fmaxf(x2, x3)); const float e0 = __expf(x0 - mx), e1 = __expf(x1 - mx), e2 = __expf(x2 - mx), e3 = __expf(x3 - mx);
      const float inv = 1.0f / (e0 + e1 + e2 + e3); float acc = 0.f; if (L > 0) acc += e0; if (L > 1) acc += e1; if (L > 2) acc += e2; lb = acc * inv; }
    const float loglb = __logf(fmaxf(lb, 1e-20f)), l1m = __logf(1.0f - lb), oml = 1.0f - lb;
    float zr[64];
#pragma unroll
    for (int s = 0; s < 64; ++s) zr[s] = bf2f(FH[(size_t)(row0 + s) * 256 + ch]);
    float cum = 0.f, ref = 0.f;
#pragma unroll
    for (int s = 0; s < 64; ++s) {
        const float z = zr[s];
        const float ls = fminf(z, 0.f) - __logf(1.0f + __expf(-fabsf(z)));
        const float bb = l1m + ls, hi = fmaxf(loglb, bb), df = fabsf(loglb - bb);
        cum += hi + __logf(1.0f + __expf(-df));
        asm volatile("" : "+v"(cum));
        if (s == 31) ref = cum;
    }
    const float last = cum;
    DEC[unit * 64 + lane] = __expf(last);
    cum = 0.f;
#ifndef H1_NO_P2
#pragma unroll 1
    for (int s8 = 0; s8 < 8; ++s8) {
        unsigned kp[4], ip[4]; float kd8[8]; unsigned short i8[8];
#pragma unroll
        for (int j = 0; j < 8; ++j) {
            const int s = s8 * 8 + j; const size_t gi = (size_t)(row0 + s) * 256 + ch;
            const float z = bf2f(FH[gi]), qv = bf2f(QH[gi]); i8[j] = IH[gi];
            const float ls = fminf(z, 0.f) - __logf(1.0f + __expf(-fabsf(z)));
            const float bb = l1m + ls, hi = fmaxf(loglb, bb), df = fabsf(loglb - bb);
            cum += hi + __logf(1.0f + __expf(-df));
            const float key = oml * __builtin_amdgcn_rcpf(1.0f + __expf(z));
            const float qs = qv * __builtin_amdgcn_rcpf(1.0f + __expf(-qv)) * 0.125f;
            const float av = qs * __expf(fminf(cum - ref, 80.f)), bv = key * __expf(fminf(ref - cum, 80.f)), qd = qs * __expf(cum);
            kd8[j] = key * __expf(last - cum);
#ifndef H1_NO_AB
            Am[s * 64 + lane] = (bf16)(cvtpk(av, 0.f) & 0xffffu); Bm[s * 64 + lane] = (bf16)(cvtpk(bv, 0.f) & 0xffffu);
#endif
#ifndef H1_NO_QD
            QDEC[gi] = (bf16)(cvtpk(qd, 0.f) & 0xffffu);
#endif
        }
#pragma unroll
        for (int j = 0; j < 4; ++j) { kp[j] = cvtpk(kd8[2 * j], kd8[2 * j + 1]); ip[j] = (unsigned)i8[2 * j] | ((unsigned)i8[2 * j + 1] << 16); }
        *(u32x4*)(KD + lane * 64 + s8 * 8) = (u32x4){kp[0], kp[1], kp[2], kp[3]};
        *(u32x4*)(IT + lane * 64 + s8 * 8) = (u32x4){ip[0], ip[1], ip[2], ip[3]};
    }
#endif
    asm volatile("s_waitcnt lgkmcnt(0)" ::: "memory");
#ifndef H1_NO_MM
    bf16x8 itf[2][2][2];
#pragma unroll
    for (int mv = 0; mv < 2; ++mv)
#pragma unroll
        for (int ms = 0; ms < 2; ++ms)
#pragma unroll
            for (int st = 0; st < 2; ++st) { const bf16* p = IT + (32 * mv + r) * 64 + 32 * ms + 16 * st + 4 * h; const u32x2 x0 = *(const u32x2*)p, x1 = *(const u32x2*)(p + 8);
                itf[mv][ms][st] = __builtin_bit_cast(bf16x8, ((u32x4){x0.x, x0.y, x1.x, x1.y})); }
    float* alb = ALOC + (size_t)unit * 4096 + (4 * h) * 64 + r;
#pragma unroll
    for (int nk = 0; nk < 2; ++nk) {
        bf16x8 kdf[2][2];
#pragma unroll
        for (int ms = 0; ms < 2; ++ms)
#pragma unroll
            for (int st = 0; st < 2; ++st) { const bf16* p = KD + (32 * nk + r) * 64 + 32 * ms + 16 * st + 4 * h; const u32x2 x0 = *(const u32x2*)p, x1 = *(const u32x2*)(p + 8);
                kdf[ms][st] = __builtin_bit_cast(bf16x8, ((u32x4){x0.x, x0.y, x1.x, x1.y})); }
#pragma unroll
        for (int mv = 0; mv < 2; ++mv) {
            f32x16 acc = zero16();
#pragma unroll
            for (int ms = 0; ms < 2; ++ms)
#pragma unroll
                for (int st = 0; st < 2; ++st) acc = MFMA32(itf[mv][ms][st], kdf[ms][st], acc);
#pragma unroll
            for (int i = 0; i < 16; ++i) alb[(32 * mv + (i & 3) + 8 * (i >> 2)) * 64 + 32 * nk] = acc[i];
        }
    }
#pragma unroll
    for (int nt = 0; nt < 2; ++nt) {
        bf16x8 af[4];
#pragma unroll
        for (int ks = 0; ks < 4; ++ks) af[ks] = *(const bf16x8*)(Am + (32 * nt + r) * 64 + 16 * ks + 8 * h);
        f32x16 oi[2]; oi[0] = zero16(); oi[1] = zero16();
#pragma unroll
        for (int ms = 0; ms < 2; ++ms) {
            if (ms <= nt) {
                f32x16 sacc = zero16();
#pragma unroll
                for (int ks = 0; ks < 4; ++ks) { const bf16x8 bf_ = *(const bf16x8*)(Bm + (32 * ms + r) * 64 + 16 * ks + 8 * h); sacc = MFMA32(bf_, af[ks], sacc); }
                if (ms == nt) {
#pragma unroll
                    for (int i = 0; i < 16; ++i) if (crow(i, h) > r) sacc[i] = 0.f;
                }
#pragma unroll
                for (int st = 0; st < 2; ++st) { const bf16x8 pf = pack8(sacc, st); oi[0] = MFMA32(itf[0][ms][st], pf, oi[0]); oi[1] = MFMA32(itf[1][ms][st], pf, oi[1]); }
            }
        }
        const size_t orow = (size_t)(row0 + 32 * nt + r) * 256 + hh * 64;
#pragma unroll
        for (int mv = 0; mv < 2; ++mv)
#pragma unroll
            for (int gq = 0; gq < 4; ++gq) *(f32x4*)(OINTRA + orow + 32 * mv + 8 * gq + 4 * h) = (f32x4){oi[mv][4 * gq], oi[mv][4 * gq + 1], oi[mv][4 * gq + 2], oi[mv][4 * gq + 3]};
    }
#endif
    asm volatile("s_waitcnt lgkmcnt(0)" ::: "memory");
}

DI void phase_t(const Ctx& a, int L, unsigned char* lds, int gw, int NGW, int wave, int lane) {
#ifndef NO_POOL
    for (int u = gw; u < 2048; u += NGW) pool_unit(a, L, u, lane);
#endif
#ifndef NO_WC
#ifdef DBG_WC_ALWAYS
    { float* scr = (float*)(lds + wave * 16384); for (int it = gw; it < WC_ITEMS; it += NGW) wconv_item(a, (L + 1) & 3, it, scr, lane); }
#else
    if (L + 1 < DEPTH) { float* scr = (float*)(lds + wave * 16384); for (int it = gw; it < WC_ITEMS; it += NGW) wconv_item(a, L + 1, it, scr, lane); }
#endif
#endif
    __syncthreads();
#ifndef NO_H1
    if (wave < 4) { const int hw = (gw >> 3) * 4 + wave, NHW = (NGW >> 3) * 4; for (int u = hw; u < 1024; u += NHW) h1_unit(a, L, u, lds + wave * 32768, lane); }
#endif
}

DI void attn_unit(const Ctx& a, int bh, int qb, unsigned char* lds, int tid, int wave, int lane) {
    asm volatile("" : "+v"(lane), "+v"(tid));
    const int r = lane & 31, h = lane >> 5, b = bh >> 3, hd = bh & 7, own = qb, nsel = own < 3 ? own : 3;
    const bf16* Q = (const bf16*)(a.ws + WS_R + R_Q); const bf16* Kb = (const bf16*)(a.ws + WS_R + R_K); const bf16* Vb = (const bf16*)(a.ws + WS_R + R_V);
    const float* kmp = (const float*)(a.ws + WS_KMP); bf16* Y = (bf16*)(a.ws + WS_R + R_Y);
    unsigned char* part = lds;
    unsigned short* llist = (unsigned short*)(lds + 104448);
    int* lcnt = (int*)(lds + 120832); int* itab = lcnt + 32;
    const size_t qbase = ((size_t)bh * SEQ + (size_t)qb * 256) * 64;
    if (own > 0) {
        if (tid < 32) lcnt[tid] = 0;
        float* km = (float*)(lds + 122880);
        for (int idx = tid; idx < own * 64; idx += NTHR) { const float* p0 = kmp + (size_t)((b * 32 + (idx >> 6)) * 2) * 512 + hd * 64 + (idx & 63); km[idx] = p0[0] + p0[512]; }
        __syncthreads();
        if (tid < 256) {
            float q[64];
            { const u32x4* qp = (const u32x4*)(Q + qbase + (size_t)tid * 64);
#pragma unroll
              for (int i = 0; i < 8; ++i) { const u32x4 w = qp[i];
                  q[8 * i + 0] = __uint_as_float(w.x << 16); q[8 * i + 1] = __uint_as_float(w.x & 0xffff0000u); q[8 * i + 2] = __uint_as_float(w.y << 16); q[8 * i + 3] = __uint_as_float(w.y & 0xffff0000u);
                  q[8 * i + 4] = __uint_as_float(w.z << 16); q[8 * i + 5] = __uint_as_float(w.z & 0xffff0000u); q[8 * i + 6] = __uint_as_float(w.w << 16); q[8 * i + 7] = __uint_as_float(w.w & 0xffff0000u); } }
            float g0 = -INFINITY, g1 = -INFINITY, g2 = -INFINITY; int i0 = 0, i1 = 0, i2 = 0;
            for (int j = 0; j < own; ++j) {
                const float* kj = km + j * 64;
                float g = 0.f;
#pragma unroll
                for (int d = 0; d < 64; d += 4) { const f32x4 x0 = *(const f32x4*)(kj + d);
                    g += q[d] * x0[0] + q[d + 1] * x0[1] + q[d + 2] * x0[2] + q[d + 3] * x0[3]; }
                if (g > g0) { g2 = g1; i2 = i1; g1 = g0; i1 = i0; g0 = g; i0 = j; }
                else if (g > g1) { g2 = g1; i2 = i1; g1 = g; i1 = j; }
                else if (g > g2) { g2 = g; i2 = j; }
            }
#pragma unroll
            for (int s = 0; s < 3; ++s) {
                if (s < nsel) { const int j = s == 0 ? i0 : (s == 1 ? i1 : i2); const int pos = atomicAdd(lcnt + j, 1); llist[j * 256 + pos] = (unsigned short)(tid | (s << 8)); }
            }
        }
        __syncthreads();
        if (tid == 0) { int n = 0; for (int j = 0; j < own; ++j) { const int ng = (lcnt[j] + 31) >> 5; for (int g = 0; g < ng; ++g) itab[n++] = j | (g << 8); } itab[64] = n; }
        __syncthreads();
        const int nitems = __builtin_amdgcn_readfirstlane(itab[64]);
        for (int it = wave; it < nitems; it += NWAVES) {
            const int ent = __builtin_amdgcn_readfirstlane(itab[it]); const int j = ent & 255, g = ent >> 8, n = __builtin_amdgcn_readfirstlane(lcnt[j]);
            const int idx = g * 32 + r; const bool valid = idx < n;
            const unsigned e = llist[j * 256 + (valid ? idx : 0)];
            const int qi = e & 255, slot = e >> 8;
            float mo, lo_; f32x16 ot[2];
            attn_core<false>(Q + qbase + (size_t)qi * 64, Kb + ((size_t)bh * 32 + j) * 16384, Vb + ((size_t)bh * 32 + j) * 16384, 8, r, h, mo, lo_, ot);
            if (valid) {
                unsigned char* rec = part + (qi * 3 + slot) * 136; const float inv = 1.0f / lo_;
#pragma unroll
                for (int md = 0; md < 2; ++md)
#pragma unroll
                    for (int gq = 0; gq < 4; ++gq) { u32x2 o; o.x = cvtpk(ot[md][4 * gq] * inv, ot[md][4 * gq + 1] * inv); o.y = cvtpk(ot[md][4 * gq + 2] * inv, ot[md][4 * gq + 3] * inv);
                        *(u32x2*)(rec + 2 * (32 * md + 8 * gq + 4 * h)) = o; }
                if (h == 0) { *(float*)(rec + 128) = mo; *(float*)(rec + 132) = lo_; }
            }
        }
        __syncthreads();
    }
    {
        const int ql = 32 * wave + r, t = qb * 256 + ql;
        float m0, l0; f32x16 ot[2];
        attn_core<true>(Q + qbase + (size_t)ql * 64, Kb + ((size_t)bh * 32 + qb) * 16384, Vb + ((size_t)bh * 32 + qb) * 16384, wave + 1, r, h, m0, l0, ot);
        float ms[3], ls[3]; float mx = m0;
#pragma unroll
        for (int s = 0; s < 3; ++s) { ms[s] = -INFINITY; ls[s] = 0.f; if (s < nsel) { const unsigned char* rec = part + (ql * 3 + s) * 136; ms[s] = *(const float*)(rec + 128); ls[s] = *(const float*)(rec + 132); mx = fmaxf(mx, ms[s]); } }
        const float w0 = __expf(m0 - mx); float den = w0 * l0;
#pragma unroll
        for (int md = 0; md < 2; ++md)
#pragma unroll
            for (int i = 0; i < 16; ++i) ot[md][i] *= w0;
#pragma unroll
        for (int s = 0; s < 3; ++s) {
            if (s < nsel) {
                const unsigned char* rec = part + (ql * 3 + s) * 136; const float ws_ = __expf(ms[s] - mx) * ls[s]; den += ws_;
#pragma unroll
                for (int md = 0; md < 2; ++md)
#pragma unroll
                    for (int gq = 0; gq < 4; ++gq) { const u32x2 w = *(const u32x2*)(rec + 2 * (32 * md + 8 * gq + 4 * h));
                        ot[md][4 * gq] += ws_ * __uint_as_float(w.x << 16); ot[md][4 * gq + 1] += ws_ * __uint_as_float(w.x & 0xffff0000u);
                        ot[md][4 * gq + 2] += ws_ * __uint_as_float(w.y << 16); ot[md][4 * gq + 3] += ws_ * __uint_as_float(w.y & 0xffff0000u); }
            }
        }
        float inv = 1.0f / den; const size_t yrow = (size_t)(b * SEQ + t) * 1024 + hd * 64;
#ifdef DBG_AMP_ATTN
        inv *= 64.f;
#endif
#pragma unroll
        for (int md = 0; md < 2; ++md)
#pragma unroll
            for (int gq = 0; gq < 4; ++gq) { u32x2 o; o.x = cvtpk(ot[md][4 * gq] * inv, ot[md][4 * gq + 1] * inv); o.y = cvtpk(ot[md][4 * gq + 2] * inv, ot[md][4 * gq + 3] * inv);
                *(u32x2*)(Y + yrow + 32 * md + 8 * gq + 4 * h) = o; }
    }
    __syncthreads();
}

DI void phase_a(const Ctx& a, int L, unsigned char* lds, int gw, int NGW, int tid, int wave, int lane) {
    if ((gw & 3) == 0 && (gw >> 2) < 512) {
        const int chunk = gw >> 2, bhh = chunk >> 6, e = (chunk & 63) * 64 + lane, k = e & 63;
        const float* ALOC = (const float*)(a.ws + WS_R + R_ALOC); const float* DEC = (const float*)(a.ws + WS_DEC); bf16* SP = (bf16*)(a.ws + WS_R + R_SP);
        float st = 0.f;
#pragma unroll 8
        for (int n = 0; n < 128; ++n) { const int item = bhh * 128 + n; const float av = ALOC[(size_t)item * 4096 + e], dv = DEC[item * 64 + k];
            SP[(size_t)item * 4096 + e] = (bf16)(cvtpk(st, 0.f) & 0xffffu); st = dv * st + av; }
    }
    const int G = NGW / NWAVES, blk = gw / NWAVES;
    for (int u = blk; u < 512; u += G) {
        const int v = u & 255, bh = v >> 4, qb = (u < 256) ? (v & 15) : 31 - (v & 15);
        attn_unit(a, bh, qb, lds, tid, wave, lane);
    }
}

DI void own_unit(const Ctx& a, int bhi, int qg, int lane) {
    asm volatile("" : "+v"(lane));
    const int r = lane & 31, h = lane >> 5, t0 = qg * 32, j = t0 >> 8, nkg = ((t0 & 255) >> 5) + 1, t = t0 + r;
    const int b = bhi >> 3, hd = bhi & 7; const size_t bh = (size_t)bhi;
    const bf16* Q = (const bf16*)(a.ws + WS_R + R_Q); const bf16* Kb = (const bf16*)(a.ws + WS_R + R_K); const bf16* Vb = (const bf16*)(a.ws + WS_R + R_V);
    const bf16* PO = (const bf16*)(a.ws + WS_R + R_PO); const float* PML = (const float*)(a.ws + WS_R + R_PML); bf16* Y = (bf16*)(a.ws + WS_R + R_Y);
    float m0, l0; f32x16 ot[2];
    attn_core<true>(Q + (bh * SEQ + t) * 64, Kb + (bh * 32 + j) * 16384, Vb + (bh * 32 + j) * 16384, nkg, r, h, m0, l0, ot);
#ifdef DBG_OWN_ONLY
    const int nsel = 0;
#else
    const int nsel = j < 3 ? j : 3;
#endif
    const size_t pi = (bh * SEQ + t) * 3;
    float ms[3], ls[3]; float mx = m0;
#pragma unroll
    for (int s = 0; s < 3; ++s) { ms[s] = -INFINITY; ls[s] = 0.f; if (s < nsel) { ms[s] = ld_sc1f(PML + (pi + s) * 2); ls[s] = ld_sc1f(PML + (pi + s) * 2 + 1); mx = fmaxf(mx, ms[s]); } }
    const float w0 = __expf(m0 - mx); float den = w0 * l0;
#pragma unroll
    for (int md = 0; md < 2; ++md)
#pragma unroll
        for (int i = 0; i < 16; ++i) ot[md][i] *= w0;
#pragma unroll
    for (int s = 0; s < 3; ++s) {
        if (s < nsel) {
            const float ws_ = __expf(ms[s] - mx) * ls[s]; den += ws_;
#pragma unroll
            for (int md = 0; md < 2; ++md)
#pragma unroll
                for (int gq = 0; gq < 4; ++gq) { const u32x2 w = *(const u32x2*)(PO + (pi + s) * 64 + 32 * md + 8 * gq + 4 * h);
                    ot[md][4 * gq] += ws_ * __uint_as_float(w.x << 16); ot[md][4 * gq + 1] += ws_ * __uint_as_float(w.x & 0xffff0000u);
                    ot[md][4 * gq + 2] += ws_ * __uint_as_float(w.y << 16); ot[md][4 * gq + 3] += ws_ * __uint_as_float(w.y & 0xffff0000u); }
        }
    }
    float inv = 1.0f / den; const size_t yrow = (size_t)(b * SEQ + t) * 1024 + hd * 64;
#ifdef DBG_ZERO_ATTN
    inv = 0.f;
#endif
#pragma unroll
    for (int md = 0; md < 2; ++md)
#pragma unroll
        for (int gq = 0; gq < 4; ++gq) { u32x2 o; o.x = cvtpk(ot[md][4 * gq] * inv, ot[md][4 * gq + 1] * inv); o.y = cvtpk(ot[md][4 * gq + 2] * inv, ot[md][4 * gq + 3] * inv);
            *(u32x2*)(Y + yrow + 32 * md + 8 * gq + 4 * h) = o; }
}

DI void h3_unit(const Ctx& a, int L, int unit, int lane) {
    asm volatile("" : "+v"(lane));
    const int b = unit >> 9, hh = (unit >> 7) & 3, n = unit & 127, r = lane & 31, h = lane >> 5;
    const int row0 = b * SEQ + n * 64;
    const bf16* SP = (const bf16*)(a.ws + WS_R + R_SP) + (size_t)unit * 4096; const bf16* QDEC = (const bf16*)(a.ws + WS_R + R_QDEC);
    const float* OINTRA = (const float*)(a.ws + WS_R + R_OINTRA); const bf16* GH = (const bf16*)(a.ws + WS_R + R_U5) + (size_t)4 * M * 256; bf16* Y = (bf16*)(a.ws + WS_R + R_Y);
    const float* on = a.in(I_HON) + L * 64;
    bf16x8 sf[2][4];
#pragma unroll
    for (int mv = 0; mv < 2; ++mv)
#pragma unroll
        for (int ks = 0; ks < 4; ++ks) sf[mv][ks] = *(const bf16x8*)(SP + (32 * mv + r) * 64 + 16 * ks + 8 * h);
#pragma unroll
    for (int nt = 0; nt < 2; ++nt) {
        const size_t trow = (size_t)(row0 + 32 * nt + r) * 256 + hh * 64;
        f32x16 o[2]; o[0] = zero16(); o[1] = zero16();
#pragma unroll
        for (int ks = 0; ks < 4; ++ks) { const bf16x8 qf = *(const bf16x8*)(QDEC + trow + 16 * ks + 8 * h); o[0] = MFMA32(sf[0][ks], qf, o[0]); o[1] = MFMA32(sf[1][ks], qf, o[1]); }
        float ss = 0.f;
#pragma unroll
        for (int mv = 0; mv < 2; ++mv)
#pragma unroll
            for (int gq = 0; gq < 4; ++gq) { const f32x4 x = *(const f32x4*)(OINTRA + trow + 32 * mv + 8 * gq + 4 * h);
#pragma unroll
                for (int i = 0; i < 4; ++i) { o[mv][4 * gq + i] += x[i]; ss += o[mv][4 * gq + i] * o[mv][4 * gq + i]; } }
        ss += __shfl_xor(ss, 32);
        float rn = rsqrtf(ss * (1.0f / 64.0f) + 1e-6f);
#ifdef DBG_ZERO_HGRN
        rn = 0.f;
#endif
#ifdef DBG_AMP_HGRN
        rn *= 16.f;
#endif
        const size_t yrow = (size_t)(row0 + 32 * nt + r) * 1024 + 768 + hh * 64;
#pragma unroll
        for (int mv = 0; mv < 2; ++mv)
#pragma unroll
            for (int gq = 0; gq < 4; ++gq) { const int v0 = 32 * mv + 8 * gq + 4 * h; const f32x4 gn = *(const f32x4*)(on + v0); const u32x2 gw_ = *(const u32x2*)(GH + trow + v0);
                const float g0 = __uint_as_float(gw_.x << 16), g1 = __uint_as_float(gw_.x & 0xffff0000u), g2 = __uint_as_float(gw_.y << 16), g3 = __uint_as_float(gw_.y & 0xffff0000u);
                u32x2 w; w.x = cvtpk(o[mv][4 * gq] * rn * gn[0] * pg8::silu_f(g0), o[mv][4 * gq + 1] * rn * gn[1] * pg8::silu_f(g1));
                w.y = cvtpk(o[mv][4 * gq + 2] * rn * gn[2] * pg8::silu_f(g2), o[mv][4 * gq + 3] * rn * gn[3] * pg8::silu_f(g3));
                *(u32x2*)(Y + yrow + v0) = w; }
    }
}

DI void phase_c(const Ctx& a, int L, int gw, int NGW, int lane) {
    for (int u = gw; u < 1024; u += NGW) h3_unit(a, L, u, lane);
}

#define LAS __attribute__((address_space(3)))
#define XB_TMO      128
#define XB_XCNT(j)  (256  + 64 * (j))
#define XB_XSUB(j)  (1280 + 64 * (j))
#define XB_XGEN(j)  (2304 + 64 * (j))
#define XB_TOP      3328
#define XB_TOPGEN   3392
#define XCD_BAR_WORDS 3456
#define XB_SPIN_CAP (1u << 18)

__device__ __forceinline__ unsigned xb_ld(unsigned* p)              { return __hip_atomic_load(p, __ATOMIC_RELAXED, __HIP_MEMORY_SCOPE_AGENT); }
__device__ __forceinline__ unsigned xb_add(unsigned* p, unsigned v) { return __hip_atomic_fetch_add(p, v, __ATOMIC_RELAXED, __HIP_MEMORY_SCOPE_AGENT); }
__device__ __forceinline__ unsigned xb_xcc_id() { return (unsigned)__builtin_amdgcn_s_getreg((3 << 11) | 20) & 0xFu; }
#define XB_SPIN(cond, bar) do { unsigned _sp = 0; while (cond) { __builtin_amdgcn_s_sleep(1); \
    if ((++_sp & 255u) == 0u) { if (xb_ld(&(bar)[XB_TMO])) break; if (_sp > XB_SPIN_CAP) { atomicAdd(&(bar)[XB_TMO], 1u); break; } } } } while (0)

struct XcdBarrier {
    unsigned* bar; unsigned x;
    volatile LAS unsigned* st;
};

__device__ __forceinline__ XcdBarrier xcd_barrier_post(unsigned* bar, volatile LAS unsigned* st) {
    XcdBarrier b; b.bar = bar; b.x = xb_xcc_id(); b.st = st;
    if (threadIdx.x == 0) (void)xb_add(&bar[XB_XCNT(b.x)], 1u);
    return b;
}
__device__ __forceinline__ void xcd_barrier_complete(unsigned* bar, unsigned x, unsigned& nloc, unsigned& nx) {
    const unsigned G = gridDim.x * gridDim.y * gridDim.z;
    unsigned sum, cnt, mine, sp = 0u;
    for (;;) {
        sum = 0u; cnt = 0u; mine = 0u;
#pragma unroll
        for (unsigned j = 0; j < 16; ++j) { const unsigned c = xb_ld(&bar[XB_XCNT(j)]); sum += c; cnt += (c > 0u) ? 1u : 0u; mine = (j == x) ? c : mine; }
        if (sum == G) break;
        __builtin_amdgcn_s_sleep(1);
        if ((++sp & 255u) == 0u) { if (xb_ld(&bar[XB_TMO])) break; if (sp > XB_SPIN_CAP) { atomicAdd(&bar[XB_TMO], 1u); break; } }
    }
    nloc = mine > 0u ? mine : 1u; nx = cnt > 0u ? cnt : 1u;
}

__device__ __forceinline__ void xcd_barrier(const XcdBarrier& b) {
    asm volatile("s_waitcnt vmcnt(0)" ::: "memory");
    __syncthreads();
    if (threadIdx.x == 0) {
        unsigned* bar = b.bar;
        __builtin_amdgcn_s_waitcnt(0);
        unsigned nloc = b.st[0], nx = b.st[1];
        if (nloc == 0u) { xcd_barrier_complete(bar, b.x, nloc, nx); b.st[0] = nloc; b.st[1] = nx; }
        const unsigned old = xb_add(&bar[XB_XSUB(b.x)], 1u);
        const unsigned gen = old / nloc;
        if (old + 1u == (gen + 1u) * nloc) {
            __builtin_amdgcn_fence(__ATOMIC_RELEASE, "agent");
            asm volatile("s_waitcnt vmcnt(0)" ::: "memory");
            const unsigned og = xb_add(&bar[XB_TOP], 1u);
            const unsigned tg = og / nx;
            if (og + 1u == (tg + 1u) * nx) xb_add(&bar[XB_TOPGEN], 1u);
            else XB_SPIN(xb_ld(&bar[XB_TOPGEN]) == tg, bar);
            __builtin_amdgcn_fence(__ATOMIC_ACQUIRE, "agent");
            xb_add(&bar[XB_XGEN(b.x)], 1u);
            asm volatile("s_waitcnt vmcnt(0)" ::: "memory");
        } else {
            XB_SPIN(xb_ld(&bar[XB_XGEN(b.x)]) == gen, bar);
            __builtin_amdgcn_fence(__ATOMIC_ACQUIRE, "agent");
            asm volatile("s_waitcnt vmcnt(0)" ::: "memory");
        }
    }
    __syncthreads();
}

template <int MASK> __global__ void __launch_bounds__(NTHR, 2) mk_fwd(Args args) {
    extern __shared__ __attribute__((aligned(16))) unsigned char lds[];
    const int G = gridDim.x, NGW = G * NWAVES;
    cg::grid_group grid = cg::this_grid();
    const int ph_lo = args.ph_lo, ph_hi = args.ph_hi;
    volatile LAS unsigned* bst = (volatile LAS unsigned*)((LAS unsigned char*)lds + 131072);
    if (threadIdx.x == 0) { bst[0] = 0u; bst[1] = 0u; }
    __syncthreads();
    XcdBarrier bar; bar.bar = nullptr; bar.x = 0; bar.st = bst;
    for (int ph = ph_lo; ph < ph_hi; ++ph) {
        if (ph > ph_lo) {
            if (ph == ph_lo + 1) {
                grid.sync();
                bar = xcd_barrier_post((unsigned*)(args.ws + WS_CTL + 65536), bst);
            } else xcd_barrier(bar);
        }
        int tid_v = threadIdx.x; asm volatile("" : "+v"(tid_v));
        const int tid = tid_v, lane = tid & 63, wave = __builtin_amdgcn_readfirstlane(tid >> 6), gw = blockIdx.x * NWAVES + wave;
        kptr_t kp = (kptr_t)__builtin_amdgcn_kernarg_segment_ptr();
        asm volatile("" : "+s"(kp));
        Ctx a; a.kp = kp; a.out = *(float* const __attribute__((address_space(4)))*)(kp + 144); a.ws = *(unsigned char* const __attribute__((address_space(4)))*)(kp + 152);
        unsigned char* ws = a.ws;
        float* stats = (float*)(ws + WS_STATS); bf16* xb = (bf16*)(ws + WS_XB); bf16* hid = (bf16*)(ws + WS_R + R_HID);
        if (ph == 0) {
if constexpr (MASK & 1) phase_p0(a, lds, gw, NGW, wave, lane);
 __syncthreads(); continue; }
        const int L = (ph - 1) / 9, sub = (ph - 1) % 9;
        unsigned char* wb = ws + WS_W + (size_t)(L & 1) * WSZ;
        if (sub == 0 || sub == 7) {
            pg8::Gemm g{xb, (const bf16*)(wb + (sub == 0 ? W_GU1 : W_GU2)), M, 2 * FF, D}; pg8::StaticOrder S; S.init(M, 2 * FF, G, (int)blockIdx.x);
            pg8::EpiSwiGLU E{hid, stats, FF};
            if constexpr (MASK & 2) pg8::gemm_phase<pg8::EpiSwiGLU, pg8::StaticOrder, PG8_ALIGN, PG8_SP2>((PG8_LAS unsigned char*)lds, g, S, E);
        } else if (sub == 1 || sub == 6 || sub == 8) {
            const bf16* A = sub == 6 ? (const bf16*)(ws + WS_R + R_Y) : hid; const int K = sub == 6 ? D : FF;
            const bf16* Bt = (const bf16*)(wb + (sub == 1 ? W_D1 : (sub == 6 ? W_OUT : W_D2)));
            pg8::Gemm g{A, Bt, M, D, K}; pg8::StaticOrder S; S.init(M, D, G, (int)blockIdx.x);
            pg8::EpiResid E{a.out, xb, stats, sub == 6 ? 1.0f : 0.5f};
            if constexpr (MASK & 4) pg8::gemm_phase<pg8::EpiResid, pg8::StaticOrder, PG8_ALIGN, PG8_SP2>((PG8_LAS unsigned char*)lds, g, S, E);
        } else if (sub == 2) {
            pg8::Gemm g{xb, (const bf16*)(wb + W_IN), M, INW, D}; pg8::StaticOrder S; S.init(M, INW, G, (int)blockIdx.x);
            pg8::EpiProj E{(bf16*)(ws + WS_R + R_Q), (bf16*)(ws + WS_R + R_K), (bf16*)(ws + WS_R + R_V), (bf16*)(ws + WS_R + R_U5), (float*)(ws + WS_KMP), stats,
                           (const float*)(ws + WS_ROPEC), (const float*)(ws + WS_ROPES), a.in(I_QN) + L * 64, a.in(I_KN) + L * 64};
            if constexpr (MASK & 8) pg8::gemm_phase<pg8::EpiProj, pg8::StaticOrder, PG8_ALIGN, PG8_SP2>((PG8_LAS unsigned char*)lds, g, S, E);
        } else if (sub == 3) {
if constexpr (MASK & 16) { phase_t(a, L, lds, gw, NGW, wave, lane);
#if defined(DBG_DUP_SUB) && DBG_DUP_SUB == 3
 __syncthreads(); phase_t(a, L, lds, gw, NGW, wave, lane);
#endif
 }
 __syncthreads(); }
        else if (sub == 4) {
if constexpr (MASK & 32) { phase_a(a, L, lds, gw, NGW, tid, wave, lane);
#if defined(DBG_DUP_SUB) && DBG_DUP_SUB == 4
 __syncthreads(); phase_a(a, L, lds, gw, NGW, tid, wave, lane);
#endif
 }
 __syncthreads(); }
        else {
if constexpr (MASK & 64) { phase_c(a, L, gw, NGW, lane);
#if defined(DBG_DUP_SUB) && DBG_DUP_SUB == 5
 __syncthreads(); phase_c(a, L, gw, NGW, lane);
#endif
 }
 __syncthreads(); }
    }
}

#ifndef MK_MULTI
#define MK_MULTI 0
#define DBG_WC_ALWAYS
#endif
#ifndef DBG_NPH
#define DBG_NPH (1 + 9 * DEPTH)
#endif
constexpr int N_PHASES = DBG_NPH;
static int phase_mask(int ph) { if (ph == 0) return 1; const int sub = (ph - 1) % 9; const int m[9] = {2, 4, 8, 16, 32, 64, 4, 2, 4}; return m[sub]; }
template <int MASK> static bool setup_one(int& per_cu) {
    if (hipFuncSetAttribute((const void*)mk_fwd<MASK>, hipFuncAttributeMaxDynamicSharedMemorySize, LDS_BYTES) != hipSuccess) return false;
    if (hipOccupancyMaxActiveBlocksPerMultiprocessor(&per_cu, (const void*)mk_fwd<MASK>, NTHR, LDS_BYTES) != hipSuccess) per_cu = 1;
    (void)hipGetLastError(); return true;
}
template <int MASK> static void launch_one(const Args& a, int grid, hipStream_t stream) { hipLaunchKernelGGL(mk_fwd<MASK>, dim3(grid), dim3(NTHR), LDS_BYTES, stream, a); }
extern "C" void kernel_launch(void* const* d_in, const int* in_sizes, int n_in, void* d_out, int out_size, void* d_ws, size_t ws_size, hipStream_t stream) {
    static int grid = 0;
    if (grid == 0) {
        if (n_in != 18 || in_sizes[0] != M * D || out_size != M * D || ws_size < WS_END) { fprintf(stderr, "kernel_launch: unexpected shapes / workspace (n_in %d, ws %zu < %zu)\n", n_in, ws_size, (size_t)WS_END); grid = -1; return; }
        int dev = 0, cus = 0, per_cu = 0; bool ok = true;
        (void)hipGetDevice(&dev); (void)hipDeviceGetAttribute(&cus, hipDeviceAttributeMultiprocessorCount, dev);
#if MK_MULTI
        ok = setup_one<1>(per_cu) && setup_one<2>(per_cu) && setup_one<4>(per_cu) && setup_one<8>(per_cu) && setup_one<16>(per_cu) && setup_one<32>(per_cu) && setup_one<64>(per_cu);
#else
        ok = setup_one<127>(per_cu);
#endif
        if (!ok) { fprintf(stderr, "kernel_launch: hipFuncSetAttribute failed\n"); grid = -1; return; }
        grid = cus;
    }
    if (grid < 0) return;
    Args a{};
    for (int i = 0; i < 18; ++i) a.in[i] = (const float*)d_in[i];
    a.out = (float*)d_out; a.ws = (unsigned char*)d_ws;
#if MK_MULTI
    for (int ph = 0; ph < N_PHASES; ++ph) { a.ph_lo = ph; a.ph_hi = ph + 1;
        switch (phase_mask(ph)) { case 1: launch_one<1>(a, grid, stream); break; case 2: launch_one<2>(a, grid, stream); break; case 4: launch_one<4>(a, grid, stream); break; case 8: launch_one<8>(a, grid, stream); break;
                                  case 16: launch_one<16>(a, grid, stream); break; case 32: launch_one<32>(a, grid, stream); break; default: launch_one<64>(a, grid, stream); break; } }
#else
    a.ph_lo = 0; a.ph_hi = N_PHASES;
    void* args[] = {&a};
    hipError_t e = hipLaunchCooperativeKernel((const void*)mk_fwd<127>, dim3(grid), dim3(NTHR), args, LDS_BYTES, stream);
    if (e != hipSuccess) fprintf(stderr, "cooperative launch failed: %s (grid %d)\n", hipGetErrorString(e), grid);
#endif
}
```

```cpp
#include <hip/hip_runtime.h>
#include <hip/hip_cooperative_groups.h>
#include <cstdio>
#include <cstdint>
namespace cg = cooperative_groups;
#define MK_MULTI 0
namespace pg8 {
#define PG8_LAS __attribute__((address_space(3)))
typedef unsigned short bf16_t;
typedef short bf16x8 __attribute__((ext_vector_type(8)));
typedef float f32x4 __attribute__((ext_vector_type(4)));
typedef unsigned u32x4 __attribute__((ext_vector_type(4)));
constexpr int BM = 256, BK = 64, HALF = 128, HTB = HALF * BK * 2  , STAGE_BYTES = 8 * HTB, NXCD = 8, WGM = 8;

__host__ __device__ __forceinline__ int lds_byte(int r, int c) { const int st = (r >> 4) * 2 + (c >> 5), rr = r & 15, cc = c & 31, ob = rr * 64 + cc * 2; return st * 1024 + (ob ^ (((ob >> 9) & 1) << 5)); }
__host__ __device__ __forceinline__ void stage_rc(int b, int& R, int& C) { const int st = b / 1024, sb = b % 1024, swz = sb ^ (((sb >> 9) & 1) << 5); R = (st >> 1) * 16 + swz / 64; C = (st & 1) * 32 + (swz % 64) / 2; }
__host__ __device__ __forceinline__ int perm32(int rho) { const int n = rho >> 4, i = rho & 15; return 8 * (i >> 2) + 4 * n + (i & 3); }

struct Unit { int pm, pn; };
struct Gemm { const bf16_t* A; const bf16_t* Bt; int M, N, K; };

struct StaticOrder {
    int nM, nN, nwg, G, c;
    __host__ __device__ void init(int M, int N, int G_, int c_) { nM = M / BM; nN = N / BM; nwg = nM * nN; G = G_; c = c_; }
    __host__ __device__ bool next(int i, Unit& u) const {
        const long L = (long)i * G + c; if (L >= nwg) return false;
        int wgid = (int)L; { const int q = nwg / NXCD, r = nwg % NXCD, xcd = wgid % NXCD, off = wgid / NXCD; wgid = (xcd < r ? xcd * (q + 1) : r * (q + 1) + (xcd - r) * q) + off; }
        const int nig = WGM * nN, gid = wgid / nig, fm = gid * WGM, gsz = (nM - fm) < WGM ? (nM - fm) : WGM;
        u.pm = fm + ((wgid % nig) % gsz); u.pn = (wgid % nig) / gsz; return true;
    }
    __device__ __forceinline__ void a_ready(const Unit&) const {}
    __device__ __forceinline__ void done(const Unit&) const {}
};

__device__ __forceinline__ unsigned cvt_pk_bf16(float lo, float hi) { unsigned r; asm volatile("v_cvt_pk_bf16_f32 %0, %1, %2" : "=v"(r) : "v"(lo), "v"(hi)); return r; }
typedef float f32x2 __attribute__((ext_vector_type(2)));
typedef unsigned u32x2 __attribute__((ext_vector_type(2)));
typedef __bf16 bf16x2_t __attribute__((ext_vector_type(2)));
__device__ __forceinline__ unsigned cvtpk(float lo, float hi) { f32x2 v = {lo, hi}; bf16x2_t b = __builtin_convertvector(v, bf16x2_t); return __builtin_bit_cast(unsigned, b); }
__device__ __forceinline__ float row_rstd(const float* stats, int row) {
    const f32x4* p = (const f32x4*)(stats + (size_t)row * 16);
    const f32x4 a = p[0], b = p[1], c = p[2], d = p[3];
    const float s = ((a[0] + a[1]) + (a[2] + a[3])) + ((b[0] + b[1]) + (b[2] + b[3])) + ((c[0] + c[1]) + (c[2] + c[3])) + ((d[0] + d[1]) + (d[2] + d[3]));
    return rsqrtf(s * (1.0f / 1024.0f) + 1e-6f);
}
__device__ __forceinline__ float silu_f(float g) { return g * __builtin_amdgcn_rcpf(1.0f + __expf(-g)); }

struct EpiSwiGLU {
    static constexpr bool PERM = true, AFTER_DRAIN = false;
    bf16_t* H; const float* stats; int ldh;
    __device__ __forceinline__ void operator()(const f32x4 (&acc)[2][2][4][2], const Unit& u, int wr, int wc, int fr, int fq) const {
        asm volatile("" : "+v"(fr), "+v"(fq));
        const int row0 = u.pm * BM + wr * 64 + fr, col0 = u.pn * HALF + wc * 32 + 8 * fq;
#pragma unroll
        for (int ai = 0; ai < 2; ++ai)
#pragma unroll
            for (int m = 0; m < 4; ++m) {
                const int row = row0 + ai * HALF + m * 16;
                const float rs = row_rstd(stats, row);
                float h[8];
#pragma unroll
                for (int n = 0; n < 2; ++n)
#pragma unroll
                    for (int i = 0; i < 4; ++i) { const float g = acc[ai][0][m][n][i] * rs, up = acc[ai][1][m][n][i] * rs; h[4 * n + i] = silu_f(g) * up; }
                u32x4 w; w.x = cvtpk(h[0], h[1]); w.y = cvtpk(h[2], h[3]); w.z = cvtpk(h[4], h[5]); w.w = cvtpk(h[6], h[7]);
                *(u32x4*)(H + (size_t)row * ldh + col0) = w;
            }
    }
};

struct EpiResid {
    static constexpr bool PERM = true, AFTER_DRAIN = false;
    float* X; bf16_t* XB; float* stats; float scale;
    __device__ __forceinline__ void operator()(const f32x4 (&acc)[2][2][4][2], const Unit& u, int wr, int wc, int fr, int fq) const {
        asm volatile("" : "+v"(fr), "+v"(fq));
        const int row0 = u.pm * BM + wr * 64 + fr, col0 = u.pn * BM + wc * 32 + 8 * fq;
#pragma unroll
        for (int ai = 0; ai < 2; ++ai)
#pragma unroll
            for (int m = 0; m < 4; ++m) {
                const int row = row0 + ai * HALF + m * 16; float ss = 0.f;
#pragma unroll
                for (int bj = 0; bj < 2; ++bj) {
                    float* xp = X + (size_t)row * 1024 + col0 + bj * HALF;
                    f32x4 x0 = *(const f32x4*)xp, x1 = *(const f32x4*)(xp + 4);
                    x0 = x0 + acc[ai][bj][m][0] * scale; x1 = x1 + acc[ai][bj][m][1] * scale;
                    *(f32x4*)xp = x0; *(f32x4*)(xp + 4) = x1;
                    ss += (x0[0] * x0[0] + x0[1] * x0[1]) + (x0[2] * x0[2] + x0[3] * x0[3]) + (x1[0] * x1[0] + x1[1] * x1[1]) + (x1[2] * x1[2] + x1[3] * x1[3]);
                    u32x4 w; w.x = cvtpk(x0[0], x0[1]); w.y = cvtpk(x0[2], x0[3]); w.z = cvtpk(x1[0], x1[1]); w.w = cvtpk(x1[2], x1[3]);
                    *(u32x4*)(XB + (size_t)row * 1024 + col0 + bj * HALF) = w;
                }
                ss += __shfl_xor(ss, 16); ss += __shfl_xor(ss, 32);
                if (fq == 0) stats[(size_t)row * 16 + u.pn * 4 + wc] = ss;
            }
    }
};

struct EpiProj {
    static constexpr bool PERM = true, AFTER_DRAIN = false;
    bf16_t* Q; bf16_t* Kb; bf16_t* Vb; bf16_t* U5; float* kmp; const float* stats; const float* ropeC; const float* ropeS; const float* qn; const float* kn;
    __device__ __forceinline__ void operator()(const f32x4 (&acc)[2][2][4][2], const Unit& u, int wr, int wc, int fr, int fq) const {
        asm volatile("" : "+v"(fr), "+v"(fq));
        const int row0 = u.pm * BM + wr * 64 + fr;
        const int pn = u.pn;
        if (pn >= 6) {
            bf16_t* O = U5 + (size_t)(pn - 6) * (16384 * 256);
            const int col0 = wc * 32 + 8 * fq;
#pragma unroll
            for (int ai = 0; ai < 2; ++ai)
#pragma unroll
                for (int m = 0; m < 4; ++m) {
                    const int row = row0 + ai * HALF + m * 16; const float rs = row_rstd(stats, row);
#pragma unroll
                    for (int bj = 0; bj < 2; ++bj) {
                        const f32x4 v0 = acc[ai][bj][m][0] * rs, v1 = acc[ai][bj][m][1] * rs;
                        u32x4 w; w.x = cvtpk(v0[0], v0[1]); w.y = cvtpk(v0[2], v0[3]); w.z = cvtpk(v1[0], v1[1]); w.w = cvtpk(v1[2], v1[3]);
                        *(u32x4*)(O + (size_t)row * 256 + col0 + bj * HALF) = w;
                    }
                }
            return;
        }
        const int head = (pn & 1) * 4 + wc, b = u.pm >> 5, j = u.pm & 31;
        const size_t bh = (size_t)(b * 8 + head);
        if (pn >= 4) {
            bf16_t* vb = Vb + (bh * 32 + j) * 16384;
#pragma unroll
            for (int ai = 0; ai < 2; ++ai)
#pragma unroll
                for (int m = 0; m < 4; ++m) {
                    const int row = row0 + ai * HALF + m * 16; const float rs = row_rstd(stats, row);
                    const int kk = ai * HALF + wr * 64 + m * 16 + fr;
                    const int kg = kk >> 5, w = kk & 31, st = w >> 4, w16 = w & 15, hh = (w16 >> 2) & 1, jj = 4 * (w16 >> 3) + (w16 & 3);
#pragma unroll
                    for (int bj = 0; bj < 2; ++bj)
#pragma unroll
                        for (int n = 0; n < 2; ++n) {
                            const unsigned p0 = cvtpk(acc[ai][bj][m][n][0] * rs, acc[ai][bj][m][n][1] * rs), p1 = cvtpk(acc[ai][bj][m][n][2] * rs, acc[ai][bj][m][n][3] * rs);
#pragma unroll
                            for (int i = 0; i < 4; ++i) {
                                const int r = 8 * fq + 4 * n + i;
                                const unsigned pv = (i < 2) ? p0 : p1;
                                vb[((((kg * 2 + st) * 2 + bj) * 32 + r) * 2 + hh) * 8 + jj] = (bf16_t)((i & 1) ? (pv >> 16) : (pv & 0xffffu));
                            }
                        }
                }
            return;
        }
        const bool isk = pn >= 2;
        const float* gn = isk ? kn : qn;
        float ksum[16];
#pragma unroll
        for (int e = 0; e < 16; ++e) ksum[e] = 0.f;
#pragma unroll
        for (int ai = 0; ai < 2; ++ai)
#pragma unroll
            for (int m = 0; m < 4; ++m) {
                const int row = row0 + ai * HALF + m * 16; const float rs = row_rstd(stats, row);
                const int t = row & 8191, kk = t & 255;
                float v0[8], v1[8]; float ss = 0.f;
#pragma unroll
                for (int n = 0; n < 2; ++n)
#pragma unroll
                    for (int i = 0; i < 4; ++i) { v0[4 * n + i] = acc[ai][0][m][n][i] * rs; v1[4 * n + i] = acc[ai][1][m][n][i] * rs; ss += v0[4 * n + i] * v0[4 * n + i] + v1[4 * n + i] * v1[4 * n + i]; }
                ss += __shfl_xor(ss, 16); ss += __shfl_xor(ss, 32);
                const float rn = rsqrtf(ss * (1.0f / 64.0f) + 1e-6f);
                const f32x4 c0 = *(const f32x4*)(ropeC + t * 32 + 8 * fq), c1 = *(const f32x4*)(ropeC + t * 32 + 8 * fq + 4);
                const f32x4 s0 = *(const f32x4*)(ropeS + t * 32 + 8 * fq), s1 = *(const f32x4*)(ropeS + t * 32 + 8 * fq + 4);
                const f32x4 ga0 = *(const f32x4*)(gn + 8 * fq), ga1 = *(const f32x4*)(gn + 8 * fq + 4), gb0 = *(const f32x4*)(gn + 32 + 8 * fq), gb1 = *(const f32x4*)(gn + 36 + 8 * fq);
                float o0[8], o1[8];
#pragma unroll
                for (int e = 0; e < 8; ++e) {
                    const float x1 = v0[e] * rn * (e < 4 ? ga0[e & 3] : ga1[e & 3]), x2 = v1[e] * rn * (e < 4 ? gb0[e & 3] : gb1[e & 3]);
                    const float cs = e < 4 ? c0[e & 3] : c1[e & 3], sn = e < 4 ? s0[e & 3] : s1[e & 3];
                    o0[e] = x1 * cs - x2 * sn; o1[e] = x2 * cs + x1 * sn;
                }
                u32x4 w0, w1;
                w0.x = cvtpk(o0[0], o0[1]); w0.y = cvtpk(o0[2], o0[3]); w0.z = cvtpk(o0[4], o0[5]); w0.w = cvtpk(o0[6], o0[7]);
                w1.x = cvtpk(o1[0], o1[1]); w1.y = cvtpk(o1[2], o1[3]); w1.z = cvtpk(o1[4], o1[5]); w1.w = cvtpk(o1[6], o1[7]);
                if (!isk) {
                    bf16_t* qp = Q + (bh * 8192 + t) * 64 + 8 * fq;
                    *(u32x4*)qp = w0; *(u32x4*)(qp + 32) = w1;
                } else {
                    bf16_t* kb = Kb + (bh * 32 + j) * 16384;
                    const int kg = kk >> 5, r = kk & 31, hq = fq & 1, ksl = fq >> 1;
                    *(u32x4*)(kb + (((kg * 4 + ksl) * 32 + r) * 2 + hq) * 8) = w0;
                    *(u32x4*)(kb + (((kg * 4 + 2 + ksl) * 32 + r) * 2 + hq) * 8) = w1;
#pragma unroll
                    for (int e = 0; e < 8; ++e) { ksum[e] += o0[e]; ksum[8 + e] += o1[e]; }
                }
                asm volatile("" ::: "memory");
            }
        if (isk) {
#pragma unroll
            for (int e = 0; e < 16; ++e) { float s = ksum[e]; s += __shfl_xor(s, 1); s += __shfl_xor(s, 2); s += __shfl_xor(s, 4); s += __shfl_xor(s, 8); ksum[e] = s; }
            if (fr == 0) {
                float* kp = kmp + ((size_t)(u.pm * 2 + wr) * 512) + head * 64 + 8 * fq;
                *(f32x4*)kp = (f32x4){ksum[0], ksum[1], ksum[2], ksum[3]}; *(f32x4*)(kp + 4) = (f32x4){ksum[4], ksum[5], ksum[6], ksum[7]};
                *(f32x4*)(kp + 32) = (f32x4){ksum[8], ksum[9], ksum[10], ksum[11]}; *(f32x4*)(kp + 36) = (f32x4){ksum[12], ksum[13], ksum[14], ksum[15]};
            }
        }
    }
};

template <class Epi, class Sched, bool ALIGN_EPI = false, bool SP2 = false>
__device__ __forceinline__ void gemm_phase(PG8_LAS unsigned char* lds, const Gemm g, const Sched& S, const Epi& E) {
    int tid_v = threadIdx.x; asm volatile("" : "+v"(tid_v));
    const int tid = tid_v, wid = __builtin_amdgcn_readfirstlane(tid >> 6), lane = tid & 63, wr = wid >> 2, wc = wid & 3, fr = lane & 15, fq = lane >> 4;
    const int K = g.K, nt = K / BK;
    unsigned voffA[2], voffB[2];
#pragma unroll
    for (int i = 0; i < 2; ++i) { int R, C; stage_rc(tid * 16 + i * 8192, R, C); const int Rb = Epi::PERM ? ((R & ~31) + perm32(R & 31)) : R;
        voffA[i] = (unsigned)(R * K + C) * 2u; voffB[i] = (unsigned)(Rb * K + C) * 2u; }
    const size_t kstep = (size_t)(BK * 2);
    const size_t hstep = (size_t)HALF * K * 2;
    const size_t tstep = 2 * hstep;
    const unsigned ldsw = (unsigned)wid * 1024u;
    const int aoff = lds_byte(wr * 64 + fr, fq * 8), boff = lds_byte(wc * 32 + fr, fq * 8);
#define PG8_SA(b, h) (((b) * 2 + (h)) * HTB)
#define PG8_SB(b, h) ((4 + (b) * 2 + (h)) * HTB)
#define PG8_STAGE(bufoff, gbase, voff) do { _Pragma("unroll") for (int _i = 0; _i < 2; ++_i) \
        __builtin_amdgcn_global_load_lds((const unsigned*)((const char*)(gbase) + (voff)[_i]), (PG8_LAS unsigned*)(lds + (bufoff) + ldsw + _i * 8192), 16, 0, 0); } while (0)
#define PG8_LDA(dst, b, h) do { _Pragma("unroll") for (int m = 0; m < 4; ++m) _Pragma("unroll") for (int k = 0; k < 2; ++k) dst[m][k] = *(const PG8_LAS bf16x8*)(lds + PG8_SA(b, h) + aoff + m * 2048 + k * 1024); } while (0)
#define PG8_LDB(dst, b, h) do { _Pragma("unroll") for (int n = 0; n < 2; ++n) _Pragma("unroll") for (int k = 0; k < 2; ++k) dst[n][k] = *(const PG8_LAS bf16x8*)(lds + PG8_SB(b, h) + boff + n * 2048 + k * 1024); } while (0)
#define PG8_MMA(ai, bj, At, Bt) do { __builtin_amdgcn_s_setprio(1); _Pragma("unroll") for (int m = 0; m < 4; ++m) _Pragma("unroll") for (int n = 0; n < 2; ++n) _Pragma("unroll") for (int k = 0; k < 2; ++k) \
        acc[ai][bj][m][n] = __builtin_amdgcn_mfma_f32_16x16x32_bf16(Bt[n][k], At[m][k], acc[ai][bj][m][n], 0, 0, 0); __builtin_amdgcn_s_setprio(0); } while (0)
#define PG8_WAIT_V(n) asm volatile("s_waitcnt vmcnt(" #n ")" ::: "memory")
#define PG8_WAIT_L(n) asm volatile("s_waitcnt lgkmcnt(" #n ")" ::: "memory")
#define PG8_BAR __builtin_amdgcn_s_barrier()
#define PG8_SCHED __builtin_amdgcn_sched_barrier(0)
    Unit cur, nxt; int ui = 0;
    if (!S.next(0, cur)) return;
    f32x4 acc[2][2][4][2];
#pragma unroll
    for (int a = 0; a < 2; ++a)
#pragma unroll
        for (int b = 0; b < 2; ++b)
#pragma unroll
            for (int m = 0; m < 4; ++m)
#pragma unroll
                for (int n = 0; n < 2; ++n) acc[a][b][m][n] = (f32x4){0.f, 0.f, 0.f, 0.f};
    bf16x8 At[4][2], B0[2][2], B1[2][2];
    const char* cA = (const char*)g.A + (size_t)cur.pm * tstep; const char* cB = (const char*)g.Bt + (size_t)cur.pn * tstep;
    S.a_ready(cur);
    if constexpr (SP2) {
        PG8_STAGE(PG8_SB(0, 0), cB, voffB); PG8_STAGE(PG8_SB(0, 1), cB + hstep, voffB); PG8_STAGE(PG8_SA(0, 0), cA, voffA); PG8_STAGE(PG8_SA(0, 1), cA + hstep, voffA);
        if (wr == 1) PG8_BAR;
        PG8_WAIT_V(2); PG8_BAR;
        PG8_STAGE(PG8_SB(1, 0), cB + kstep, voffB); PG8_STAGE(PG8_SA(1, 0), cA + kstep, voffA); PG8_STAGE(PG8_SB(1, 1), cB + hstep + kstep, voffB);
        PG8_WAIT_V(6); PG8_BAR;
    } else {
        PG8_STAGE(PG8_SB(0, 0), cB, voffB); PG8_STAGE(PG8_SA(0, 0), cA, voffA); PG8_STAGE(PG8_SB(0, 1), cB + hstep, voffB); PG8_STAGE(PG8_SA(0, 1), cA + hstep, voffA);
        if (wr == 1) PG8_BAR;
        PG8_WAIT_V(4); PG8_BAR;
        PG8_STAGE(PG8_SB(1, 0), cB + kstep, voffB); PG8_STAGE(PG8_SA(1, 0), cA + kstep, voffA); PG8_STAGE(PG8_SB(1, 1), cB + hstep + kstep, voffB);
        PG8_WAIT_V(6); PG8_BAR;
    }
    for (;;) {
        const bool has_next = S.next(ui + 1, nxt);
        const char* nA = has_next ? (const char*)g.A + (size_t)nxt.pm * tstep : cA; const char* nB = has_next ? (const char*)g.Bt + (size_t)nxt.pn * tstep : cB;
        for (int t = 0; t < nt; t += 2) {
            const bool last = (t == nt - 2);
            const char* a1 = cA + (size_t)(t + 1) * kstep;
            const char* a2 = last ? nA : cA + (size_t)(t + 2) * kstep; const char* b2 = last ? nB : cB + (size_t)(t + 2) * kstep;
            const char* a3 = a2 + kstep; const char* b3 = b2 + kstep;
            if (last && has_next) S.a_ready(nxt);
            if constexpr (SP2) {
            PG8_LDB(B0, 0, 0); PG8_LDB(B1, 0, 1); PG8_SCHED; PG8_LDA(At, 0, 0); PG8_STAGE(PG8_SA(1, 1), a1 + hstep, voffA);
            PG8_WAIT_V(8); PG8_WAIT_L(0); PG8_BAR; PG8_MMA(0, 0, At, B0); PG8_MMA(0, 1, At, B1); PG8_BAR; PG8_SCHED;
            PG8_LDA(At, 0, 1); PG8_STAGE(PG8_SB(0, 0), b2, voffB); PG8_STAGE(PG8_SB(0, 1), b2 + hstep, voffB); PG8_STAGE(PG8_SA(0, 0), a2, voffA);
            PG8_WAIT_V(8); PG8_WAIT_L(0); PG8_BAR; PG8_MMA(1, 0, At, B0); PG8_MMA(1, 1, At, B1); PG8_BAR; PG8_SCHED;
            PG8_LDB(B0, 1, 0); PG8_LDB(B1, 1, 1); PG8_SCHED; PG8_LDA(At, 1, 0); PG8_STAGE(PG8_SA(0, 1), a2 + hstep, voffA);
            PG8_WAIT_V(8); PG8_WAIT_L(0); PG8_BAR; PG8_MMA(0, 0, At, B0); PG8_MMA(0, 1, At, B1); PG8_BAR; PG8_SCHED;
            PG8_LDA(At, 1, 1); PG8_STAGE(PG8_SB(1, 0), b3, voffB); PG8_STAGE(PG8_SB(1, 1), b3 + hstep, voffB); PG8_STAGE(PG8_SA(1, 0), a3, voffA);
            PG8_WAIT_V(8); PG8_WAIT_L(0); PG8_BAR; PG8_MMA(1, 0, At, B0); PG8_MMA(1, 1, At, B1); PG8_BAR; PG8_SCHED;
            } else {
            PG8_LDB(B0, 0, 0); PG8_SCHED; PG8_LDA(At, 0, 0); PG8_STAGE(PG8_SA(1, 1), a1 + hstep, voffA);
            PG8_WAIT_L(8); PG8_BAR; PG8_WAIT_L(0); PG8_MMA(0, 0, At, B0); PG8_BAR; PG8_SCHED;
            PG8_LDB(B1, 0, 1); PG8_STAGE(PG8_SB(0, 0), b2, voffB);
            PG8_BAR; PG8_WAIT_L(0); PG8_MMA(0, 1, At, B1); PG8_BAR;
            PG8_LDA(At, 0, 1); PG8_STAGE(PG8_SA(0, 0), a2, voffA);
            PG8_BAR; PG8_WAIT_L(0); PG8_MMA(1, 0, At, B0); PG8_BAR; PG8_SCHED;
            PG8_STAGE(PG8_SB(0, 1), b2 + hstep, voffB);
            PG8_WAIT_V(6); PG8_BAR; PG8_MMA(1, 1, At, B1); PG8_BAR;
            PG8_LDB(B0, 1, 0); PG8_SCHED; PG8_LDA(At, 1, 0); PG8_STAGE(PG8_SA(0, 1), a2 + hstep, voffA);
            PG8_WAIT_L(8); PG8_BAR; PG8_WAIT_L(0); PG8_MMA(0, 0, At, B0); PG8_BAR; PG8_SCHED;
            PG8_LDB(B1, 1, 1); PG8_STAGE(PG8_SB(1, 0), b3, voffB);
            PG8_BAR; PG8_WAIT_L(0); PG8_MMA(0, 1, At, B1); PG8_BAR;
            PG8_LDA(At, 1, 1); PG8_STAGE(PG8_SA(1, 0), a3, voffA);
            PG8_BAR; PG8_WAIT_L(0); PG8_MMA(1, 0, At, B0); PG8_BAR; PG8_SCHED;
            PG8_STAGE(PG8_SB(1, 1), b3 + hstep, voffB);
            PG8_WAIT_V(6); PG8_BAR; PG8_MMA(1, 1, At, B1); PG8_BAR;
            }
        }
        if constexpr (ALIGN_EPI) { if (wr == 0) PG8_BAR; }
        if constexpr (!Epi::AFTER_DRAIN) { E(acc, cur, wr, wc, fr, fq); S.done(cur); }
        if (!has_next) break;
#pragma unroll
        for (int a = 0; a < 2; ++a)
#pragma unroll
            for (int b = 0; b < 2; ++b)
#pragma unroll
                for (int m = 0; m < 4; ++m)
#pragma unroll
                    for (int n = 0; n < 2; ++n) acc[a][b][m][n] = (f32x4){0.f, 0.f, 0.f, 0.f};
        cur = nxt; cA = nA; cB = nB; ++ui;
        if constexpr (ALIGN_EPI) { if (wr == 1) PG8_BAR; }
    }
    PG8_WAIT_V(0);
    if constexpr (!ALIGN_EPI) { if (wr == 0) PG8_BAR; }
    PG8_BAR;
    if constexpr (Epi::AFTER_DRAIN) { E.fused(acc, cur, wr, wc, fr, fq, lds, wid, lane); S.done(cur); }
#undef PG8_SA
#undef PG8_SB
#undef PG8_STAGE
#undef PG8_LDA
#undef PG8_LDB
#undef PG8_MMA
#undef PG8_WAIT_V
#undef PG8_WAIT_L
#undef PG8_BAR
#undef PG8_SCHED
}
}

#ifndef PG8_SP2
#define PG8_SP2 true
#endif
#ifndef PG8_ALIGN
#define PG8_ALIGN true
#endif

#define DI __device__ __forceinline__
typedef unsigned short bf16;
typedef short bf16x8 __attribute__((ext_vector_type(8)));
typedef float f32x4 __attribute__((ext_vector_type(4)));
typedef float f32x16 __attribute__((ext_vector_type(16)));
typedef unsigned u32x4 __attribute__((ext_vector_type(4)));
typedef unsigned u32x2 __attribute__((ext_vector_type(2)));
#define MFMA32(a, b, c) __builtin_amdgcn_mfma_f32_32x32x16_bf16((a), (b), (c), 0, 0, 0)

constexpr int NWAVES = 8, NTHR = 512;
constexpr int M = 16384, D = 1024, FF = 2816, INW = 2816, SEQ = 8192, DEPTH = 4;
constexpr int LDS_BYTES = 147456;
constexpr size_t MiB = 1u << 20;
constexpr size_t WS_CTL = 0;
constexpr size_t WS_STATS = 1 * MiB;
constexpr size_t WS_KMP = 2 * MiB;
constexpr size_t WS_DEC = 2 * MiB + 512 * 1024;
constexpr size_t WS_ROPEC = 3 * MiB, WS_ROPES = 4 * MiB;
constexpr size_t WS_W = 5 * MiB, WSZ = 42467328;
constexpr size_t W_GU1 = 0, W_D1 = 11534336, W_IN = 17301504, W_OUT = 23068672, W_GU2 = 25165824, W_D2 = 36700160;
constexpr size_t WS_XB = 86 * MiB;
constexpr size_t WS_R = 118 * MiB;
constexpr size_t R_HID = 0;
constexpr size_t R_Q = 0, R_K = 16 * MiB, R_V = 32 * MiB, R_U5 = 48 * MiB  , R_Y = 88 * MiB, R_PO = 120 * MiB, R_PML = 168 * MiB,
                 R_LIST = 172 * MiB  , R_ALOC = 188 * MiB, R_OINTRA = 204 * MiB, R_QDEC = 220 * MiB, R_SP = 228 * MiB, R_END = 236 * MiB;
constexpr size_t WS_END = WS_R + R_END;

DI float bf2f(unsigned short b) { return __uint_as_float((unsigned)b << 16); }
DI unsigned cvtpk(float lo, float hi) { return pg8::cvtpk(lo, hi); }
DI float wave_sum(float v) {
#pragma unroll
    for (int o = 1; o < 64; o <<= 1) v += __shfl_xor(v, o);
    return v;
}
DI void st_sc1(unsigned* p, unsigned v) { __hip_atomic_store(p, v, __ATOMIC_RELAXED, __HIP_MEMORY_SCOPE_AGENT); }
DI unsigned ld_sc1(const unsigned* p) { return __hip_atomic_load(p, __ATOMIC_RELAXED, __HIP_MEMORY_SCOPE_AGENT); }
DI float ld_sc1f(const float* p) { return __uint_as_float(__hip_atomic_load((const unsigned*)p, __ATOMIC_RELAXED, __HIP_MEMORY_SCOPE_AGENT)); }
DI int crow(int reg, int h) { return (reg & 3) + 8 * (reg >> 2) + 4 * h; }
DI bf16x8 pack8(const f32x16& x, int s) {
    u32x4 p; p.x = cvtpk(x[8 * s], x[8 * s + 1]); p.y = cvtpk(x[8 * s + 2], x[8 * s + 3]); p.z = cvtpk(x[8 * s + 4], x[8 * s + 5]); p.w = cvtpk(x[8 * s + 6], x[8 * s + 7]);
    return __builtin_bit_cast(bf16x8, p);
}
DI f32x16 zero16() { f32x16 z;
#pragma unroll
    for (int i = 0; i < 16; ++i) z[i] = 0.f; return z; }

struct Args { const float* in[18]; float* out; unsigned char* ws; int ph_lo, ph_hi; };
typedef const float* cfp_t;
typedef const __attribute__((address_space(4))) unsigned char* kptr_t;
struct Ctx { kptr_t kp; unsigned char* ws; float* out;
    DI const float* in(int i) const { return *(const __attribute__((address_space(4))) cfp_t*)(kp + 8 * i); } };
enum { I_X = 0, I_F1N, I_F1G, I_F1U, I_F1D, I_MIXN, I_WIN, I_QN, I_KN, I_PW, I_PS, I_LB, I_HON, I_WOUT, I_F2N, I_F2G, I_F2U, I_F2D };

DI void wconv_tile(const float* W, int ld, int srccol, const float* gain, bf16* WT, int K, int nrow0, int k0, float* scr, int lane) {
    asm volatile("" : "+v"(lane));
#pragma unroll 16
    for (int i = 0; i < 32; ++i) { const int kk = 2 * i + (lane >> 5); float v = W[(size_t)(k0 + kk) * ld + srccol + (lane & 31)]; if (gain) v *= gain[k0 + kk]; scr[kk * 33 + (lane & 31)] = v; }
    asm volatile("s_waitcnt lgkmcnt(0)" ::: "memory");
    const int c = lane & 7;
#pragma unroll
    for (int j = 0; j < 4; ++j) { const int n = (lane >> 3) + 8 * j; const float* s = scr + (8 * c) * 33 + n;
        u32x4 o; o.x = cvtpk(s[0 * 33], s[1 * 33]); o.y = cvtpk(s[2 * 33], s[3 * 33]); o.z = cvtpk(s[4 * 33], s[5 * 33]); o.w = cvtpk(s[6 * 33], s[7 * 33]);
        *(u32x4*)(WT + (size_t)(nrow0 + n) * K + k0 + 8 * c) = o; }
    asm volatile("s_waitcnt lgkmcnt(0)" ::: "memory");
}
constexpr int WC_I0 = 2816, WC_I1 = 1408, WC_I2 = 1408, WC_I3 = 512, WC_I4 = 2816, WC_I5 = 1408, WC_ITEMS = WC_I0 + WC_I1 + WC_I2 + WC_I3 + WC_I4 + WC_I5;
DI void wconv_item(const Ctx& a, int L, int item, float* scr, int lane) {
    unsigned char* wb = a.ws + WS_W + (size_t)(L & 1) * WSZ;
    int r = item;
    if (r < WC_I0 || (r >= WC_I0 + WC_I1 + WC_I2 + WC_I3 && r < WC_I0 + WC_I1 + WC_I2 + WC_I3 + WC_I4)) {
        const bool second = r >= WC_I0; if (second) r -= WC_I0 + WC_I1 + WC_I2 + WC_I3;
        const int kb = r / 176, nb = r % 176, n0 = nb * 32, pn = n0 >> 8, c = n0 & 255, bj = c >> 7, col = 128 * pn + (c & 127);
        const float* src = a.in(second ? (bj ? I_F2U : I_F2G) : (bj ? I_F1U : I_F1G)) + (size_t)L * D * FF;
        const float* gain = a.in(second ? I_F2N : I_F1N) + L * D;
        wconv_tile(src, FF, col, gain, (bf16*)(wb + (second ? W_GU2 : W_GU1)), D, n0, kb * 64, scr, lane); return;
    }
    r -= WC_I0;
    if (r < WC_I1) { const int kb = r / 32, nb = r % 32; wconv_tile(a.in(I_F1D) + (size_t)L * FF * D, D, nb * 32, nullptr, (bf16*)(wb + W_D1), FF, nb * 32, kb * 64, scr, lane); return; }
    r -= WC_I1;
    if (r < WC_I2) { const int kb = r / 88, nb = r % 88, n0 = nb * 32, pn = n0 >> 8, c = n0 & 255;
        const int col = pn < 6 ? (pn >> 1) * 512 + 64 * ((pn & 1) * 4 + ((c >> 5) & 3)) + 32 * (c >> 7) : n0;
        wconv_tile(a.in(I_WIN) + (size_t)L * D * INW, INW, col, a.in(I_MIXN) + L * D, (bf16*)(wb + W_IN), D, n0, kb * 64, scr, lane); return; }
    r -= WC_I2;
    if (r < WC_I3) { const int kb = r / 32, nb = r % 32; wconv_tile(a.in(I_WOUT) + (size_t)L * D * D, D, nb * 32, nullptr, (bf16*)(wb + W_OUT), D, nb * 32, kb * 64, scr, lane); return; }
    r -= WC_I3 + WC_I4;
    { const int kb = r / 32, nb = r % 32; wconv_tile(a.in(I_F2D) + (size_t)L * FF * D, D, nb * 32, nullptr, (bf16*)(wb + W_D2), FF, nb * 32, kb * 64, scr, lane); }
}

DI void phase_p0(const Ctx& a, unsigned char* lds, int gw, int NGW, int wave, int lane) {
    const float* x = a.in(I_X); float* out = a.out; bf16* xb = (bf16*)(a.ws + WS_XB); float* stats = (float*)(a.ws + WS_STATS);
    for (int m0 = gw * 2; m0 < M; m0 += NGW * 2) {
        f32x4 v[2][4]; float sq[2];
#pragma unroll
        for (int k = 0; k < 2; ++k) { const f32x4* xr = (const f32x4*)(x + (size_t)(m0 + k) * D) + lane;
#pragma unroll
            for (int j = 0; j < 4; ++j) v[k][j] = xr[64 * j]; }
#pragma unroll
        for (int k = 0; k < 2; ++k) { float s = 0.f;
#pragma unroll
            for (int j = 0; j < 4; ++j) s += (v[k][j][0] * v[k][j][0] + v[k][j][1] * v[k][j][1]) + (v[k][j][2] * v[k][j][2] + v[k][j][3] * v[k][j][3]);
            sq[k] = wave_sum(s); }
#pragma unroll
        for (int k = 0; k < 2; ++k) { const int m = m0 + k;
            f32x4* orow = (f32x4*)(out + (size_t)m * D) + lane; u32x2* brow = (u32x2*)(xb + (size_t)m * D) + lane;
#pragma unroll
            for (int j = 0; j < 4; ++j) { orow[64 * j] = v[k][j]; u32x2 w; w.x = cvtpk(v[k][j][0], v[k][j][1]); w.y = cvtpk(v[k][j][2], v[k][j][3]); brow[64 * j] = w; }
            if (lane < 16) stats[(size_t)m * 16 + lane] = (lane == 0) ? sq[k] : 0.f; }
    }
    { unsigned* cz = (unsigned*)(a.ws + WS_CTL + 65536); for (int i = gw * 64 + lane; i < 3456; i += NGW * 64) cz[i] = 0u; }
    float* rc = (float*)(a.ws + WS_ROPEC); float* rs = (float*)(a.ws + WS_ROPES);
    for (int e = gw * 64 + lane; e < SEQ * 32; e += NGW * 64) {
        const int t = e >> 5, i = e & 31;
        double c = 0.15915494309189535;
        for (int k = 0; k < i; ++k) c *= 0.74989420933245582;
        const float chi = (float)c, clo = (float)(c - (double)chi), tf = (float)t;
        const float p = tf * chi, pe = fmaf(tf, chi, -p);
        float fr = __builtin_amdgcn_fractf(p) + (pe + tf * clo);
        rc[e] = __builtin_amdgcn_cosf(fr); rs[e] = __builtin_amdgcn_sinf(fr);
    }
    float* scr = (float*)(lds + wave * 16384);
    for (int it = gw; it < WC_ITEMS; it += NGW) wconv_item(a, 0, it, scr, lane);
}

template <bool DIAG>
DI void attn_core(const bf16* qrow, const bf16* kblk, const bf16* vblk, int nkg, int r, int h, float& m_out, float& l_out, f32x16 (&ot)[2]) {
    bf16x8 qf[4];
#pragma unroll
    for (int ks = 0; ks < 4; ++ks) qf[ks] = *(const bf16x8*)(qrow + 16 * ks + 8 * h);
    f32x16 st[8];
    const int lo = (r * 2 + h) * 8;
#pragma unroll
    for (int hf = 0; hf < 2; ++hf) {
        if (!DIAG || 4 * hf < nkg) {
            bf16x8 kf[16];
#pragma unroll
            for (int i = 0; i < 16; ++i) kf[i] = (!DIAG || 4 * hf + (i >> 2) < nkg) ? *(const bf16x8*)(kblk + ((4 * hf + (i >> 2)) * 4 + (i & 3)) * 512 + lo) : qf[0];
#pragma unroll
            for (int g = 0; g < 4; ++g) {
                const int kg = 4 * hf + g;
                f32x16 acc = zero16();
                if (!DIAG || kg < nkg) {
#pragma unroll
                    for (int ks = 0; ks < 4; ++ks) acc = MFMA32(kf[4 * g + ks], qf[ks], acc);
                    if (DIAG && kg == nkg - 1) {
#pragma unroll
                        for (int i = 0; i < 16; ++i) if (crow(i, h) > r) acc[i] = -INFINITY;
                    }
                } else {
#pragma unroll
                    for (int i = 0; i < 16; ++i) acc[i] = -INFINITY;
                }
                st[kg] = acc;
            }
        } else {
#pragma unroll
            for (int g = 0; g < 4; ++g)
#pragma unroll
                for (int i = 0; i < 16; ++i) st[4 * hf + g][i] = -INFINITY;
        }
    }
    float mx = -INFINITY;
#pragma unroll
    for (int kg = 0; kg < 8; ++kg)
#pragma unroll
        for (int i = 0; i < 16; ++i) mx = fmaxf(mx, st[kg][i]);
    mx = fmaxf(mx, __shfl_xor(mx, 32));
    const float c = 0.125f * 1.4426950408889634f; const float mc = mx * c;
    float l = 0.f;
#pragma unroll
    for (int kg = 0; kg < 8; ++kg)
#pragma unroll
        for (int i = 0; i < 16; ++i) { const float p = __builtin_amdgcn_exp2f(st[kg][i] * c - mc); st[kg][i] = p; l += p; }
    l += __shfl_xor(l, 32);
    ot[0] = zero16(); ot[1] = zero16();
#pragma unroll
    for (int pr = 0; pr < 4; ++pr) {
        if (!DIAG || 2 * pr < nkg) {
            bf16x8 vf[8];
#pragma unroll
            for (int i = 0; i < 8; ++i) vf[i] = (!DIAG || 2 * pr + (i >> 2) < nkg) ? *(const bf16x8*)(vblk + (((2 * pr + (i >> 2)) * 2 + ((i >> 1) & 1)) * 2 + (i & 1)) * 512 + lo) : qf[0];
#pragma unroll
            for (int g = 0; g < 2; ++g) {
                const int kg = 2 * pr + g;
                if (!DIAG || kg < nkg) {
#pragma unroll
                    for (int s2 = 0; s2 < 2; ++s2) { const bf16x8 pf = pack8(st[kg], s2); ot[0] = MFMA32(vf[4 * g + 2 * s2], pf, ot[0]); ot[1] = MFMA32(vf[4 * g + 2 * s2 + 1], pf, ot[1]); }
                }
            }
        }
    }
    m_out = mx * 0.125f; l_out = l;
}

DI void topk_unit(const Ctx& a, int L, int unit, int lane) {
    asm volatile("" : "+v"(lane));
    const int b = unit >> 10, hd = (unit >> 7) & 7, c = unit & 127, own = c >> 2;
    if (own == 0) return;
    const bf16* Q = (const bf16*)(a.ws + WS_R + R_Q); const float* kmp = (const float*)(a.ws + WS_KMP);
    unsigned* cnt = (unsigned*)(a.ws + WS_CTL) + L * 512; unsigned* lists = (unsigned*)(a.ws + WS_R + R_LIST);
    const int t = c * 64 + lane; const size_t bh = (size_t)(b * 8 + hd);
    float q[64];
    { const u32x4* qp = (const u32x4*)(Q + (bh * SEQ + t) * 64);
#pragma unroll
      for (int i = 0; i < 8; ++i) { const u32x4 w = qp[i];
          q[8 * i + 0] = __uint_as_float(w.x << 16); q[8 * i + 1] = __uint_as_float(w.x & 0xffff0000u); q[8 * i + 2] = __uint_as_float(w.y << 16); q[8 * i + 3] = __uint_as_float(w.y & 0xffff0000u);
          q[8 * i + 4] = __uint_as_float(w.z << 16); q[8 * i + 5] = __uint_as_float(w.z & 0xffff0000u); q[8 * i + 6] = __uint_as_float(w.w << 16); q[8 * i + 7] = __uint_as_float(w.w & 0xffff0000u); } }
    float g0 = -INFINITY, g1 = -INFINITY, g2 = -INFINITY; int i0 = 0, i1 = 0, i2 = 0;
    for (int j = 0; j < own; ++j) {
        const float* p0 = kmp + (size_t)((b * 32 + j) * 2) * 512 + hd * 64; const float* p1 = p0 + 512;
        float g = 0.f;
#pragma unroll
        for (int d = 0; d < 64; d += 4) { const f32x4 x0 = *(const f32x4*)(p0 + d), x1 = *(const f32x4*)(p1 + d);
            g += q[d] * (x0[0] + x1[0]) + q[d + 1] * (x0[1] + x1[1]) + q[d + 2] * (x0[2] + x1[2]) + q[d + 3] * (x0[3] + x1[3]); }
#ifdef DBG_FIXED_SEL
        g = -(float)j;
#endif
        if (g > g0) { g2 = g1; i2 = i1; g1 = g0; i1 = i0; g0 = g; i0 = j; }
        else if (g > g1) { g2 = g1; i2 = i1; g1 = g; i1 = j; }
        else if (g > g2) { g2 = g; i2 = j; }
    }
    const int nsel = own < 3 ? own : 3;
#pragma unroll
    for (int s = 0; s < 3; ++s) {
        if (s < nsel) { const int j = s == 0 ? i0 : (s == 1 ? i1 : i2); const int li = (int)bh * 32 + j;
            const unsigned pos = atomicAdd(cnt + li, 1u); st_sc1(lists + (size_t)li * 8192 + pos, (unsigned)(t | (s << 13))); }
    }
}

DI void pool_unit(const Ctx& a, int L, int unit, int lane) {
    asm volatile("" : "+v"(lane));
    const int tile = unit >> 2, g = unit & 3, w = 2 << g, r = lane & 31, h = lane >> 5;
    const bf16* U = (const bf16*)(a.ws + WS_R + R_U5); bf16* Y = (bf16*)(a.ws + WS_R + R_Y);
    const float* pw = a.in(I_PW) + (size_t)(L * 4 + g) * 4096; const float* ps = a.in(I_PS) + L * 256 + g * 64;
    const float* pwl = pw + (8 * h) * 64 + r;
    bf16x8 wf[2][4];
#pragma unroll
    for (int me = 0; me < 2; ++me)
#pragma unroll
        for (int ks = 0; ks < 4; ++ks) { float f[8];
#pragma unroll
            for (int j = 0; j < 8; ++j) f[j] = pwl[(16 * ks + j) * 64 + 32 * me];
            u32x4 p; p.x = cvtpk(f[0], f[1]); p.y = cvtpk(f[2], f[3]); p.z = cvtpk(f[4], f[5]); p.w = cvtpk(f[6], f[7]); wf[me][ks] = __builtin_bit_cast(bf16x8, p); }
#pragma unroll 1
    for (int nt = 0; nt < 4; ++nt) {
        const int m = tile * 128 + nt * 32 + r, tpos = m & (SEQ - 1);
        const int cntw = tpos + 1 < w ? tpos + 1 : w; const float invc = 1.0f / (float)cntw;
        f32x16 acc[2]; acc[0] = zero16(); acc[1] = zero16();
#pragma unroll
        for (int ks = 0; ks < 4; ++ks) {
            const bf16* up = U + (size_t)m * 256 + g * 64 + 16 * ks + 8 * h;
            float sum[8], self[8];
            { const u32x4 wv = *(const u32x4*)up;
              self[0] = __uint_as_float(wv.x << 16); self[1] = __uint_as_float(wv.x & 0xffff0000u); self[2] = __uint_as_float(wv.y << 16); self[3] = __uint_as_float(wv.y & 0xffff0000u);
              self[4] = __uint_as_float(wv.z << 16); self[5] = __uint_as_float(wv.z & 0xffff0000u); self[6] = __uint_as_float(wv.w << 16); self[7] = __uint_as_float(wv.w & 0xffff0000u); }
#pragma unroll
            for (int j = 0; j < 8; ++j) sum[j] = self[j];
            u32x4 rows[15];
#pragma unroll
            for (int i = 1; i < 16; ++i) { const bool ok = (i < w) && (i <= tpos); rows[i - 1] = *(const u32x4*)(up - (size_t)(ok ? i : 0) * 256); }
#pragma unroll
            for (int i = 1; i < 16; ++i) { const bool ok = (i < w) && (i <= tpos); const float kf = ok ? 1.f : 0.f; const u32x4 wv = rows[i - 1];
                sum[0] += kf * __uint_as_float(wv.x << 16); sum[1] += kf * __uint_as_float(wv.x & 0xffff0000u); sum[2] += kf * __uint_as_float(wv.y << 16); sum[3] += kf * __uint_as_float(wv.y & 0xffff0000u);
                sum[4] += kf * __uint_as_float(wv.z << 16); sum[5] += kf * __uint_as_float(wv.z & 0xffff0000u); sum[6] += kf * __uint_as_float(wv.w << 16); sum[7] += kf * __uint_as_float(wv.w & 0xffff0000u); }
            u32x4 p; p.x = cvtpk(sum[0] * invc - self[0], sum[1] * invc - self[1]); p.y = cvtpk(sum[2] * invc - self[2], sum[3] * invc - self[3]);
            p.z = cvtpk(sum[4] * invc - self[4], sum[5] * invc - self[5]); p.w = cvtpk(sum[6] * invc - self[6], sum[7] * invc - self[7]);
            const bf16x8 df = __builtin_bit_cast(bf16x8, p);
            acc[0] = MFMA32(wf[0][ks], df, acc[0]); acc[1] = MFMA32(wf[1][ks], df, acc[1]);
        }
#pragma unroll
        for (int me = 0; me < 2; ++me)
#pragma unroll
            for (int gq = 0; gq < 4; ++gq) { const int e0 = 32 * me + 8 * gq + 4 * h; const f32x4 sc = *(const f32x4*)(ps + e0);
                u32x2 o; o.x = cvtpk(acc[me][4 * gq] * sc[0], acc[me][4 * gq + 1] * sc[1]); o.y = cvtpk(acc[me][4 * gq + 2] * sc[2], acc[me][4 * gq + 3] * sc[3]);
                *(u32x2*)(Y + (size_t)m * 1024 + 512 + g * 64 + e0) = o; }
    }
}

DI void h1_unit(const Ctx& a, int L, int unit, unsigned char* sm, int lane) {
    asm volatile("" : "+v"(lane));
    const int b = unit >> 9, hh = (unit >> 7) & 3, n = unit & 127, r = lane & 31, h = lane >> 5;
    const int row0 = b * SEQ + n * 64, ch = hh * 64 + lane;
    const bf16* QH = (const bf16*)(a.ws + WS_R + R_U5) + (size_t)1 * M * 256; const bf16* FH = QH + (size_t)M * 256; const bf16* IH = FH + (size_t)M * 256;
    bf16* QDEC = (bf16*)(a.ws + WS_R + R_QDEC); float* ALOC = (float*)(a.ws + WS_R + R_ALOC); float* OINTRA = (float*)(a.ws + WS_R + R_OINTRA); float* DEC = (float*)(a.ws + WS_DEC);
    bf16* KD = (bf16*)sm; bf16* IT = (bf16*)(sm + 8192); bf16* Am = (bf16*)(sm + 16384); bf16* Bm = (bf16*)(sm + 24576);
#ifdef DBG_H1_CLEAR
    { u32x4* z4 = (u32x4*)sm;
#pragma unroll 4
      for (int i = 0; i < 32; ++i) z4[i * 64 + lane] = (u32x4){0u, 0u, 0u, 0u}; asm volatile("s_waitcnt lgkmcnt(0)" ::: "memory"); }
#endif
    float lb;
    { const float* lp = a.in(I_LB) + ch; const float x0 = lp[0], x1 = lp[256], x2 = lp[512], x3 = lp[768];
      const float mx = fmaxf(fmaxf(x0, x1), fmaxf(x2, x3)); const float e0 = __expf(x0 - mx), e1 = __expf(x1 - mx), e2 = __expf(x2 - mx), e3 = __expf(x3 - mx);
      const float inv = 1.0f / (e0 + e1 + e2 + e3); float acc = 0.f; if (L > 0) acc += e0; if (L > 1) acc += e1; if (L > 2) acc += e2; lb = acc * inv; }
    const float loglb = __logf(fmaxf(lb, 1e-20f)), l1m = __logf(1.0f - lb), oml = 1.0f - lb;
    float zr[64];
#pragma unroll
    for (int s = 0; s < 64; ++s) zr[s] = bf2f(FH[(size_t)(row0 + s) * 256 + ch]);
    float cum = 0.f, ref = 0.f;
#pragma unroll
    for (int s = 0; s < 64; ++s) {
        const float z = zr[s];
        const float ls = fminf(z, 0.f) - __logf(1.0f + __expf(-fabsf(z)));
        const float bb = l1m + ls, hi = fmaxf(loglb, bb), df = fabsf(loglb - bb);
        cum += hi + __logf(1.0f + __expf(-df));
        asm volatile("" : "+v"(cum));
        if (s == 31) ref = cum;
    }
    const float last = cum;
    DEC[unit * 64 + lane] = __expf(last);
    cum = 0.f;
#ifndef H1_NO_P2
#pragma unroll 1
    for (int s8 = 0; s8 < 8; ++s8) {
        unsigned kp[4], ip[4]; float kd8[8]; unsigned short i8[8];
#pragma unroll
        for (int j = 0; j < 8; ++j) {
            const int s = s8 * 8 + j; const size_t gi = (size_t)(row0 + s) * 256 + ch;
            const float z = bf2f(FH[gi]), qv = bf2f(QH[gi]); i8[j] = IH[gi];
            const float ls = fminf(z, 0.f) - __logf(1.0f + __expf(-fabsf(z)));
            const float bb = l1m + ls, hi = fmaxf(loglb, bb), df = fabsf(loglb - bb);
            cum += hi + __logf(1.0f + __expf(-df));
            const float key = oml * __builtin_amdgcn_rcpf(1.0f + __expf(z));
            const float qs = qv * __builtin_amdgcn_rcpf(1.0f + __expf(-qv)) * 0.125f;
            const float av = qs * __expf(fminf(cum - ref, 80.f)), bv = key * __expf(fminf(ref - cum, 80.f)), qd = qs * __expf(cum);
            kd8[j] = key * __expf(last - cum);
#ifndef H1_NO_AB
            Am[s * 64 + lane] = (bf16)(cvtpk(av, 0.f) & 0xffffu); Bm[s * 64 + lane] = (bf16)(cvtpk(bv, 0.f) & 0xffffu);
#endif
#ifndef H1_NO_QD
            QDEC[gi] = (bf16)(cvtpk(qd, 0.f) & 0xffffu);
#endif
        }
#pragma unroll
        for (int j = 0; j < 4; ++j) { kp[j] = cvtpk(kd8[2 * j], kd8[2 * j + 1]); ip[j] = (unsigned)i8[2 * j] | ((unsigned)i8[2 * j + 1] << 16); }
        *(u32x4*)(KD + lane * 64 + s8 * 8) = (u32x4){kp[0], kp[1], kp[2], kp[3]};
        *(u32x4*)(IT + lane * 64 + s8 * 8) = (u32x4){ip[0], ip[1], ip[2], ip[3]};
    }
#endif
    asm volatile("s_waitcnt lgkmcnt(0)" ::: "memory");
#ifndef H1_NO_MM
    bf16x8 itf[2][2][2];
#pragma unroll
    for (int mv = 0; mv < 2; ++mv)
#pragma unroll
        for (int ms = 0; ms < 2; ++ms)
#pragma unroll
            for (int st = 0; st < 2; ++st) { const bf16* p = IT + (32 * mv + r) * 64 + 32 * ms + 16 * st + 4 * h; const u32x2 x0 = *(const u32x2*)p, x1 = *(const u32x2*)(p + 8);
                itf[mv][ms][st] = __builtin_bit_cast(bf16x8, ((u32x4){x0.x, x0.y, x1.x, x1.y})); }
    float* alb = ALOC + (size_t)unit * 4096 + (4 * h) * 64 + r;
#pragma unroll
    for (int nk = 0; nk < 2; ++nk) {
        bf16x8 kdf[2][2];
#pragma unroll
        for (int ms = 0; ms < 2; ++ms)
#pragma unroll
            for (int st = 0; st < 2; ++st) { const bf16* p = KD + (32 * nk + r) * 64 + 32 * ms + 16 * st + 4 * h; const u32x2 x0 = *(const u32x2*)p, x1 = *(const u32x2*)(p + 8);
                kdf[ms][st] = __builtin_bit_cast(bf16x8, ((u32x4){x0.x, x0.y, x1.x, x1.y})); }
#pragma unroll
        for (int mv = 0; mv < 2; ++mv) {
            f32x16 acc = zero16();
#pragma unroll
            for (int ms = 0; ms < 2; ++ms)
#pragma unroll
                for (int st = 0; st < 2; ++st) acc = MFMA32(itf[mv][ms][st], kdf[ms][st], acc);
#pragma unroll
            for (int i = 0; i < 16; ++i) alb[(32 * mv + (i & 3) + 8 * (i >> 2)) * 64 + 32 * nk] = acc[i];
        }
    }
#pragma unroll
    for (int nt = 0; nt < 2; ++nt) {
        bf16x8 af[4];
#pragma unroll
        for (int ks = 0; ks < 4; ++ks) af[ks] = *(const bf16x8*)(Am + (32 * nt + r) * 64 + 16 * ks + 8 * h);
        f32x16 oi[2]; oi[0] = zero16(); oi[1] = zero16();
#pragma unroll
        for (int ms = 0; ms < 2; ++ms) {
            if (ms <= nt) {
                f32x16 sacc = zero16();
#pragma unroll
                for (int ks = 0; ks < 4; ++ks) { const bf16x8 bf_ = *(const bf16x8*)(Bm + (32 * ms + r) * 64 + 16 * ks + 8 * h); sacc = MFMA32(bf_, af[ks], sacc); }
                if (ms == nt) {
#pragma unroll
                    for (int i = 0; i < 16; ++i) if (crow(i, h) > r) sacc[i] = 0.f;
                }
#pragma unroll
                for (int st = 0; st < 2; ++st) { const bf16x8 pf = pack8(sacc, st); oi[0] = MFMA32(itf[0][ms][st], pf, oi[0]); oi[1] = MFMA32(itf[1][ms][st], pf, oi[1]); }
            }
        }
        const size_t orow = (size_t)(row0 + 32 * nt + r) * 256 + hh * 64;
#pragma unroll
        for (int mv = 0; mv < 2; ++mv)
#pragma unroll
            for (int gq = 0; gq < 4; ++gq) *(f32x4*)(OINTRA + orow + 32 * mv + 8 * gq + 4 * h) = (f32x4){oi[mv][4 * gq], oi[mv][4 * gq + 1], oi[mv][4 * gq + 2], oi[mv][4 * gq + 3]};
    }
#endif
    asm volatile("s_waitcnt lgkmcnt(0)" ::: "memory");
}

DI void phase_t(const Ctx& a, int L, unsigned char* lds, int gw, int NGW, int wave, int lane) {
    for (int u = gw; u < 2048; u += NGW) pool_unit(a, L, u, lane);
    { float* scr = (float*)(lds + wave * 16384); for (int it = gw; it < WC_ITEMS; it += NGW) wconv_item(a, (L + 1) & 3, it, scr, lane); }
    __syncthreads();
    if (wave < 4) { const int hw = (gw >> 3) * 4 + wave, NHW = (NGW >> 3) * 4; for (int u = hw; u < 1024; u += NHW) h1_unit(a, L, u, lds + wave * 32768, lane); }
}

DI void attn_unit(const Ctx& a, int bh, int qb, unsigned char* lds, int tid, int wave, int lane) {
    asm volatile("" : "+v"(lane), "+v"(tid));
    const int r = lane & 31, h = lane >> 5, b = bh >> 3, hd = bh & 7, own = qb, nsel = own < 3 ? own : 3;
    const bf16* Q = (const bf16*)(a.ws + WS_R + R_Q); const bf16* Kb = (const bf16*)(a.ws + WS_R + R_K); const bf16* Vb = (const bf16*)(a.ws + WS_R + R_V);
    const float* kmp = (const float*)(a.ws + WS_KMP); bf16* Y = (bf16*)(a.ws + WS_R + R_Y);
    unsigned char* part = lds;
    unsigned short* llist = (unsigned short*)(lds + 104448);
    int* lcnt = (int*)(lds + 120832); int* itab = lcnt + 32;
    const size_t qbase = ((size_t)bh * SEQ + (size_t)qb * 256) * 64;
    if (own > 0) {
        if (tid < 32) lcnt[tid] = 0;
        float* km = (float*)(lds + 122880);
        for (int idx = tid; idx < own * 64; idx += NTHR) { const float* p0 = kmp + (size_t)((b * 32 + (idx >> 6)) * 2) * 512 + hd * 64 + (idx & 63); km[idx] = p0[0] + p0[512]; }
        __syncthreads();
        if (tid < 256) {
            float q[64];
            { const u32x4* qp = (const u32x4*)(Q + qbase + (size_t)tid * 64);
#pragma unroll
              for (int i = 0; i < 8; ++i) { const u32x4 w = qp[i];
                  q[8 * i + 0] = __uint_as_float(w.x << 16); q[8 * i + 1] = __uint_as_float(w.x & 0xffff0000u); q[8 * i + 2] = __uint_as_float(w.y << 16); q[8 * i + 3] = __uint_as_float(w.y & 0xffff0000u);
                  q[8 * i + 4] = __uint_as_float(w.z << 16); q[8 * i + 5] = __uint_as_float(w.z & 0xffff0000u); q[8 * i + 6] = __uint_as_float(w.w << 16); q[8 * i + 7] = __uint_as_float(w.w & 0xffff0000u); } }
            float g0 = -INFINITY, g1 = -INFINITY, g2 = -INFINITY; int i0 = 0, i1 = 0, i2 = 0;
            for (int j = 0; j < own; ++j) {
                const float* kj = km + j * 64;
                float g = 0.f;
#pragma unroll
                for (int d = 0; d < 64; d += 4) { const f32x4 x0 = *(const f32x4*)(kj + d);
                    g += q[d] * x0[0] + q[d + 1] * x0[1] + q[d + 2] * x0[2] + q[d + 3] * x0[3]; }
                if (g > g0) { g2 = g1; i2 = i1; g1 = g0; i1 = i0; g0 = g; i0 = j; }
                else if (g > g1) { g2 = g1; i2 = i1; g1 = g; i1 = j; }
                else if (g > g2) { g2 = g; i2 = j; }
            }
#pragma unroll
            for (int s = 0; s < 3; ++s) {
                if (s < nsel) { const int j = s == 0 ? i0 : (s == 1 ? i1 : i2); const int pos = atomicAdd(lcnt + j, 1); llist[j * 256 + pos] = (unsigned short)(tid | (s << 8)); }
            }
        }
        __syncthreads();
        if (tid == 0) { int n = 0; for (int j = 0; j < own; ++j) { const int ng = (lcnt[j] + 31) >> 5; for (int g = 0; g < ng; ++g) itab[n++] = j | (g << 8); } itab[64] = n; }
        __syncthreads();
        const int nitems = __builtin_amdgcn_readfirstlane(itab[64]);
        for (int it = wave; it < nitems; it += NWAVES) {
            const int ent = __builtin_amdgcn_readfirstlane(itab[it]); const int j = ent & 255, g = ent >> 8, n = __builtin_amdgcn_readfirstlane(lcnt[j]);
            const int idx = g * 32 + r; const bool valid = idx < n;
            const unsigned e = llist[j * 256 + (valid ? idx : 0)];
            const int qi = e & 255, slot = e >> 8;
            float mo, lo_; f32x16 ot[2];
            attn_core<false>(Q + qbase + (size_t)qi * 64, Kb + ((size_t)bh * 32 + j) * 16384, Vb + ((size_t)bh * 32 + j) * 16384, 8, r, h, mo, lo_, ot);
            if (valid) {
                unsigned char* rec = part + (qi * 3 + slot) * 136; const float inv = 1.0f / lo_;
#pragma unroll
                for (int md = 0; md < 2; ++md)
#pragma unroll
                    for (int gq = 0; gq < 4; ++gq) { u32x2 o; o.x = cvtpk(ot[md][4 * gq] * inv, ot[md][4 * gq + 1] * inv); o.y = cvtpk(ot[md][4 * gq + 2] * inv, ot[md][4 * gq + 3] * inv);
                        *(u32x2*)(rec + 2 * (32 * md + 8 * gq + 4 * h)) = o; }
                if (h == 0) { *(float*)(rec + 128) = mo; *(float*)(rec + 132) = lo_; }
            }
        }
        __syncthreads();
    }
    {
        const int ql = 32 * wave + r, t = qb * 256 + ql;
        float m0, l0; f32x16 ot[2];
        attn_core<true>(Q + qbase + (size_t)ql * 64, Kb + ((size_t)bh * 32 + qb) * 16384, Vb + ((size_t)bh * 32 + qb) * 16384, wave + 1, r, h, m0, l0, ot);
        float ms[3], ls[3]; float mx = m0;
#pragma unroll
        for (int s = 0; s < 3; ++s) { ms[s] = -INFINITY; ls[s] = 0.f; if (s < nsel) { const unsigned char* rec = part + (ql * 3 + s) * 136; ms[s] = *(const float*)(rec + 128); ls[s] = *(const float*)(rec + 132); mx = fmaxf(mx, ms[s]); } }
        const float w0 = __expf(m0 - mx); float den = w0 * l0;
#pragma unroll
        for (int md = 0; md < 2; ++md)
#pragma unroll
            for (int i = 0; i < 16; ++i) ot[md][i] *= w0;
#pragma unroll
        for (int s = 0; s < 3; ++s) {
            if (s < nsel) {
                const unsigned char* rec = part + (ql * 3 + s) * 136; const float ws_ = __expf(ms[s] - mx) * ls[s]; den += ws_;
#pragma unroll
                for (int md = 0; md < 2; ++md)
#pragma unroll
                    for (int gq = 0; gq < 4; ++gq) { const u32x2 w = *(const u32x2*)(rec + 2 * (32 * md + 8 * gq + 4 * h));
                        ot[md][4 * gq] += ws_ * __uint_as_float(w.x << 16); ot[md][4 * gq + 1] += ws_ * __uint_as_float(w.x & 0xffff0000u);
                        ot[md][4 * gq + 2] += ws_ * __uint_as_float(w.y << 16); ot[md][4 * gq + 3] += ws_ * __uint_as_float(w.y & 0xffff0000u); }
            }
        }
        float inv = 1.0f / den; const size_t yrow = (size_t)(b * SEQ + t) * 1024 + hd * 64;
#ifdef DBG_AMP_ATTN
        inv *= 64.f;
#endif
#pragma unroll
        for (int md = 0; md < 2; ++md)
#pragma unroll
            for (int gq = 0; gq < 4; ++gq) { u32x2 o; o.x = cvtpk(ot[md][4 * gq] * inv, ot[md][4 * gq + 1] * inv); o.y = cvtpk(ot[md][4 * gq + 2] * inv, ot[md][4 * gq + 3] * inv);
                *(u32x2*)(Y + yrow + 32 * md + 8 * gq + 4 * h) = o; }
    }
    __syncthreads();
}

DI void phase_a(const Ctx& a, int L, unsigned char* lds, int gw, int NGW, int tid, int wave, int lane) {
    if ((gw & 3) == 0 && (gw >> 2) < 512) {
        const int chunk = gw >> 2, bhh = chunk >> 6, e = (chunk & 63) * 64 + lane, k = e & 63;
        const float* ALOC = (const float*)(a.ws + WS_R + R_ALOC); const float* DEC = (const float*)(a.ws + WS_DEC); bf16* SP = (bf16*)(a.ws + WS_R + R_SP);
        float st = 0.f;
#pragma unroll 8
        for (int n = 0; n < 128; ++n) { const int item = bhh * 128 + n; const float av = ALOC[(size_t)item * 4096 + e], dv = DEC[item * 64 + k];
            SP[(size_t)item * 4096 + e] = (bf16)(cvtpk(st, 0.f) & 0xffffu); st = dv * st + av; }
    }
    const int G = NGW / NWAVES, blk = gw / NWAVES;
    for (int u = blk; u < 512; u += G) {
        const int v = u & 255, bh = v >> 4, qb = (u < 256) ? (v & 15) : 31 - (v & 15);
        attn_unit(a, bh, qb, lds, tid, wave, lane);
    }
}

DI void own_unit(const Ctx& a, int bhi, int qg, int lane) {
    asm volatile("" : "+v"(lane));
    const int r = lane & 31, h = lane >> 5, t0 = qg * 32, j = t0 >> 8, nkg = ((t0 & 255) >> 5) + 1, t = t0 + r;
    const int b = bhi >> 3, hd = bhi & 7; const size_t bh = (size_t)bhi;
    const bf16* Q = (const bf16*)(a.ws + WS_R + R_Q); const bf16* Kb = (const bf16*)(a.ws + WS_R + R_K); const bf16* Vb = (const bf16*)(a.ws + WS_R + R_V);
    const bf16* PO = (const bf16*)(a.ws + WS_R + R_PO); const float* PML = (const float*)(a.ws + WS_R + R_PML); bf16* Y = (bf16*)(a.ws + WS_R + R_Y);
    float m0, l0; f32x16 ot[2];
    attn_core<true>(Q + (bh * SEQ + t) * 64, Kb + (bh * 32 + j) * 16384, Vb + (bh * 32 + j) * 16384, nkg, r, h, m0, l0, ot);
#ifdef DBG_OWN_ONLY
    const int nsel = 0;
#else
    const int nsel = j < 3 ? j : 3;
#endif
    const size_t pi = (bh * SEQ + t) * 3;
    float ms[3], ls[3]; float mx = m0;
#pragma unroll
    for (int s = 0; s < 3; ++s) { ms[s] = -INFINITY; ls[s] = 0.f; if (s < nsel) { ms[s] = ld_sc1f(PML + (pi + s) * 2); ls[s] = ld_sc1f(PML + (pi + s) * 2 + 1); mx = fmaxf(mx, ms[s]); } }
    const float w0 = __expf(m0 - mx); float den = w0 * l0;
#pragma unroll
    for (int md = 0; md < 2; ++md)
#pragma unroll
        for (int i = 0; i < 16; ++i) ot[md][i] *= w0;
#pragma unroll
    for (int s = 0; s < 3; ++s) {
        if (s < nsel) {
            const float ws_ = __expf(ms[s] - mx) * ls[s]; den += ws_;
#pragma unroll
            for (int md = 0; md < 2; ++md)
#pragma unroll
                for (int gq = 0; gq < 4; ++gq) { const u32x2 w = *(const u32x2*)(PO + (pi + s) * 64 + 32 * md + 8 * gq + 4 * h);
                    ot[md][4 * gq] += ws_ * __uint_as_float(w.x << 16); ot[md][4 * gq + 1] += ws_ * __uint_as_float(w.x & 0xffff0000u);
                    ot[md][4 * gq + 2] += ws_ * __uint_as_float(w.y << 16); ot[md][4 * gq + 3] += ws_ * __uint_as_float(w.y & 0xffff0000u); }
        }
    }
    float inv = 1.0f / den; const size_t yrow = (size_t)(b * SEQ + t) * 1024 + hd * 64;
#ifdef DBG_ZERO_ATTN
    inv = 0.f;
#endif
#pragma unroll
    for (int md = 0; md < 2; ++md)
#pragma unroll
        for (int gq = 0; gq < 4; ++gq) { u32x2 o; o.x = cvtpk(ot[md][4 * gq] * inv, ot[md][4 * gq + 1] * inv); o.y = cvtpk(ot[md][4 * gq + 2] * inv, ot[md][4 * gq + 3] * inv);
            *(u32x2*)(Y + yrow + 32 * md + 8 * gq + 4 * h) = o; }
}

DI void h3_unit(const Ctx& a, int L, int unit, int lane) {
    asm volatile("" : "+v"(lane));
    const int b = unit >> 9, hh = (unit >> 7) & 3, n = unit & 127, r = lane & 31, h = lane >> 5;
    const int row0 = b * SEQ + n * 64;
    const bf16* SP = (const bf16*)(a.ws + WS_R + R_SP) + (size_t)unit * 4096; const bf16* QDEC = (const bf16*)(a.ws + WS_R + R_QDEC);
    const float* OINTRA = (const float*)(a.ws + WS_R + R_OINTRA); const bf16* GH = (const bf16*)(a.ws + WS_R + R_U5) + (size_t)4 * M * 256; bf16* Y = (bf16*)(a.ws + WS_R + R_Y);
    const float* on = a.in(I_HON) + L * 64;
    bf16x8 sf[2][4];
#pragma unroll
    for (int mv = 0; mv < 2; ++mv)
#pragma unroll
        for (int ks = 0; ks < 4; ++ks) sf[mv][ks] = *(const bf16x8*)(SP + (32 * mv + r) * 64 + 16 * ks + 8 * h);
#pragma unroll
    for (int nt = 0; nt < 2; ++nt) {
        const size_t trow = (size_t)(row0 + 32 * nt + r) * 256 + hh * 64;
        f32x16 o[2]; o[0] = zero16(); o[1] = zero16();
#pragma unroll
        for (int ks = 0; ks < 4; ++ks) { const bf16x8 qf = *(const bf16x8*)(QDEC + trow + 16 * ks + 8 * h); o[0] = MFMA32(sf[0][ks], qf, o[0]); o[1] = MFMA32(sf[1][ks], qf, o[1]); }
        float ss = 0.f;
#pragma unroll
        for (int mv = 0; mv < 2; ++mv)
#pragma unroll
            for (int gq = 0; gq < 4; ++gq) { const f32x4 x = *(const f32x4*)(OINTRA + trow + 32 * mv + 8 * gq + 4 * h);
#pragma unroll
                for (int i = 0; i < 4; ++i) { o[mv][4 * gq + i] += x[i]; ss += o[mv][4 * gq + i] * o[mv][4 * gq + i]; } }
        ss += __shfl_xor(ss, 32);
        float rn = rsqrtf(ss * (1.0f / 64.0f) + 1e-6f);
#ifdef DBG_ZERO_HGRN
        rn = 0.f;
#endif
#ifdef DBG_AMP_HGRN
        rn *= 16.f;
#endif
        const size_t yrow = (size_t)(row0 + 32 * nt + r) * 1024 + 768 + hh * 64;
#pragma unroll
        for (int mv = 0; mv < 2; ++mv)
#pragma unroll
            for (int gq = 0; gq < 4; ++gq) { const int v0 = 32 * mv + 8 * gq + 4 * h; const f32x4 gn = *(const f32x4*)(on + v0); const u32x2 gw_ = *(const u32x2*)(GH + trow + v0);
                const float g0 = __uint_as_float(gw_.x << 16), g1 = __uint_as_float(gw_.x & 0xffff0000u), g2 = __uint_as_float(gw_.y << 16), g3 = __uint_as_float(gw_.y & 0xffff0000u);
                u32x2 w; w.x = cvtpk(o[mv][4 * gq] * rn * gn[0] * pg8::silu_f(g0), o[mv][4 * gq + 1] * rn * gn[1] * pg8::silu_f(g1));
                w.y = cvtpk(o[mv][4 * gq + 2] * rn * gn[2] * pg8::silu_f(g2), o[mv][4 * gq + 3] * rn * gn[3] * pg8::silu_f(g3));
                *(u32x2*)(Y + yrow + v0) = w; }
    }
}

DI void phase_c(const Ctx& a, int L, int gw, int NGW, int lane) {
    for (int u = gw; u < 1024; u += NGW) h3_unit(a, L, u, lane);
}

#define LAS __attribute__((address_space(3)))
#define XB_TMO      128
#define XB_XCNT(j)  (256  + 64 * (j))
#define XB_XSUB(j)  (1280 + 64 * (j))
#define XB_XGEN(j)  (2304 + 64 * (j))
#define XB_TOP      3328
#define XB_TOPGEN   3392
#define XCD_BAR_WORDS 3456
#define XB_SPIN_CAP (1u << 18)

__device__ __forceinline__ unsigned xb_ld(unsigned* p)              { return __hip_atomic_load(p, __ATOMIC_RELAXED, __HIP_MEMORY_SCOPE_AGENT); }
__device__ __forceinline__ unsigned xb_add(unsigned* p, unsigned v) { return __hip_atomic_fetch_add(p, v, __ATOMIC_RELAXED, __HIP_MEMORY_SCOPE_AGENT); }
__device__ __forceinline__ unsigned xb_xcc_id() { return (unsigned)__builtin_amdgcn_s_getreg((3 << 11) | 20) & 0xFu; }
#define XB_SPIN(cond, bar) do { unsigned _sp = 0; while (cond) { __builtin_amdgcn_s_sleep(1); \
    if ((++_sp & 255u) == 0u) { if (xb_ld(&(bar)[XB_TMO])) break; if (_sp > XB_SPIN_CAP) { atomicAdd(&(bar)[XB_TMO], 1u); break; } } } } while (0)

struct XcdBarrier {
    unsigned* bar; unsigned x;
    volatile LAS unsigned* st;
};

__device__ __forceinline__ XcdBarrier xcd_barrier_post(unsigned* bar, volatile LAS unsigned* st) {
    XcdBarrier b; b.bar = bar; b.x = xb_xcc_id(); b.st = st;
    if (threadIdx.x == 0) (void)xb_add(&bar[XB_XCNT(b.x)], 1u);
    return b;
}
__device__ __forceinline__ void xcd_barrier_complete(unsigned* bar, unsigned x, unsigned& nloc, unsigned& nx) {
    const unsigned G = gridDim.x * gridDim.y * gridDim.z;
    unsigned sum, cnt, mine, sp = 0u;
    for (;;) {
        sum = 0u; cnt = 0u; mine = 0u;
#pragma unroll
        for (unsigned j = 0; j < 16; ++j) { const unsigned c = xb_ld(&bar[XB_XCNT(j)]); sum += c; cnt += (c > 0u) ? 1u : 0u; mine = (j == x) ? c : mine; }
        if (sum == G) break;
        __builtin_amdgcn_s_sleep(1);
        if ((++sp & 255u) == 0u) { if (xb_ld(&bar[XB_TMO])) break; if (sp > XB_SPIN_CAP) { atomicAdd(&bar[XB_TMO], 1u); break; } }
    }
    nloc = mine > 0u ? mine : 1u; nx = cnt > 0u ? cnt : 1u;
}

__device__ __forceinline__ void xcd_barrier(const XcdBarrier& b) {
    asm volatile("s_waitcnt vmcnt(0)" ::: "memory");
    __syncthreads();
    if (threadIdx.x == 0) {
        unsigned* bar = b.bar;
        __builtin_amdgcn_s_waitcnt(0);
        unsigned nloc = b.st[0], nx = b.st[1];
        if (nloc == 0u) { xcd_barrier_complete(bar, b.x, nloc, nx); b.st[0] = nloc; b.st[1] = nx; }
        const unsigned old = xb_add(&bar[XB_XSUB(b.x)], 1u);
        const unsigned gen = old / nloc;
        if (old + 1u == (gen + 1u) * nloc) {
            __builtin_amdgcn_fence(__ATOMIC_RELEASE, "agent");
            asm volatile("s_waitcnt vmcnt(0)" ::: "memory");
            const unsigned og = xb_add(&bar[XB_TOP], 1u);
            const unsigned tg = og / nx;
            if (og + 1u == (tg + 1u) * nx) xb_add(&bar[XB_TOPGEN], 1u);
            else XB_SPIN(xb_ld(&bar[XB_TOPGEN]) == tg, bar);
            __builtin_amdgcn_fence(__ATOMIC_ACQUIRE, "agent");
            xb_add(&bar[XB_XGEN(b.x)], 1u);
            asm volatile("s_waitcnt vmcnt(0)" ::: "memory");
        } else {
            XB_SPIN(xb_ld(&bar[XB_XGEN(b.x)]) == gen, bar);
            __builtin_amdgcn_fence(__ATOMIC_ACQUIRE, "agent");
            asm volatile("s_waitcnt vmcnt(0)" ::: "memory");
        }
    }
    __syncthreads();
}

template <int MASK> __global__ void __launch_bounds__(NTHR, 2) mk_fwd(Args args) {
    extern __shared__ __attribute__((aligned(16))) unsigned char lds[];
    const int G = gridDim.x, NGW = G * NWAVES;
    cg::grid_group grid = cg::this_grid();
    const int ph_lo = args.ph_lo, ph_hi = args.ph_hi;
    volatile LAS unsigned* bst = (volatile LAS unsigned*)((LAS unsigned char*)lds + 131072);
    if (threadIdx.x == 0) { bst[0] = 0u; bst[1] = 0u; }
    __syncthreads();
    XcdBarrier bar; bar.bar = nullptr; bar.x = 0; bar.st = bst;
    for (int ph = ph_lo; ph < ph_hi; ++ph) {
        if (ph > ph_lo) {
            if (ph == ph_lo + 1) {
                grid.sync();
                bar = xcd_barrier_post((unsigned*)(args.ws + WS_CTL + 65536), bst);
            } else { xcd_barrier(bar);
#ifdef DBG_DUP_BAR
                xcd_barrier(bar);
#endif
            }
        }
        int tid_v = threadIdx.x; asm volatile("" : "+v"(tid_v));
        const int tid = tid_v, lane = tid & 63, wave = __builtin_amdgcn_readfirstlane(tid >> 6), gw = blockIdx.x * NWAVES + wave;
        kptr_t kp = (kptr_t)__builtin_amdgcn_kernarg_segment_ptr();
        asm volatile("" : "+s"(kp));
        Ctx a; a.kp = kp; a.out = *(float* const __attribute__((address_space(4)))*)(kp + 144); a.ws = *(unsigned char* const __attribute__((address_space(4)))*)(kp + 152);
        unsigned char* ws = a.ws;
        float* stats = (float*)(ws + WS_STATS); bf16* xb = (bf16*)(ws + WS_XB); bf16* hid = (bf16*)(ws + WS_R + R_HID);
        if (ph == 0) {
if constexpr (MASK & 1) { phase_p0(a, lds, gw, NGW, wave, lane);
#ifdef DBG_DUP_P0
 __syncthreads(); phase_p0(a, lds, gw, NGW, wave, lane);
#endif
 }
 __syncthreads(); continue; }
        const int L = (ph - 1) / 9, sub = (ph - 1) % 9;
        unsigned char* wb = ws + WS_W + (size_t)(L & 1) * WSZ;
        if (sub == 0 || sub == 7) {
            pg8::Gemm g{xb, (const bf16*)(wb + (sub == 0 ? W_GU1 : W_GU2)), M, 2 * FF, D}; pg8::StaticOrder S; S.init(M, 2 * FF, G, (int)blockIdx.x);
            pg8::EpiSwiGLU E{hid, stats, FF};
            if constexpr (MASK & 2) pg8::gemm_phase<pg8::EpiSwiGLU, pg8::StaticOrder, PG8_ALIGN, PG8_SP2>((PG8_LAS unsigned char*)lds, g, S, E);
#if defined(DBG_DUP_G) && DBG_DUP_G == 1
            __syncthreads(); if constexpr (MASK & 2) pg8::gemm_phase<pg8::EpiSwiGLU, pg8::StaticOrder, PG8_ALIGN, PG8_SP2>((PG8_LAS unsigned char*)lds, g, S, E);
#endif
        } else if (sub == 1 || sub == 6 || sub == 8) {
            const bf16* A = sub == 6 ? (const bf16*)(ws + WS_R + R_Y) : hid; const int K = sub == 6 ? D : FF;
            const bf16* Bt = (const bf16*)(wb + (sub == 1 ? W_D1 : (sub == 6 ? W_OUT : W_D2)));
            pg8::Gemm g{A, Bt, M, D, K}; pg8::StaticOrder S; S.init(M, D, G, (int)blockIdx.x);
            pg8::EpiResid E{a.out, xb, stats, sub == 6 ? 1.0f : 0.5f};
            if constexpr (MASK & 4) pg8::gemm_phase<pg8::EpiResid, pg8::StaticOrder, PG8_ALIGN, PG8_SP2>((PG8_LAS unsigned char*)lds, g, S, E);
#if defined(DBG_DUP_G) && DBG_DUP_G == 2
            __syncthreads(); { pg8::EpiResid E0{a.out, xb, stats, 0.0f}; if constexpr (MASK & 4) pg8::gemm_phase<pg8::EpiResid, pg8::StaticOrder, PG8_ALIGN, PG8_SP2>((PG8_LAS unsigned char*)lds, g, S, E0); }
#endif
        } else if (sub == 2) {
            pg8::Gemm g{xb, (const bf16*)(wb + W_IN), M, INW, D}; pg8::StaticOrder S; S.init(M, INW, G, (int)blockIdx.x);
            pg8::EpiProj E{(bf16*)(ws + WS_R + R_Q), (bf16*)(ws + WS_R + R_K), (bf16*)(ws + WS_R + R_V), (bf16*)(ws + WS_R + R_U5), (float*)(ws + WS_KMP), stats,
                           (const float*)(ws + WS_ROPEC), (const float*)(ws + WS_ROPES), a.in(I_QN) + L * 64, a.in(I_KN) + L * 64};
            if constexpr (MASK & 8) pg8::gemm_phase<pg8::EpiProj, pg8::StaticOrder, PG8_ALIGN, PG8_SP2>((PG8_LAS unsigned char*)lds, g, S, E);
#if defined(DBG_DUP_G) && DBG_DUP_G == 3
            __syncthreads(); if constexpr (MASK & 8) pg8::gemm_phase<pg8::EpiProj, pg8::StaticOrder, PG8_ALIGN, PG8_SP2>((PG8_LAS unsigned char*)lds, g, S, E);
#endif
        } else if (sub == 3) {
if constexpr (MASK & 16) { phase_t(a, L, lds, gw, NGW, wave, lane);
#if defined(DBG_DUP_SUB) && DBG_DUP_SUB == 3
 __syncthreads(); phase_t(a, L, lds, gw, NGW, wave, lane);
#endif
 }
 __syncthreads(); }
        else if (sub == 4) {
if constexpr (MASK & 32) { phase_a(a, L, lds, gw, NGW, tid, wave, lane);
#if defined(DBG_DUP_SUB) && DBG_DUP_SUB == 4
 __syncthreads(); phase_a(a, L, lds, gw, NGW, tid, wave, lane);
#endif
 }
 __syncthreads(); }
        else {
if constexpr (MASK & 64) { phase_c(a, L, gw, NGW, lane);
#if defined(DBG_DUP_SUB) && DBG_DUP_SUB == 5
 __syncthreads(); phase_c(a, L, gw, NGW, lane);
#endif
 }
 __syncthreads(); }
    }
}

#ifndef MK_MULTI
#define MK_MULTI 0
#endif
#ifndef DBG_NPH
#define DBG_NPH (1 + 9 * DEPTH)
#endif
constexpr int N_PHASES = DBG_NPH;
static int phase_mask(int ph) { if (ph == 0) return 1; const int sub = (ph - 1) % 9; const int m[9] = {2, 4, 8, 16, 32, 64, 4, 2, 4}; return m[sub]; }
template <int MASK> static bool setup_one(int& per_cu) {
    if (hipFuncSetAttribute((const void*)mk_fwd<MASK>, hipFuncAttributeMaxDynamicSharedMemorySize, LDS_BYTES) != hipSuccess) return false;
    if (hipOccupancyMaxActiveBlocksPerMultiprocessor(&per_cu, (const void*)mk_fwd<MASK>, NTHR, LDS_BYTES) != hipSuccess) per_cu = 1;
    (void)hipGetLastError(); return true;
}
template <int MASK> static void launch_one(const Args& a, int grid, hipStream_t stream) { hipLaunchKernelGGL(mk_fwd<MASK>, dim3(grid), dim3(NTHR), LDS_BYTES, stream, a); }
extern "C" void kernel_launch(void* const* d_in, const int* in_sizes, int n_in, void* d_out, int out_size, void* d_ws, size_t ws_size, hipStream_t stream) {
    static int grid = 0;
    if (grid == 0) {
        if (n_in != 18 || in_sizes[0] != M * D || out_size != M * D || ws_size < WS_END) { fprintf(stderr, "kernel_launch: unexpected shapes / workspace (n_in %d, ws %zu < %zu)\n", n_in, ws_size, (size_t)WS_END); grid = -1; return; }
        int dev = 0, cus = 0, per_cu = 0; bool ok = true;
        (void)hipGetDevice(&dev); (void)hipDeviceGetAttribute(&cus, hipDeviceAttributeMultiprocessorCount, dev);
#if MK_MULTI
        ok = setup_one<1>(per_cu) && setup_one<2>(per_cu) && setup_one<4>(per_cu) && setup_one<8>(per_cu) && setup_one<16>(per_cu) && setup_one<32>(per_cu) && setup_one<64>(per_cu);
#else
        ok = setup_one<127>(per_cu);
#endif
        if (!ok) { fprintf(stderr, "kernel_launch: hipFuncSetAttribute failed\n"); grid = -1; return; }
        grid = cus;
    }
    if (grid < 0) return;
    Args a{};
    for (int i = 0; i < 18; ++i) a.in[i] = (const float*)d_in[i];
    a.out = (float*)d_out; a.ws = (unsigned char*)d_ws;
#if MK_MULTI
    for (int ph = 0; ph < N_PHASES; ++ph) { a.ph_lo = ph; a.ph_hi = ph + 1;
        switch (phase_mask(ph)) { case 1: launch_one<1>(a, grid, stream); break; case 2: launch_one<2>(a, grid, stream); break; case 4: launch_one<4>(a, grid, stream); break; case 8: launch_one<8>(a, grid, stream); break;
                                  case 16: launch_one<16>(a, grid, stream); break; case 32: launch_one<32>(a, grid, stream); break; default: launch_one<64>(a, grid, stream); break; } }
#else
    a.ph_lo = 0; a.ph_hi = N_PHASES;
    void* args[] = {&a};
    hipError_t e = hipLaunchCooperativeKernel((const void*)mk_fwd<127>, dim3(grid), dim3(NTHR), args, LDS_BYTES, stream);
    if (e != hipSuccess) fprintf(stderr, "cooperative launch failed: %s (grid %d)\n", hipGetErrorString(e), grid);
#endif
}
```

```cpp
#include <hip/hip_runtime.h>
#include <hip/hip_cooperative_groups.h>
#include <cstdio>
#include <cstdint>
namespace cg = cooperative_groups;
#define MK_MULTI 0
namespace pg8 {
#define PG8_LAS __attribute__((address_space(3)))
typedef unsigned short bf16_t;
typedef short bf16x8 __attribute__((ext_vector_type(8)));
typedef float f32x4 __attribute__((ext_vector_type(4)));
typedef unsigned u32x4 __attribute__((ext_vector_type(4)));
constexpr int BM = 256, BK = 64, HALF = 128, HTB = HALF * BK * 2  , STAGE_BYTES = 8 * HTB, NXCD = 8, WGM = 8;

__host__ __device__ __forceinline__ int lds_byte(int r, int c) { const int st = (r >> 4) * 2 + (c >> 5), rr = r & 15, cc = c & 31, ob = rr * 64 + cc * 2; return st * 1024 + (ob ^ (((ob >> 9) & 1) << 5)); }
__host__ __device__ __forceinline__ void stage_rc(int b, int& R, int& C) { const int st = b / 1024, sb = b % 1024, swz = sb ^ (((sb >> 9) & 1) << 5); R = (st >> 1) * 16 + swz / 64; C = (st & 1) * 32 + (swz % 64) / 2; }
__host__ __device__ __forceinline__ int perm32(int rho) { const int n = rho >> 4, i = rho & 15; return 8 * (i >> 2) + 4 * n + (i & 3); }

struct Unit { int pm, pn; };
struct Gemm { const bf16_t* A; const bf16_t* Bt; int M, N, K; };

struct StaticOrder {
    int nM, nN, nwg, G, c;
    __host__ __device__ void init(int M, int N, int G_, int c_) { nM = M / BM; nN = N / BM; nwg = nM * nN; G = G_; c = c_; }
    __host__ __device__ bool next(int i, Unit& u) const {
        const long L = (long)i * G + c; if (L >= nwg) return false;
        int wgid = (int)L; { const int q = nwg / NXCD, r = nwg % NXCD, xcd = wgid % NXCD, off = wgid / NXCD; wgid = (xcd < r ? xcd * (q + 1) : r * (q + 1) + (xcd - r) * q) + off; }
        const int nig = WGM * nN, gid = wgid / nig, fm = gid * WGM, gsz = (nM - fm) < WGM ? (nM - fm) : WGM;
        u.pm = fm + ((wgid % nig) % gsz); u.pn = (wgid % nig) / gsz; return true;
    }
    __device__ __forceinline__ void a_ready(const Unit&) const {}
    __device__ __forceinline__ void done(const Unit&) const {}
};

__device__ __forceinline__ unsigned cvt_pk_bf16(float lo, float hi) { unsigned r; asm volatile("v_cvt_pk_bf16_f32 %0, %1, %2" : "=v"(r) : "v"(lo), "v"(hi)); return r; }
typedef float f32x2 __attribute__((ext_vector_type(2)));
typedef unsigned u32x2 __attribute__((ext_vector_type(2)));
typedef __bf16 bf16x2_t __attribute__((ext_vector_type(2)));
__device__ __forceinline__ unsigned cvtpk(float lo, float hi) { f32x2 v = {lo, hi}; bf16x2_t b = __builtin_convertvector(v, bf16x2_t); return __builtin_bit_cast(unsigned, b); }
__device__ __forceinline__ float row_rstd(const float* stats, int row) {
    const f32x4* p = (const f32x4*)(stats + (size_t)row * 16);
    const f32x4 a = p[0], b = p[1], c = p[2], d = p[3];
    const float s = ((a[0] + a[1]) + (a[2] + a[3])) + ((b[0] + b[1]) + (b[2] + b[3])) + ((c[0] + c[1]) + (c[2] + c[3])) + ((d[0] + d[1]) + (d[2] + d[3]));
    return rsqrtf(s * (1.0f / 1024.0f) + 1e-6f);
}
__device__ __forceinline__ float silu_f(float g) { return g * __builtin_amdgcn_rcpf(1.0f + __expf(-g)); }

struct EpiSwiGLU {
    static constexpr bool PERM = true, AFTER_DRAIN = false;
    bf16_t* H; const float* stats; int ldh;
    __device__ __forceinline__ void operator()(const f32x4 (&acc)[2][2][4][2], const Unit& u, int wr, int wc, int fr, int fq) const {
        asm volatile("" : "+v"(fr), "+v"(fq));
        const int row0 = u.pm * BM + wr * 64 + fr, col0 = u.pn * HALF + wc * 32 + 8 * fq;
#pragma unroll
        for (int ai = 0; ai < 2; ++ai)
#pragma unroll
            for (int m = 0; m < 4; ++m) {
                const int row = row0 + ai * HALF + m * 16;
                const float rs = row_rstd(stats, row);
                float h[8];
#pragma unroll
                for (int n = 0; n < 2; ++n)
#pragma unroll
                    for (int i = 0; i < 4; ++i) { const float g = acc[ai][0][m][n][i] * rs, up = acc[ai][1][m][n][i] * rs; h[4 * n + i] = silu_f(g) * up; }
                u32x4 w; w.x = cvtpk(h[0], h[1]); w.y = cvtpk(h[2], h[3]); w.z = cvtpk(h[4], h[5]); w.w = cvtpk(h[6], h[7]);
                *(u32x4*)(H + (size_t)row * ldh + col0) = w;
            }
    }
};

struct EpiResid {
    static constexpr bool PERM = true, AFTER_DRAIN = false;
    float* X; bf16_t* XB; float* stats; float scale;
    __device__ __forceinline__ void operator()(const f32x4 (&acc)[2][2][4][2], const Unit& u, int wr, int wc, int fr, int fq) const {
        asm volatile("" : "+v"(fr), "+v"(fq));
        const int row0 = u.pm * BM + wr * 64 + fr, col0 = u.pn * BM + wc * 32 + 8 * fq;
#pragma unroll
        for (int ai = 0; ai < 2; ++ai)
#pragma unroll
            for (int m = 0; m < 4; ++m) {
                const int row = row0 + ai * HALF + m * 16; float ss = 0.f;
#pragma unroll
                for (int bj = 0; bj < 2; ++bj) {
                    float* xp = X + (size_t)row * 1024 + col0 + bj * HALF;
                    f32x4 x0 = *(const f32x4*)xp, x1 = *(const f32x4*)(xp + 4);
                    x0 = x0 + acc[ai][bj][m][0] * scale; x1 = x1 + acc[ai][bj][m][1] * scale;
                    *(f32x4*)xp = x0; *(f32x4*)(xp + 4) = x1;
                    ss += (x0[0] * x0[0] + x0[1] * x0[1]) + (x0[2] * x0[2] + x0[3] * x0[3]) + (x1[0] * x1[0] + x1[1] * x1[1]) + (x1[2] * x1[2] + x1[3] * x1[3]);
                    u32x4 w; w.x = cvtpk(x0[0], x0[1]); w.y = cvtpk(x0[2], x0[3]); w.z = cvtpk(x1[0], x1[1]); w.w = cvtpk(x1[2], x1[3]);
                    *(u32x4*)(XB + (size_t)row * 1024 + col0 + bj * HALF) = w;
                }
                ss += __shfl_xor(ss, 16); ss += __shfl_xor(ss, 32);
                if (fq == 0) stats[(size_t)row * 16 + u.pn * 4 + wc] = ss;
            }
    }
};

struct EpiProj {
    static constexpr bool PERM = true, AFTER_DRAIN = false;
    bf16_t* Q; bf16_t* Kb; bf16_t* Vb; bf16_t* U5; float* kmp; const float* stats; const float* ropeC; const float* ropeS; const float* qn; const float* kn;
    __device__ __forceinline__ void operator()(const f32x4 (&acc)[2][2][4][2], const Unit& u, int wr, int wc, int fr, int fq) const {
        asm volatile("" : "+v"(fr), "+v"(fq));
        const int row0 = u.pm * BM + wr * 64 + fr;
        const int pn = u.pn;
        if (pn >= 6) {
            bf16_t* O = U5 + (size_t)(pn - 6) * (16384 * 256);
            const int col0 = wc * 32 + 8 * fq;
#pragma unroll
            for (int ai = 0; ai < 2; ++ai)
#pragma unroll
                for (int m = 0; m < 4; ++m) {
                    const int row = row0 + ai * HALF + m * 16; const float rs = row_rstd(stats, row);
#pragma unroll
                    for (int bj = 0; bj < 2; ++bj) {
                        const f32x4 v0 = acc[ai][bj][m][0] * rs, v1 = acc[ai][bj][m][1] * rs;
                        u32x4 w; w.x = cvtpk(v0[0], v0[1]); w.y = cvtpk(v0[2], v0[3]); w.z = cvtpk(v1[0], v1[1]); w.w = cvtpk(v1[2], v1[3]);
                        *(u32x4*)(O + (size_t)row * 256 + col0 + bj * HALF) = w;
                    }
                }
            return;
        }
        const int head = (pn & 1) * 4 + wc, b = u.pm >> 5, j = u.pm & 31;
        const size_t bh = (size_t)(b * 8 + head);
        if (pn >= 4) {
            bf16_t* vb = Vb + (bh * 32 + j) * 16384;
#pragma unroll
            for (int ai = 0; ai < 2; ++ai)
#pragma unroll
                for (int m = 0; m < 4; ++m) {
                    const int row = row0 + ai * HALF + m * 16; const float rs = row_rstd(stats, row);
                    const int kk = ai * HALF + wr * 64 + m * 16 + fr;
                    const int kg = kk >> 5, w = kk & 31, st = w >> 4, w16 = w & 15, hh = (w16 >> 2) & 1, jj = 4 * (w16 >> 3) + (w16 & 3);
#pragma unroll
                    for (int bj = 0; bj < 2; ++bj)
#pragma unroll
                        for (int n = 0; n < 2; ++n) {
                            const unsigned p0 = cvtpk(acc[ai][bj][m][n][0] * rs, acc[ai][bj][m][n][1] * rs), p1 = cvtpk(acc[ai][bj][m][n][2] * rs, acc[ai][bj][m][n][3] * rs);
#pragma unroll
                            for (int i = 0; i < 4; ++i) {
                                const int r = 8 * fq + 4 * n + i;
                                const unsigned pv = (i < 2) ? p0 : p1;
                                vb[((((kg * 2 + st) * 2 + bj) * 32 + r) * 2 + hh) * 8 + jj] = (bf16_t)((i & 1) ? (pv >> 16) : (pv & 0xffffu));
                            }
                        }
                }
            return;
        }
        const bool isk = pn >= 2;
        const float* gn = isk ? kn : qn;
        float ksum[16];
#pragma unroll
        for (int e = 0; e < 16; ++e) ksum[e] = 0.f;
#pragma unroll
        for (int ai = 0; ai < 2; ++ai)
#pragma unroll
            for (int m = 0; m < 4; ++m) {
                const int row = row0 + ai * HALF + m * 16; const float rs = row_rstd(stats, row);
                const int t = row & 8191, kk = t & 255;
                float v0[8], v1[8]; float ss = 0.f;
#pragma unroll
                for (int n = 0; n < 2; ++n)
#pragma unroll
                    for (int i = 0; i < 4; ++i) { v0[4 * n + i] = acc[ai][0][m][n][i] * rs; v1[4 * n + i] = acc[ai][1][m][n][i] * rs; ss += v0[4 * n + i] * v0[4 * n + i] + v1[4 * n + i] * v1[4 * n + i]; }
                ss += __shfl_xor(ss, 16); ss += __shfl_xor(ss, 32);
                const float rn = rsqrtf(ss * (1.0f / 64.0f) + 1e-6f);
                const f32x4 c0 = *(const f32x4*)(ropeC + t * 32 + 8 * fq), c1 = *(const f32x4*)(ropeC + t * 32 + 8 * fq + 4);
                const f32x4 s0 = *(const f32x4*)(ropeS + t * 32 + 8 * fq), s1 = *(const f32x4*)(ropeS + t * 32 + 8 * fq + 4);
                const f32x4 ga0 = *(const f32x4*)(gn + 8 * fq), ga1 = *(const f32x4*)(gn + 8 * fq + 4), gb0 = *(const f32x4*)(gn + 32 + 8 * fq), gb1 = *(const f32x4*)(gn + 36 + 8 * fq);
                float o0[8], o1[8];
#pragma unroll
                for (int e = 0; e < 8; ++e) {
                    const float x1 = v0[e] * rn * (e < 4 ? ga0[e & 3] : ga1[e & 3]), x2 = v1[e] * rn * (e < 4 ? gb0[e & 3] : gb1[e & 3]);
                    const float cs = e < 4 ? c0[e & 3] : c1[e & 3], sn = e < 4 ? s0[e & 3] : s1[e & 3];
                    o0[e] = x1 * cs - x2 * sn; o1[e] = x2 * cs + x1 * sn;
                }
                u32x4 w0, w1;
                w0.x = cvtpk(o0[0], o0[1]); w0.y = cvtpk(o0[2], o0[3]); w0.z = cvtpk(o0[4], o0[5]); w0.w = cvtpk(o0[6], o0[7]);
                w1.x = cvtpk(o1[0], o1[1]); w1.y = cvtpk(o1[2], o1[3]); w1.z = cvtpk(o1[4], o1[5]); w1.w = cvtpk(o1[6], o1[7]);
                if (!isk) {
                    bf16_t* qp = Q + (bh * 8192 + t) * 64 + 8 * fq;
                    *(u32x4*)qp = w0; *(u32x4*)(qp + 32) = w1;
                } else {
                    bf16_t* kb = Kb + (bh * 32 + j) * 16384;
                    const int kg = kk >> 5, r = kk & 31, hq = fq & 1, ksl = fq >> 1;
                    *(u32x4*)(kb + (((kg * 4 + ksl) * 32 + r) * 2 + hq) * 8) = w0;
                    *(u32x4*)(kb + (((kg * 4 + 2 + ksl) * 32 + r) * 2 + hq) * 8) = w1;
#pragma unroll
                    for (int e = 0; e < 8; ++e) { ksum[e] += o0[e]; ksum[8 + e] += o1[e]; }
                }
                asm volatile("" ::: "memory");
            }
        if (isk) {
#pragma unroll
            for (int e = 0; e < 16; ++e) { float s = ksum[e]; s += __shfl_xor(s, 1); s += __shfl_xor(s, 2); s += __shfl_xor(s, 4); s += __shfl_xor(s, 8); ksum[e] = s; }
            if (fr == 0) {
                float* kp = kmp + ((size_t)(u.pm * 2 + wr) * 512) + head * 64 + 8 * fq;
                *(f32x4*)kp = (f32x4){ksum[0], ksum[1], ksum[2], ksum[3]}; *(f32x4*)(kp + 4) = (f32x4){ksum[4], ksum[5], ksum[6], ksum[7]};
                *(f32x4*)(kp + 32) = (f32x4){ksum[8], ksum[9], ksum[10], ksum[11]}; *(f32x4*)(kp + 36) = (f32x4){ksum[12], ksum[13], ksum[14], ksum[15]};
            }
        }
    }
};

template <class Epi, class Sched, bool ALIGN_EPI = false, bool SP2 = false>
__device__ __forceinline__ void gemm_phase(PG8_LAS unsigned char* lds, const Gemm g, const Sched& S, const Epi& E) {
    int tid_v = threadIdx.x; asm volatile("" : "+v"(tid_v));
    const int tid = tid_v, wid = __builtin_amdgcn_readfirstlane(tid >> 6), lane = tid & 63, wr = wid >> 2, wc = wid & 3, fr = lane & 15, fq = lane >> 4;
    const int K = g.K, nt = K / BK;
    unsigned voffA[2], voffB[2];
#pragma unroll
    for (int i = 0; i < 2; ++i) { int R, C; stage_rc(tid * 16 + i * 8192, R, C); const int Rb = Epi::PERM ? ((R & ~31) + perm32(R & 31)) : R;
        voffA[i] = (unsigned)(R * K + C) * 2u; voffB[i] = (unsigned)(Rb * K + C) * 2u; }
    const size_t kstep = (size_t)(BK * 2);
    const size_t hstep = (size_t)HALF * K * 2;
    const size_t tstep = 2 * hstep;
    const unsigned ldsw = (unsigned)wid * 1024u;
    const int aoff = lds_byte(wr * 64 + fr, fq * 8), boff = lds_byte(wc * 32 + fr, fq * 8);
#define PG8_SA(b, h) (((b) * 2 + (h)) * HTB)
#define PG8_SB(b, h) ((4 + (b) * 2 + (h)) * HTB)
#define PG8_STAGE(bufoff, gbase, voff) do { _Pragma("unroll") for (int _i = 0; _i < 2; ++_i) \
        __builtin_amdgcn_global_load_lds((const unsigned*)((const char*)(gbase) + (voff)[_i]), (PG8_LAS unsigned*)(lds + (bufoff) + ldsw + _i * 8192), 16, 0, 0); } while (0)
#define PG8_LDA(dst, b, h) do { _Pragma("unroll") for (int m = 0; m < 4; ++m) _Pragma("unroll") for (int k = 0; k < 2; ++k) dst[m][k] = *(const PG8_LAS bf16x8*)(lds + PG8_SA(b, h) + aoff + m * 2048 + k * 1024); } while (0)
#define PG8_LDB(dst, b, h) do { _Pragma("unroll") for (int n = 0; n < 2; ++n) _Pragma("unroll") for (int k = 0; k < 2; ++k) dst[n][k] = *(const PG8_LAS bf16x8*)(lds + PG8_SB(b, h) + boff + n * 2048 + k * 1024); } while (0)
#define PG8_MMA(ai, bj, At, Bt) do { __builtin_amdgcn_s_setprio(1); _Pragma("unroll") for (int m = 0; m < 4; ++m) _Pragma("unroll") for (int n = 0; n < 2; ++n) _Pragma("unroll") for (int k = 0; k < 2; ++k) \
        acc[ai][bj][m][n] = __builtin_amdgcn_mfma_f32_16x16x32_bf16(Bt[n][k], At[m][k], acc[ai][bj][m][n], 0, 0, 0); __builtin_amdgcn_s_setprio(0); } while (0)
#define PG8_WAIT_V(n) asm volatile("s_waitcnt vmcnt(" #n ")" ::: "memory")
#define PG8_WAIT_L(n) asm volatile("s_waitcnt lgkmcnt(" #n ")" ::: "memory")
#define PG8_BAR __builtin_amdgcn_s_barrier()
#define PG8_SCHED __builtin_amdgcn_sched_barrier(0)
    Unit cur, nxt; int ui = 0;
    if (!S.next(0, cur)) return;
    f32x4 acc[2][2][4][2];
#pragma unroll
    for (int a = 0; a < 2; ++a)
#pragma unroll
        for (int b = 0; b < 2; ++b)
#pragma unroll
            for (int m = 0; m < 4; ++m)
#pragma unroll
                for (int n = 0; n < 2; ++n) acc[a][b][m][n] = (f32x4){0.f, 0.f, 0.f, 0.f};
    bf16x8 At[4][2], B0[2][2], B1[2][2];
    const char* cA = (const char*)g.A + (size_t)cur.pm * tstep; const char* cB = (const char*)g.Bt + (size_t)cur.pn * tstep;
    S.a_ready(cur);
    if constexpr (SP2) {
        PG8_STAGE(PG8_SB(0, 0), cB, voffB); PG8_STAGE(PG8_SB(0, 1), cB + hstep, voffB); PG8_STAGE(PG8_SA(0, 0), cA, voffA); PG8_STAGE(PG8_SA(0, 1), cA + hstep, voffA);
        if (wr == 1) PG8_BAR;
        PG8_WAIT_V(2); PG8_BAR;
        PG8_STAGE(PG8_SB(1, 0), cB + kstep, voffB); PG8_STAGE(PG8_SA(1, 0), cA + kstep, voffA); PG8_STAGE(PG8_SB(1, 1), cB + hstep + kstep, voffB);
        PG8_WAIT_V(6); PG8_BAR;
    } else {
        PG8_STAGE(PG8_SB(0, 0), cB, voffB); PG8_STAGE(PG8_SA(0, 0), cA, voffA); PG8_STAGE(PG8_SB(0, 1), cB + hstep, voffB); PG8_STAGE(PG8_SA(0, 1), cA + hstep, voffA);
        if (wr == 1) PG8_BAR;
        PG8_WAIT_V(4); PG8_BAR;
        PG8_STAGE(PG8_SB(1, 0), cB + kstep, voffB); PG8_STAGE(PG8_SA(1, 0), cA + kstep, voffA); PG8_STAGE(PG8_SB(1, 1), cB + hstep + kstep, voffB);
        PG8_WAIT_V(6); PG8_BAR;
    }
    for (;;) {
        const bool has_next = S.next(ui + 1, nxt);
        const char* nA = has_next ? (const char*)g.A + (size_t)nxt.pm * tstep : cA; const char* nB = has_next ? (const char*)g.Bt + (size_t)nxt.pn * tstep : cB;
        for (int t = 0; t < nt; t += 2) {
            const bool last = (t == nt - 2);
            const char* a1 = cA + (size_t)(t + 1) * kstep;
            const char* a2 = last ? nA : cA + (size_t)(t + 2) * kstep; const char* b2 = last ? nB : cB + (size_t)(t + 2) * kstep;
            const char* a3 = a2 + kstep; const char* b3 = b2 + kstep;
            if (last && has_next) S.a_ready(nxt);
            if constexpr (SP2) {
            PG8_LDB(B0, 0, 0); PG8_LDB(B1, 0, 1); PG8_SCHED; PG8_LDA(At, 0, 0); PG8_STAGE(PG8_SA(1, 1), a1 + hstep, voffA);
            PG8_WAIT_V(8); PG8_WAIT_L(0); PG8_BAR; PG8_MMA(0, 0, At, B0); PG8_MMA(0, 1, At, B1); PG8_BAR; PG8_SCHED;
            PG8_LDA(At, 0, 1); PG8_STAGE(PG8_SB(0, 0), b2, voffB); PG8_STAGE(PG8_SB(0, 1), b2 + hstep, voffB); PG8_STAGE(PG8_SA(0, 0), a2, voffA);
            PG8_WAIT_V(8); PG8_WAIT_L(0); PG8_BAR; PG8_MMA(1, 0, At, B0); PG8_MMA(1, 1, At, B1); PG8_BAR; PG8_SCHED;
            PG8_LDB(B0, 1, 0); PG8_LDB(B1, 1, 1); PG8_SCHED; PG8_LDA(At, 1, 0); PG8_STAGE(PG8_SA(0, 1), a2 + hstep, voffA);
            PG8_WAIT_V(8); PG8_WAIT_L(0); PG8_BAR; PG8_MMA(0, 0, At, B0); PG8_MMA(0, 1, At, B1); PG8_BAR; PG8_SCHED;
            PG8_LDA(At, 1, 1); PG8_STAGE(PG8_SB(1, 0), b3, voffB); PG8_STAGE(PG8_SB(1, 1), b3 + hstep, voffB); PG8_STAGE(PG8_SA(1, 0), a3, voffA);
            PG8_WAIT_V(8); PG8_WAIT_L(0); PG8_BAR; PG8_MMA(1, 0, At, B0); PG8_MMA(1, 1, At, B1); PG8_BAR; PG8_SCHED;
            } else {
            PG8_LDB(B0, 0, 0); PG8_SCHED; PG8_LDA(At, 0, 0); PG8_STAGE(PG8_SA(1, 1), a1 + hstep, voffA);
            PG8_WAIT_L(8); PG8_BAR; PG8_WAIT_L(0); PG8_MMA(0, 0, At, B0); PG8_BAR; PG8_SCHED;
            PG8_LDB(B1, 0, 1); PG8_STAGE(PG8_SB(0, 0), b2, voffB);
            PG8_BAR; PG8_WAIT_L(0); PG8_MMA(0, 1, At, B1); PG8_BAR;
            PG8_LDA(At, 0, 1); PG8_STAGE(PG8_SA(0, 0), a2, voffA);
            PG8_BAR; PG8_WAIT_L(0); PG8_MMA(1, 0, At, B0); PG8_BAR; PG8_SCHED;
            PG8_STAGE(PG8_SB(0, 1), b2 + hstep, voffB);
            PG8_WAIT_V(6); PG8_BAR; PG8_MMA(1, 1, At, B1); PG8_BAR;
            PG8_LDB(B0, 1, 0); PG8_SCHED; PG8_LDA(At, 1, 0); PG8_STAGE(PG8_SA(0, 1), a2 + hstep, voffA);
            PG8_WAIT_L(8); PG8_BAR; PG8_WAIT_L(0); PG8_MMA(0, 0, At, B0); PG8_BAR; PG8_SCHED;
            PG8_LDB(B1, 1, 1); PG8_STAGE(PG8_SB(1, 0), b3, voffB);
            PG8_BAR; PG8_WAIT_L(0); PG8_MMA(0, 1, At, B1); PG8_BAR;
            PG8_LDA(At, 1, 1); PG8_STAGE(PG8_SA(1, 0), a3, voffA);
            PG8_BAR; PG8_WAIT_L(0); PG8_MMA(1, 0, At, B0); PG8_BAR; PG8_SCHED;
            PG8_STAGE(PG8_SB(1, 1), b3 + hstep, voffB);
            PG8_WAIT_V(6); PG8_BAR; PG8_MMA(1, 1, At, B1); PG8_BAR;
            }
        }
        if constexpr (ALIGN_EPI) { if (wr == 0) PG8_BAR; }
        if constexpr (!Epi::AFTER_DRAIN) { E(acc, cur, wr, wc, fr, fq); S.done(cur); }
        if (!has_next) break;
#pragma unroll
        for (int a = 0; a < 2; ++a)
#pragma unroll
            for (int b = 0; b < 2; ++b)
#pragma unroll
                for (int m = 0; m < 4; ++m)
#pragma unroll
                    for (int n = 0; n < 2; ++n) acc[a][b][m][n] = (f32x4){0.f, 0.f, 0.f, 0.f};
        cur = nxt; cA = nA; cB = nB; ++ui;
        if constexpr (ALIGN_EPI) { if (wr == 1) PG8_BAR; }
    }
    PG8_WAIT_V(0);
    if constexpr (!ALIGN_EPI) { if (wr == 0) PG8_BAR; }
    PG8_BAR;
    if constexpr (Epi::AFTER_DRAIN) { E.fused(acc, cur, wr, wc, fr, fq, lds, wid, lane); S.done(cur); }
#undef PG8_SA
#undef PG8_SB
#undef PG8_STAGE
#undef PG8_LDA
#undef PG8_LDB
#undef PG8_MMA
#undef PG8_WAIT_V
#undef PG8_WAIT_L
#undef PG8_BAR
#undef PG8_SCHED
}
}

#ifndef PG8_SP2
#define PG8_SP2 true
#endif
#ifndef PG8_ALIGN
#define PG8_ALIGN true
#endif

#define DI __device__ __forceinline__
typedef unsigned short bf16;
typedef short bf16x8 __attribute__((ext_vector_type(8)));
typedef float f32x4 __attribute__((ext_vector_type(4)));
typedef float f32x16 __attribute__((ext_vector_type(16)));
typedef unsigned u32x4 __attribute__((ext_vector_type(4)));
typedef unsigned u32x2 __attribute__((ext_vector_type(2)));
#define MFMA32(a, b, c) __builtin_amdgcn_mfma_f32_32x32x16_bf16((a), (b), (c), 0, 0, 0)

constexpr int NWAVES = 8, NTHR = 512;
constexpr int M = 16384, D = 1024, FF = 2816, INW = 2816, SEQ = 8192, DEPTH = 4;
constexpr int LDS_BYTES = 147456;
constexpr size_t MiB = 1u << 20;
constexpr size_t WS_CTL = 0;
constexpr size_t WS_STATS = 1 * MiB;
constexpr size_t WS_KMP = 2 * MiB;
constexpr size_t WS_DEC = 2 * MiB + 512 * 1024;
constexpr size_t WS_ROPEC = 3 * MiB, WS_ROPES = 4 * MiB;
constexpr size_t WS_W = 5 * MiB, WSZ = 42467328;
constexpr size_t W_GU1 = 0, W_D1 = 11534336, W_IN = 17301504, W_OUT = 23068672, W_GU2 = 25165824, W_D2 = 36700160;
constexpr size_t WS_XB = 86 * MiB;
constexpr size_t WS_R = 118 * MiB;
constexpr size_t R_HID = 0;
constexpr size_t R_Q = 0, R_K = 16 * MiB, R_V = 32 * MiB, R_U5 = 48 * MiB  , R_Y = 88 * MiB, R_PO = 120 * MiB, R_PML = 168 * MiB,
                 R_LIST = 172 * MiB  , R_ALOC = 188 * MiB, R_OINTRA = 204 * MiB, R_QDEC = 220 * MiB, R_SP = 228 * MiB, R_END = 236 * MiB;
constexpr size_t WS_END = WS_R + R_END;

DI float bf2f(unsigned short b) { return __uint_as_float((unsigned)b << 16); }
DI unsigned cvtpk(float lo, float hi) { return pg8::cvtpk(lo, hi); }
DI float wave_sum(float v) {
#pragma unroll
    for (int o = 1; o < 64; o <<= 1) v += __shfl_xor(v, o);
    return v;
}
DI void st_sc1(unsigned* p, unsigned v) { __hip_atomic_store(p, v, __ATOMIC_RELAXED, __HIP_MEMORY_SCOPE_AGENT); }
DI unsigned ld_sc1(const unsigned* p) { return __hip_atomic_load(p, __ATOMIC_RELAXED, __HIP_MEMORY_SCOPE_AGENT); }
DI float ld_sc1f(const float* p) { return __uint_as_float(__hip_atomic_load((const unsigned*)p, __ATOMIC_RELAXED, __HIP_MEMORY_SCOPE_AGENT)); }
DI int crow(int reg, int h) { return (reg & 3) + 8 * (reg >> 2) + 4 * h; }
DI bf16x8 pack8(const f32x16& x, int s) {
    u32x4 p; p.x = cvtpk(x[8 * s], x[8 * s + 1]); p.y = cvtpk(x[8 * s + 2], x[8 * s + 3]); p.z = cvtpk(x[8 * s + 4], x[8 * s + 5]); p.w = cvtpk(x[8 * s + 6], x[8 * s + 7]);
    return __builtin_bit_cast(bf16x8, p);
}
DI f32x16 zero16() { f32x16 z;
#pragma unroll
    for (int i = 0; i < 16; ++i) z[i] = 0.f; return z; }

struct Args { const float* in[18]; float* out; unsigned char* ws; int ph_lo, ph_hi; };
typedef const float* cfp_t;
typedef const __attribute__((address_space(4))) unsigned char* kptr_t;
struct Ctx { kptr_t kp; unsigned char* ws; float* out;
    DI const float* in(int i) const { return *(const __attribute__((address_space(4))) cfp_t*)(kp + 8 * i); } };
enum { I_X = 0, I_F1N, I_F1G, I_F1U, I_F1D, I_MIXN, I_WIN, I_QN, I_KN, I_PW, I_PS, I_LB, I_HON, I_WOUT, I_F2N, I_F2G, I_F2U, I_F2D };

DI void wconv_tile(const float* W, int ld, int srccol, const float* gain, bf16* WT, int K, int nrow0, int k0, float* scr, int lane) {
    asm volatile("" : "+v"(lane));
#pragma unroll 16
    for (int i = 0; i < 32; ++i) { const int kk = 2 * i + (lane >> 5); float v = W[(size_t)(k0 + kk) * ld + srccol + (lane & 31)]; if (gain) v *= gain[k0 + kk]; scr[kk * 33 + (lane & 31)] = v; }
    asm volatile("s_waitcnt lgkmcnt(0)" ::: "memory");
    const int c = lane & 7;
#pragma unroll
    for (int j = 0; j < 4; ++j) { const int n = (lane >> 3) + 8 * j; const float* s = scr + (8 * c) * 33 + n;
        u32x4 o; o.x = cvtpk(s[0 * 33], s[1 * 33]); o.y = cvtpk(s[2 * 33], s[3 * 33]); o.z = cvtpk(s[4 * 33], s[5 * 33]); o.w = cvtpk(s[6 * 33], s[7 * 33]);
        *(u32x4*)(WT + (size_t)(nrow0 + n) * K + k0 + 8 * c) = o; }
    asm volatile("s_waitcnt lgkmcnt(0)" ::: "memory");
}
constexpr int WC_I0 = 2816, WC_I1 = 1408, WC_I2 = 1408, WC_I3 = 512, WC_I4 = 2816, WC_I5 = 1408, WC_ITEMS = WC_I0 + WC_I1 + WC_I2 + WC_I3 + WC_I4 + WC_I5;
DI void wconv_item(const Ctx& a, int L, int item, float* scr, int lane) {
    unsigned char* wb = a.ws + WS_W + (size_t)(L & 1) * WSZ;
    int r = item;
    if (r < WC_I0 || (r >= WC_I0 + WC_I1 + WC_I2 + WC_I3 && r < WC_I0 + WC_I1 + WC_I2 + WC_I3 + WC_I4)) {
        const bool second = r >= WC_I0; if (second) r -= WC_I0 + WC_I1 + WC_I2 + WC_I3;
        const int kb = r / 176, nb = r % 176, n0 = nb * 32, pn = n0 >> 8, c = n0 & 255, bj = c >> 7, col = 128 * pn + (c & 127);
        const float* src = a.in(second ? (bj ? I_F2U : I_F2G) : (bj ? I_F1U : I_F1G)) + (size_t)L * D * FF;
        const float* gain = a.in(second ? I_F2N : I_F1N) + L * D;
        wconv_tile(src, FF, col, gain, (bf16*)(wb + (second ? W_GU2 : W_GU1)), D, n0, kb * 64, scr, lane); return;
    }
    r -= WC_I0;
    if (r < WC_I1) { const int kb = r / 32, nb = r % 32; wconv_tile(a.in(I_F1D) + (size_t)L * FF * D, D, nb * 32, nullptr, (bf16*)(wb + W_D1), FF, nb * 32, kb * 64, scr, lane); return; }
    r -= WC_I1;
    if (r < WC_I2) { const int kb = r / 88, nb = r % 88, n0 = nb * 32, pn = n0 >> 8, c = n0 & 255;
        const int col = pn < 6 ? (pn >> 1) * 512 + 64 * ((pn & 1) * 4 + ((c >> 5) & 3)) + 32 * (c >> 7) : n0;
        wconv_tile(a.in(I_WIN) + (size_t)L * D * INW, INW, col, a.in(I_MIXN) + L * D, (bf16*)(wb + W_IN), D, n0, kb * 64, scr, lane); return; }
    r -= WC_I2;
    if (r < WC_I3) { const int kb = r / 32, nb = r % 32; wconv_tile(a.in(I_WOUT) + (size_t)L * D * D, D, nb * 32, nullptr, (bf16*)(wb + W_OUT), D, nb * 32, kb * 64, scr, lane); return; }
    r -= WC_I3 + WC_I4;
    { const int kb = r / 32, nb = r % 32; wconv_tile(a.in(I_F2D) + (size_t)L * FF * D, D, nb * 32, nullptr, (bf16*)(wb + W_D2), FF, nb * 32, kb * 64, scr, lane); }
}

DI void phase_p0(const Ctx& a, unsigned char* lds, int gw, int NGW, int wave, int lane) {
    const float* x = a.in(I_X); float* out = a.out; bf16* xb = (bf16*)(a.ws + WS_XB); float* stats = (float*)(a.ws + WS_STATS);
    for (int m0 = gw * 2; m0 < M; m0 += NGW * 2) {
        f32x4 v[2][4]; float sq[2];
#pragma unroll
        for (int k = 0; k < 2; ++k) { const f32x4* xr = (const f32x4*)(x + (size_t)(m0 + k) * D) + lane;
#pragma unroll
            for (int j = 0; j < 4; ++j) v[k][j] = xr[64 * j]; }
#pragma unroll
        for (int k = 0; k < 2; ++k) { float s = 0.f;
#pragma unroll
            for (int j = 0; j < 4; ++j) s += (v[k][j][0] * v[k][j][0] + v[k][j][1] * v[k][j][1]) + (v[k][j][2] * v[k][j][2] + v[k][j][3] * v[k][j][3]);
            sq[k] = wave_sum(s); }
#pragma unroll
        for (int k = 0; k < 2; ++k) { const int m = m0 + k;
            f32x4* orow = (f32x4*)(out + (size_t)m * D) + lane; u32x2* brow = (u32x2*)(xb + (size_t)m * D) + lane;
#pragma unroll
            for (int j = 0; j < 4; ++j) { orow[64 * j] = v[k][j]; u32x2 w; w.x = cvtpk(v[k][j][0], v[k][j][1]); w.y = cvtpk(v[k][j][2], v[k][j][3]); brow[64 * j] = w; }
            if (lane < 16) stats[(size_t)m * 16 + lane] = (lane == 0) ? sq[k] : 0.f; }
    }
    { unsigned* cz = (unsigned*)(a.ws + WS_CTL + 65536); for (int i = gw * 64 + lane; i < 3456; i += NGW * 64) cz[i] = 0u; }
    float* rc = (float*)(a.ws + WS_ROPEC); float* rs = (float*)(a.ws + WS_ROPES);
    for (int e = gw * 64 + lane; e < SEQ * 32; e += NGW * 64) {
        const int t = e >> 5, i = e & 31;
        double c = 0.15915494309189535;
        for (int k = 0; k < i; ++k) c *= 0.74989420933245582;
        const float chi = (float)c, clo = (float)(c - (double)chi), tf = (float)t;
        const float p = tf * chi, pe = fmaf(tf, chi, -p);
        float fr = __builtin_amdgcn_fractf(p) + (pe + tf * clo);
        rc[e] = __builtin_amdgcn_cosf(fr); rs[e] = __builtin_amdgcn_sinf(fr);
    }
    float* scr = (float*)(lds + wave * 16384);
    for (int it = gw; it < WC_ITEMS; it += NGW) wconv_item(a, 0, it, scr, lane);
}

template <bool DIAG>
DI void attn_core(const bf16* qrow, const bf16* kblk, const bf16* vblk, int nkg, int r, int h, float& m_out, float& l_out, f32x16 (&ot)[2]) {
    bf16x8 qf[4];
#pragma unroll
    for (int ks = 0; ks < 4; ++ks) qf[ks] = *(const bf16x8*)(qrow + 16 * ks + 8 * h);
    f32x16 st[8];
    const int lo = (r * 2 + h) * 8;
#pragma unroll
    for (int hf = 0; hf < 2; ++hf) {
        if (!DIAG || 4 * hf < nkg) {
            bf16x8 kf[16];
#pragma unroll
            for (int i = 0; i < 16; ++i) kf[i] = (!DIAG || 4 * hf + (i >> 2) < nkg) ? *(const bf16x8*)(kblk + ((4 * hf + (i >> 2)) * 4 + (i & 3)) * 512 + lo) : qf[0];
#pragma unroll
            for (int g = 0; g < 4; ++g) {
                const int kg = 4 * hf + g;
                f32x16 acc = zero16();
                if (!DIAG || kg < nkg) {
#pragma unroll
                    for (int ks = 0; ks < 4; ++ks) acc = MFMA32(kf[4 * g + ks], qf[ks], acc);
                    if (DIAG && kg == nkg - 1) {
#pragma unroll
                        for (int i = 0; i < 16; ++i) if (crow(i, h) > r) acc[i] = -INFINITY;
                    }
                } else {
#pragma unroll
                    for (int i = 0; i < 16; ++i) acc[i] = -INFINITY;
                }
                st[kg] = acc;
            }
        } else {
#pragma unroll
            for (int g = 0; g < 4; ++g)
#pragma unroll
                for (int i = 0; i < 16; ++i) st[4 * hf + g][i] = -INFINITY;
        }
    }
    float mx = -INFINITY;
#pragma unroll
    for (int kg = 0; kg < 8; ++kg)
#pragma unroll
        for (int i = 0; i < 16; ++i) mx = fmaxf(mx, st[kg][i]);
    mx = fmaxf(mx, __shfl_xor(mx, 32));
    const float c = 0.125f * 1.4426950408889634f; const float mc = mx * c;
    float l = 0.f;
#pragma unroll
    for (int kg = 0; kg < 8; ++kg)
#pragma unroll
        for (int i = 0; i < 16; ++i) { const float p = __builtin_amdgcn_exp2f(st[kg][i] * c - mc); st[kg][i] = p; l += p; }
    l += __shfl_xor(l, 32);
    ot[0] = zero16(); ot[1] = zero16();
#pragma unroll
    for (int pr = 0; pr < 4; ++pr) {
        if (!DIAG || 2 * pr < nkg) {
            bf16x8 vf[8];
#pragma unroll
            for (int i = 0; i < 8; ++i) vf[i] = (!DIAG || 2 * pr + (i >> 2) < nkg) ? *(const bf16x8*)(vblk + (((2 * pr + (i >> 2)) * 2 + ((i >> 1) & 1)) * 2 + (i & 1)) * 512 + lo) : qf[0];
#pragma unroll
            for (int g = 0; g < 2; ++g) {
                const int kg = 2 * pr + g;
                if (!DIAG || kg < nkg) {
#pragma unroll
                    for (int s2 = 0; s2 < 2; ++s2) { const bf16x8 pf = pack8(st[kg], s2); ot[0] = MFMA32(vf[4 * g + 2 * s2], pf, ot[0]); ot[1] = MFMA32(vf[4 * g + 2 * s2 + 1], pf, ot[1]); }
                }
            }
        }
    }
    m_out = mx * 0.125f; l_out = l;
}

DI void topk_unit(const Ctx& a, int L, int unit, int lane) {
    asm volatile("" : "+v"(lane));
    const int b = unit >> 10, hd = (unit >> 7) & 7, c = unit & 127, own = c >> 2;
    if (own == 0) return;
    const bf16* Q = (const bf16*)(a.ws + WS_R + R_Q); const float* kmp = (const float*)(a.ws + WS_KMP);
    unsigned* cnt = (unsigned*)(a.ws + WS_CTL) + L * 512; unsigned* lists = (unsigned*)(a.ws + WS_R + R_LIST);
    const int t = c * 64 + lane; const size_t bh = (size_t)(b * 8 + hd);
    float q[64];
    { const u32x4* qp = (const u32x4*)(Q + (bh * SEQ + t) * 64);
#pragma unroll
      for (int i = 0; i < 8; ++i) { const u32x4 w = qp[i];
          q[8 * i + 0] = __uint_as_float(w.x << 16); q[8 * i + 1] = __uint_as_float(w.x & 0xffff0000u); q[8 * i + 2] = __uint_as_float(w.y << 16); q[8 * i + 3] = __uint_as_float(w.y & 0xffff0000u);
          q[8 * i + 4] = __uint_as_float(w.z << 16); q[8 * i + 5] = __uint_as_float(w.z & 0xffff0000u); q[8 * i + 6] = __uint_as_float(w.w << 16); q[8 * i + 7] = __uint_as_float(w.w & 0xffff0000u); } }
    float g0 = -INFINITY, g1 = -INFINITY, g2 = -INFINITY; int i0 = 0, i1 = 0, i2 = 0;
    for (int j = 0; j < own; ++j) {
        const float* p0 = kmp + (size_t)((b * 32 + j) * 2) * 512 + hd * 64; const float* p1 = p0 + 512;
        float g = 0.f;
#pragma unroll
        for (int d = 0; d < 64; d += 4) { const f32x4 x0 = *(const f32x4*)(p0 + d), x1 = *(const f32x4*)(p1 + d);
            g += q[d] * (x0[0] + x1[0]) + q[d + 1] * (x0[1] + x1[1]) + q[d + 2] * (x0[2] + x1[2]) + q[d + 3] * (x0[3] + x1[3]); }
#ifdef DBG_FIXED_SEL
        g = -(float)j;
#endif
        if (g > g0) { g2 = g1; i2 = i1; g1 = g0; i1 = i0; g0 = g; i0 = j; }
        else if (g > g1) { g2 = g1; i2 = i1; g1 = g; i1 = j; }
        else if (g > g2) { g2 = g; i2 = j; }
    }
    const int nsel = own < 3 ? own : 3;
#pragma unroll
    for (int s = 0; s < 3; ++s) {
        if (s < nsel) { const int j = s == 0 ? i0 : (s == 1 ? i1 : i2); const int li = (int)bh * 32 + j;
            const unsigned pos = atomicAdd(cnt + li, 1u); st_sc1(lists + (size_t)li * 8192 + pos, (unsigned)(t | (s << 13))); }
    }
}

DI void pool_unit(const Ctx& a, int L, int unit, int lane) {
    asm volatile("" : "+v"(lane));
    const int tile = unit >> 2, g = unit & 3, w = 2 << g, r = lane & 31, h = lane >> 5;
    const bf16* U = (const bf16*)(a.ws + WS_R + R_U5); bf16* Y = (bf16*)(a.ws + WS_R + R_Y);
    const float* pw = a.in(I_PW) + (size_t)(L * 4 + g) * 4096; const float* ps = a.in(I_PS) + L * 256 + g * 64;
    const float* pwl = pw + (8 * h) * 64 + r;
    bf16x8 wf[2][4];
#pragma unroll
    for (int me = 0; me < 2; ++me)
#pragma unroll
        for (int ks = 0; ks < 4; ++ks) { float f[8];
#pragma unroll
            for (int j = 0; j < 8; ++j) f[j] = pwl[(16 * ks + j) * 64 + 32 * me];
            u32x4 p; p.x = cvtpk(f[0], f[1]); p.y = cvtpk(f[2], f[3]); p.z = cvtpk(f[4], f[5]); p.w = cvtpk(f[6], f[7]); wf[me][ks] = __builtin_bit_cast(bf16x8, p); }
#pragma unroll 1
    for (int nt = 0; nt < 4; ++nt) {
        const int m = tile * 128 + nt * 32 + r, tpos = m & (SEQ - 1);
        const int cntw = tpos + 1 < w ? tpos + 1 : w; const float invc = 1.0f / (float)cntw;
        f32x16 acc[2]; acc[0] = zero16(); acc[1] = zero16();
#pragma unroll
        for (int ks = 0; ks < 4; ++ks) {
            const bf16* up = U + (size_t)m * 256 + g * 64 + 16 * ks + 8 * h;
            float sum[8], self[8];
            { const u32x4 wv = *(const u32x4*)up;
              self[0] = __uint_as_float(wv.x << 16); self[1] = __uint_as_float(wv.x & 0xffff0000u); self[2] = __uint_as_float(wv.y << 16); self[3] = __uint_as_float(wv.y & 0xffff0000u);
              self[4] = __uint_as_float(wv.z << 16); self[5] = __uint_as_float(wv.z & 0xffff0000u); self[6] = __uint_as_float(wv.w << 16); self[7] = __uint_as_float(wv.w & 0xffff0000u); }
#pragma unroll
            for (int j = 0; j < 8; ++j) sum[j] = self[j];
            u32x4 rows[15];
#pragma unroll
            for (int i = 1; i < 16; ++i) { const bool ok = (i < w) && (i <= tpos); rows[i - 1] = *(const u32x4*)(up - (size_t)(ok ? i : 0) * 256); }
#pragma unroll
            for (int i = 1; i < 16; ++i) { const bool ok = (i < w) && (i <= tpos); const float kf = ok ? 1.f : 0.f; const u32x4 wv = rows[i - 1];
                sum[0] += kf * __uint_as_float(wv.x << 16); sum[1] += kf * __uint_as_float(wv.x & 0xffff0000u); sum[2] += kf * __uint_as_float(wv.y << 16); sum[3] += kf * __uint_as_float(wv.y & 0xffff0000u);
                sum[4] += kf * __uint_as_float(wv.z << 16); sum[5] += kf * __uint_as_float(wv.z & 0xffff0000u); sum[6] += kf * __uint_as_float(wv.w << 16); sum[7] += kf * __uint_as_float(wv.w & 0xffff0000u); }
            u32x4 p; p.x = cvtpk(sum[0] * invc - self[0], sum[1] * invc - self[1]); p.y = cvtpk(sum[2] * invc - self[2], sum[3] * invc - self[3]);
            p.z = cvtpk(sum[4] * invc - self[4], sum[5] * invc - self[5]); p.w = cvtpk(sum[6] * invc - self[6], sum[7] * invc - self[7]);
            const bf16x8 df = __builtin_bit_cast(bf16x8, p);
            acc[0] = MFMA32(wf[0][ks], df, acc[0]); acc[1] = MFMA32(wf[1][ks], df, acc[1]);
        }
#pragma unroll
        for (int me = 0; me < 2; ++me)
#pragma unroll
            for (int gq = 0; gq < 4; ++gq) { const int e0 = 32 * me + 8 * gq + 4 * h; const f32x4 sc = *(const f32x4*)(ps + e0);
                u32x2 o; o.x = cvtpk(acc[me][4 * gq] * sc[0], acc[me][4 * gq + 1] * sc[1]); o.y = cvtpk(acc[me][4 * gq + 2] * sc[2], acc[me][4 * gq + 3] * sc[3]);
                *(u32x2*)(Y + (size_t)m * 1024 + 512 + g * 64 + e0) = o; }
    }
}

DI void h1_unit(const Ctx& a, int L, int unit, unsigned char* sm, int lane) {
    asm volatile("" : "+v"(lane));
    const int b = unit >> 9, hh = (unit >> 7) & 3, n = unit & 127, r = lane & 31, h = lane >> 5;
    const int row0 = b * SEQ + n * 64, ch = hh * 64 + lane;
    const bf16* QH = (const bf16*)(a.ws + WS_R + R_U5) + (size_t)1 * M * 256; const bf16* FH = QH + (size_t)M * 256; const bf16* IH = FH + (size_t)M * 256;
    bf16* QDEC = (bf16*)(a.ws + WS_R + R_QDEC); float* ALOC = (float*)(a.ws + WS_R + R_ALOC); float* OINTRA = (float*)(a.ws + WS_R + R_OINTRA); float* DEC = (float*)(a.ws + WS_DEC);
    bf16* KD = (bf16*)sm; bf16* IT = (bf16*)(sm + 8192); bf16* Am = (bf16*)(sm + 16384); bf16* Bm = (bf16*)(sm + 24576);
#ifdef DBG_H1_CLEAR
    { u32x4* z4 = (u32x4*)sm;
#pragma unroll 4
      for (int i = 0; i < 32; ++i) z4[i * 64 + lane] = (u32x4){0u, 0u, 0u, 0u}; asm volatile("s_waitcnt lgkmcnt(0)" ::: "memory"); }
#endif
    float lb;
    { const float* lp = a.in(I_LB) + ch; const float x0 = lp[0], x1 = lp[256], x2 = lp[512], x3 = lp[768];
      const float mx = fmaxf(fmaxf(x0, x1), fmaxf(x2, x3)); const float e0 = __expf(x0 - mx), e1 = __expf(x1 - mx), e2 = __expf(x2 - mx), e3 = __expf(x3 - mx);
      const float inv = 1.0f / (e0 + e1 + e2 + e3); float acc = 0.f; if (L > 0) acc += e0; if (L > 1) acc += e1; if (L > 2) acc += e2; lb = acc * inv; }
    const float loglb = __logf(fmaxf(lb, 1e-20f)), l1m = __logf(1.0f - lb), oml = 1.0f - lb;
    float zr[64];
#pragma unroll
    for (int s = 0; s < 64; ++s) zr[s] = bf2f(FH[(size_t)(row0 + s) * 256 + ch]);
    float cum = 0.f, ref = 0.f;
#pragma unroll
    for (int s = 0; s < 64; ++s) {
        const float z = zr[s];
        const float ls = fminf(z, 0.f) - __logf(1.0f + __expf(-fabsf(z)));
        const float bb = l1m + ls, hi = fmaxf(loglb, bb), df = fabsf(loglb - bb);
        cum += hi + __logf(1.0f + __expf(-df));
        asm volatile("" : "+v"(cum));
        if (s == 31) ref = cum;
    }
    const float last = cum;
    DEC[unit * 64 + lane] = __expf(last);
    cum = 0.f;
#ifndef H1_NO_P2
#pragma unroll 1
    for (int s8 = 0; s8 < 8; ++s8) {
        unsigned kp[4], ip[4]; float kd8[8]; unsigned short i8[8];
#pragma unroll
        for (int j = 0; j < 8; ++j) {
            const int s = s8 * 8 + j; const size_t gi = (size_t)(row0 + s) * 256 + ch;
            const float z = bf2f(FH[gi]), qv = bf2f(QH[gi]); i8[j] = IH[gi];
            const float ls = fminf(z, 0.f) - __logf(1.0f + __expf(-fabsf(z)));
            const float bb = l1m + ls, hi = fmaxf(loglb, bb), df = fabsf(loglb - bb);
            cum += hi + __logf(1.0f + __expf(-df));
            const float key = oml * __builtin_amdgcn_rcpf(1.0f + __expf(z));
            const float qs = qv * __builtin_amdgcn_rcpf(1.0f + __expf(-qv)) * 0.125f;
            const float av = qs * __expf(fminf(cum - ref, 80.f)), bv = key * __expf(fminf(ref - cum, 80.f)), qd = qs * __expf(cum);
            kd8[j] = key * __expf(last - cum);
#ifndef H1_NO_AB
            Am[s * 64 + lane] = (bf16)(cvtpk(av, 0.f) & 0xffffu); Bm[s * 64 + lane] = (bf16)(cvtpk(bv, 0.f) & 0xffffu);
#endif
#ifndef H1_NO_QD
            QDEC[gi] = (bf16)(cvtpk(qd, 0.f) & 0xffffu);
#endif
        }
#pragma unroll
        for (int j = 0; j < 4; ++j) { kp[j] = cvtpk(kd8[2 * j], kd8[2 * j + 1]); ip[j] = (unsigned)i8[2 * j] | ((unsigned)i8[2 * j + 1] << 16); }
        *(u32x4*)(KD + lane * 64 + s8 * 8) = (u32x4){kp[0], kp[1], kp[2], kp[3]};
        *(u32x4*)(IT + lane * 64 + s8 * 8) = (u32x4){ip[0], ip[1], ip[2], ip[3]};
    }
#endif
    asm volatile("s_waitcnt lgkmcnt(0)" ::: "memory");
#ifndef H1_NO_MM
    bf16x8 itf[2][2][2];
#pragma unroll
    for (int mv = 0; mv < 2; ++mv)
#pragma unroll
        for (int ms = 0; ms < 2; ++ms)
#pragma unroll
            for (int st = 0; st < 2; ++st) { const bf16* p = IT + (32 * mv + r) * 64 + 32 * ms + 16 * st + 4 * h; const u32x2 x0 = *(const u32x2*)p, x1 = *(const u32x2*)(p + 8);
                itf[mv][ms][st] = __builtin_bit_cast(bf16x8, ((u32x4){x0.x, x0.y, x1.x, x1.y})); }
    float* alb = ALOC + (size_t)unit * 4096 + (4 * h) * 64 + r;
#pragma unroll
    for (int nk = 0; nk < 2; ++nk) {
        bf16x8 kdf[2][2];
#pragma unroll
        for (int ms = 0; ms < 2; ++ms)
#pragma unroll
            for (int st = 0; st < 2; ++st) { const bf16* p = KD + (32 * nk + r) * 64 + 32 * ms + 16 * st + 4 * h; const u32x2 x0 = *(const u32x2*)p, x1 = *(const u32x2*)(p + 8);
                kdf[ms][st] = __builtin_bit_cast(bf16x8, ((u32x4){x0.x, x0.y, x1.x, x1.y})); }
#pragma unroll
        for (int mv = 0; mv < 2; ++mv) {
            f32x16 acc = zero16();
#pragma unroll
            for (int ms = 0; ms < 2; ++ms)
#pragma unroll
                for (int st = 0; st < 2; ++st) acc = MFMA32(itf[mv][ms][st], kdf[ms][st], acc);
#pragma unroll
            for (int i = 0; i < 16; ++i) alb[(32 * mv + (i & 3) + 8 * (i >> 2)) * 64 + 32 * nk] = acc[i];
        }
    }
#pragma unroll
    for (int nt = 0; nt < 2; ++nt) {
        bf16x8 af[4];
#pragma unroll
        for (int ks = 0; ks < 4; ++ks) af[ks] = *(const bf16x8*)(Am + (32 * nt + r) * 64 + 16 * ks + 8 * h);
        f32x16 oi[2]; oi[0] = zero16(); oi[1] = zero16();
#pragma unroll
        for (int ms = 0; ms < 2; ++ms) {
            if (ms <= nt) {
                f32x16 sacc = zero16();
#pragma unroll
                for (int ks = 0; ks < 4; ++ks) { const bf16x8 bf_ = *(const bf16x8*)(Bm + (32 * ms + r) * 64 + 16 * ks + 8 * h); sacc = MFMA32(bf_, af[ks], sacc); }
                if (ms == nt) {
#pragma unroll
                    for (int i = 0; i < 16; ++i) if (crow(i, h) > r) sacc[i] = 0.f;
                }
#pragma unroll
                for (int st = 0; st < 2; ++st) { const bf16x8 pf = pack8(sacc, st); oi[0] = MFMA32(itf[0][ms][st], pf, oi[0]); oi[1] = MFMA32(itf[1][ms][st], pf, oi[1]); }
            }
        }
        const size_t orow = (size_t)(row0 + 32 * nt + r) * 256 + hh * 64;
#pragma unroll
        for (int mv = 0; mv < 2; ++mv)
#pragma unroll
            for (int gq = 0; gq < 4; ++gq) *(f32x4*)(OINTRA + orow + 32 * mv + 8 * gq + 4 * h) = (f32x4){oi[mv][4 * gq], oi[mv][4 * gq + 1], oi[mv][4 * gq + 2], oi[mv][4 * gq + 3]};
    }
#endif
    asm volatile("s_waitcnt lgkmcnt(0)" ::: "memory");
}

DI void phase_t(const Ctx& a, int L, unsigned char* lds, int gw, int NGW, int wave, int lane) {
    const int blk = gw >> 3, G = NGW >> 3;
    if (wave < 4) { for (int u = blk * 4 + wave; u < 1024; u += G * 4) h1_unit(a, L, u, lds + wave * 32768, lane); }
    else if (wave < 6) { for (int u = blk * 2 + (wave - 4); u < 512; u += G * 2) pool_unit(a, L, u, lane); }
    __syncthreads();
    if (L + 1 < DEPTH) { float* scr = (float*)(lds + wave * 16384); for (int it = gw; it < WC_ITEMS; it += NGW) wconv_item(a, L + 1, it, scr, lane); }
}

DI void attn_unit(const Ctx& a, int bh, int qb, unsigned char* lds, int tid, int wave, int lane) {
    asm volatile("" : "+v"(lane), "+v"(tid));
    const int r = lane & 31, h = lane >> 5, b = bh >> 3, hd = bh & 7, own = qb, nsel = own < 3 ? own : 3;
    const bf16* Q = (const bf16*)(a.ws + WS_R + R_Q); const bf16* Kb = (const bf16*)(a.ws + WS_R + R_K); const bf16* Vb = (const bf16*)(a.ws + WS_R + R_V);
    const float* kmp = (const float*)(a.ws + WS_KMP); bf16* Y = (bf16*)(a.ws + WS_R + R_Y);
    unsigned char* part = lds;
    unsigned short* llist = (unsigned short*)(lds + 104448);
    int* lcnt = (int*)(lds + 120832); int* itab = lcnt + 32;
    const size_t qbase = ((size_t)bh * SEQ + (size_t)qb * 256) * 64;
    if (own > 0) {
        if (tid < 32) lcnt[tid] = 0;
        float* km = (float*)(lds + 122880);
        for (int idx = tid; idx < own * 64; idx += NTHR) { const float* p0 = kmp + (size_t)((b * 32 + (idx >> 6)) * 2) * 512 + hd * 64 + (idx & 63); km[idx] = p0[0] + p0[512]; }
        __syncthreads();
        if (tid < 256) {
            float q[64];
            { const u32x4* qp = (const u32x4*)(Q + qbase + (size_t)tid * 64);
#pragma unroll
              for (int i = 0; i < 8; ++i) { const u32x4 w = qp[i];
                  q[8 * i + 0] = __uint_as_float(w.x << 16); q[8 * i + 1] = __uint_as_float(w.x & 0xffff0000u); q[8 * i + 2] = __uint_as_float(w.y << 16); q[8 * i + 3] = __uint_as_float(w.y & 0xffff0000u);
                  q[8 * i + 4] = __uint_as_float(w.z << 16); q[8 * i + 5] = __uint_as_float(w.z & 0xffff0000u); q[8 * i + 6] = __uint_as_float(w.w << 16); q[8 * i + 7] = __uint_as_float(w.w & 0xffff0000u); } }
            float g0 = -INFINITY, g1 = -INFINITY, g2 = -INFINITY; int i0 = 0, i1 = 0, i2 = 0;
            for (int j = 0; j < own; ++j) {
                const float* kj = km + j * 64;
                float g = 0.f;
#pragma unroll
                for (int d = 0; d < 64; d += 4) { const f32x4 x0 = *(const f32x4*)(kj + d);
                    g += q[d] * x0[0] + q[d + 1] * x0[1] + q[d + 2] * x0[2] + q[d + 3] * x0[3]; }
                if (g > g0) { g2 = g1; i2 = i1; g1 = g0; i1 = i0; g0 = g; i0 = j; }
                else if (g > g1) { g2 = g1; i2 = i1; g1 = g; i1 = j; }
                else if (g > g2) { g2 = g; i2 = j; }
            }
#pragma unroll
            for (int s = 0; s < 3; ++s) {
                if (s < nsel) { const int j = s == 0 ? i0 : (s == 1 ? i1 : i2); const int pos = atomicAdd(lcnt + j, 1); llist[j * 256 + pos] = (unsigned short)(tid | (s << 8)); }
            }
        }
        __syncthreads();
        if (tid == 0) { int n = 0; for (int j = 0; j < own; ++j) { const int ng = (lcnt[j] + 31) >> 5; for (int g = 0; g < ng; ++g) itab[n++] = j | (g << 8); } itab[64] = n; }
        __syncthreads();
        const int nitems = __builtin_amdgcn_readfirstlane(itab[64]);
        for (int it = wave; it < nitems; it += NWAVES) {
            const int ent = __builtin_amdgcn_readfirstlane(itab[it]); const int j = ent & 255, g = ent >> 8, n = __builtin_amdgcn_readfirstlane(lcnt[j]);
            const int idx = g * 32 + r; const bool valid = idx < n;
            const unsigned e = llist[j * 256 + (valid ? idx : 0)];
            const int qi = e & 255, slot = e >> 8;
            float mo, lo_; f32x16 ot[2];
            attn_core<false>(Q + qbase + (size_t)qi * 64, Kb + ((size_t)bh * 32 + j) * 16384, Vb + ((size_t)bh * 32 + j) * 16384, 8, r, h, mo, lo_, ot);
            if (valid) {
                unsigned char* rec = part + (qi * 3 + slot) * 136; const float inv = 1.0f / lo_;
#pragma unroll
                for (int md = 0; md < 2; ++md)
#pragma unroll
                    for (int gq = 0; gq < 4; ++gq) { u32x2 o; o.x = cvtpk(ot[md][4 * gq] * inv, ot[md][4 * gq + 1] * inv); o.y = cvtpk(ot[md][4 * gq + 2] * inv, ot[md][4 * gq + 3] * inv);
                        *(u32x2*)(rec + 2 * (32 * md + 8 * gq + 4 * h)) = o; }
                if (h == 0) { *(float*)(rec + 128) = mo; *(float*)(rec + 132) = lo_; }
            }
        }
        __syncthreads();
    }
    {
        const int ql = 32 * wave + r, t = qb * 256 + ql;
        float m0, l0; f32x16 ot[2];
        attn_core<true>(Q + qbase + (size_t)ql * 64, Kb + ((size_t)bh * 32 + qb) * 16384, Vb + ((size_t)bh * 32 + qb) * 16384, wave + 1, r, h, m0, l0, ot);
        float ms[3], ls[3]; float mx = m0;
#pragma unroll
        for (int s = 0; s < 3; ++s) { ms[s] = -INFINITY; ls[s] = 0.f; if (s < nsel) { const unsigned char* rec = part + (ql * 3 + s) * 136; ms[s] = *(const float*)(rec + 128); ls[s] = *(const float*)(rec + 132); mx = fmaxf(mx, ms[s]); } }
        const float w0 = __expf(m0 - mx); float den = w0 * l0;
#pragma unroll
        for (int md = 0; md < 2; ++md)
#pragma unroll
            for (int i = 0; i < 16; ++i) ot[md][i] *= w0;
#pragma unroll
        for (int s = 0; s < 3; ++s) {
            if (s < nsel) {
                const unsigned char* rec = part + (ql * 3 + s) * 136; const float ws_ = __expf(ms[s] - mx) * ls[s]; den += ws_;
#pragma unroll
                for (int md = 0; md < 2; ++md)
#pragma unroll
                    for (int gq = 0; gq < 4; ++gq) { const u32x2 w = *(const u32x2*)(rec + 2 * (32 * md + 8 * gq + 4 * h));
                        ot[md][4 * gq] += ws_ * __uint_as_float(w.x << 16); ot[md][4 * gq + 1] += ws_ * __uint_as_float(w.x & 0xffff0000u);
                        ot[md][4 * gq + 2] += ws_ * __uint_as_float(w.y << 16); ot[md][4 * gq + 3] += ws_ * __uint_as_float(w.y & 0xffff0000u); }
            }
        }
        float inv = 1.0f / den; const size_t yrow = (size_t)(b * SEQ + t) * 1024 + hd * 64;
#ifdef DBG_AMP_ATTN
        inv *= 64.f;
#endif
#pragma unroll
        for (int md = 0; md < 2; ++md)
#pragma unroll
            for (int gq = 0; gq < 4; ++gq) { u32x2 o; o.x = cvtpk(ot[md][4 * gq] * inv, ot[md][4 * gq + 1] * inv); o.y = cvtpk(ot[md][4 * gq + 2] * inv, ot[md][4 * gq + 3] * inv);
                *(u32x2*)(Y + yrow + 32 * md + 8 * gq + 4 * h) = o; }
    }
    __syncthreads();
}

DI void phase_a(const Ctx& a, int L, unsigned char* lds, int gw, int NGW, int tid, int wave, int lane) {
    if ((gw & 3) == 0 && (gw >> 2) < 512) {
        const int chunk = gw >> 2, bhh = chunk >> 6, e = (chunk & 63) * 64 + lane, k = e & 63;
        const float* ALOC = (const float*)(a.ws + WS_R + R_ALOC); const float* DEC = (const float*)(a.ws + WS_DEC); bf16* SP = (bf16*)(a.ws + WS_R + R_SP);
        float st = 0.f;
#pragma unroll 8
        for (int n = 0; n < 128; ++n) { const int item = bhh * 128 + n; const float av = ALOC[(size_t)item * 4096 + e], dv = DEC[item * 64 + k];
            SP[(size_t)item * 4096 + e] = (bf16)(cvtpk(st, 0.f) & 0xffffu); st = dv * st + av; }
    }
    const int G = NGW / NWAVES, blk = gw / NWAVES;
    for (int u = blk; u < 512; u += G) {
        const int v = u & 255, bh = v >> 4, qb = (u < 256) ? (v & 15) : 31 - (v & 15);
        attn_unit(a, bh, qb, lds, tid, wave, lane);
    }
}

DI void own_unit(const Ctx& a, int bhi, int qg, int lane) {
    asm volatile("" : "+v"(lane));
    const int r = lane & 31, h = lane >> 5, t0 = qg * 32, j = t0 >> 8, nkg = ((t0 & 255) >> 5) + 1, t = t0 + r;
    const int b = bhi >> 3, hd = bhi & 7; const size_t bh = (size_t)bhi;
    const bf16* Q = (const bf16*)(a.ws + WS_R + R_Q); const bf16* Kb = (const bf16*)(a.ws + WS_R + R_K); const bf16* Vb = (const bf16*)(a.ws + WS_R + R_V);
    const bf16* PO = (const bf16*)(a.ws + WS_R + R_PO); const float* PML = (const float*)(a.ws + WS_R + R_PML); bf16* Y = (bf16*)(a.ws + WS_R + R_Y);
    float m0, l0; f32x16 ot[2];
    attn_core<true>(Q + (bh * SEQ + t) * 64, Kb + (bh * 32 + j) * 16384, Vb + (bh * 32 + j) * 16384, nkg, r, h, m0, l0, ot);
#ifdef DBG_OWN_ONLY
    const int nsel = 0;
#else
    const int nsel = j < 3 ? j : 3;
#endif
    const size_t pi = (bh * SEQ + t) * 3;
    float ms[3], ls[3]; float mx = m0;
#pragma unroll
    for (int s = 0; s < 3; ++s) { ms[s] = -INFINITY; ls[s] = 0.f; if (s < nsel) { ms[s] = ld_sc1f(PML + (pi + s) * 2); ls[s] = ld_sc1f(PML + (pi + s) * 2 + 1); mx = fmaxf(mx, ms[s]); } }
    const float w0 = __expf(m0 - mx); float den = w0 * l0;
#pragma unroll
    for (int md = 0; md < 2; ++md)
#pragma unroll
        for (int i = 0; i < 16; ++i) ot[md][i] *= w0;
#pragma unroll
    for (int s = 0; s < 3; ++s) {
        if (s < nsel) {
            const float ws_ = __expf(ms[s] - mx) * ls[s]; den += ws_;
#pragma unroll
            for (int md = 0; md < 2; ++md)
#pragma unroll
                for (int gq = 0; gq < 4; ++gq) { const u32x2 w = *(const u32x2*)(PO + (pi + s) * 64 + 32 * md + 8 * gq + 4 * h);
                    ot[md][4 * gq] += ws_ * __uint_as_float(w.x << 16); ot[md][4 * gq + 1] += ws_ * __uint_as_float(w.x & 0xffff0000u);
                    ot[md][4 * gq + 2] += ws_ * __uint_as_float(w.y << 16); ot[md][4 * gq + 3] += ws_ * __uint_as_float(w.y & 0xffff0000u); }
        }
    }
    float inv = 1.0f / den; const size_t yrow = (size_t)(b * SEQ + t) * 1024 + hd * 64;
#ifdef DBG_ZERO_ATTN
    inv = 0.f;
#endif
#pragma unroll
    for (int md = 0; md < 2; ++md)
#pragma unroll
        for (int gq = 0; gq < 4; ++gq) { u32x2 o; o.x = cvtpk(ot[md][4 * gq] * inv, ot[md][4 * gq + 1] * inv); o.y = cvtpk(ot[md][4 * gq + 2] * inv, ot[md][4 * gq + 3] * inv);
            *(u32x2*)(Y + yrow + 32 * md + 8 * gq + 4 * h) = o; }
}

DI void h3_unit(const Ctx& a, int L, int unit, int lane) {
    asm volatile("" : "+v"(lane));
    const int b = unit >> 9, hh = (unit >> 7) & 3, n = unit & 127, r = lane & 31, h = lane >> 5;
    const int row0 = b * SEQ + n * 64;
    const bf16* SP = (const bf16*)(a.ws + WS_R + R_SP) + (size_t)unit * 4096; const bf16* QDEC = (const bf16*)(a.ws + WS_R + R_QDEC);
    const float* OINTRA = (const float*)(a.ws + WS_R + R_OINTRA); const bf16* GH = (const bf16*)(a.ws + WS_R + R_U5) + (size_t)4 * M * 256; bf16* Y = (bf16*)(a.ws + WS_R + R_Y);
    const float* on = a.in(I_HON) + L * 64;
    bf16x8 sf[2][4];
#pragma unroll
    for (int mv = 0; mv < 2; ++mv)
#pragma unroll
        for (int ks = 0; ks < 4; ++ks) sf[mv][ks] = *(const bf16x8*)(SP + (32 * mv + r) * 64 + 16 * ks + 8 * h);
#pragma unroll
    for (int nt = 0; nt < 2; ++nt) {
        const size_t trow = (size_t)(row0 + 32 * nt + r) * 256 + hh * 64;
        f32x16 o[2]; o[0] = zero16(); o[1] = zero16();
#pragma unroll
        for (int ks = 0; ks < 4; ++ks) { const bf16x8 qf = *(const bf16x8*)(QDEC + trow + 16 * ks + 8 * h); o[0] = MFMA32(sf[0][ks], qf, o[0]); o[1] = MFMA32(sf[1][ks], qf, o[1]); }
        float ss = 0.f;
#pragma unroll
        for (int mv = 0; mv < 2; ++mv)
#pragma unroll
            for (int gq = 0; gq < 4; ++gq) { const f32x4 x = *(const f32x4*)(OINTRA + trow + 32 * mv + 8 * gq + 4 * h);
#pragma unroll
                for (int i = 0; i < 4; ++i) { o[mv][4 * gq + i] += x[i]; ss += o[mv][4 * gq + i] * o[mv][4 * gq + i]; } }
        ss += __shfl_xor(ss, 32);
        float rn = rsqrtf(ss * (1.0f / 64.0f) + 1e-6f);
#ifdef DBG_ZERO_HGRN
        rn = 0.f;
#endif
#ifdef DBG_AMP_HGRN
        rn *= 16.f;
#endif
        const size_t yrow = (size_t)(row0 + 32 * nt + r) * 1024 + 768 + hh * 64;
#pragma unroll
        for (int mv = 0; mv < 2; ++mv)
#pragma unroll
            for (int gq = 0; gq < 4; ++gq) { const int v0 = 32 * mv + 8 * gq + 4 * h; const f32x4 gn = *(const f32x4*)(on + v0); const u32x2 gw_ = *(const u32x2*)(GH + trow + v0);
                const float g0 = __uint_as_float(gw_.x << 16), g1 = __uint_as_float(gw_.x & 0xffff0000u), g2 = __uint_as_float(gw_.y << 16), g3 = __uint_as_float(gw_.y & 0xffff0000u);
                u32x2 w; w.x = cvtpk(o[mv][4 * gq] * rn * gn[0] * pg8::silu_f(g0), o[mv][4 * gq + 1] * rn * gn[1] * pg8::silu_f(g1));
                w.y = cvtpk(o[mv][4 * gq + 2] * rn * gn[2] * pg8::silu_f(g2), o[mv][4 * gq + 3] * rn * gn[3] * pg8::silu_f(g3));
                *(u32x2*)(Y + yrow + v0) = w; }
    }
}

DI void phase_c(const Ctx& a, int L, int gw, int NGW, int lane) {
    for (int u = gw; u < 1024; u += NGW) h3_unit(a, L, u, lane);
}

#define LAS __attribute__((address_space(3)))
#define XB_TMO      128
#define XB_XCNT(j)  (256  + 64 * (j))
#define XB_XSUB(j)  (1280 + 64 * (j))
#define XB_XGEN(j)  (2304 + 64 * (j))
#define XB_TOP      3328
#define XB_TOPGEN   3392
#define XCD_BAR_WORDS 3456
#define XB_SPIN_CAP (1u << 18)

__device__ __forceinline__ unsigned xb_ld(unsigned* p)              { return __hip_atomic_load(p, __ATOMIC_RELAXED, __HIP_MEMORY_SCOPE_AGENT); }
__device__ __forceinline__ unsigned xb_add(unsigned* p, unsigned v) { return __hip_atomic_fetch_add(p, v, __ATOMIC_RELAXED, __HIP_MEMORY_SCOPE_AGENT); }
__device__ __forceinline__ unsigned xb_xcc_id() { return (unsigned)__builtin_amdgcn_s_getreg((3 << 11) | 20) & 0xFu; }
#define XB_SPIN(cond, bar) do { unsigned _sp = 0; while (cond) { __builtin_amdgcn_s_sleep(1); \
    if ((++_sp & 255u) == 0u) { if (xb_ld(&(bar)[XB_TMO])) break; if (_sp > XB_SPIN_CAP) { atomicAdd(&(bar)[XB_TMO], 1u); break; } } } } while (0)

struct XcdBarrier {
    unsigned* bar; unsigned x;
    volatile LAS unsigned* st;
};

__device__ __forceinline__ XcdBarrier xcd_barrier_post(unsigned* bar, volatile LAS unsigned* st) {
    XcdBarrier b; b.bar = bar; b.x = xb_xcc_id(); b.st = st;
    if (threadIdx.x == 0) (void)xb_add(&bar[XB_XCNT(b.x)], 1u);
    return b;
}
__device__ __forceinline__ void xcd_barrier_complete(unsigned* bar, unsigned x, unsigned& nloc, unsigned& nx) {
    const unsigned G = gridDim.x * gridDim.y * gridDim.z;
    unsigned sum, cnt, mine, sp = 0u;
    for (;;) {
        sum = 0u; cnt = 0u; mine = 0u;
#pragma unroll
        for (unsigned j = 0; j < 16; ++j) { const unsigned c = xb_ld(&bar[XB_XCNT(j)]); sum += c; cnt += (c > 0u) ? 1u : 0u; mine = (j == x) ? c : mine; }
        if (sum == G) break;
        __builtin_amdgcn_s_sleep(1);
        if ((++sp & 255u) == 0u) { if (xb_ld(&bar[XB_TMO])) break; if (sp > XB_SPIN_CAP) { atomicAdd(&bar[XB_TMO], 1u); break; } }
    }
    nloc = mine > 0u ? mine : 1u; nx = cnt > 0u ? cnt : 1u;
}

__device__ __forceinline__ void xcd_barrier(const XcdBarrier& b) {
    asm volatile("s_waitcnt vmcnt(0)" ::: "memory");
    __syncthreads();
    if (threadIdx.x == 0) {
        unsigned* bar = b.bar;
        __builtin_amdgcn_s_waitcnt(0);
        unsigned nloc = b.st[0], nx = b.st[1];
        if (nloc == 0u) { xcd_barrier_complete(bar, b.x, nloc, nx); b.st[0] = nloc; b.st[1] = nx; }
        const unsigned old = xb_add(&bar[XB_XSUB(b.x)], 1u);
        const unsigned gen = old / nloc;
        if (old + 1u == (gen + 1u) * nloc) {
            __builtin_amdgcn_fence(__ATOMIC_RELEASE, "agent");
            asm volatile("s_waitcnt vmcnt(0)" ::: "memory");
            const unsigned og = xb_add(&bar[XB_TOP], 1u);
            const unsigned tg = og / nx;
            if (og + 1u == (tg + 1u) * nx) xb_add(&bar[XB_TOPGEN], 1u);
            else XB_SPIN(xb_ld(&bar[XB_TOPGEN]) == tg, bar);
            __builtin_amdgcn_fence(__ATOMIC_ACQUIRE, "agent");
            xb_add(&bar[XB_XGEN(b.x)], 1u);
            asm volatile("s_waitcnt vmcnt(0)" ::: "memory");
        } else {
            XB_SPIN(xb_ld(&bar[XB_XGEN(b.x)]) == gen, bar);
            __builtin_amdgcn_fence(__ATOMIC_ACQUIRE, "agent");
            asm volatile("s_waitcnt vmcnt(0)" ::: "memory");
        }
    }
    __syncthreads();
}

template <int MASK> __global__ void __launch_bounds__(NTHR, 2) mk_fwd(Args args) {
    extern __shared__ __attribute__((aligned(16))) unsigned char lds[];
    const int G = gridDim.x, NGW = G * NWAVES;
    cg::grid_group grid = cg::this_grid();
    const int ph_lo = args.ph_lo, ph_hi = args.ph_hi;
    volatile LAS unsigned* bst = (volatile LAS unsigned*)((LAS unsigned char*)lds + 131072);
    if (threadIdx.x == 0) { bst[0] = 0u; bst[1] = 0u; }
    __syncthreads();
    XcdBarrier bar; bar.bar = nullptr; bar.x = 0; bar.st = bst;
    for (int ph = ph_lo; ph < ph_hi; ++ph) {
        if (ph > ph_lo) {
            if (ph == ph_lo + 1) {
                grid.sync();
                bar = xcd_barrier_post((unsigned*)(args.ws + WS_CTL + 65536), bst);
            } else { xcd_barrier(bar);
#ifdef DBG_DUP_BAR
                xcd_barrier(bar);
#endif
            }
        }
        int tid_v = threadIdx.x; asm volatile("" : "+v"(tid_v));
        const int tid = tid_v, lane = tid & 63, wave = __builtin_amdgcn_readfirstlane(tid >> 6), gw = blockIdx.x * NWAVES + wave;
        kptr_t kp = (kptr_t)__builtin_amdgcn_kernarg_segment_ptr();
        asm volatile("" : "+s"(kp));
        Ctx a; a.kp = kp; a.out = *(float* const __attribute__((address_space(4)))*)(kp + 144); a.ws = *(unsigned char* const __attribute__((address_space(4)))*)(kp + 152);
        unsigned char* ws = a.ws;
        float* stats = (float*)(ws + WS_STATS); bf16* xb = (bf16*)(ws + WS_XB); bf16* hid = (bf16*)(ws + WS_R + R_HID);
        if (ph == 0) {
if constexpr (MASK & 1) { phase_p0(a, lds, gw, NGW, wave, lane);
#ifdef DBG_DUP_P0
 __syncthreads(); phase_p0(a, lds, gw, NGW, wave, lane);
#endif
 }
 __syncthreads(); continue; }
        const int L = (ph - 1) / 9, sub = (ph - 1) % 9;
        unsigned char* wb = ws + WS_W + (size_t)(L & 1) * WSZ;
        if (sub == 0 || sub == 7) {
            pg8::Gemm g{xb, (const bf16*)(wb + (sub == 0 ? W_GU1 : W_GU2)), M, 2 * FF, D}; pg8::StaticOrder S; S.init(M, 2 * FF, G, (int)blockIdx.x);
            pg8::EpiSwiGLU E{hid, stats, FF};
            if constexpr (MASK & 2) pg8::gemm_phase<pg8::EpiSwiGLU, pg8::StaticOrder, PG8_ALIGN, PG8_SP2>((PG8_LAS unsigned char*)lds, g, S, E);
#if defined(DBG_DUP_G) && DBG_DUP_G == 1
            __syncthreads(); if constexpr (MASK & 2) pg8::gemm_phase<pg8::EpiSwiGLU, pg8::StaticOrder, PG8_ALIGN, PG8_SP2>((PG8_LAS unsigned char*)lds, g, S, E);
#endif
        } else if (sub == 1 || sub == 6 || sub == 8) {
            const bf16* A = sub == 6 ? (const bf16*)(ws + WS_R + R_Y) : hid; const int K = sub == 6 ? D : FF;
            const bf16* Bt = (const bf16*)(wb + (sub == 1 ? W_D1 : (sub == 6 ? W_OUT : W_D2)));
            pg8::Gemm g{A, Bt, M, D, K}; pg8::StaticOrder S; S.init(M, D, G, (int)blockIdx.x);
            pg8::EpiResid E{a.out, xb, stats, sub == 6 ? 1.0f : 0.5f};
            if constexpr (MASK & 4) pg8::gemm_phase<pg8::EpiResid, pg8::StaticOrder, PG8_ALIGN, PG8_SP2>((PG8_LAS unsigned char*)lds, g, S, E);
#if defined(DBG_DUP_G) && DBG_DUP_G == 2
            __syncthreads(); { pg8::EpiResid E0{a.out, xb, stats, 0.0f}; if constexpr (MASK & 4) pg8::gemm_phase<pg8::EpiResid, pg8::StaticOrder, PG8_ALIGN, PG8_SP2>((PG8_LAS unsigned char*)lds, g, S, E0); }
#endif
        } else if (sub == 2) {
            pg8::Gemm g{xb, (const bf16*)(wb + W_IN), M, INW, D}; pg8::StaticOrder S; S.init(M, INW, G, (int)blockIdx.x);
            pg8::EpiProj E{(bf16*)(ws + WS_R + R_Q), (bf16*)(ws + WS_R + R_K), (bf16*)(ws + WS_R + R_V), (bf16*)(ws + WS_R + R_U5), (float*)(ws + WS_KMP), stats,
                           (const float*)(ws + WS_ROPEC), (const float*)(ws + WS_ROPES), a.in(I_QN) + L * 64, a.in(I_KN) + L * 64};
            if constexpr (MASK & 8) pg8::gemm_phase<pg8::EpiProj, pg8::StaticOrder, PG8_ALIGN, PG8_SP2>((PG8_LAS unsigned char*)lds, g, S, E);
#if defined(DBG_DUP_G) && DBG_DUP_G == 3
            __syncthreads(); if constexpr (MASK & 8) pg8::gemm_phase<pg8::EpiProj, pg8::StaticOrder, PG8_ALIGN, PG8_SP2>((PG8_LAS unsigned char*)lds, g, S, E);
#endif
        } else if (sub == 3) {
if constexpr (MASK & 16) { phase_t(a, L, lds, gw, NGW, wave, lane);
#if defined(DBG_DUP_SUB) && DBG_DUP_SUB == 3
 __syncthreads(); phase_t(a, L, lds, gw, NGW, wave, lane);
#endif
 }
 __syncthreads(); }
        else if (sub == 4) {
if constexpr (MASK & 32) { phase_a(a, L, lds, gw, NGW, tid, wave, lane);
#if defined(DBG_DUP_SUB) && DBG_DUP_SUB == 4
 __syncthreads(); phase_a(a, L, lds, gw, NGW, tid, wave, lane);
#endif
 }
 __syncthreads(); }
        else {
if constexpr (MASK & 64) { phase_c(a, L, gw, NGW, lane);
#if defined(DBG_DUP_SUB) && DBG_DUP_SUB == 5
 __syncthreads(); phase_c(a, L, gw, NGW, lane);
#endif
 }
 __syncthreads(); }
    }
}

#ifndef MK_MULTI
#define MK_MULTI 0
#endif
#ifndef DBG_NPH
#define DBG_NPH (1 + 9 * DEPTH)
#endif
constexpr int N_PHASES = DBG_NPH;
static int phase_mask(int ph) { if (ph == 0) return 1; const int sub = (ph - 1) % 9; const int m[9] = {2, 4, 8, 16, 32, 64, 4, 2, 4}; return m[sub]; }
template <int MASK> static bool setup_one(int& per_cu) {
    if (hipFuncSetAttribute((const void*)mk_fwd<MASK>, hipFuncAttributeMaxDynamicSharedMemorySize, LDS_BYTES) != hipSuccess) return false;
    if (hipOccupancyMaxActiveBlocksPerMultiprocessor(&per_cu, (const void*)mk_fwd<MASK>, NTHR, LDS_BYTES) != hipSuccess) per_cu = 1;
    (void)hipGetLastError(); return true;
}
template <int MASK> static void launch_one(const Args& a, int grid, hipStream_t stream) { hipLaunchKernelGGL(mk_fwd<MASK>, dim3(grid), dim3(NTHR), LDS_BYTES, stream, a); }
extern "C" void kernel_launch(void* const* d_in, const int* in_sizes, int n_in, void* d_out, int out_size, void* d_ws, size_t ws_size, hipStream_t stream) {
    static int grid = 0;
    if (grid == 0) {
        if (n_in != 18 || in_sizes[0] != M * D || out_size != M * D || ws_size < WS_END) { fprintf(stderr, "kernel_launch: unexpected shapes / workspace (n_in %d, ws %zu < %zu)\n", n_in, ws_size, (size_t)WS_END); grid = -1; return; }
        int dev = 0, cus = 0, per_cu = 0; bool ok = true;
        (void)hipGetDevice(&dev); (void)hipDeviceGetAttribute(&cus, hipDeviceAttributeMultiprocessorCount, dev);
#if MK_MULTI
        ok = setup_one<1>(per_cu) && setup_one<2>(per_cu) && setup_one<4>(per_cu) && setup_one<8>(per_cu) && setup_one<16>(per_cu) && setup_one<32>(per_cu) && setup_one<64>(per_cu);
#else
        ok = setup_one<127>(per_cu);
#endif
        if (!ok) { fprintf(stderr, "kernel_launch: hipFuncSetAttribute failed\n"); grid = -1; return; }
        grid = cus;
    }
    if (grid < 0) return;
    Args a{};
    for (int i = 0; i < 18; ++i) a.in[i] = (const float*)d_in[i];
    a.out = (float*)d_out; a.ws = (unsigned char*)d_ws;
#if MK_MULTI
    for (int ph = 0; ph < N_PHASES; ++ph) { a.ph_lo = ph; a.ph_hi = ph + 1;
        switch (phase_mask(ph)) { case 1: launch_one<1>(a, grid, stream); break; case 2: launch_one<2>(a, grid, stream); break; case 4: launch_one<4>(a, grid, stream); break; case 8: launch_one<8>(a, grid, stream); break;
                                  case 16: launch_one<16>(a, grid, stream); break; case 32: launch_one<32>(a, grid, stream); break; default: launch_one<64>(a, grid, stream); break; } }
#else
    a.ph_lo = 0; a.ph_hi = N_PHASES;
    void* args[] = {&a};
    hipError_t e = hipLaunchCooperativeKernel((const void*)mk_fwd<127>, dim3(grid), dim3(NTHR), args, LDS_BYTES, stream);
    if (e != hipSuccess) fprintf(stderr, "cooperative launch failed: %s (grid %d)\n", hipGetErrorString(e), grid);
#endif
}
```

```cpp
#include <hip/hip_runtime.h>
#include <hip/hip_cooperative_groups.h>
#include <cstdio>
#include <cstdint>
namespace cg = cooperative_groups;
#define MK_MULTI 0
namespace pg8 {
#define PG8_LAS __attribute__((address_space(3)))
typedef unsigned short bf16_t;
typedef short bf16x8 __attribute__((ext_vector_type(8)));
typedef float f32x4 __attribute__((ext_vector_type(4)));
typedef unsigned u32x4 __attribute__((ext_vector_type(4)));
constexpr int BM = 256, BK = 64, HALF = 128, HTB = HALF * BK * 2  , STAGE_BYTES = 8 * HTB, NXCD = 8, WGM = 8;

__host__ __device__ __forceinline__ int lds_byte(int r, int c) { const int st = (r >> 4) * 2 + (c >> 5), rr = r & 15, cc = c & 31, ob = rr * 64 + cc * 2; return st * 1024 + (ob ^ (((ob >> 9) & 1) << 5)); }
__host__ __device__ __forceinline__ void stage_rc(int b, int& R, int& C) { const int st = b / 1024, sb = b % 1024, swz = sb ^ (((sb >> 9) & 1) << 5); R = (st >> 1) * 16 + swz / 64; C = (st & 1) * 32 + (swz % 64) / 2; }
__host__ __device__ __forceinline__ int perm32(int rho) { const int n = rho >> 4, i = rho & 15; return 8 * (i >> 2) + 4 * n + (i & 3); }

struct Unit { int pm, pn; };
struct Gemm { const bf16_t* A; const bf16_t* Bt; int M, N, K; };

struct StaticOrder {
    int nM, nN, nwg, G, c;
    __host__ __device__ void init(int M, int N, int G_, int c_) { nM = M / BM; nN = N / BM; nwg = nM * nN; G = G_; c = c_; }
    __host__ __device__ bool next(int i, Unit& u) const {
        const long L = (long)i * G + c; if (L >= nwg) return false;
        int wgid = (int)L; { const int q = nwg / NXCD, r = nwg % NXCD, xcd = wgid % NXCD, off = wgid / NXCD; wgid = (xcd < r ? xcd * (q + 1) : r * (q + 1) + (xcd - r) * q) + off; }
        const int nig = WGM * nN, gid = wgid / nig, fm = gid * WGM, gsz = (nM - fm) < WGM ? (nM - fm) : WGM;
        u.pm = fm + ((wgid % nig) % gsz); u.pn = (wgid % nig) / gsz; return true;
    }
    __device__ __forceinline__ void a_ready(const Unit&) const {}
    __device__ __forceinline__ void done(const Unit&) const {}
};

__device__ __forceinline__ unsigned cvt_pk_bf16(float lo, float hi) { unsigned r; asm volatile("v_cvt_pk_bf16_f32 %0, %1, %2" : "=v"(r) : "v"(lo), "v"(hi)); return r; }
typedef float f32x2 __attribute__((ext_vector_type(2)));
typedef unsigned u32x2 __attribute__((ext_vector_type(2)));
typedef __bf16 bf16x2_t __attribute__((ext_vector_type(2)));
__device__ __forceinline__ unsigned cvtpk(float lo, float hi) { f32x2 v = {lo, hi}; bf16x2_t b = __builtin_convertvector(v, bf16x2_t); return __builtin_bit_cast(unsigned, b); }
__device__ __forceinline__ float row_rstd(const float* stats, int row) {
    const f32x4* p = (const f32x4*)(stats + (size_t)row * 16);
    const f32x4 a = p[0], b = p[1], c = p[2], d = p[3];
    const float s = ((a[0] + a[1]) + (a[2] + a[3])) + ((b[0] + b[1]) + (b[2] + b[3])) + ((c[0] + c[1]) + (c[2] + c[3])) + ((d[0] + d[1]) + (d[2] + d[3]));
    return rsqrtf(s * (1.0f / 1024.0f) + 1e-6f);
}
__device__ __forceinline__ float silu_f(float g) { return g * __builtin_amdgcn_rcpf(1.0f + __expf(-g)); }

struct EpiSwiGLU {
    static constexpr bool PERM = true, AFTER_DRAIN = false;
    bf16_t* H; const float* stats; int ldh;
    __device__ __forceinline__ void operator()(const f32x4 (&acc)[2][2][4][2], const Unit& u, int wr, int wc, int fr, int fq) const {
        asm volatile("" : "+v"(fr), "+v"(fq));
        const int row0 = u.pm * BM + wr * 64 + fr, col0 = u.pn * HALF + wc * 32 + 8 * fq;
#pragma unroll
        for (int ai = 0; ai < 2; ++ai)
#pragma unroll
            for (int m = 0; m < 4; ++m) {
                const int row = row0 + ai * HALF + m * 16;
                const float rs = row_rstd(stats, row);
                float h[8];
#pragma unroll
                for (int n = 0; n < 2; ++n)
#pragma unroll
                    for (int i = 0; i < 4; ++i) { const float g = acc[ai][0][m][n][i] * rs, up = acc[ai][1][m][n][i] * rs; h[4 * n + i] = silu_f(g) * up; }
                u32x4 w; w.x = cvtpk(h[0], h[1]); w.y = cvtpk(h[2], h[3]); w.z = cvtpk(h[4], h[5]); w.w = cvtpk(h[6], h[7]);
                *(u32x4*)(H + (size_t)row * ldh + col0) = w;
            }
    }
};

struct EpiResid {
    static constexpr bool PERM = true, AFTER_DRAIN = false;
    float* X; bf16_t* XB; float* stats; float scale;
    __device__ __forceinline__ void operator()(const f32x4 (&acc)[2][2][4][2], const Unit& u, int wr, int wc, int fr, int fq) const {
        asm volatile("" : "+v"(fr), "+v"(fq));
        const int row0 = u.pm * BM + wr * 64 + fr, col0 = u.pn * BM + wc * 32 + 8 * fq;
#pragma unroll
        for (int ai = 0; ai < 2; ++ai)
#pragma unroll
            for (int m = 0; m < 4; ++m) {
                const int row = row0 + ai * HALF + m * 16; float ss = 0.f;
#pragma unroll
                for (int bj = 0; bj < 2; ++bj) {
                    float* xp = X + (size_t)row * 1024 + col0 + bj * HALF;
                    f32x4 x0 = *(const f32x4*)xp, x1 = *(const f32x4*)(xp + 4);
                    x0 = x0 + acc[ai][bj][m][0] * scale; x1 = x1 + acc[ai][bj][m][1] * scale;
                    *(f32x4*)xp = x0; *(f32x4*)(xp + 4) = x1;
                    ss += (x0[0] * x0[0] + x0[1] * x0[1]) + (x0[2] * x0[2] + x0[3] * x0[3]) + (x1[0] * x1[0] + x1[1] * x1[1]) + (x1[2] * x1[2] + x1[3] * x1[3]);
                    u32x4 w; w.x = cvtpk(x0[0], x0[1]); w.y = cvtpk(x0[2], x0[3]); w.z = cvtpk(x1[0], x1[1]); w.w = cvtpk(x1[2], x1[3]);
                    *(u32x4*)(XB + (size_t)row * 1024 + col0 + bj * HALF) = w;
                }
                ss += __shfl_xor(ss, 16); ss += __shfl_xor(ss, 32);
                if (fq == 0) stats[(size_t)row * 16 + u.pn * 4 + wc] = ss;
            }
    }
};

struct EpiProj {
    static constexpr bool PERM = true, AFTER_DRAIN = false;
    bf16_t* Q; bf16_t* Kb; bf16_t* Vb; bf16_t* U5; float* kmp; const float* stats; const float* ropeC; const float* ropeS; const float* qn; const float* kn;
    __device__ __forceinline__ void operator()(const f32x4 (&acc)[2][2][4][2], const Unit& u, int wr, int wc, int fr, int fq) const {
        asm volatile("" : "+v"(fr), "+v"(fq));
        const int row0 = u.pm * BM + wr * 64 + fr;
        const int pn = u.pn;
        if (pn >= 6) {
            bf16_t* O = U5 + (size_t)(pn - 6) * (16384 * 256);
            const int col0 = wc * 32 + 8 * fq;
#pragma unroll
            for (int ai = 0; ai < 2; ++ai)
#pragma unroll
                for (int m = 0; m < 4; ++m) {
                    const int row = row0 + ai * HALF + m * 16; const float rs = row_rstd(stats, row);
#pragma unroll
                    for (int bj = 0; bj < 2; ++bj) {
                        const f32x4 v0 = acc[ai][bj][m][0] * rs, v1 = acc[ai][bj][m][1] * rs;
                        u32x4 w; w.x = cvtpk(v0[0], v0[1]); w.y = cvtpk(v0[2], v0[3]); w.z = cvtpk(v1[0], v1[1]); w.w = cvtpk(v1[2], v1[3]);
                        *(u32x4*)(O + (size_t)row * 256 + col0 + bj * HALF) = w;
                    }
                }
            return;
        }
        const int head = (pn & 1) * 4 + wc, b = u.pm >> 5, j = u.pm & 31;
        const size_t bh = (size_t)(b * 8 + head);
        if (pn >= 4) {
            bf16_t* vb = Vb + (bh * 32 + j) * 16384;
#pragma unroll
            for (int ai = 0; ai < 2; ++ai)
#pragma unroll
                for (int m = 0; m < 4; ++m) {
                    const int row = row0 + ai * HALF + m * 16; const float rs = row_rstd(stats, row);
                    const int kk = ai * HALF + wr * 64 + m * 16 + fr;
                    const int kg = kk >> 5, w = kk & 31, st = w >> 4, w16 = w & 15, hh = (w16 >> 2) & 1, jj = 4 * (w16 >> 3) + (w16 & 3);
#pragma unroll
                    for (int bj = 0; bj < 2; ++bj)
#pragma unroll
                        for (int n = 0; n < 2; ++n) {
                            const unsigned p0 = cvtpk(acc[ai][bj][m][n][0] * rs, acc[ai][bj][m][n][1] * rs), p1 = cvtpk(acc[ai][bj][m][n][2] * rs, acc[ai][bj][m][n][3] * rs);
#pragma unroll
                            for (int i = 0; i < 4; ++i) {
                                const int r = 8 * fq + 4 * n + i;
                                const unsigned pv = (i < 2) ? p0 : p1;
                                vb[((((kg * 2 + st) * 2 + bj) * 32 + r) * 2 + hh) * 8 + jj] = (bf16_t)((i & 1) ? (pv >> 16) : (pv & 0xffffu));
                            }
                        }
                }
            return;
        }
        const bool isk = pn >= 2;
        const float* gn = isk ? kn : qn;
        float ksum[16];
#pragma unroll
        for (int e = 0; e < 16; ++e) ksum[e] = 0.f;
#pragma unroll
        for (int ai = 0; ai < 2; ++ai)
#pragma unroll
            for (int m = 0; m < 4; ++m) {
                const int row = row0 + ai * HALF + m * 16; const float rs = row_rstd(stats, row);
                const int t = row & 8191, kk = t & 255;
                float v0[8], v1[8]; float ss = 0.f;
#pragma unroll
                for (int n = 0; n < 2; ++n)
#pragma unroll
                    for (int i = 0; i < 4; ++i) { v0[4 * n + i] = acc[ai][0][m][n][i] * rs; v1[4 * n + i] = acc[ai][1][m][n][i] * rs; ss += v0[4 * n + i] * v0[4 * n + i] + v1[4 * n + i] * v1[4 * n + i]; }
                ss += __shfl_xor(ss, 16); ss += __shfl_xor(ss, 32);
                const float rn = rsqrtf(ss * (1.0f / 64.0f) + 1e-6f);
                const f32x4 c0 = *(const f32x4*)(ropeC + t * 32 + 8 * fq), c1 = *(const f32x4*)(ropeC + t * 32 + 8 * fq + 4);
                const f32x4 s0 = *(const f32x4*)(ropeS + t * 32 + 8 * fq), s1 = *(const f32x4*)(ropeS + t * 32 + 8 * fq + 4);
                const f32x4 ga0 = *(const f32x4*)(gn + 8 * fq), ga1 = *(const f32x4*)(gn + 8 * fq + 4), gb0 = *(const f32x4*)(gn + 32 + 8 * fq), gb1 = *(const f32x4*)(gn + 36 + 8 * fq);
                float o0[8], o1[8];
#pragma unroll
                for (int e = 0; e < 8; ++e) {
                    const float x1 = v0[e] * rn * (e < 4 ? ga0[e & 3] : ga1[e & 3]), x2 = v1[e] * rn * (e < 4 ? gb0[e & 3] : gb1[e & 3]);
                    const float cs = e < 4 ? c0[e & 3] : c1[e & 3], sn = e < 4 ? s0[e & 3] : s1[e & 3];
                    o0[e] = x1 * cs - x2 * sn; o1[e] = x2 * cs + x1 * sn;
                }
                u32x4 w0, w1;
                w0.x = cvtpk(o0[0], o0[1]); w0.y = cvtpk(o0[2], o0[3]); w0.z = cvtpk(o0[4], o0[5]); w0.w = cvtpk(o0[6], o0[7]);
                w1.x = cvtpk(o1[0], o1[1]); w1.y = cvtpk(o1[2], o1[3]); w1.z = cvtpk(o1[4], o1[5]); w1.w = cvtpk(o1[6], o1[7]);
                if (!isk) {
                    bf16_t* qp = Q + (bh * 8192 + t) * 64 + 8 * fq;
                    *(u32x4*)qp = w0; *(u32x4*)(qp + 32) = w1;
                } else {
                    bf16_t* kb = Kb + (bh * 32 + j) * 16384;
                    const int kg = kk >> 5, r = kk & 31, hq = fq & 1, ksl = fq >> 1;
                    *(u32x4*)(kb + (((kg * 4 + ksl) * 32 + r) * 2 + hq) * 8) = w0;
                    *(u32x4*)(kb + (((kg * 4 + 2 + ksl) * 32 + r) * 2 + hq) * 8) = w1;
#pragma unroll
                    for (int e = 0; e < 8; ++e) { ksum[e] += o0[e]; ksum[8 + e] += o1[e]; }
                }
                asm volatile("" ::: "memory");
            }
        if (isk) {
#pragma unroll
            for (int e = 0; e < 16; ++e) { float s = ksum[e]; s += __shfl_xor(s, 1); s += __shfl_xor(s, 2); s += __shfl_xor(s, 4); s += __shfl_xor(s, 8); ksum[e] = s; }
            if (fr == 0) {
                float* kp = kmp + ((size_t)(u.pm * 2 + wr) * 512) + head * 64 + 8 * fq;
                *(f32x4*)kp = (f32x4){ksum[0], ksum[1], ksum[2], ksum[3]}; *(f32x4*)(kp + 4) = (f32x4){ksum[4], ksum[5], ksum[6], ksum[7]};
                *(f32x4*)(kp + 32) = (f32x4){ksum[8], ksum[9], ksum[10], ksum[11]}; *(f32x4*)(kp + 36) = (f32x4){ksum[12], ksum[13], ksum[14], ksum[15]};
            }
        }
    }
};

template <class Epi, class Sched, bool ALIGN_EPI = false, bool SP2 = false>
__device__ __forceinline__ void gemm_phase(PG8_LAS unsigned char* lds, const Gemm g, const Sched& S, const Epi& E) {
    int tid_v = threadIdx.x; asm volatile("" : "+v"(tid_v));
    const int tid = tid_v, wid = __builtin_amdgcn_readfirstlane(tid >> 6), lane = tid & 63, wr = wid >> 2, wc = wid & 3, fr = lane & 15, fq = lane >> 4;
    const int K = g.K, nt = K / BK;
    unsigned voffA[2], voffB[2];
#pragma unroll
    for (int i = 0; i < 2; ++i) { int R, C; stage_rc(tid * 16 + i * 8192, R, C); const int Rb = Epi::PERM ? ((R & ~31) + perm32(R & 31)) : R;
        voffA[i] = (unsigned)(R * K + C) * 2u; voffB[i] = (unsigned)(Rb * K + C) * 2u; }
    const size_t kstep = (size_t)(BK * 2);
    const size_t hstep = (size_t)HALF * K * 2;
    const size_t tstep = 2 * hstep;
    const unsigned ldsw = (unsigned)wid * 1024u;
    const int aoff = lds_byte(wr * 64 + fr, fq * 8), boff = lds_byte(wc * 32 + fr, fq * 8);
#define PG8_SA(b, h) (((b) * 2 + (h)) * HTB)
#define PG8_SB(b, h) ((4 + (b) * 2 + (h)) * HTB)
#define PG8_STAGE(bufoff, gbase, voff) do { _Pragma("unroll") for (int _i = 0; _i < 2; ++_i) \
        __builtin_amdgcn_global_load_lds((const unsigned*)((const char*)(gbase) + (voff)[_i]), (PG8_LAS unsigned*)(lds + (bufoff) + ldsw + _i * 8192), 16, 0, 0); } while (0)
#define PG8_LDA(dst, b, h) do { _Pragma("unroll") for (int m = 0; m < 4; ++m) _Pragma("unroll") for (int k = 0; k < 2; ++k) dst[m][k] = *(const PG8_LAS bf16x8*)(lds + PG8_SA(b, h) + aoff + m * 2048 + k * 1024); } while (0)
#define PG8_LDB(dst, b, h) do { _Pragma("unroll") for (int n = 0; n < 2; ++n) _Pragma("unroll") for (int k = 0; k < 2; ++k) dst[n][k] = *(const PG8_LAS bf16x8*)(lds + PG8_SB(b, h) + boff + n * 2048 + k * 1024); } while (0)
#define PG8_MMA(ai, bj, At, Bt) do { __builtin_amdgcn_s_setprio(1); _Pragma("unroll") for (int m = 0; m < 4; ++m) _Pragma("unroll") for (int n = 0; n < 2; ++n) _Pragma("unroll") for (int k = 0; k < 2; ++k) \
        acc[ai][bj][m][n] = __builtin_amdgcn_mfma_f32_16x16x32_bf16(Bt[n][k], At[m][k], acc[ai][bj][m][n], 0, 0, 0); __builtin_amdgcn_s_setprio(0); } while (0)
#define PG8_WAIT_V(n) asm volatile("s_waitcnt vmcnt(" #n ")" ::: "memory")
#define PG8_WAIT_L(n) asm volatile("s_waitcnt lgkmcnt(" #n ")" ::: "memory")
#define PG8_BAR __builtin_amdgcn_s_barrier()
#define PG8_SCHED __builtin_amdgcn_sched_barrier(0)
    Unit cur, nxt; int ui = 0;
    if (!S.next(0, cur)) return;
    f32x4 acc[2][2][4][2];
#pragma unroll
    for (int a = 0; a < 2; ++a)
#pragma unroll
        for (int b = 0; b < 2; ++b)
#pragma unroll
            for (int m = 0; m < 4; ++m)
#pragma unroll
                for (int n = 0; n < 2; ++n) acc[a][b][m][n] = (f32x4){0.f, 0.f, 0.f, 0.f};
    bf16x8 At[4][2], B0[2][2], B1[2][2];
    const char* cA = (const char*)g.A + (size_t)cur.pm * tstep; const char* cB = (const char*)g.Bt + (size_t)cur.pn * tstep;
    S.a_ready(cur);
    if constexpr (SP2) {
        PG8_STAGE(PG8_SB(0, 0), cB, voffB); PG8_STAGE(PG8_SB(0, 1), cB + hstep, voffB); PG8_STAGE(PG8_SA(0, 0), cA, voffA); PG8_STAGE(PG8_SA(0, 1), cA + hstep, voffA);
        if (wr == 1) PG8_BAR;
        PG8_WAIT_V(2); PG8_BAR;
        PG8_STAGE(PG8_SB(1, 0), cB + kstep, voffB); PG8_STAGE(PG8_SA(1, 0), cA + kstep, voffA); PG8_STAGE(PG8_SB(1, 1), cB + hstep + kstep, voffB);
        PG8_WAIT_V(6); PG8_BAR;
    } else {
        PG8_STAGE(PG8_SB(0, 0), cB, voffB); PG8_STAGE(PG8_SA(0, 0), cA, voffA); PG8_STAGE(PG8_SB(0, 1), cB + hstep, voffB); PG8_STAGE(PG8_SA(0, 1), cA + hstep, voffA);
        if (wr == 1) PG8_BAR;
        PG8_WAIT_V(4); PG8_BAR;
        PG8_STAGE(PG8_SB(1, 0), cB + kstep, voffB); PG8_STAGE(PG8_SA(1, 0), cA + kstep, voffA); PG8_STAGE(PG8_SB(1, 1), cB + hstep + kstep, voffB);
        PG8_WAIT_V(6); PG8_BAR;
    }
    for (;;) {
        const bool has_next = S.next(ui + 1, nxt);
        const char* nA = has_next ? (const char*)g.A + (size_t)nxt.pm * tstep : cA; const char* nB = has_next ? (const char*)g.Bt + (size_t)nxt.pn * tstep : cB;
        for (int t = 0; t < nt; t += 2) {
            const bool last = (t == nt - 2);
            const char* a1 = cA + (size_t)(t + 1) * kstep;
            const char* a2 = last ? nA : cA + (size_t)(t + 2) * kstep; const char* b2 = last ? nB : cB + (size_t)(t + 2) * kstep;
            const char* a3 = a2 + kstep; const char* b3 = b2 + kstep;
            if (last && has_next) S.a_ready(nxt);
            if constexpr (SP2) {
            PG8_LDB(B0, 0, 0); PG8_LDB(B1, 0, 1); PG8_SCHED; PG8_LDA(At, 0, 0); PG8_STAGE(PG8_SA(1, 1), a1 + hstep, voffA);
            PG8_WAIT_V(8); PG8_WAIT_L(0); PG8_BAR; PG8_MMA(0, 0, At, B0); PG8_MMA(0, 1, At, B1); PG8_BAR; PG8_SCHED;
            PG8_LDA(At, 0, 1); PG8_STAGE(PG8_SB(0, 0), b2, voffB); PG8_STAGE(PG8_SB(0, 1), b2 + hstep, voffB); PG8_STAGE(PG8_SA(0, 0), a2, voffA);
            PG8_WAIT_V(8); PG8_WAIT_L(0); PG8_BAR; PG8_MMA(1, 0, At, B0); PG8_MMA(1, 1, At, B1); PG8_BAR; PG8_SCHED;
            PG8_LDB(B0, 1, 0); PG8_LDB(B1, 1, 1); PG8_SCHED; PG8_LDA(At, 1, 0); PG8_STAGE(PG8_SA(0, 1), a2 + hstep, voffA);
            PG8_WAIT_V(8); PG8_WAIT_L(0); PG8_BAR; PG8_MMA(0, 0, At, B0); PG8_MMA(0, 1, At, B1); PG8_BAR; PG8_SCHED;
            PG8_LDA(At, 1, 1); PG8_STAGE(PG8_SB(1, 0), b3, voffB); PG8_STAGE(PG8_SB(1, 1), b3 + hstep, voffB); PG8_STAGE(PG8_SA(1, 0), a3, voffA);
            PG8_WAIT_V(8); PG8_WAIT_L(0); PG8_BAR; PG8_MMA(1, 0, At, B0); PG8_MMA(1, 1, At, B1); PG8_BAR; PG8_SCHED;
            } else {
            PG8_LDB(B0, 0, 0); PG8_SCHED; PG8_LDA(At, 0, 0); PG8_STAGE(PG8_SA(1, 1), a1 + hstep, voffA);
            PG8_WAIT_L(8); PG8_BAR; PG8_WAIT_L(0); PG8_MMA(0, 0, At, B0); PG8_BAR; PG8_SCHED;
            PG8_LDB(B1, 0, 1); PG8_STAGE(PG8_SB(0, 0), b2, voffB);
            PG8_BAR; PG8_WAIT_L(0); PG8_MMA(0, 1, At, B1); PG8_BAR;
            PG8_LDA(At, 0, 1); PG8_STAGE(PG8_SA(0, 0), a2, voffA);
            PG8_BAR; PG8_WAIT_L(0); PG8_MMA(1, 0, At, B0); PG8_BAR; PG8_SCHED;
            PG8_STAGE(PG8_SB(0, 1), b2 + hstep, voffB);
            PG8_WAIT_V(6); PG8_BAR; PG8_MMA(1, 1, At, B1); PG8_BAR;
            PG8_LDB(B0, 1, 0); PG8_SCHED; PG8_LDA(At, 1, 0); PG8_STAGE(PG8_SA(0, 1), a2 + hstep, voffA);
            PG8_WAIT_L(8); PG8_BAR; PG8_WAIT_L(0); PG8_MMA(0, 0, At, B0); PG8_BAR; PG8_SCHED;
            PG8_LDB(B1, 1, 1); PG8_STAGE(PG8_SB(1, 0), b3, voffB);
            PG8_BAR; PG8_WAIT_L(0); PG8_MMA(0, 1, At, B1); PG8_BAR;
            PG8_LDA(At, 1, 1); PG8_STAGE(PG8_SA(1, 0), a3, voffA);
            PG8_BAR; PG8_WAIT_L(0); PG8_MMA(1, 0, At, B0); PG8_BAR; PG8_SCHED;
            PG8_STAGE(PG8_SB(1, 1), b3 + hstep, voffB);
            PG8_WAIT_V(6); PG8_BAR; PG8_MMA(1, 1, At, B1); PG8_BAR;
            }
        }
        if constexpr (ALIGN_EPI) { if (wr == 0) PG8_BAR; }
        if constexpr (!Epi::AFTER_DRAIN) { E(acc, cur, wr, wc, fr, fq); S.done(cur); }
        if (!has_next) break;
#pragma unroll
        for (int a = 0; a < 2; ++a)
#pragma unroll
            for (int b = 0; b < 2; ++b)
#pragma unroll
                for (int m = 0; m < 4; ++m)
#pragma unroll
                    for (int n = 0; n < 2; ++n) acc[a][b][m][n] = (f32x4){0.f, 0.f, 0.f, 0.f};
        cur = nxt; cA = nA; cB = nB; ++ui;
        if constexpr (ALIGN_EPI) { if (wr == 1) PG8_BAR; }
    }
    PG8_WAIT_V(0);
    if constexpr (!ALIGN_EPI) { if (wr == 0) PG8_BAR; }
    PG8_BAR;
    if constexpr (Epi::AFTER_DRAIN) { E.fused(acc, cur, wr, wc, fr, fq, lds, wid, lane); S.done(cur); }
#undef PG8_SA
#undef PG8_SB
#undef PG8_STAGE
#undef PG8_LDA
#undef PG8_LDB
#undef PG8_MMA
#undef PG8_WAIT_V
#undef PG8_WAIT_L
#undef PG8_BAR
#undef PG8_SCHED
}
}

#ifndef PG8_SP2
#define PG8_SP2 true
#endif
#ifndef PG8_ALIGN
#define PG8_ALIGN true
#endif

#define DI __device__ __forceinline__
typedef unsigned short bf16;
typedef short bf16x8 __attribute__((ext_vector_type(8)));
typedef float f32x4 __attribute__((ext_vector_type(4)));
typedef float f32x16 __attribute__((ext_vector_type(16)));
typedef unsigned u32x4 __attribute__((ext_vector_type(4)));
typedef unsigned u32x2 __attribute__((ext_vector_type(2)));
#define MFMA32(a, b, c) __builtin_amdgcn_mfma_f32_32x32x16_bf16((a), (b), (c), 0, 0, 0)

constexpr int NWAVES = 8, NTHR = 512;
constexpr int M = 16384, D = 1024, FF = 2816, INW = 2816, SEQ = 8192, DEPTH = 4;
constexpr int LDS_BYTES = 147456;
constexpr size_t MiB = 1u << 20;
constexpr size_t WS_CTL = 0;
constexpr size_t WS_STATS = 1 * MiB;
constexpr size_t WS_KMP = 2 * MiB;
constexpr size_t WS_DEC = 2 * MiB + 512 * 1024;
constexpr size_t WS_ROPEC = 3 * MiB, WS_ROPES = 4 * MiB;
constexpr size_t WS_W = 5 * MiB, WSZ = 42467328;
constexpr size_t W_GU1 = 0, W_D1 = 11534336, W_IN = 17301504, W_OUT = 23068672, W_GU2 = 25165824, W_D2 = 36700160;
constexpr size_t WS_XB = 86 * MiB;
constexpr size_t WS_R = 118 * MiB;
constexpr size_t R_HID = 0;
constexpr size_t R_Q = 0, R_K = 16 * MiB, R_V = 32 * MiB, R_U5 = 48 * MiB  , R_Y = 88 * MiB, R_PO = 120 * MiB, R_PML = 168 * MiB,
                 R_LIST = 172 * MiB  , R_ALOC = 188 * MiB, R_OINTRA = 204 * MiB, R_QDEC = 220 * MiB, R_SP = 228 * MiB, R_END = 236 * MiB;
constexpr size_t WS_END = WS_R + R_END;

DI float bf2f(unsigned short b) { return __uint_as_float((unsigned)b << 16); }
DI unsigned cvtpk(float lo, float hi) { return pg8::cvtpk(lo, hi); }
DI float wave_sum(float v) {
#pragma unroll
    for (int o = 1; o < 64; o <<= 1) v += __shfl_xor(v, o);
    return v;
}
DI void st_sc1(unsigned* p, unsigned v) { __hip_atomic_store(p, v, __ATOMIC_RELAXED, __HIP_MEMORY_SCOPE_AGENT); }
DI unsigned ld_sc1(const unsigned* p) { return __hip_atomic_load(p, __ATOMIC_RELAXED, __HIP_MEMORY_SCOPE_AGENT); }
DI float ld_sc1f(const float* p) { return __uint_as_float(__hip_atomic_load((const unsigned*)p, __ATOMIC_RELAXED, __HIP_MEMORY_SCOPE_AGENT)); }
DI int crow(int reg, int h) { return (reg & 3) + 8 * (reg >> 2) + 4 * h; }
DI bf16x8 pack8(const f32x16& x, int s) {
    u32x4 p; p.x = cvtpk(x[8 * s], x[8 * s + 1]); p.y = cvtpk(x[8 * s + 2], x[8 * s + 3]); p.z = cvtpk(x[8 * s + 4], x[8 * s + 5]); p.w = cvtpk(x[8 * s + 6], x[8 * s + 7]);
    return __builtin_bit_cast(bf16x8, p);
}
DI f32x16 zero16() { f32x16 z;
#pragma unroll
    for (int i = 0; i < 16; ++i) z[i] = 0.f; return z; }

struct Args { const float* in[18]; float* out; unsigned char* ws; int ph_lo, ph_hi; };
typedef const float* cfp_t;
typedef const __attribute__((address_space(4))) unsigned char* kptr_t;
struct Ctx { kptr_t kp; unsigned char* ws; float* out;
    DI const float* in(int i) const { return *(const __attribute__((address_space(4))) cfp_t*)(kp + 8 * i); } };
enum { I_X = 0, I_F1N, I_F1G, I_F1U, I_F1D, I_MIXN, I_WIN, I_QN, I_KN, I_PW, I_PS, I_LB, I_HON, I_WOUT, I_F2N, I_F2G, I_F2U, I_F2D };

DI void wconv_tile(const float* W, int ld, int srccol, const float* gain, bf16* WT, int K, int nrow0, int k0, float* scr, int lane) {
    asm volatile("" : "+v"(lane));
#pragma unroll 16
    for (int i = 0; i < 32; ++i) { const int kk = 2 * i + (lane >> 5); float v = W[(size_t)(k0 + kk) * ld + srccol + (lane & 31)]; if (gain) v *= gain[k0 + kk]; scr[kk * 33 + (lane & 31)] = v; }
    asm volatile("s_waitcnt lgkmcnt(0)" ::: "memory");
    const int c = lane & 7;
#pragma unroll
    for (int j = 0; j < 4; ++j) { const int n = (lane >> 3) + 8 * j; const float* s = scr + (8 * c) * 33 + n;
        u32x4 o; o.x = cvtpk(s[0 * 33], s[1 * 33]); o.y = cvtpk(s[2 * 33], s[3 * 33]); o.z = cvtpk(s[4 * 33], s[5 * 33]); o.w = cvtpk(s[6 * 33], s[7 * 33]);
        *(u32x4*)(WT + (size_t)(nrow0 + n) * K + k0 + 8 * c) = o; }
    asm volatile("s_waitcnt lgkmcnt(0)" ::: "memory");
}
constexpr int WC_I0 = 2816, WC_I1 = 1408, WC_I2 = 1408, WC_I3 = 512, WC_I4 = 2816, WC_I5 = 1408, WC_ITEMS = WC_I0 + WC_I1 + WC_I2 + WC_I3 + WC_I4 + WC_I5;
DI void wconv_item(const Ctx& a, int L, int item, float* scr, int lane) {
    unsigned char* wb = a.ws + WS_W + (size_t)(L & 1) * WSZ;
    int r = item;
    if (r < WC_I0 || (r >= WC_I0 + WC_I1 + WC_I2 + WC_I3 && r < WC_I0 + WC_I1 + WC_I2 + WC_I3 + WC_I4)) {
        const bool second = r >= WC_I0; if (second) r -= WC_I0 + WC_I1 + WC_I2 + WC_I3;
        const int kb = r / 176, nb = r % 176, n0 = nb * 32, pn = n0 >> 8, c = n0 & 255, bj = c >> 7, col = 128 * pn + (c & 127);
        const float* src = a.in(second ? (bj ? I_F2U : I_F2G) : (bj ? I_F1U : I_F1G)) + (size_t)L * D * FF;
        const float* gain = a.in(second ? I_F2N : I_F1N) + L * D;
        wconv_tile(src, FF, col, gain, (bf16*)(wb + (second ? W_GU2 : W_GU1)), D, n0, kb * 64, scr, lane); return;
    }
    r -= WC_I0;
    if (r < WC_I1) { const int kb = r / 32, nb = r % 32; wconv_tile(a.in(I_F1D) + (size_t)L * FF * D, D, nb * 32, nullptr, (bf16*)(wb + W_D1), FF, nb * 32, kb * 64, scr, lane); return; }
    r -= WC_I1;
    if (r < WC_I2) { const int kb = r / 88, nb = r % 88, n0 = nb * 32, pn = n0 >> 8, c = n0 & 255;
        const int col = pn < 6 ? (pn >> 1) * 512 + 64 * ((pn & 1) * 4 + ((c >> 5) & 3)) + 32 * (c >> 7) : n0;
        wconv_tile(a.in(I_WIN) + (size_t)L * D * INW, INW, col, a.in(I_MIXN) + L * D, (bf16*)(wb + W_IN), D, n0, kb * 64, scr, lane); return; }
    r -= WC_I2;
    if (r < WC_I3) { const int kb = r / 32, nb = r % 32; wconv_tile(a.in(I_WOUT) + (size_t)L * D * D, D, nb * 32, nullptr, (bf16*)(wb + W_OUT), D, nb * 32, kb * 64, scr, lane); return; }
    r -= WC_I3 + WC_I4;
    { const int kb = r / 32, nb = r % 32; wconv_tile(a.in(I_F2D) + (size_t)L * FF * D, D, nb * 32, nullptr, (bf16*)(wb + W_D2), FF, nb * 32, kb * 64, scr, lane); }
}

DI void phase_p0(const Ctx& a, unsigned char* lds, int gw, int NGW, int wave, int lane) {
    const float* x = a.in(I_X); float* out = a.out; bf16* xb = (bf16*)(a.ws + WS_XB); float* stats = (float*)(a.ws + WS_STATS);
    for (int m0 = gw * 2; m0 < M; m0 += NGW * 2) {
        f32x4 v[2][4]; float sq[2];
#pragma unroll
        for (int k = 0; k < 2; ++k) { const f32x4* xr = (const f32x4*)(x + (size_t)(m0 + k) * D) + lane;
#pragma unroll
            for (int j = 0; j < 4; ++j) v[k][j] = xr[64 * j]; }
#pragma unroll
        for (int k = 0; k < 2; ++k) { float s = 0.f;
#pragma unroll
            for (int j = 0; j < 4; ++j) s += (v[k][j][0] * v[k][j][0] + v[k][j][1] * v[k][j][1]) + (v[k][j][2] * v[k][j][2] + v[k][j][3] * v[k][j][3]);
            sq[k] = wave_sum(s); }
#pragma unroll
        for (int k = 0; k < 2; ++k) { const int m = m0 + k;
            f32x4* orow = (f32x4*)(out + (size_t)m * D) + lane; u32x2* brow = (u32x2*)(xb + (size_t)m * D) + lane;
#pragma unroll
            for (int j = 0; j < 4; ++j) { orow[64 * j] = v[k][j]; u32x2 w; w.x = cvtpk(v[k][j][0], v[k][j][1]); w.y = cvtpk(v[k][j][2], v[k][j][3]); brow[64 * j] = w; }
            if (lane < 16) stats[(size_t)m * 16 + lane] = (lane == 0) ? sq[k] : 0.f; }
    }
    { unsigned* cz = (unsigned*)(a.ws + WS_CTL + 65536); for (int i = gw * 64 + lane; i < 3456; i += NGW * 64) cz[i] = 0u; }
    float* rc = (float*)(a.ws + WS_ROPEC); float* rs = (float*)(a.ws + WS_ROPES);
    for (int e = gw * 64 + lane; e < SEQ * 32; e += NGW * 64) {
        const int t = e >> 5, i = e & 31;
        double c = 0.15915494309189535;
        for (int k = 0; k < i; ++k) c *= 0.74989420933245582;
        const float chi = (float)c, clo = (float)(c - (double)chi), tf = (float)t;
        const float p = tf * chi, pe = fmaf(tf, chi, -p);
        float fr = __builtin_amdgcn_fractf(p) + (pe + tf * clo);
        rc[e] = __builtin_amdgcn_cosf(fr); rs[e] = __builtin_amdgcn_sinf(fr);
    }
    float* scr = (float*)(lds + wave * 16384);
    for (int it = gw; it < WC_ITEMS; it += NGW) wconv_item(a, 0, it, scr, lane);
}

template <bool DIAG>
DI void attn_core(const bf16* qrow, const bf16* kblk, const bf16* vblk, int nkg, int r, int h, float& m_out, float& l_out, f32x16 (&ot)[2]) {
    bf16x8 qf[4];
#pragma unroll
    for (int ks = 0; ks < 4; ++ks) qf[ks] = *(const bf16x8*)(qrow + 16 * ks + 8 * h);
    f32x16 st[8];
    const int lo = (r * 2 + h) * 8;
#pragma unroll
    for (int hf = 0; hf < 2; ++hf) {
        if (!DIAG || 4 * hf < nkg) {
            bf16x8 kf[16];
#pragma unroll
            for (int i = 0; i < 16; ++i) kf[i] = (!DIAG || 4 * hf + (i >> 2) < nkg) ? *(const bf16x8*)(kblk + ((4 * hf + (i >> 2)) * 4 + (i & 3)) * 512 + lo) : qf[0];
#pragma unroll
            for (int g = 0; g < 4; ++g) {
                const int kg = 4 * hf + g;
                f32x16 acc = zero16();
                if (!DIAG || kg < nkg) {
#pragma unroll
                    for (int ks = 0; ks < 4; ++ks) acc = MFMA32(kf[4 * g + ks], qf[ks], acc);
                    if (DIAG && kg == nkg - 1) {
#pragma unroll
                        for (int i = 0; i < 16; ++i) if (crow(i, h) > r) acc[i] = -INFINITY;
                    }
                } else {
#pragma unroll
                    for (int i = 0; i < 16; ++i) acc[i] = -INFINITY;
                }
                st[kg] = acc;
            }
        } else {
#pragma unroll
            for (int g = 0; g < 4; ++g)
#pragma unroll
                for (int i = 0; i < 16; ++i) st[4 * hf + g][i] = -INFINITY;
        }
    }
    float mx = -INFINITY;
#pragma unroll
    for (int kg = 0; kg < 8; ++kg)
#pragma unroll
        for (int i = 0; i < 16; ++i) mx = fmaxf(mx, st[kg][i]);
    mx = fmaxf(mx, __shfl_xor(mx, 32));
    const float c = 0.125f * 1.4426950408889634f; const float mc = mx * c;
    float l = 0.f;
#pragma unroll
    for (int kg = 0; kg < 8; ++kg)
#pragma unroll
        for (int i = 0; i < 16; ++i) { const float p = __builtin_amdgcn_exp2f(st[kg][i] * c - mc); st[kg][i] = p; l += p; }
    l += __shfl_xor(l, 32);
    ot[0] = zero16(); ot[1] = zero16();
#pragma unroll
    for (int pr = 0; pr < 4; ++pr) {
        if (!DIAG || 2 * pr < nkg) {
            bf16x8 vf[8];
#pragma unroll
            for (int i = 0; i < 8; ++i) vf[i] = (!DIAG || 2 * pr + (i >> 2) < nkg) ? *(const bf16x8*)(vblk + (((2 * pr + (i >> 2)) * 2 + ((i >> 1) & 1)) * 2 + (i & 1)) * 512 + lo) : qf[0];
#pragma unroll
            for (int g = 0; g < 2; ++g) {
                const int kg = 2 * pr + g;
                if (!DIAG || kg < nkg) {
#pragma unroll
                    for (int s2 = 0; s2 < 2; ++s2) { const bf16x8 pf = pack8(st[kg], s2); ot[0] = MFMA32(vf[4 * g + 2 * s2], pf, ot[0]); ot[1] = MFMA32(vf[4 * g + 2 * s2 + 1], pf, ot[1]); }
                }
            }
        }
    }
    m_out = mx * 0.125f; l_out = l;
}

DI void topk_unit(const Ctx& a, int L, int unit, int lane) {
    asm volatile("" : "+v"(lane));
    const int b = unit >> 10, hd = (unit >> 7) & 7, c = unit & 127, own = c >> 2;
    if (own == 0) return;
    const bf16* Q = (const bf16*)(a.ws + WS_R + R_Q); const float* kmp = (const float*)(a.ws + WS_KMP);
    unsigned* cnt = (unsigned*)(a.ws + WS_CTL) + L * 512; unsigned* lists = (unsigned*)(a.ws + WS_R + R_LIST);
    const int t = c * 64 + lane; const size_t bh = (size_t)(b * 8 + hd);
    float q[64];
    { const u32x4* qp = (const u32x4*)(Q + (bh * SEQ + t) * 64);
#pragma unroll
      for (int i = 0; i < 8; ++i) { const u32x4 w = qp[i];
          q[8 * i + 0] = __uint_as_float(w.x << 16); q[8 * i + 1] = __uint_as_float(w.x & 0xffff0000u); q[8 * i + 2] = __uint_as_float(w.y << 16); q[8 * i + 3] = __uint_as_float(w.y & 0xffff0000u);
          q[8 * i + 4] = __uint_as_float(w.z << 16); q[8 * i + 5] = __uint_as_float(w.z & 0xffff0000u); q[8 * i + 6] = __uint_as_float(w.w << 16); q[8 * i + 7] = __uint_as_float(w.w & 0xffff0000u); } }
    float g0 = -INFINITY, g1 = -INFINITY, g2 = -INFINITY; int i0 = 0, i1 = 0, i2 = 0;
    for (int j = 0; j < own; ++j) {
        const float* p0 = kmp + (size_t)((b * 32 + j) * 2) * 512 + hd * 64; const float* p1 = p0 + 512;
        float g = 0.f;
#pragma unroll
        for (int d = 0; d < 64; d += 4) { const f32x4 x0 = *(const f32x4*)(p0 + d), x1 = *(const f32x4*)(p1 + d);
            g += q[d] * (x0[0] + x1[0]) + q[d + 1] * (x0[1] + x1[1]) + q[d + 2] * (x0[2] + x1[2]) + q[d + 3] * (x0[3] + x1[3]); }
#ifdef DBG_FIXED_SEL
        g = -(float)j;
#endif
        if (g > g0) { g2 = g1; i2 = i1; g1 = g0; i1 = i0; g0 = g; i0 = j; }
        else if (g > g1) { g2 = g1; i2 = i1; g1 = g; i1 = j; }
        else if (g > g2) { g2 = g; i2 = j; }
    }
    const int nsel = own < 3 ? own : 3;
#pragma unroll
    for (int s = 0; s < 3; ++s) {
        if (s < nsel) { const int j = s == 0 ? i0 : (s == 1 ? i1 : i2); const int li = (int)bh * 32 + j;
            const unsigned pos = atomicAdd(cnt + li, 1u); st_sc1(lists + (size_t)li * 8192 + pos, (unsigned)(t | (s << 13))); }
    }
}

DI void pool_unit(const Ctx& a, int L, int unit, int lane) {
    asm volatile("" : "+v"(lane));
    const int tile = unit >> 2, g = unit & 3, w = 2 << g, r = lane & 31, h = lane >> 5;
    const bf16* U = (const bf16*)(a.ws + WS_R + R_U5); bf16* Y = (bf16*)(a.ws + WS_R + R_Y);
    const float* pw = a.in(I_PW) + (size_t)(L * 4 + g) * 4096; const float* ps = a.in(I_PS) + L * 256 + g * 64;
    const float* pwl = pw + (8 * h) * 64 + r;
    bf16x8 wf[2][4];
#pragma unroll
    for (int me = 0; me < 2; ++me)
#pragma unroll
        for (int ks = 0; ks < 4; ++ks) { float f[8];
#pragma unroll
            for (int j = 0; j < 8; ++j) f[j] = pwl[(16 * ks + j) * 64 + 32 * me];
            u32x4 p; p.x = cvtpk(f[0], f[1]); p.y = cvtpk(f[2], f[3]); p.z = cvtpk(f[4], f[5]); p.w = cvtpk(f[6], f[7]); wf[me][ks] = __builtin_bit_cast(bf16x8, p); }
#pragma unroll 1
    for (int nt = 0; nt < 4; ++nt) {
        const int m = tile * 128 + nt * 32 + r, tpos = m & (SEQ - 1);
        const int cntw = tpos + 1 < w ? tpos + 1 : w; const float invc = 1.0f / (float)cntw;
        f32x16 acc[2]; acc[0] = zero16(); acc[1] = zero16();
#pragma unroll
        for (int ks = 0; ks < 4; ++ks) {
            const bf16* up = U + (size_t)m * 256 + g * 64 + 16 * ks + 8 * h;
            float sum[8], self[8];
            { const u32x4 wv = *(const u32x4*)up;
              self[0] = __uint_as_float(wv.x << 16); self[1] = __uint_as_float(wv.x & 0xffff0000u); self[2] = __uint_as_float(wv.y << 16); self[3] = __uint_as_float(wv.y & 0xffff0000u);
              self[4] = __uint_as_float(wv.z << 16); self[5] = __uint_as_float(wv.z & 0xffff0000u); self[6] = __uint_as_float(wv.w << 16); self[7] = __uint_as_float(wv.w & 0xffff0000u); }
#pragma unroll
            for (int j = 0; j < 8; ++j) sum[j] = self[j];
            u32x4 rows[15];
#pragma unroll
            for (int i = 1; i < 16; ++i) { const bool ok = (i < w) && (i <= tpos); rows[i - 1] = *(const u32x4*)(up - (size_t)(ok ? i : 0) * 256); }
#pragma unroll
            for (int i = 1; i < 16; ++i) { const bool ok = (i < w) && (i <= tpos); const float kf = ok ? 1.f : 0.f; const u32x4 wv = rows[i - 1];
                sum[0] += kf * __uint_as_float(wv.x << 16); sum[1] += kf * __uint_as_float(wv.x & 0xffff0000u); sum[2] += kf * __uint_as_float(wv.y << 16); sum[3] += kf * __uint_as_float(wv.y & 0xffff0000u);
                sum[4] += kf * __uint_as_float(wv.z << 16); sum[5] += kf * __uint_as_float(wv.z & 0xffff0000u); sum[6] += kf * __uint_as_float(wv.w << 16); sum[7] += kf * __uint_as_float(wv.w & 0xffff0000u); }
            u32x4 p; p.x = cvtpk(sum[0] * invc - self[0], sum[1] * invc - self[1]); p.y = cvtpk(sum[2] * invc - self[2], sum[3] * invc - self[3]);
            p.z = cvtpk(sum[4] * invc - self[4], sum[5] * invc - self[5]); p.w = cvtpk(sum[6] * invc - self[6], sum[7] * invc - self[7]);
            const bf16x8 df = __builtin_bit_cast(bf16x8, p);
            acc[0] = MFMA32(wf[0][ks], df, acc[0]); acc[1] = MFMA32(wf[1][ks], df, acc[1]);
        }
#pragma unroll
        for (int me = 0; me < 2; ++me)
#pragma unroll
            for (int gq = 0; gq < 4; ++gq) { const int e0 = 32 * me + 8 * gq + 4 * h; const f32x4 sc = *(const f32x4*)(ps + e0);
                u32x2 o; o.x = cvtpk(acc[me][4 * gq] * sc[0], acc[me][4 * gq + 1] * sc[1]); o.y = cvtpk(acc[me][4 * gq + 2] * sc[2], acc[me][4 * gq + 3] * sc[3]);
                *(u32x2*)(Y + (size_t)m * 1024 + 512 + g * 64 + e0) = o; }
    }
}

DI void h1_unit(const Ctx& a, int L, int unit, unsigned char* sm, int lane) {
    asm volatile("" : "+v"(lane));
    const int b = unit >> 9, hh = (unit >> 7) & 3, n = unit & 127, r = lane & 31, h = lane >> 5;
    const int row0 = b * SEQ + n * 64, ch = hh * 64 + lane;
    const bf16* QH = (const bf16*)(a.ws + WS_R + R_U5) + (size_t)1 * M * 256; const bf16* FH = QH + (size_t)M * 256; const bf16* IH = FH + (size_t)M * 256;
    bf16* QDEC = (bf16*)(a.ws + WS_R + R_QDEC); float* ALOC = (float*)(a.ws + WS_R + R_ALOC); float* OINTRA = (float*)(a.ws + WS_R + R_OINTRA); float* DEC = (float*)(a.ws + WS_DEC);
    bf16* KD = (bf16*)sm; bf16* IT = (bf16*)(sm + 8192); bf16* Am = (bf16*)(sm + 16384); bf16* Bm = (bf16*)(sm + 24576);
#ifdef DBG_H1_CLEAR
    { u32x4* z4 = (u32x4*)sm;
#pragma unroll 4
      for (int i = 0; i < 32; ++i) z4[i * 64 + lane] = (u32x4){0u, 0u, 0u, 0u}; asm volatile("s_waitcnt lgkmcnt(0)" ::: "memory"); }
#endif
    float lb;
    { const float* lp = a.in(I_LB) + ch; const float x0 = lp[0], x1 = lp[256], x2 = lp[512], x3 = lp[768];
      const float mx = fmaxf(fmaxf(x0, x1), fmaxf(x2, x3)); const float e0 = __expf(x0 - mx), e1 = __expf(x1 - mx), e2 = __expf(x2 - mx), e3 = __expf(x3 - mx);
      const float inv = 1.0f / (e0 + e1 + e2 + e3); float acc = 0.f; if (L > 0) acc += e0; if (L > 1) acc += e1; if (L > 2) acc += e2; lb = acc * inv; }
    const float loglb = __logf(fmaxf(lb, 1e-20f)), l1m = __logf(1.0f - lb), oml = 1.0f - lb;
    float zr[64];
#pragma unroll
    for (int s = 0; s < 64; ++s) zr[s] = bf2f(FH[(size_t)(row0 + s) * 256 + ch]);
    float cum = 0.f, ref = 0.f;
#pragma unroll
    for (int s = 0; s < 64; ++s) {
        const float z = zr[s];
        const float ls = fminf(z, 0.f) - __logf(1.0f + __expf(-fabsf(z)));
        const float bb = l1m + ls, hi = fmaxf(loglb, bb), df = fabsf(loglb - bb);
        cum += hi + __logf(1.0f + __expf(-df));
        asm volatile("" : "+v"(cum));
        if (s == 31) ref = cum;
    }
    const float last = cum;
    DEC[unit * 64 + lane] = __expf(last);
    cum = 0.f;
#ifndef H1_NO_P2
    unsigned short zc[8], qc[8], ic[8];
#pragma unroll
    for (int j = 0; j < 8; ++j) { const size_t gi = (size_t)(row0 + j) * 256 + ch; zc[j] = FH[gi]; qc[j] = QH[gi]; ic[j] = IH[gi]; }
#pragma unroll 1
    for (int s8 = 0; s8 < 8; ++s8) {
        unsigned kp[4], ip[4]; float kd8[8]; unsigned short i8[8];
        unsigned short zn[8], qn[8], in_[8];
        { const int sn = (s8 < 7 ? s8 + 1 : 7) * 8;
#pragma unroll
          for (int j = 0; j < 8; ++j) { const size_t gi = (size_t)(row0 + sn + j) * 256 + ch; zn[j] = FH[gi]; qn[j] = QH[gi]; in_[j] = IH[gi]; } }
#pragma unroll
        for (int j = 0; j < 8; ++j) {
            const int s = s8 * 8 + j; const size_t gi = (size_t)(row0 + s) * 256 + ch;
            const float z = bf2f(zc[j]), qv = bf2f(qc[j]); i8[j] = ic[j];
            const float ls = fminf(z, 0.f) - __logf(1.0f + __expf(-fabsf(z)));
            const float bb = l1m + ls, hi = fmaxf(loglb, bb), df = fabsf(loglb - bb);
            cum += hi + __logf(1.0f + __expf(-df));
            const float key = oml * __builtin_amdgcn_rcpf(1.0f + __expf(z));
            const float qs = qv * __builtin_amdgcn_rcpf(1.0f + __expf(-qv)) * 0.125f;
            const float av = qs * __expf(fminf(cum - ref, 80.f)), bv = key * __expf(fminf(ref - cum, 80.f)), qd = qs * __expf(cum);
            kd8[j] = key * __expf(last - cum);
#ifndef H1_NO_AB
            Am[s * 64 + lane] = (bf16)(cvtpk(av, 0.f) & 0xffffu); Bm[s * 64 + lane] = (bf16)(cvtpk(bv, 0.f) & 0xffffu);
#endif
#ifndef H1_NO_QD
            QDEC[gi] = (bf16)(cvtpk(qd, 0.f) & 0xffffu);
#endif
        }
#pragma unroll
        for (int j = 0; j < 4; ++j) { kp[j] = cvtpk(kd8[2 * j], kd8[2 * j + 1]); ip[j] = (unsigned)i8[2 * j] | ((unsigned)i8[2 * j + 1] << 16); }
        *(u32x4*)(KD + lane * 64 + s8 * 8) = (u32x4){kp[0], kp[1], kp[2], kp[3]};
        *(u32x4*)(IT + lane * 64 + s8 * 8) = (u32x4){ip[0], ip[1], ip[2], ip[3]};
#pragma unroll
        for (int j = 0; j < 8; ++j) { zc[j] = zn[j]; qc[j] = qn[j]; ic[j] = in_[j]; }
    }
#endif
    asm volatile("s_waitcnt lgkmcnt(0)" ::: "memory");
#ifndef H1_NO_MM
    bf16x8 itf[2][2][2];
#pragma unroll
    for (int mv = 0; mv < 2; ++mv)
#pragma unroll
        for (int ms = 0; ms < 2; ++ms)
#pragma unroll
            for (int st = 0; st < 2; ++st) { const bf16* p = IT + (32 * mv + r) * 64 + 32 * ms + 16 * st + 4 * h; const u32x2 x0 = *(const u32x2*)p, x1 = *(const u32x2*)(p + 8);
                itf[mv][ms][st] = __builtin_bit_cast(bf16x8, ((u32x4){x0.x, x0.y, x1.x, x1.y})); }
    float* alb = ALOC + (size_t)unit * 4096 + (4 * h) * 64 + r;
#pragma unroll
    for (int nk = 0; nk < 2; ++nk) {
        bf16x8 kdf[2][2];
#pragma unroll
        for (int ms = 0; ms < 2; ++ms)
#pragma unroll
            for (int st = 0; st < 2; ++st) { const bf16* p = KD + (32 * nk + r) * 64 + 32 * ms + 16 * st + 4 * h; const u32x2 x0 = *(const u32x2*)p, x1 = *(const u32x2*)(p + 8);
                kdf[ms][st] = __builtin_bit_cast(bf16x8, ((u32x4){x0.x, x0.y, x1.x, x1.y})); }
#pragma unroll
        for (int mv = 0; mv < 2; ++mv) {
            f32x16 acc = zero16();
#pragma unroll
            for (int ms = 0; ms < 2; ++ms)
#pragma unroll
                for (int st = 0; st < 2; ++st) acc = MFMA32(itf[mv][ms][st], kdf[ms][st], acc);
#pragma unroll
            for (int i = 0; i < 16; ++i) alb[(32 * mv + (i & 3) + 8 * (i >> 2)) * 64 + 32 * nk] = acc[i];
        }
    }
#pragma unroll
    for (int nt = 0; nt < 2; ++nt) {
        bf16x8 af[4];
#pragma unroll
        for (int ks = 0; ks < 4; ++ks) af[ks] = *(const bf16x8*)(Am + (32 * nt + r) * 64 + 16 * ks + 8 * h);
        f32x16 oi[2]; oi[0] = zero16(); oi[1] = zero16();
#pragma unroll
        for (int ms = 0; ms < 2; ++ms) {
            if (ms <= nt) {
                f32x16 sacc = zero16();
#pragma unroll
                for (int ks = 0; ks < 4; ++ks) { const bf16x8 bf_ = *(const bf16x8*)(Bm + (32 * ms + r) * 64 + 16 * ks + 8 * h); sacc = MFMA32(bf_, af[ks], sacc); }
                if (ms == nt) {
#pragma unroll
                    for (int i = 0; i < 16; ++i) if (crow(i, h) > r) sacc[i] = 0.f;
                }
#pragma unroll
                for (int st = 0; st < 2; ++st) { const bf16x8 pf = pack8(sacc, st); oi[0] = MFMA32(itf[0][ms][st], pf, oi[0]); oi[1] = MFMA32(itf[1][ms][st], pf, oi[1]); }
            }
        }
        const size_t orow = (size_t)(row0 + 32 * nt + r) * 256 + hh * 64;
#pragma unroll
        for (int mv = 0; mv < 2; ++mv)
#pragma unroll
            for (int gq = 0; gq < 4; ++gq) *(f32x4*)(OINTRA + orow + 32 * mv + 8 * gq + 4 * h) = (f32x4){oi[mv][4 * gq], oi[mv][4 * gq + 1], oi[mv][4 * gq + 2], oi[mv][4 * gq + 3]};
    }
#endif
    asm volatile("s_waitcnt lgkmcnt(0)" ::: "memory");
}

DI void phase_t(const Ctx& a, int L, unsigned char* lds, int gw, int NGW, int wave, int lane) {
    const int blk = gw >> 3, G = NGW >> 3;
    if (wave < 4) { for (int u = blk * 4 + wave; u < 1024; u += G * 4) h1_unit(a, L, u, lds + wave * 32768, lane); }
    else if (wave < 6) { for (int u = blk * 2 + (wave - 4); u < 512; u += G * 2) pool_unit(a, L, u, lane); }
    __syncthreads();
    if (L + 1 < DEPTH) { float* scr = (float*)(lds + wave * 16384); for (int it = gw; it < WC_ITEMS; it += NGW) wconv_item(a, L + 1, it, scr, lane); }
}

DI void attn_unit(const Ctx& a, int bh, int qb, unsigned char* lds, int tid, int wave, int lane) {
    asm volatile("" : "+v"(lane), "+v"(tid));
    const int r = lane & 31, h = lane >> 5, b = bh >> 3, hd = bh & 7, own = qb, nsel = own < 3 ? own : 3;
    const bf16* Q = (const bf16*)(a.ws + WS_R + R_Q); const bf16* Kb = (const bf16*)(a.ws + WS_R + R_K); const bf16* Vb = (const bf16*)(a.ws + WS_R + R_V);
    const float* kmp = (const float*)(a.ws + WS_KMP); bf16* Y = (bf16*)(a.ws + WS_R + R_Y);
    unsigned char* part = lds;
    unsigned short* llist = (unsigned short*)(lds + 104448);
    int* lcnt = (int*)(lds + 120832); int* itab = lcnt + 32;
    const size_t qbase = ((size_t)bh * SEQ + (size_t)qb * 256) * 64;
    if (own > 0) {
        if (tid < 32) lcnt[tid] = 0;
        float* km = (float*)(lds + 122880);
        for (int idx = tid; idx < own * 64; idx += NTHR) { const float* p0 = kmp + (size_t)((b * 32 + (idx >> 6)) * 2) * 512 + hd * 64 + (idx & 63); km[idx] = p0[0] + p0[512]; }
        __syncthreads();
        if (tid < 256) {
            float q[64];
            { const u32x4* qp = (const u32x4*)(Q + qbase + (size_t)tid * 64);
#pragma unroll
              for (int i = 0; i < 8; ++i) { const u32x4 w = qp[i];
                  q[8 * i + 0] = __uint_as_float(w.x << 16); q[8 * i + 1] = __uint_as_float(w.x & 0xffff0000u); q[8 * i + 2] = __uint_as_float(w.y << 16); q[8 * i + 3] = __uint_as_float(w.y & 0xffff0000u);
                  q[8 * i + 4] = __uint_as_float(w.z << 16); q[8 * i + 5] = __uint_as_float(w.z & 0xffff0000u); q[8 * i + 6] = __uint_as_float(w.w << 16); q[8 * i + 7] = __uint_as_float(w.w & 0xffff0000u); } }
            float g0 = -INFINITY, g1 = -INFINITY, g2 = -INFINITY; int i0 = 0, i1 = 0, i2 = 0;
            for (int j = 0; j < own; ++j) {
                const float* kj = km + j * 64;
                float g = 0.f;
#pragma unroll
                for (int d = 0; d < 64; d += 4) { const f32x4 x0 = *(const f32x4*)(kj + d);
                    g += q[d] * x0[0] + q[d + 1] * x0[1] + q[d + 2] * x0[2] + q[d + 3] * x0[3]; }
                if (g > g0) { g2 = g1; i2 = i1; g1 = g0; i1 = i0; g0 = g; i0 = j; }
                else if (g > g1) { g2 = g1; i2 = i1; g1 = g; i1 = j; }
                else if (g > g2) { g2 = g; i2 = j; }
            }
#pragma unroll
            for (int s = 0; s < 3; ++s) {
                if (s < nsel) { const int j = s == 0 ? i0 : (s == 1 ? i1 : i2); const int pos = atomicAdd(lcnt + j, 1); llist[j * 256 + pos] = (unsigned short)(tid | (s << 8)); }
            }
        }
        __syncthreads();
        if (tid == 0) { int n = 0; for (int j = 0; j < own; ++j) { const int ng = (lcnt[j] + 31) >> 5; for (int g = 0; g < ng; ++g) itab[n++] = j | (g << 8); } itab[64] = n; }
        __syncthreads();
        const int nitems = __builtin_amdgcn_readfirstlane(itab[64]);
        for (int it = wave; it < nitems; it += NWAVES) {
            const int ent = __builtin_amdgcn_readfirstlane(itab[it]); const int j = ent & 255, g = ent >> 8, n = __builtin_amdgcn_readfirstlane(lcnt[j]);
            const int idx = g * 32 + r; const bool valid = idx < n;
            const unsigned e = llist[j * 256 + (valid ? idx : 0)];
            const int qi = e & 255, slot = e >> 8;
            float mo, lo_; f32x16 ot[2];
            attn_core<false>(Q + qbase + (size_t)qi * 64, Kb + ((size_t)bh * 32 + j) * 16384, Vb + ((size_t)bh * 32 + j) * 16384, 8, r, h, mo, lo_, ot);
            if (valid) {
                unsigned char* rec = part + (qi * 3 + slot) * 136; const float inv = 1.0f / lo_;
#pragma unroll
                for (int md = 0; md < 2; ++md)
#pragma unroll
                    for (int gq = 0; gq < 4; ++gq) { u32x2 o; o.x = cvtpk(ot[md][4 * gq] * inv, ot[md][4 * gq + 1] * inv); o.y = cvtpk(ot[md][4 * gq + 2] * inv, ot[md][4 * gq + 3] * inv);
                        *(u32x2*)(rec + 2 * (32 * md + 8 * gq + 4 * h)) = o; }
                if (h == 0) { *(float*)(rec + 128) = mo; *(float*)(rec + 132) = lo_; }
            }
        }
        __syncthreads();
    }
    {
        const int ql = 32 * wave + r, t = qb * 256 + ql;
        float m0, l0; f32x16 ot[2];
        attn_core<true>(Q + qbase + (size_t)ql * 64, Kb + ((size_t)bh * 32 + qb) * 16384, Vb + ((size_t)bh * 32 + qb) * 16384, wave + 1, r, h, m0, l0, ot);
        float ms[3], ls[3]; float mx = m0;
#pragma unroll
        for (int s = 0; s < 3; ++s) { ms[s] = -INFINITY; ls[s] = 0.f; if (s < nsel) { const unsigned char* rec = part + (ql * 3 + s) * 136; ms[s] = *(const float*)(rec + 128); ls[s] = *(const float*)(rec + 132); mx = fmaxf(mx, ms[s]); } }
        const float w0 = __expf(m0 - mx); float den = w0 * l0;
#pragma unroll
        for (int md = 0; md < 2; ++md)
#pragma unroll
            for (int i = 0; i < 16; ++i) ot[md][i] *= w0;
#pragma unroll
        for (int s = 0; s < 3; ++s) {
            if (s < nsel) {
                const unsigned char* rec = part + (ql * 3 + s) * 136; const float ws_ = __expf(ms[s] - mx) * ls[s]; den += ws_;
#pragma unroll
                for (int md = 0; md < 2; ++md)
#pragma unroll
                    for (int gq = 0; gq < 4; ++gq) { const u32x2 w = *(const u32x2*)(rec + 2 * (32 * md + 8 * gq + 4 * h));
                        ot[md][4 * gq] += ws_ * __uint_as_float(w.x << 16); ot[md][4 * gq + 1] += ws_ * __uint_as_float(w.x & 0xffff0000u);
                        ot[md][4 * gq + 2] += ws_ * __uint_as_float(w.y << 16); ot[md][4 * gq + 3] += ws_ * __uint_as_float(w.y & 0xffff0000u); }
            }
        }
        float inv = 1.0f / den; const size_t yrow = (size_t)(b * SEQ + t) * 1024 + hd * 64;
#ifdef DBG_AMP_ATTN
        inv *= 64.f;
#endif
#pragma unroll
        for (int md = 0; md < 2; ++md)
#pragma unroll
            for (int gq = 0; gq < 4; ++gq) { u32x2 o; o.x = cvtpk(ot[md][4 * gq] * inv, ot[md][4 * gq + 1] * inv); o.y = cvtpk(ot[md][4 * gq + 2] * inv, ot[md][4 * gq + 3] * inv);
                *(u32x2*)(Y + yrow + 32 * md + 8 * gq + 4 * h) = o; }
    }
    __syncthreads();
}

DI void phase_a(const Ctx& a, int L, unsigned char* lds, int gw, int NGW, int tid, int wave, int lane) {
    if ((gw & 3) == 0 && (gw >> 2) < 512) {
        const int chunk = gw >> 2, bhh = chunk >> 6, e = (chunk & 63) * 64 + lane, k = e & 63;
        const float* ALOC = (const float*)(a.ws + WS_R + R_ALOC); const float* DEC = (const float*)(a.ws + WS_DEC); bf16* SP = (bf16*)(a.ws + WS_R + R_SP);
        float st = 0.f;
#pragma unroll 8
        for (int n = 0; n < 128; ++n) { const int item = bhh * 128 + n; const float av = ALOC[(size_t)item * 4096 + e], dv = DEC[item * 64 + k];
            SP[(size_t)item * 4096 + e] = (bf16)(cvtpk(st, 0.f) & 0xffffu); st = dv * st + av; }
    }
    const int G = NGW / NWAVES, blk = gw / NWAVES;
    for (int u = blk; u < 512; u += G) {
        const int v = u & 255, bh = v >> 4, qb = (u < 256) ? (v & 15) : 31 - (v & 15);
        attn_unit(a, bh, qb, lds, tid, wave, lane);
    }
}

DI void own_unit(const Ctx& a, int bhi, int qg, int lane) {
    asm volatile("" : "+v"(lane));
    const int r = lane & 31, h = lane >> 5, t0 = qg * 32, j = t0 >> 8, nkg = ((t0 & 255) >> 5) + 1, t = t0 + r;
    const int b = bhi >> 3, hd = bhi & 7; const size_t bh = (size_t)bhi;
    const bf16* Q = (const bf16*)(a.ws + WS_R + R_Q); const bf16* Kb = (const bf16*)(a.ws + WS_R + R_K); const bf16* Vb = (const bf16*)(a.ws + WS_R + R_V);
    const bf16* PO = (const bf16*)(a.ws + WS_R + R_PO); const float* PML = (const float*)(a.ws + WS_R + R_PML); bf16* Y = (bf16*)(a.ws + WS_R + R_Y);
    float m0, l0; f32x16 ot[2];
    attn_core<true>(Q + (bh * SEQ + t) * 64, Kb + (bh * 32 + j) * 16384, Vb + (bh * 32 + j) * 16384, nkg, r, h, m0, l0, ot);
#ifdef DBG_OWN_ONLY
    const int nsel = 0;
#else
    const int nsel = j < 3 ? j : 3;
#endif
    const size_t pi = (bh * SEQ + t) * 3;
    float ms[3], ls[3]; float mx = m0;
#pragma unroll
    for (int s = 0; s < 3; ++s) { ms[s] = -INFINITY; ls[s] = 0.f; if (s < nsel) { ms[s] = ld_sc1f(PML + (pi + s) * 2); ls[s] = ld_sc1f(PML + (pi + s) * 2 + 1); mx = fmaxf(mx, ms[s]); } }
    const float w0 = __expf(m0 - mx); float den = w0 * l0;
#pragma unroll
    for (int md = 0; md < 2; ++md)
#pragma unroll
        for (int i = 0; i < 16; ++i) ot[md][i] *= w0;
#pragma unroll
    for (int s = 0; s < 3; ++s) {
        if (s < nsel) {
            const float ws_ = __expf(ms[s] - mx) * ls[s]; den += ws_;
#pragma unroll
            for (int md = 0; md < 2; ++md)
#pragma unroll
                for (int gq = 0; gq < 4; ++gq) { const u32x2 w = *(const u32x2*)(PO + (pi + s) * 64 + 32 * md + 8 * gq + 4 * h);
                    ot[md][4 * gq] += ws_ * __uint_as_float(w.x << 16); ot[md][4 * gq + 1] += ws_ * __uint_as_float(w.x & 0xffff0000u);
                    ot[md][4 * gq + 2] += ws_ * __uint_as_float(w.y << 16); ot[md][4 * gq + 3] += ws_ * __uint_as_float(w.y & 0xffff0000u); }
        }
    }
    float inv = 1.0f / den; const size_t yrow = (size_t)(b * SEQ + t) * 1024 + hd * 64;
#ifdef DBG_ZERO_ATTN
    inv = 0.f;
#endif
#pragma unroll
    for (int md = 0; md < 2; ++md)
#pragma unroll
        for (int gq = 0; gq < 4; ++gq) { u32x2 o; o.x = cvtpk(ot[md][4 * gq] * inv, ot[md][4 * gq + 1] * inv); o.y = cvtpk(ot[md][4 * gq + 2] * inv, ot[md][4 * gq + 3] * inv);
            *(u32x2*)(Y + yrow + 32 * md + 8 * gq + 4 * h) = o; }
}

DI void h3_unit(const Ctx& a, int L, int unit, int lane) {
    asm volatile("" : "+v"(lane));
    const int b = unit >> 9, hh = (unit >> 7) & 3, n = unit & 127, r = lane & 31, h = lane >> 5;
    const int row0 = b * SEQ + n * 64;
    const bf16* SP = (const bf16*)(a.ws + WS_R + R_SP) + (size_t)unit * 4096; const bf16* QDEC = (const bf16*)(a.ws + WS_R + R_QDEC);
    const float* OINTRA = (const float*)(a.ws + WS_R + R_OINTRA); const bf16* GH = (const bf16*)(a.ws + WS_R + R_U5) + (size_t)4 * M * 256; bf16* Y = (bf16*)(a.ws + WS_R + R_Y);
    const float* on = a.in(I_HON) + L * 64;
    bf16x8 sf[2][4];
#pragma unroll
    for (int mv = 0; mv < 2; ++mv)
#pragma unroll
        for (int ks = 0; ks < 4; ++ks) sf[mv][ks] = *(const bf16x8*)(SP + (32 * mv + r) * 64 + 16 * ks + 8 * h);
#pragma unroll
    for (int nt = 0; nt < 2; ++nt) {
        const size_t trow = (size_t)(row0 + 32 * nt + r) * 256 + hh * 64;
        f32x16 o[2]; o[0] = zero16(); o[1] = zero16();
#pragma unroll
        for (int ks = 0; ks < 4; ++ks) { const bf16x8 qf = *(const bf16x8*)(QDEC + trow + 16 * ks + 8 * h); o[0] = MFMA32(sf[0][ks], qf, o[0]); o[1] = MFMA32(sf[1][ks], qf, o[1]); }
        float ss = 0.f;
#pragma unroll
        for (int mv = 0; mv < 2; ++mv)
#pragma unroll
            for (int gq = 0; gq < 4; ++gq) { const f32x4 x = *(const f32x4*)(OINTRA + trow + 32 * mv + 8 * gq + 4 * h);
#pragma unroll
                for (int i = 0; i < 4; ++i) { o[mv][4 * gq + i] += x[i]; ss += o[mv][4 * gq + i] * o[mv][4 * gq + i]; } }
        ss += __shfl_xor(ss, 32);
        float rn = rsqrtf(ss * (1.0f / 64.0f) + 1e-6f);
#ifdef DBG_ZERO_HGRN
        rn = 0.f;
#endif
#ifdef DBG_AMP_HGRN
        rn *= 16.f;
#endif
        const size_t yrow = (size_t)(row0 + 32 * nt + r) * 1024 + 768 + hh * 64;
#pragma unroll
        for (int mv = 0; mv < 2; ++mv)
#pragma unroll
            for (int gq = 0; gq < 4; ++gq) { const int v0 = 32 * mv + 8 * gq + 4 * h; const f32x4 gn = *(const f32x4*)(on + v0); const u32x2 gw_ = *(const u32x2*)(GH + trow + v0);
                const float g0 = __uint_as_float(gw_.x << 16), g1 = __uint_as_float(gw_.x & 0xffff0000u), g2 = __uint_as_float(gw_.y << 16), g3 = __uint_as_float(gw_.y & 0xffff0000u);
                u32x2 w; w.x = cvtpk(o[mv][4 * gq] * rn * gn[0] * pg8::silu_f(g0), o[mv][4 * gq + 1] * rn * gn[1] * pg8::silu_f(g1));
                w.y = cvtpk(o[mv][4 * gq + 2] * rn * gn[2] * pg8::silu_f(g2), o[mv][4 * gq + 3] * rn * gn[3] * pg8::silu_f(g3));
                *(u32x2*)(Y + yrow + v0) = w; }
    }
}

DI void phase_c(const Ctx& a, int L, int gw, int NGW, int lane) {
    for (int u = gw; u < 1024; u += NGW) h3_unit(a, L, u, lane);
}

#define LAS __attribute__((address_space(3)))
#define XB_TMO      128
#define XB_XCNT(j)  (256  + 64 * (j))
#define XB_XSUB(j)  (1280 + 64 * (j))
#define XB_XGEN(j)  (2304 + 64 * (j))
#define XB_TOP      3328
#define XB_TOPGEN   3392
#define XCD_BAR_WORDS 3456
#define XB_SPIN_CAP (1u << 18)

__device__ __forceinline__ unsigned xb_ld(unsigned* p)              { return __hip_atomic_load(p, __ATOMIC_RELAXED, __HIP_MEMORY_SCOPE_AGENT); }
__device__ __forceinline__ unsigned xb_add(unsigned* p, unsigned v) { return __hip_atomic_fetch_add(p, v, __ATOMIC_RELAXED, __HIP_MEMORY_SCOPE_AGENT); }
__device__ __forceinline__ unsigned xb_xcc_id() { return (unsigned)__builtin_amdgcn_s_getreg((3 << 11) | 20) & 0xFu; }
#define XB_SPIN(cond, bar) do { unsigned _sp = 0; while (cond) { __builtin_amdgcn_s_sleep(1); \
    if ((++_sp & 255u) == 0u) { if (xb_ld(&(bar)[XB_TMO])) break; if (_sp > XB_SPIN_CAP) { atomicAdd(&(bar)[XB_TMO], 1u); break; } } } } while (0)

struct XcdBarrier {
    unsigned* bar; unsigned x;
    volatile LAS unsigned* st;
};

__device__ __forceinline__ XcdBarrier xcd_barrier_post(unsigned* bar, volatile LAS unsigned* st) {
    XcdBarrier b; b.bar = bar; b.x = xb_xcc_id(); b.st = st;
    if (threadIdx.x == 0) (void)xb_add(&bar[XB_XCNT(b.x)], 1u);
    return b;
}
__device__ __forceinline__ void xcd_barrier_complete(unsigned* bar, unsigned x, unsigned& nloc, unsigned& nx) {
    const unsigned G = gridDim.x * gridDim.y * gridDim.z;
    unsigned sum, cnt, mine, sp = 0u;
    for (;;) {
        sum = 0u; cnt = 0u; mine = 0u;
#pragma unroll
        for (unsigned j = 0; j < 16; ++j) { const unsigned c = xb_ld(&bar[XB_XCNT(j)]); sum += c; cnt += (c > 0u) ? 1u : 0u; mine = (j == x) ? c : mine; }
        if (sum == G) break;
        __builtin_amdgcn_s_sleep(1);
        if ((++sp & 255u) == 0u) { if (xb_ld(&bar[XB_TMO])) break; if (sp > XB_SPIN_CAP) { atomicAdd(&bar[XB_TMO], 1u); break; } }
    }
    nloc = mine > 0u ? mine : 1u; nx = cnt > 0u ? cnt : 1u;
}

__device__ __forceinline__ void xcd_barrier(const XcdBarrier& b) {
    asm volatile("s_waitcnt vmcnt(0)" ::: "memory");
    __syncthreads();
    if (threadIdx.x == 0) {
        unsigned* bar = b.bar;
        __builtin_amdgcn_s_waitcnt(0);
        unsigned nloc = b.st[0], nx = b.st[1];
        if (nloc == 0u) { xcd_barrier_complete(bar, b.x, nloc, nx); b.st[0] = nloc; b.st[1] = nx; }
        const unsigned old = xb_add(&bar[XB_XSUB(b.x)], 1u);
        const unsigned gen = old / nloc;
        if (old + 1u == (gen + 1u) * nloc) {
            __builtin_amdgcn_fence(__ATOMIC_RELEASE, "agent");
            asm volatile("s_waitcnt vmcnt(0)" ::: "memory");
            const unsigned og = xb_add(&bar[XB_TOP], 1u);
            const unsigned tg = og / nx;
            if (og + 1u == (tg + 1u) * nx) xb_add(&bar[XB_TOPGEN], 1u);
            else XB_SPIN(xb_ld(&bar[XB_TOPGEN]) == tg, bar);
            __builtin_amdgcn_fence(__ATOMIC_ACQUIRE, "agent");
            xb_add(&bar[XB_XGEN(b.x)], 1u);
            asm volatile("s_waitcnt vmcnt(0)" ::: "memory");
        } else {
            XB_SPIN(xb_ld(&bar[XB_XGEN(b.x)]) == gen, bar);
            __builtin_amdgcn_fence(__ATOMIC_ACQUIRE, "agent");
            asm volatile("s_waitcnt vmcnt(0)" ::: "memory");
        }
    }
    __syncthreads();
}

template <int MASK> __global__ void __launch_bounds__(NTHR, 2) mk_fwd(Args args) {
    extern __shared__ __attribute__((aligned(16))) unsigned char lds[];
    const int G = gridDim.x, NGW = G * NWAVES;
    cg::grid_group grid = cg::this_grid();
    const int ph_lo = args.ph_lo, ph_hi = args.ph_hi;
    volatile LAS unsigned* bst = (volatile LAS unsigned*)((LAS unsigned char*)lds + 131072);
    if (threadIdx.x == 0) { bst[0] = 0u; bst[1] = 0u; }
    __syncthreads();
    XcdBarrier bar; bar.bar = nullptr; bar.x = 0; bar.st = bst;
    for (int ph = ph_lo; ph < ph_hi; ++ph) {
        if (ph > ph_lo) {
            if (ph == ph_lo + 1) {
                grid.sync();
                bar = xcd_barrier_post((unsigned*)(args.ws + WS_CTL + 65536), bst);
            } else { xcd_barrier(bar);
#ifdef DBG_DUP_BAR
                xcd_barrier(bar);
#endif
            }
        }
        int tid_v = threadIdx.x; asm volatile("" : "+v"(tid_v));
        const int tid = tid_v, lane = tid & 63, wave = __builtin_amdgcn_readfirstlane(tid >> 6), gw = blockIdx.x * NWAVES + wave;
        kptr_t kp = (kptr_t)__builtin_amdgcn_kernarg_segment_ptr();
        asm volatile("" : "+s"(kp));
        Ctx a; a.kp = kp; a.out = *(float* const __attribute__((address_space(4)))*)(kp + 144); a.ws = *(unsigned char* const __attribute__((address_space(4)))*)(kp + 152);
        unsigned char* ws = a.ws;
        float* stats = (float*)(ws + WS_STATS); bf16* xb = (bf16*)(ws + WS_XB); bf16* hid = (bf16*)(ws + WS_R + R_HID);
        if (ph == 0) {
if constexpr (MASK & 1) { phase_p0(a, lds, gw, NGW, wave, lane);
#ifdef DBG_DUP_P0
 __syncthreads(); phase_p0(a, lds, gw, NGW, wave, lane);
#endif
 }
 __syncthreads(); continue; }
        const int L = (ph - 1) / 9, sub = (ph - 1) % 9;
        unsigned char* wb = ws + WS_W + (size_t)(L & 1) * WSZ;
        if (sub == 0 || sub == 7) {
            pg8::Gemm g{xb, (const bf16*)(wb + (sub == 0 ? W_GU1 : W_GU2)), M, 2 * FF, D}; pg8::StaticOrder S; S.init(M, 2 * FF, G, (int)blockIdx.x);
            pg8::EpiSwiGLU E{hid, stats, FF};
            if constexpr (MASK & 2) pg8::gemm_phase<pg8::EpiSwiGLU, pg8::StaticOrder, PG8_ALIGN, PG8_SP2>((PG8_LAS unsigned char*)lds, g, S, E);
#if defined(DBG_DUP_G) && DBG_DUP_G == 1
            __syncthreads(); if constexpr (MASK & 2) pg8::gemm_phase<pg8::EpiSwiGLU, pg8::StaticOrder, PG8_ALIGN, PG8_SP2>((PG8_LAS unsigned char*)lds, g, S, E);
#endif
        } else if (sub == 1 || sub == 6 || sub == 8) {
            const bf16* A = sub == 6 ? (const bf16*)(ws + WS_R + R_Y) : hid; const int K = sub == 6 ? D : FF;
            const bf16* Bt = (const bf16*)(wb + (sub == 1 ? W_D1 : (sub == 6 ? W_OUT : W_D2)));
            pg8::Gemm g{A, Bt, M, D, K}; pg8::StaticOrder S; S.init(M, D, G, (int)blockIdx.x);
            pg8::EpiResid E{a.out, xb, stats, sub == 6 ? 1.0f : 0.5f};
            if constexpr (MASK & 4) pg8::gemm_phase<pg8::EpiResid, pg8::StaticOrder, PG8_ALIGN, PG8_SP2>((PG8_LAS unsigned char*)lds, g, S, E);
#if defined(DBG_DUP_G) && DBG_DUP_G == 2
            __syncthreads(); { pg8::EpiResid E0{a.out, xb, stats, 0.0f}; if constexpr (MASK & 4) pg8::gemm_phase<pg8::EpiResid, pg8::StaticOrder, PG8_ALIGN, PG8_SP2>((PG8_LAS unsigned char*)lds, g, S, E0); }
#endif
        } else if (sub == 2) {
            pg8::Gemm g{xb, (const bf16*)(wb + W_IN), M, INW, D}; pg8::StaticOrder S; S.init(M, INW, G, (int)blockIdx.x);
            pg8::EpiProj E{(bf16*)(ws + WS_R + R_Q), (bf16*)(ws + WS_R + R_K), (bf16*)(ws + WS_R + R_V), (bf16*)(ws + WS_R + R_U5), (float*)(ws + WS_KMP), stats,
                           (const float*)(ws + WS_ROPEC), (const float*)(ws + WS_ROPES), a.in(I_QN) + L * 64, a.in(I_KN) + L * 64};
            if constexpr (MASK & 8) pg8::gemm_phase<pg8::EpiProj, pg8::StaticOrder, PG8_ALIGN, PG8_SP2>((PG8_LAS unsigned char*)lds, g, S, E);
#if defined(DBG_DUP_G) && DBG_DUP_G == 3
            __syncthreads(); if constexpr (MASK & 8) pg8::gemm_phase<pg8::EpiProj, pg8::StaticOrder, PG8_ALIGN, PG8_SP2>((PG8_LAS unsigned char*)lds, g, S, E);
#endif
        } else if (sub == 3) {
if constexpr (MASK & 16) { phase_t(a, L, lds, gw, NGW, wave, lane);
#if defined(DBG_DUP_SUB) && DBG_DUP_SUB == 3
 __syncthreads(); phase_t(a, L, lds, gw, NGW, wave, lane);
#endif
 }
 __syncthreads(); }
        else if (sub == 4) {
if constexpr (MASK & 32) { phase_a(a, L, lds, gw, NGW, tid, wave, lane);
#if defined(DBG_DUP_SUB) && DBG_DUP_SUB == 4
 __syncthreads(); phase_a(a, L, lds, gw, NGW, tid, wave, lane);
#endif
 }
 __syncthreads(); }
        else {
if constexpr (MASK & 64) { phase_c(a, L, gw, NGW, lane);
#if defined(DBG_DUP_SUB) && DBG_DUP_SUB == 5
 __syncthreads(); phase_c(a, L, gw, NGW, lane);
#endif
 }
 __syncthreads(); }
    }
}

#ifndef MK_MULTI
#define MK_MULTI 0
#endif
#ifndef DBG_NPH
#define DBG_NPH (1 + 9 * DEPTH)
#endif
constexpr int N_PHASES = DBG_NPH;
static int phase_mask(int ph) { if (ph == 0) return 1; const int sub = (ph - 1) % 9; const int m[9] = {2, 4, 8, 16, 32, 64, 4, 2, 4}; return m[sub]; }
template <int MASK> static bool setup_one(int& per_cu) {
    if (hipFuncSetAttribute((const void*)mk_fwd<MASK>, hipFuncAttributeMaxDynamicSharedMemorySize, LDS_BYTES) != hipSuccess) return false;
    if (hipOccupancyMaxActiveBlocksPerMultiprocessor(&per_cu, (const void*)mk_fwd<MASK>, NTHR, LDS_BYTES) != hipSuccess) per_cu = 1;
    (void)hipGetLastError(); return true;
}
template <int MASK> static void launch_one(const Args& a, int grid, hipStream_t stream) { hipLaunchKernelGGL(mk_fwd<MASK>, dim3(grid), dim3(NTHR), LDS_BYTES, stream, a); }
extern "C" void kernel_launch(void* const* d_in, const int* in_sizes, int n_in, void* d_out, int out_size, void* d_ws, size_t ws_size, hipStream_t stream) {
    static int grid = 0;
    if (grid == 0) {
        if (n_in != 18 || in_sizes[0] != M * D || out_size != M * D || ws_size < WS_END) { fprintf(stderr, "kernel_launch: unexpected shapes / workspace (n_in %d, ws %zu < %zu)\n", n_in, ws_size, (size_t)WS_END); grid = -1; return; }
        int dev = 0, cus = 0, per_cu = 0; bool ok = true;
        (void)hipGetDevice(&dev); (void)hipDeviceGetAttribute(&cus, hipDeviceAttributeMultiprocessorCount, dev);
#if MK_MULTI
        ok = setup_one<1>(per_cu) && setup_one<2>(per_cu) && setup_one<4>(per_cu) && setup_one<8>(per_cu) && setup_one<16>(per_cu) && setup_one<32>(per_cu) && setup_one<64>(per_cu);
#else
        ok = setup_one<127>(per_cu);
#endif
        if (!ok) { fprintf(stderr, "kernel_launch: hipFuncSetAttribute failed\n"); grid = -1; return; }
        grid = cus;
    }
    if (grid < 0) return;
    Args a{};
    for (int i = 0; i < 18; ++i) a.in[i] = (const float*)d_in[i];
    a.out = (float*)d_out; a.ws = (unsigned char*)d_ws;
#if MK_MULTI
    for (int ph = 0; ph < N_PHASES; ++ph) { a.ph_lo = ph; a.ph_hi = ph + 1;
        switch (phase_mask(ph)) { case 1: launch_one<1>(a, grid, stream); break; case 2: launch_one<2>(a, grid, stream); break; case 4: launch_one<4>(a, grid, stream); break; case 8: launch_one<8>(a, grid, stream); break;
                                  case 16: launch_one<16>(a, grid, stream); break; case 32: launch_one<32>(a, grid, stream); break; default: launch_one<64>(a, grid, stream); break; } }
#else
    a.ph_lo = 0; a.ph_hi = N_PHASES;
    void* args[] = {&a};
    hipError_t e = hipLaunchCooperativeKernel((const void*)mk_fwd<127>, dim3(grid), dim3(NTHR), args, LDS_BYTES, stream);
    if (e != hipSuccess) fprintf(stderr, "cooperative launch failed: %s (grid %d)\n", hipGetErrorString(e), grid);
#endif
}
```

```cpp
#include <hip/hip_runtime.h>
#include <hip/hip_cooperative_groups.h>
#include <cstdio>
#include <cstdint>
namespace cg = cooperative_groups;
#define MK_MULTI 0
namespace pg8 {
#define PG8_LAS __attribute__((address_space(3)))
typedef unsigned short bf16_t;
typedef short bf16x8 __attribute__((ext_vector_type(8)));
typedef float f32x4 __attribute__((ext_vector_type(4)));
typedef unsigned u32x4 __attribute__((ext_vector_type(4)));
constexpr int BM = 256, BK = 64, HALF = 128, HTB = HALF * BK * 2  , STAGE_BYTES = 8 * HTB, NXCD = 8, WGM = 8;

__host__ __device__ __forceinline__ int lds_byte(int r, int c) { const int st = (r >> 4) * 2 + (c >> 5), rr = r & 15, cc = c & 31, ob = rr * 64 + cc * 2; return st * 1024 + (ob ^ (((ob >> 9) & 1) << 5)); }
__host__ __device__ __forceinline__ void stage_rc(int b, int& R, int& C) { const int st = b / 1024, sb = b % 1024, swz = sb ^ (((sb >> 9) & 1) << 5); R = (st >> 1) * 16 + swz / 64; C = (st & 1) * 32 + (swz % 64) / 2; }
__host__ __device__ __forceinline__ int perm32(int rho) { const int n = rho >> 4, i = rho & 15; return 8 * (i >> 2) + 4 * n + (i & 3); }

struct Unit { int pm, pn; };
struct Gemm { const bf16_t* A; const bf16_t* Bt; int M, N, K; };

struct StaticOrder {
    int nM, nN, nwg, G, c;
    __host__ __device__ void init(int M, int N, int G_, int c_) { nM = M / BM; nN = N / BM; nwg = nM * nN; G = G_; c = c_; }
    __host__ __device__ bool next(int i, Unit& u) const {
        const long L = (long)i * G + c; if (L >= nwg) return false;
        int wgid = (int)L; { const int q = nwg / NXCD, r = nwg % NXCD, xcd = wgid % NXCD, off = wgid / NXCD; wgid = (xcd < r ? xcd * (q + 1) : r * (q + 1) + (xcd - r) * q) + off; }
        const int nig = WGM * nN, gid = wgid / nig, fm = gid * WGM, gsz = (nM - fm) < WGM ? (nM - fm) : WGM;
        u.pm = fm + ((wgid % nig) % gsz); u.pn = (wgid % nig) / gsz; return true;
    }
    __device__ __forceinline__ void a_ready(const Unit&) const {}
    __device__ __forceinline__ void done(const Unit&) const {}
};

__device__ __forceinline__ unsigned cvt_pk_bf16(float lo, float hi) { unsigned r; asm volatile("v_cvt_pk_bf16_f32 %0, %1, %2" : "=v"(r) : "v"(lo), "v"(hi)); return r; }
typedef float f32x2 __attribute__((ext_vector_type(2)));
typedef unsigned u32x2 __attribute__((ext_vector_type(2)));
typedef __bf16 bf16x2_t __attribute__((ext_vector_type(2)));
__device__ __forceinline__ unsigned cvtpk(float lo, float hi) { f32x2 v = {lo, hi}; bf16x2_t b = __builtin_convertvector(v, bf16x2_t); return __builtin_bit_cast(unsigned, b); }
__device__ __forceinline__ float row_rstd(const float* stats, int row) {
    const f32x4* p = (const f32x4*)(stats + (size_t)row * 16);
    const f32x4 a = p[0], b = p[1], c = p[2], d = p[3];
    const float s = ((a[0] + a[1]) + (a[2] + a[3])) + ((b[0] + b[1]) + (b[2] + b[3])) + ((c[0] + c[1]) + (c[2] + c[3])) + ((d[0] + d[1]) + (d[2] + d[3]));
    return rsqrtf(s * (1.0f / 1024.0f) + 1e-6f);
}
__device__ __forceinline__ void row_rstd4(const float* stats, int row0, float (&rs)[4]) {
    f32x4 p[4][4];
#pragma unroll
    for (int m = 0; m < 4; ++m)
#pragma unroll
        for (int k = 0; k < 4; ++k) p[m][k] = *(const f32x4*)(stats + (size_t)(row0 + 16 * m) * 16 + 4 * k);
#pragma unroll
    for (int m = 0; m < 4; ++m) { const f32x4 a = p[m][0], b = p[m][1], c = p[m][2], d = p[m][3];
        const float s = ((a[0] + a[1]) + (a[2] + a[3])) + ((b[0] + b[1]) + (b[2] + b[3])) + ((c[0] + c[1]) + (c[2] + c[3])) + ((d[0] + d[1]) + (d[2] + d[3]));
        rs[m] = rsqrtf(s * (1.0f / 1024.0f) + 1e-6f); }
}
__device__ __forceinline__ float silu_f(float g) { return g * __builtin_amdgcn_rcpf(1.0f + __expf(-g)); }

struct EpiSwiGLU {
    static constexpr bool PERM = true, AFTER_DRAIN = false;
    bf16_t* H; const float* stats; int ldh;
    __device__ __forceinline__ void operator()(const f32x4 (&acc)[2][2][4][2], const Unit& u, int wr, int wc, int fr, int fq) const {
        asm volatile("" : "+v"(fr), "+v"(fq));
        const int row0 = u.pm * BM + wr * 64 + fr, col0 = u.pn * HALF + wc * 32 + 8 * fq;
#pragma unroll
        for (int ai = 0; ai < 2; ++ai) {
            float rs4[4]; row_rstd4(stats, row0 + ai * HALF, rs4);
#pragma unroll
            for (int m = 0; m < 4; ++m) {
                const int row = row0 + ai * HALF + m * 16;
                const float rs = rs4[m];
                float h[8];
#pragma unroll
                for (int n = 0; n < 2; ++n)
#pragma unroll
                    for (int i = 0; i < 4; ++i) { const float g = acc[ai][0][m][n][i] * rs, up = acc[ai][1][m][n][i] * rs; h[4 * n + i] = silu_f(g) * up; }
                u32x4 w; w.x = cvtpk(h[0], h[1]); w.y = cvtpk(h[2], h[3]); w.z = cvtpk(h[4], h[5]); w.w = cvtpk(h[6], h[7]);
                *(u32x4*)(H + (size_t)row * ldh + col0) = w;
            }
        }
    }
};

struct EpiResid {
    static constexpr bool PERM = true, AFTER_DRAIN = false;
    float* X; bf16_t* XB; float* stats; float scale;
    __device__ __forceinline__ void operator()(const f32x4 (&acc)[2][2][4][2], const Unit& u, int wr, int wc, int fr, int fq) const {
        asm volatile("" : "+v"(fr), "+v"(fq));
        const int row0 = u.pm * BM + wr * 64 + fr, col0 = u.pn * BM + wc * 32 + 8 * fq;
#pragma unroll
        for (int ai = 0; ai < 2; ++ai) {
            f32x4 xr[4][2][2];
#pragma unroll
            for (int m = 0; m < 4; ++m)
#pragma unroll
                for (int bj = 0; bj < 2; ++bj) { const float* xp = X + (size_t)(row0 + ai * HALF + m * 16) * 1024 + col0 + bj * HALF; xr[m][bj][0] = *(const f32x4*)xp; xr[m][bj][1] = *(const f32x4*)(xp + 4); }
#pragma unroll
            for (int m = 0; m < 4; ++m) {
                const int row = row0 + ai * HALF + m * 16; float ss = 0.f;
#pragma unroll
                for (int bj = 0; bj < 2; ++bj) {
                    float* xp = X + (size_t)row * 1024 + col0 + bj * HALF;
                    f32x4 x0 = xr[m][bj][0], x1 = xr[m][bj][1];
                    x0 = x0 + acc[ai][bj][m][0] * scale; x1 = x1 + acc[ai][bj][m][1] * scale;
                    *(f32x4*)xp = x0; *(f32x4*)(xp + 4) = x1;
                    ss += (x0[0] * x0[0] + x0[1] * x0[1]) + (x0[2] * x0[2] + x0[3] * x0[3]) + (x1[0] * x1[0] + x1[1] * x1[1]) + (x1[2] * x1[2] + x1[3] * x1[3]);
                    u32x4 w; w.x = cvtpk(x0[0], x0[1]); w.y = cvtpk(x0[2], x0[3]); w.z = cvtpk(x1[0], x1[1]); w.w = cvtpk(x1[2], x1[3]);
                    *(u32x4*)(XB + (size_t)row * 1024 + col0 + bj * HALF) = w;
                }
                ss += __shfl_xor(ss, 16); ss += __shfl_xor(ss, 32);
                if (fq == 0) stats[(size_t)row * 16 + u.pn * 4 + wc] = ss;
            }
        }
    }
};

struct EpiProj {
    static constexpr bool PERM = true, AFTER_DRAIN = false;
    bf16_t* Q; bf16_t* Kb; bf16_t* Vb; bf16_t* U5; float* kmp; const float* stats; const float* ropeC; const float* ropeS; const float* qn; const float* kn;
    __device__ __forceinline__ void operator()(const f32x4 (&acc)[2][2][4][2], const Unit& u, int wr, int wc, int fr, int fq) const {
        asm volatile("" : "+v"(fr), "+v"(fq));
        const int row0 = u.pm * BM + wr * 64 + fr;
        const int pn = u.pn;
        if (pn >= 6) {
            bf16_t* O = U5 + (size_t)(pn - 6) * (16384 * 256);
            const int col0 = wc * 32 + 8 * fq;
#pragma unroll
            for (int ai = 0; ai < 2; ++ai)
#pragma unroll
                for (int m = 0; m < 4; ++m) {
                    const int row = row0 + ai * HALF + m * 16; const float rs = row_rstd(stats, row);
#pragma unroll
                    for (int bj = 0; bj < 2; ++bj) {
                        const f32x4 v0 = acc[ai][bj][m][0] * rs, v1 = acc[ai][bj][m][1] * rs;
                        u32x4 w; w.x = cvtpk(v0[0], v0[1]); w.y = cvtpk(v0[2], v0[3]); w.z = cvtpk(v1[0], v1[1]); w.w = cvtpk(v1[2], v1[3]);
                        *(u32x4*)(O + (size_t)row * 256 + col0 + bj * HALF) = w;
                    }
                }
            return;
        }
        const int head = (pn & 1) * 4 + wc, b = u.pm >> 5, j = u.pm & 31;
        const size_t bh = (size_t)(b * 8 + head);
        if (pn >= 4) {
            bf16_t* vb = Vb + (bh * 32 + j) * 16384;
#pragma unroll
            for (int ai = 0; ai < 2; ++ai)
#pragma unroll
                for (int m = 0; m < 4; ++m) {
                    const int row = row0 + ai * HALF + m * 16; const float rs = row_rstd(stats, row);
                    const int kk = ai * HALF + wr * 64 + m * 16 + fr;
                    const int kg = kk >> 5, w = kk & 31, st = w >> 4, w16 = w & 15, hh = (w16 >> 2) & 1, jj = 4 * (w16 >> 3) + (w16 & 3);
#pragma unroll
                    for (int bj = 0; bj < 2; ++bj)
#pragma unroll
                        for (int n = 0; n < 2; ++n) {
                            const unsigned p0 = cvtpk(acc[ai][bj][m][n][0] * rs, acc[ai][bj][m][n][1] * rs), p1 = cvtpk(acc[ai][bj][m][n][2] * rs, acc[ai][bj][m][n][3] * rs);
#pragma unroll
                            for (int i = 0; i < 4; ++i) {
                                const int r = 8 * fq + 4 * n + i;
                                const unsigned pv = (i < 2) ? p0 : p1;
                                vb[((((kg * 2 + st) * 2 + bj) * 32 + r) * 2 + hh) * 8 + jj] = (bf16_t)((i & 1) ? (pv >> 16) : (pv & 0xffffu));
                            }
                        }
                }
            return;
        }
        const bool isk = pn >= 2;
        const float* gn = isk ? kn : qn;
        float ksum[16];
#pragma unroll
        for (int e = 0; e < 16; ++e) ksum[e] = 0.f;
#pragma unroll
        for (int ai = 0; ai < 2; ++ai)
#pragma unroll
            for (int m = 0; m < 4; ++m) {
                const int row = row0 + ai * HALF + m * 16; const float rs = row_rstd(stats, row);
                const int t = row & 8191, kk = t & 255;
                float v0[8], v1[8]; float ss = 0.f;
#pragma unroll
                for (int n = 0; n < 2; ++n)
#pragma unroll
                    for (int i = 0; i < 4; ++i) { v0[4 * n + i] = acc[ai][0][m][n][i] * rs; v1[4 * n + i] = acc[ai][1][m][n][i] * rs; ss += v0[4 * n + i] * v0[4 * n + i] + v1[4 * n + i] * v1[4 * n + i]; }
                ss += __shfl_xor(ss, 16); ss += __shfl_xor(ss, 32);
                const float rn = rsqrtf(ss * (1.0f / 64.0f) + 1e-6f);
                const f32x4 c0 = *(const f32x4*)(ropeC + t * 32 + 8 * fq), c1 = *(const f32x4*)(ropeC + t * 32 + 8 * fq + 4);
                const f32x4 s0 = *(const f32x4*)(ropeS + t * 32 + 8 * fq), s1 = *(const f32x4*)(ropeS + t * 32 + 8 * fq + 4);
                const f32x4 ga0 = *(const f32x4*)(gn + 8 * fq), ga1 = *(const f32x4*)(gn + 8 * fq + 4), gb0 = *(const f32x4*)(gn + 32 + 8 * fq), gb1 = *(const f32x4*)(gn + 36 + 8 * fq);
                float o0[8], o1[8];
#pragma unroll
                for (int e = 0; e < 8; ++e) {
                    const float x1 = v0[e] * rn * (e < 4 ? ga0[e & 3] : ga1[e & 3]), x2 = v1[e] * rn * (e < 4 ? gb0[e & 3] : gb1[e & 3]);
                    const float cs = e < 4 ? c0[e & 3] : c1[e & 3], sn = e < 4 ? s0[e & 3] : s1[e & 3];
                    o0[e] = x1 * cs - x2 * sn; o1[e] = x2 * cs + x1 * sn;
                }
                u32x4 w0, w1;
                w0.x = cvtpk(o0[0], o0[1]); w0.y = cvtpk(o0[2], o0[3]); w0.z = cvtpk(o0[4], o0[5]); w0.w = cvtpk(o0[6], o0[7]);
                w1.x = cvtpk(o1[0], o1[1]); w1.y = cvtpk(o1[2], o1[3]); w1.z = cvtpk(o1[4], o1[5]); w1.w = cvtpk(o1[6], o1[7]);
                if (!isk) {
                    bf16_t* qp = Q + (bh * 8192 + t) * 64 + 8 * fq;
                    *(u32x4*)qp = w0; *(u32x4*)(qp + 32) = w1;
                } else {
                    bf16_t* kb = Kb + (bh * 32 + j) * 16384;
                    const int kg = kk >> 5, r = kk & 31, hq = fq & 1, ksl = fq >> 1;
                    *(u32x4*)(kb + (((kg * 4 + ksl) * 32 + r) * 2 + hq) * 8) = w0;
                    *(u32x4*)(kb + (((kg * 4 + 2 + ksl) * 32 + r) * 2 + hq) * 8) = w1;
#pragma unroll
                    for (int e = 0; e < 8; ++e) { ksum[e] += o0[e]; ksum[8 + e] += o1[e]; }
                }
                asm volatile("" ::: "memory");
            }
        if (isk) {
#pragma unroll
            for (int e = 0; e < 16; ++e) { float s = ksum[e]; s += __shfl_xor(s, 1); s += __shfl_xor(s, 2); s += __shfl_xor(s, 4); s += __shfl_xor(s, 8); ksum[e] = s; }
            if (fr == 0) {
                float* kp = kmp + ((size_t)(u.pm * 2 + wr) * 512) + head * 64 + 8 * fq;
                *(f32x4*)kp = (f32x4){ksum[0], ksum[1], ksum[2], ksum[3]}; *(f32x4*)(kp + 4) = (f32x4){ksum[4], ksum[5], ksum[6], ksum[7]};
                *(f32x4*)(kp + 32) = (f32x4){ksum[8], ksum[9], ksum[10], ksum[11]}; *(f32x4*)(kp + 36) = (f32x4){ksum[12], ksum[13], ksum[14], ksum[15]};
            }
        }
    }
};

template <class Epi, class Sched, bool ALIGN_EPI = false, bool SP2 = false>
__device__ __forceinline__ void gemm_phase(PG8_LAS unsigned char* lds, const Gemm g, const Sched& S, const Epi& E) {
    int tid_v = threadIdx.x; asm volatile("" : "+v"(tid_v));
    const int tid = tid_v, wid = __builtin_amdgcn_readfirstlane(tid >> 6), lane = tid & 63, wr = wid >> 2, wc = wid & 3, fr = lane & 15, fq = lane >> 4;
    const int K = g.K, nt = K / BK;
    unsigned voffA[2], voffB[2];
#pragma unroll
    for (int i = 0; i < 2; ++i) { int R, C; stage_rc(tid * 16 + i * 8192, R, C); const int Rb = Epi::PERM ? ((R & ~31) + perm32(R & 31)) : R;
        voffA[i] = (unsigned)(R * K + C) * 2u; voffB[i] = (unsigned)(Rb * K + C) * 2u; }
    const size_t kstep = (size_t)(BK * 2);
    const size_t hstep = (size_t)HALF * K * 2;
    const size_t tstep = 2 * hstep;
    const unsigned ldsw = (unsigned)wid * 1024u;
    const int aoff = lds_byte(wr * 64 + fr, fq * 8), boff = lds_byte(wc * 32 + fr, fq * 8);
#define PG8_SA(b, h) (((b) * 2 + (h)) * HTB)
#define PG8_SB(b, h) ((4 + (b) * 2 + (h)) * HTB)
#define PG8_STAGE(bufoff, gbase, voff) do { _Pragma("unroll") for (int _i = 0; _i < 2; ++_i) \
        __builtin_amdgcn_global_load_lds((const unsigned*)((const char*)(gbase) + (voff)[_i]), (PG8_LAS unsigned*)(lds + (bufoff) + ldsw + _i * 8192), 16, 0, 0); } while (0)
#define PG8_LDA(dst, b, h) do { _Pragma("unroll") for (int m = 0; m < 4; ++m) _Pragma("unroll") for (int k = 0; k < 2; ++k) dst[m][k] = *(const PG8_LAS bf16x8*)(lds + PG8_SA(b, h) + aoff + m * 2048 + k * 1024); } while (0)
#define PG8_LDB(dst, b, h) do { _Pragma("unroll") for (int n = 0; n < 2; ++n) _Pragma("unroll") for (int k = 0; k < 2; ++k) dst[n][k] = *(const PG8_LAS bf16x8*)(lds + PG8_SB(b, h) + boff + n * 2048 + k * 1024); } while (0)
#define PG8_MMA(ai, bj, At, Bt) do { __builtin_amdgcn_s_setprio(1); _Pragma("unroll") for (int m = 0; m < 4; ++m) _Pragma("unroll") for (int n = 0; n < 2; ++n) _Pragma("unroll") for (int k = 0; k < 2; ++k) \
        acc[ai][bj][m][n] = __builtin_amdgcn_mfma_f32_16x16x32_bf16(Bt[n][k], At[m][k], acc[ai][bj][m][n], 0, 0, 0); __builtin_amdgcn_s_setprio(0); } while (0)
#define PG8_WAIT_V(n) asm volatile("s_waitcnt vmcnt(" #n ")" ::: "memory")
#define PG8_WAIT_L(n) asm volatile("s_waitcnt lgkmcnt(" #n ")" ::: "memory")
#define PG8_BAR __builtin_amdgcn_s_barrier()
#define PG8_SCHED __builtin_amdgcn_sched_barrier(0)
    Unit cur, nxt; int ui = 0;
    if (!S.next(0, cur)) return;
    f32x4 acc[2][2][4][2];
#pragma unroll
    for (int a = 0; a < 2; ++a)
#pragma unroll
        for (int b = 0; b < 2; ++b)
#pragma unroll
            for (int m = 0; m < 4; ++m)
#pragma unroll
                for (int n = 0; n < 2; ++n) acc[a][b][m][n] = (f32x4){0.f, 0.f, 0.f, 0.f};
    bf16x8 At[4][2], B0[2][2], B1[2][2];
    const char* cA = (const char*)g.A + (size_t)cur.pm * tstep; const char* cB = (const char*)g.Bt + (size_t)cur.pn * tstep;
    S.a_ready(cur);
    if constexpr (SP2) {
        PG8_STAGE(PG8_SB(0, 0), cB, voffB); PG8_STAGE(PG8_SB(0, 1), cB + hstep, voffB); PG8_STAGE(PG8_SA(0, 0), cA, voffA); PG8_STAGE(PG8_SA(0, 1), cA + hstep, voffA);
        if (wr == 1) PG8_BAR;
        PG8_WAIT_V(2); PG8_BAR;
        PG8_STAGE(PG8_SB(1, 0), cB + kstep, voffB); PG8_STAGE(PG8_SA(1, 0), cA + kstep, voffA); PG8_STAGE(PG8_SB(1, 1), cB + hstep + kstep, voffB);
        PG8_WAIT_V(6); PG8_BAR;
    } else {
        PG8_STAGE(PG8_SB(0, 0), cB, voffB); PG8_STAGE(PG8_SA(0, 0), cA, voffA); PG8_STAGE(PG8_SB(0, 1), cB + hstep, voffB); PG8_STAGE(PG8_SA(0, 1), cA + hstep, voffA);
        if (wr == 1) PG8_BAR;
        PG8_WAIT_V(4); PG8_BAR;
        PG8_STAGE(PG8_SB(1, 0), cB + kstep, voffB); PG8_STAGE(PG8_SA(1, 0), cA + kstep, voffA); PG8_STAGE(PG8_SB(1, 1), cB + hstep + kstep, voffB);
        PG8_WAIT_V(6); PG8_BAR;
    }
    for (;;) {
        const bool has_next = S.next(ui + 1, nxt);
        const char* nA = has_next ? (const char*)g.A + (size_t)nxt.pm * tstep : cA; const char* nB = has_next ? (const char*)g.Bt + (size_t)nxt.pn * tstep : cB;
        for (int t = 0; t < nt; t += 2) {
            const bool last = (t == nt - 2);
            const char* a1 = cA + (size_t)(t + 1) * kstep;
            const char* a2 = last ? nA : cA + (size_t)(t + 2) * kstep; const char* b2 = last ? nB : cB + (size_t)(t + 2) * kstep;
            const char* a3 = a2 + kstep; const char* b3 = b2 + kstep;
            if (last && has_next) S.a_ready(nxt);
            if constexpr (SP2) {
            PG8_LDB(B0, 0, 0); PG8_LDB(B1, 0, 1); PG8_SCHED; PG8_LDA(At, 0, 0); PG8_STAGE(PG8_SA(1, 1), a1 + hstep, voffA);
            PG8_WAIT_V(8); PG8_WAIT_L(0); PG8_BAR; PG8_MMA(0, 0, At, B0); PG8_MMA(0, 1, At, B1); PG8_BAR; PG8_SCHED;
            PG8_LDA(At, 0, 1); PG8_STAGE(PG8_SB(0, 0), b2, voffB); PG8_STAGE(PG8_SB(0, 1), b2 + hstep, voffB); PG8_STAGE(PG8_SA(0, 0), a2, voffA);
            PG8_WAIT_V(8); PG8_WAIT_L(0); PG8_BAR; PG8_MMA(1, 0, At, B0); PG8_MMA(1, 1, At, B1); PG8_BAR; PG8_SCHED;
            PG8_LDB(B0, 1, 0); PG8_LDB(B1, 1, 1); PG8_SCHED; PG8_LDA(At, 1, 0); PG8_STAGE(PG8_SA(0, 1), a2 + hstep, voffA);
            PG8_WAIT_V(8); PG8_WAIT_L(0); PG8_BAR; PG8_MMA(0, 0, At, B0); PG8_MMA(0, 1, At, B1); PG8_BAR; PG8_SCHED;
            PG8_LDA(At, 1, 1); PG8_STAGE(PG8_SB(1, 0), b3, voffB); PG8_STAGE(PG8_SB(1, 1), b3 + hstep, voffB); PG8_STAGE(PG8_SA(1, 0), a3, voffA);
            PG8_WAIT_V(8); PG8_WAIT_L(0); PG8_BAR; PG8_MMA(1, 0, At, B0); PG8_MMA(1, 1, At, B1); PG8_BAR; PG8_SCHED;
            } else {
            PG8_LDB(B0, 0, 0); PG8_SCHED; PG8_LDA(At, 0, 0); PG8_STAGE(PG8_SA(1, 1), a1 + hstep, voffA);
            PG8_WAIT_L(8); PG8_BAR; PG8_WAIT_L(0); PG8_MMA(0, 0, At, B0); PG8_BAR; PG8_SCHED;
            PG8_LDB(B1, 0, 1); PG8_STAGE(PG8_SB(0, 0), b2, voffB);
            PG8_BAR; PG8_WAIT_L(0); PG8_MMA(0, 1, At, B1); PG8_BAR;
            PG8_LDA(At, 0, 1); PG8_STAGE(PG8_SA(0, 0), a2, voffA);
            PG8_BAR; PG8_WAIT_L(0); PG8_MMA(1, 0, At, B0); PG8_BAR; PG8_SCHED;
            PG8_STAGE(PG8_SB(0, 1), b2 + hstep, voffB);
            PG8_WAIT_V(6); PG8_BAR; PG8_MMA(1, 1, At, B1); PG8_BAR;
            PG8_LDB(B0, 1, 0); PG8_SCHED; PG8_LDA(At, 1, 0); PG8_STAGE(PG8_SA(0, 1), a2 + hstep, voffA);
            PG8_WAIT_L(8); PG8_BAR; PG8_WAIT_L(0); PG8_MMA(0, 0, At, B0); PG8_BAR; PG8_SCHED;
            PG8_LDB(B1, 1, 1); PG8_STAGE(PG8_SB(1, 0), b3, voffB);
            PG8_BAR; PG8_WAIT_L(0); PG8_MMA(0, 1, At, B1); PG8_BAR;
            PG8_LDA(At, 1, 1); PG8_STAGE(PG8_SA(1, 0), a3, voffA);
            PG8_BAR; PG8_WAIT_L(0); PG8_MMA(1, 0, At, B0); PG8_BAR; PG8_SCHED;
            PG8_STAGE(PG8_SB(1, 1), b3 + hstep, voffB);
            PG8_WAIT_V(6); PG8_BAR; PG8_MMA(1, 1, At, B1); PG8_BAR;
            }
        }
        if constexpr (ALIGN_EPI) { if (wr == 0) PG8_BAR; }
        if constexpr (!Epi::AFTER_DRAIN) { E(acc, cur, wr, wc, fr, fq); S.done(cur); }
        if (!has_next) break;
#pragma unroll
        for (int a = 0; a < 2; ++a)
#pragma unroll
            for (int b = 0; b < 2; ++b)
#pragma unroll
                for (int m = 0; m < 4; ++m)
#pragma unroll
                    for (int n = 0; n < 2; ++n) acc[a][b][m][n] = (f32x4){0.f, 0.f, 0.f, 0.f};
        cur = nxt; cA = nA; cB = nB; ++ui;
        if constexpr (ALIGN_EPI) { if (wr == 1) PG8_BAR; }
    }
    PG8_WAIT_V(0);
    if constexpr (!ALIGN_EPI) { if (wr == 0) PG8_BAR; }
    PG8_BAR;
    if constexpr (Epi::AFTER_DRAIN) { E.fused(acc, cur, wr, wc, fr, fq, lds, wid, lane); S.done(cur); }
#undef PG8_SA
#undef PG8_SB
#undef PG8_STAGE
#undef PG8_LDA
#undef PG8_LDB
#undef PG8_MMA
#undef PG8_WAIT_V
#undef PG8_WAIT_L
#undef PG8_BAR
#undef PG8_SCHED
}
}

#ifndef PG8_SP2
#define PG8_SP2 true
#endif
#ifndef PG8_ALIGN
#define PG8_ALIGN true
#endif

#define DI __device__ __forceinline__
typedef unsigned short bf16;
typedef short bf16x8 __attribute__((ext_vector_type(8)));
typedef float f32x4 __attribute__((ext_vector_type(4)));
typedef float f32x16 __attribute__((ext_vector_type(16)));
typedef unsigned u32x4 __attribute__((ext_vector_type(4)));
typedef unsigned u32x2 __attribute__((ext_vector_type(2)));
#define MFMA32(a, b, c) __builtin_amdgcn_mfma_f32_32x32x16_bf16((a), (b), (c), 0, 0, 0)

constexpr int NWAVES = 8, NTHR = 512;
constexpr int M = 16384, D = 1024, FF = 2816, INW = 2816, SEQ = 8192, DEPTH = 4;
constexpr int LDS_BYTES = 147456;
constexpr size_t MiB = 1u << 20;
constexpr size_t WS_CTL = 0;
constexpr size_t WS_STATS = 1 * MiB;
constexpr size_t WS_KMP = 2 * MiB;
constexpr size_t WS_DEC = 2 * MiB + 512 * 1024;
constexpr size_t WS_ROPEC = 3 * MiB, WS_ROPES = 4 * MiB;
constexpr size_t WS_W = 5 * MiB, WSZ = 42467328;
constexpr size_t W_GU1 = 0, W_D1 = 11534336, W_IN = 17301504, W_OUT = 23068672, W_GU2 = 25165824, W_D2 = 36700160;
constexpr size_t WS_XB = 86 * MiB;
constexpr size_t WS_R = 118 * MiB;
constexpr size_t R_HID = 0;
constexpr size_t R_Q = 0, R_K = 16 * MiB, R_V = 32 * MiB, R_U5 = 48 * MiB  , R_Y = 88 * MiB, R_PO = 120 * MiB, R_PML = 168 * MiB,
                 R_LIST = 172 * MiB  , R_ALOC = 188 * MiB, R_OINTRA = 204 * MiB, R_QDEC = 220 * MiB, R_SP = 228 * MiB, R_END = 236 * MiB;
constexpr size_t WS_END = WS_R + R_END;

DI float bf2f(unsigned short b) { return __uint_as_float((unsigned)b << 16); }
DI unsigned cvtpk(float lo, float hi) { return pg8::cvtpk(lo, hi); }
DI float wave_sum(float v) {
#pragma unroll
    for (int o = 1; o < 64; o <<= 1) v += __shfl_xor(v, o);
    return v;
}
DI void st_sc1(unsigned* p, unsigned v) { __hip_atomic_store(p, v, __ATOMIC_RELAXED, __HIP_MEMORY_SCOPE_AGENT); }
DI unsigned ld_sc1(const unsigned* p) { return __hip_atomic_load(p, __ATOMIC_RELAXED, __HIP_MEMORY_SCOPE_AGENT); }
DI float ld_sc1f(const float* p) { return __uint_as_float(__hip_atomic_load((const unsigned*)p, __ATOMIC_RELAXED, __HIP_MEMORY_SCOPE_AGENT)); }
DI int crow(int reg, int h) { return (reg & 3) + 8 * (reg >> 2) + 4 * h; }
DI bf16x8 pack8(const f32x16& x, int s) {
    u32x4 p; p.x = cvtpk(x[8 * s], x[8 * s + 1]); p.y = cvtpk(x[8 * s + 2], x[8 * s + 3]); p.z = cvtpk(x[8 * s + 4], x[8 * s + 5]); p.w = cvtpk(x[8 * s + 6], x[8 * s + 7]);
    return __builtin_bit_cast(bf16x8, p);
}
DI f32x16 zero16() { f32x16 z;
#pragma unroll
    for (int i = 0; i < 16; ++i) z[i] = 0.f; return z; }

struct Args { const float* in[18]; float* out; unsigned char* ws; int ph_lo, ph_hi; };
typedef const float* cfp_t;
typedef const __attribute__((address_space(4))) unsigned char* kptr_t;
struct Ctx { kptr_t kp; unsigned char* ws; float* out;
    DI const float* in(int i) const { return *(const __attribute__((address_space(4))) cfp_t*)(kp + 8 * i); } };
enum { I_X = 0, I_F1N, I_F1G, I_F1U, I_F1D, I_MIXN, I_WIN, I_QN, I_KN, I_PW, I_PS, I_LB, I_HON, I_WOUT, I_F2N, I_F2G, I_F2U, I_F2D };

DI void wconv_tile(const float* W, int ld, int srccol, const float* gain, bf16* WT, int K, int nrow0, int k0, float* scr, int lane) {
    asm volatile("" : "+v"(lane));
    const int c4 = (lane & 7) * 4, kr = lane >> 3;
    f32x4 v[8]; float gv[8];
#pragma unroll
    for (int i = 0; i < 8; ++i) { v[i] = *(const f32x4*)(W + (size_t)(k0 + 8 * i + kr) * ld + srccol + c4); gv[i] = gain ? gain[k0 + 8 * i + kr] : 1.0f; }
#pragma unroll
    for (int i = 0; i < 8; ++i) { float* d = scr + (8 * i + kr) * 33 + c4; d[0] = v[i][0] * gv[i]; d[1] = v[i][1] * gv[i]; d[2] = v[i][2] * gv[i]; d[3] = v[i][3] * gv[i]; }
    asm volatile("s_waitcnt lgkmcnt(0)" ::: "memory");
    const int c = lane & 7;
#pragma unroll
    for (int j = 0; j < 4; ++j) { const int n = (lane >> 3) + 8 * j; const float* s = scr + (8 * c) * 33 + n;
        u32x4 o; o.x = cvtpk(s[0 * 33], s[1 * 33]); o.y = cvtpk(s[2 * 33], s[3 * 33]); o.z = cvtpk(s[4 * 33], s[5 * 33]); o.w = cvtpk(s[6 * 33], s[7 * 33]);
        *(u32x4*)(WT + (size_t)(nrow0 + n) * K + k0 + 8 * c) = o; }
    asm volatile("s_waitcnt lgkmcnt(0)" ::: "memory");
}
constexpr int WC_I0 = 2816, WC_I1 = 1408, WC_I2 = 1408, WC_I3 = 512, WC_I4 = 2816, WC_I5 = 1408, WC_ITEMS = WC_I0 + WC_I1 + WC_I2 + WC_I3 + WC_I4 + WC_I5;
DI void wconv_item(const Ctx& a, int L, int item, float* scr, int lane) {
    unsigned char* wb = a.ws + WS_W + (size_t)(L & 1) * WSZ;
    int r = item;
    if (r < WC_I0 || (r >= WC_I0 + WC_I1 + WC_I2 + WC_I3 && r < WC_I0 + WC_I1 + WC_I2 + WC_I3 + WC_I4)) {
        const bool second = r >= WC_I0; if (second) r -= WC_I0 + WC_I1 + WC_I2 + WC_I3;
        const int kb = r / 176, nb = r % 176, n0 = nb * 32, pn = n0 >> 8, c = n0 & 255, bj = c >> 7, col = 128 * pn + (c & 127);
        const float* src = a.in(second ? (bj ? I_F2U : I_F2G) : (bj ? I_F1U : I_F1G)) + (size_t)L * D * FF;
        const float* gain = a.in(second ? I_F2N : I_F1N) + L * D;
        wconv_tile(src, FF, col, gain, (bf16*)(wb + (second ? W_GU2 : W_GU1)), D, n0, kb * 64, scr, lane); return;
    }
    r -= WC_I0;
    if (r < WC_I1) { const int kb = r / 32, nb = r % 32; wconv_tile(a.in(I_F1D) + (size_t)L * FF * D, D, nb * 32, nullptr, (bf16*)(wb + W_D1), FF, nb * 32, kb * 64, scr, lane); return; }
    r -= WC_I1;
    if (r < WC_I2) { const int kb = r / 88, nb = r % 88, n0 = nb * 32, pn = n0 >> 8, c = n0 & 255;
        const int col = pn < 6 ? (pn >> 1) * 512 + 64 * ((pn & 1) * 4 + ((c >> 5) & 3)) + 32 * (c >> 7) : n0;
        wconv_tile(a.in(I_WIN) + (size_t)L * D * INW, INW, col, a.in(I_MIXN) + L * D, (bf16*)(wb + W_IN), D, n0, kb * 64, scr, lane); return; }
    r -= WC_I2;
    if (r < WC_I3) { const int kb = r / 32, nb = r % 32; wconv_tile(a.in(I_WOUT) + (size_t)L * D * D, D, nb * 32, nullptr, (bf16*)(wb + W_OUT), D, nb * 32, kb * 64, scr, lane); return; }
    r -= WC_I3 + WC_I4;
    { const int kb = r / 32, nb = r % 32; wconv_tile(a.in(I_F2D) + (size_t)L * FF * D, D, nb * 32, nullptr, (bf16*)(wb + W_D2), FF, nb * 32, kb * 64, scr, lane); }
}

DI void phase_p0(const Ctx& a, unsigned char* lds, int gw, int NGW, int wave, int lane) {
    const float* x = a.in(I_X); float* out = a.out; bf16* xb = (bf16*)(a.ws + WS_XB); float* stats = (float*)(a.ws + WS_STATS);
    for (int m0 = gw * 2; m0 < M; m0 += NGW * 2) {
        f32x4 v[2][4]; float sq[2];
#pragma unroll
        for (int k = 0; k < 2; ++k) { const f32x4* xr = (const f32x4*)(x + (size_t)(m0 + k) * D) + lane;
#pragma unroll
            for (int j = 0; j < 4; ++j) v[k][j] = xr[64 * j]; }
#pragma unroll
        for (int k = 0; k < 2; ++k) { float s = 0.f;
#pragma unroll
            for (int j = 0; j < 4; ++j) s += (v[k][j][0] * v[k][j][0] + v[k][j][1] * v[k][j][1]) + (v[k][j][2] * v[k][j][2] + v[k][j][3] * v[k][j][3]);
            sq[k] = wave_sum(s); }
#pragma unroll
        for (int k = 0; k < 2; ++k) { const int m = m0 + k;
            f32x4* orow = (f32x4*)(out + (size_t)m * D) + lane; u32x2* brow = (u32x2*)(xb + (size_t)m * D) + lane;
#pragma unroll
            for (int j = 0; j < 4; ++j) { orow[64 * j] = v[k][j]; u32x2 w; w.x = cvtpk(v[k][j][0], v[k][j][1]); w.y = cvtpk(v[k][j][2], v[k][j][3]); brow[64 * j] = w; }
            if (lane < 16) stats[(size_t)m * 16 + lane] = (lane == 0) ? sq[k] : 0.f; }
    }
    { unsigned* cz = (unsigned*)(a.ws + WS_CTL + 65536); for (int i = gw * 64 + lane; i < 3456; i += NGW * 64) cz[i] = 0u; }
    float* rc = (float*)(a.ws + WS_ROPEC); float* rs = (float*)(a.ws + WS_ROPES);
    for (int e = gw * 64 + lane; e < SEQ * 32; e += NGW * 64) {
        const int t = e >> 5, i = e & 31;
        double c = 0.15915494309189535;
        for (int k = 0; k < i; ++k) c *= 0.74989420933245582;
        const float chi = (float)c, clo = (float)(c - (double)chi), tf = (float)t;
        const float p = tf * chi, pe = fmaf(tf, chi, -p);
        float fr = __builtin_amdgcn_fractf(p) + (pe + tf * clo);
        rc[e] = __builtin_amdgcn_cosf(fr); rs[e] = __builtin_amdgcn_sinf(fr);
    }
    float* scr = (float*)(lds + wave * 16384);
    for (int it = gw; it < WC_ITEMS; it += NGW) wconv_item(a, 0, it, scr, lane);
}

template <bool DIAG>
DI void attn_core(const bf16* qrow, const bf16* kblk, const bf16* vblk, int nkg, int r, int h, float& m_out, float& l_out, f32x16 (&ot)[2]) {
    bf16x8 qf[4];
#pragma unroll
    for (int ks = 0; ks < 4; ++ks) qf[ks] = *(const bf16x8*)(qrow + 16 * ks + 8 * h);
    f32x16 st[8];
    const int lo = (r * 2 + h) * 8;
#pragma unroll
    for (int hf = 0; hf < 2; ++hf) {
        if (!DIAG || 4 * hf < nkg) {
            bf16x8 kf[16];
#pragma unroll
            for (int i = 0; i < 16; ++i) kf[i] = (!DIAG || 4 * hf + (i >> 2) < nkg) ? *(const bf16x8*)(kblk + ((4 * hf + (i >> 2)) * 4 + (i & 3)) * 512 + lo) : qf[0];
#pragma unroll
            for (int g = 0; g < 4; ++g) {
                const int kg = 4 * hf + g;
                f32x16 acc = zero16();
                if (!DIAG || kg < nkg) {
#pragma unroll
                    for (int ks = 0; ks < 4; ++ks) acc = MFMA32(kf[4 * g + ks], qf[ks], acc);
                    if (DIAG && kg == nkg - 1) {
#pragma unroll
                        for (int i = 0; i < 16; ++i) if (crow(i, h) > r) acc[i] = -INFINITY;
                    }
                } else {
#pragma unroll
                    for (int i = 0; i < 16; ++i) acc[i] = -INFINITY;
                }
                st[kg] = acc;
            }
        } else {
#pragma unroll
            for (int g = 0; g < 4; ++g)
#pragma unroll
                for (int i = 0; i < 16; ++i) st[4 * hf + g][i] = -INFINITY;
        }
    }
    float mx = -INFINITY;
#pragma unroll
    for (int kg = 0; kg < 8; ++kg)
#pragma unroll
        for (int i = 0; i < 16; ++i) mx = fmaxf(mx, st[kg][i]);
    mx = fmaxf(mx, __shfl_xor(mx, 32));
    const float c = 0.125f * 1.4426950408889634f; const float mc = mx * c;
    float l = 0.f;
#pragma unroll
    for (int kg = 0; kg < 8; ++kg)
#pragma unroll
        for (int i = 0; i < 16; ++i) { const float p = __builtin_amdgcn_exp2f(st[kg][i] * c - mc); st[kg][i] = p; l += p; }
    l += __shfl_xor(l, 32);
    ot[0] = zero16(); ot[1] = zero16();
#pragma unroll
    for (int pr = 0; pr < 4; ++pr) {
        if (!DIAG || 2 * pr < nkg) {
            bf16x8 vf[8];
#pragma unroll
            for (int i = 0; i < 8; ++i) vf[i] = (!DIAG || 2 * pr + (i >> 2) < nkg) ? *(const bf16x8*)(vblk + (((2 * pr + (i >> 2)) * 2 + ((i >> 1) & 1)) * 2 + (i & 1)) * 512 + lo) : qf[0];
#pragma unroll
            for (int g = 0; g < 2; ++g) {
                const int kg = 2 * pr + g;
                if (!DIAG || kg < nkg) {
#pragma unroll
                    for (int s2 = 0; s2 < 2; ++s2) { const bf16x8 pf = pack8(st[kg], s2); ot[0] = MFMA32(vf[4 * g + 2 * s2], pf, ot[0]); ot[1] = MFMA32(vf[4 * g + 2 * s2 + 1], pf, ot[1]); }
                }
            }
        }
    }
    m_out = mx * 0.125f; l_out = l;
}

DI void topk_unit(const Ctx& a, int L, int unit, int lane) {
    asm volatile("" : "+v"(lane));
    const int b = unit >> 10, hd = (unit >> 7) & 7, c = unit & 127, own = c >> 2;
    if (own == 0) return;
    const bf16* Q = (const bf16*)(a.ws + WS_R + R_Q); const float* kmp = (const float*)(a.ws + WS_KMP);
    unsigned* cnt = (unsigned*)(a.ws + WS_CTL) + L * 512; unsigned* lists = (unsigned*)(a.ws + WS_R + R_LIST);
    const int t = c * 64 + lane; const size_t bh = (size_t)(b * 8 + hd);
    float q[64];
    { const u32x4* qp = (const u32x4*)(Q + (bh * SEQ + t) * 64);
#pragma unroll
      for (int i = 0; i < 8; ++i) { const u32x4 w = qp[i];
          q[8 * i + 0] = __uint_as_float(w.x << 16); q[8 * i + 1] = __uint_as_float(w.x & 0xffff0000u); q[8 * i + 2] = __uint_as_float(w.y << 16); q[8 * i + 3] = __uint_as_float(w.y & 0xffff0000u);
          q[8 * i + 4] = __uint_as_float(w.z << 16); q[8 * i + 5] = __uint_as_float(w.z & 0xffff0000u); q[8 * i + 6] = __uint_as_float(w.w << 16); q[8 * i + 7] = __uint_as_float(w.w & 0xffff0000u); } }
    float g0 = -INFINITY, g1 = -INFINITY, g2 = -INFINITY; int i0 = 0, i1 = 0, i2 = 0;
    for (int j = 0; j < own; ++j) {
        const float* p0 = kmp + (size_t)((b * 32 + j) * 2) * 512 + hd * 64; const float* p1 = p0 + 512;
        float g = 0.f;
#pragma unroll
        for (int d = 0; d < 64; d += 4) { const f32x4 x0 = *(const f32x4*)(p0 + d), x1 = *(const f32x4*)(p1 + d);
            g += q[d] * (x0[0] + x1[0]) + q[d + 1] * (x0[1] + x1[1]) + q[d + 2] * (x0[2] + x1[2]) + q[d + 3] * (x0[3] + x1[3]); }
#ifdef DBG_FIXED_SEL
        g = -(float)j;
#endif
        if (g > g0) { g2 = g1; i2 = i1; g1 = g0; i1 = i0; g0 = g; i0 = j; }
        else if (g > g1) { g2 = g1; i2 = i1; g1 = g; i1 = j; }
        else if (g > g2) { g2 = g; i2 = j; }
    }
    const int nsel = own < 3 ? own : 3;
#pragma unroll
    for (int s = 0; s < 3; ++s) {
        if (s < nsel) { const int j = s == 0 ? i0 : (s == 1 ? i1 : i2); const int li = (int)bh * 32 + j;
            const unsigned pos = atomicAdd(cnt + li, 1u); st_sc1(lists + (size_t)li * 8192 + pos, (unsigned)(t | (s << 13))); }
    }
}

DI void pool_unit(const Ctx& a, int L, int unit, int lane) {
    asm volatile("" : "+v"(lane));
    const int tile = unit >> 2, g = unit & 3, w = 2 << g, r = lane & 31, h = lane >> 5;
    const bf16* U = (const bf16*)(a.ws + WS_R + R_U5); bf16* Y = (bf16*)(a.ws + WS_R + R_Y);
    const float* pw = a.in(I_PW) + (size_t)(L * 4 + g) * 4096; const float* ps = a.in(I_PS) + L * 256 + g * 64;
    const float* pwl = pw + (8 * h) * 64 + r;
    bf16x8 wf[2][4];
#pragma unroll
    for (int me = 0; me < 2; ++me)
#pragma unroll
        for (int ks = 0; ks < 4; ++ks) { float f[8];
#pragma unroll
            for (int j = 0; j < 8; ++j) f[j] = pwl[(16 * ks + j) * 64 + 32 * me];
            u32x4 p; p.x = cvtpk(f[0], f[1]); p.y = cvtpk(f[2], f[3]); p.z = cvtpk(f[4], f[5]); p.w = cvtpk(f[6], f[7]); wf[me][ks] = __builtin_bit_cast(bf16x8, p); }
#pragma unroll 1
    for (int nt = 0; nt < 4; ++nt) {
        const int m = tile * 128 + nt * 32 + r, tpos = m & (SEQ - 1);
        const int cntw = tpos + 1 < w ? tpos + 1 : w; const float invc = 1.0f / (float)cntw;
        f32x16 acc[2]; acc[0] = zero16(); acc[1] = zero16();
#pragma unroll
        for (int ks = 0; ks < 4; ++ks) {
            const bf16* up = U + (size_t)m * 256 + g * 64 + 16 * ks + 8 * h;
            float sum[8], self[8];
            { const u32x4 wv = *(const u32x4*)up;
              self[0] = __uint_as_float(wv.x << 16); self[1] = __uint_as_float(wv.x & 0xffff0000u); self[2] = __uint_as_float(wv.y << 16); self[3] = __uint_as_float(wv.y & 0xffff0000u);
              self[4] = __uint_as_float(wv.z << 16); self[5] = __uint_as_float(wv.z & 0xffff0000u); self[6] = __uint_as_float(wv.w << 16); self[7] = __uint_as_float(wv.w & 0xffff0000u); }
#pragma unroll
            for (int j = 0; j < 8; ++j) sum[j] = self[j];
            u32x4 rows[15];
#pragma unroll
            for (int i = 1; i < 16; ++i) { const bool ok = (i < w) && (i <= tpos); rows[i - 1] = *(const u32x4*)(up - (size_t)(ok ? i : 0) * 256); }
#pragma unroll
            for (int i = 1; i < 16; ++i) { const bool ok = (i < w) && (i <= tpos); const float kf = ok ? 1.f : 0.f; const u32x4 wv = rows[i - 1];
                sum[0] += kf * __uint_as_float(wv.x << 16); sum[1] += kf * __uint_as_float(wv.x & 0xffff0000u); sum[2] += kf * __uint_as_float(wv.y << 16); sum[3] += kf * __uint_as_float(wv.y & 0xffff0000u);
                sum[4] += kf * __uint_as_float(wv.z << 16); sum[5] += kf * __uint_as_float(wv.z & 0xffff0000u); sum[6] += kf * __uint_as_float(wv.w << 16); sum[7] += kf * __uint_as_float(wv.w & 0xffff0000u); }
            u32x4 p; p.x = cvtpk(sum[0] * invc - self[0], sum[1] * invc - self[1]); p.y = cvtpk(sum[2] * invc - self[2], sum[3] * invc - self[3]);
            p.z = cvtpk(sum[4] * invc - self[4], sum[5] * invc - self[5]); p.w = cvtpk(sum[6] * invc - self[6], sum[7] * invc - self[7]);
            const bf16x8 df = __builtin_bit_cast(bf16x8, p);
            acc[0] = MFMA32(wf[0][ks], df, acc[0]); acc[1] = MFMA32(wf[1][ks], df, acc[1]);
        }
#pragma unroll
        for (int me = 0; me < 2; ++me)
#pragma unroll
            for (int gq = 0; gq < 4; ++gq) { const int e0 = 32 * me + 8 * gq + 4 * h; const f32x4 sc = *(const f32x4*)(ps + e0);
                u32x2 o; o.x = cvtpk(acc[me][4 * gq] * sc[0], acc[me][4 * gq + 1] * sc[1]); o.y = cvtpk(acc[me][4 * gq + 2] * sc[2], acc[me][4 * gq + 3] * sc[3]);
                *(u32x2*)(Y + (size_t)m * 1024 + 512 + g * 64 + e0) = o; }
    }
}

DI void h1_unit(const Ctx& a, int L, int unit, unsigned char* sm, int lane) {
    asm volatile("" : "+v"(lane));
    const int b = unit >> 9, hh = (unit >> 7) & 3, n = unit & 127, r = lane & 31, h = lane >> 5;
    const int row0 = b * SEQ + n * 64, ch = hh * 64 + lane;
    const bf16* QH = (const bf16*)(a.ws + WS_R + R_U5) + (size_t)1 * M * 256; const bf16* FH = QH + (size_t)M * 256; const bf16* IH = FH + (size_t)M * 256;
    bf16* QDEC = (bf16*)(a.ws + WS_R + R_QDEC); float* ALOC = (float*)(a.ws + WS_R + R_ALOC); float* OINTRA = (float*)(a.ws + WS_R + R_OINTRA); float* DEC = (float*)(a.ws + WS_DEC);
    bf16* KD = (bf16*)sm; bf16* IT = (bf16*)(sm + 8192); bf16* Am = (bf16*)(sm + 16384); bf16* Bm = (bf16*)(sm + 24576);
#ifdef DBG_H1_CLEAR
    { u32x4* z4 = (u32x4*)sm;
#pragma unroll 4
      for (int i = 0; i < 32; ++i) z4[i * 64 + lane] = (u32x4){0u, 0u, 0u, 0u}; asm volatile("s_waitcnt lgkmcnt(0)" ::: "memory"); }
#endif
    float lb;
    { const float* lp = a.in(I_LB) + ch; const float x0 = lp[0], x1 = lp[256], x2 = lp[512], x3 = lp[768];
      const float mx = fmaxf(fmaxf(x0, x1), fmaxf(x2, x3)); const float e0 = __expf(x0 - mx), e1 = __expf(x1 - mx), e2 = __expf(x2 - mx), e3 = __expf(x3 - mx);
      const float inv = 1.0f / (e0 + e1 + e2 + e3); float acc = 0.f; if (L > 0) acc += e0; if (L > 1) acc += e1; if (L > 2) acc += e2; lb = acc * inv; }
    const float loglb = __logf(fmaxf(lb, 1e-20f)), l1m = __logf(1.0f - lb), oml = 1.0f - lb;
    float zr[64];
#pragma unroll
    for (int s = 0; s < 64; ++s) zr[s] = bf2f(FH[(size_t)(row0 + s) * 256 + ch]);
    float cum = 0.f, ref = 0.f;
#pragma unroll
    for (int s = 0; s < 64; ++s) {
        const float z = zr[s];
        const float ls = fminf(z, 0.f) - __logf(1.0f + __expf(-fabsf(z)));
        const float bb = l1m + ls, hi = fmaxf(loglb, bb), df = fabsf(loglb - bb);
        cum += hi + __logf(1.0f + __expf(-df));
        asm volatile("" : "+v"(cum));
        if (s == 31) ref = cum;
    }
    const float last = cum;
    DEC[unit * 64 + lane] = __expf(last);
    cum = 0.f;
#ifndef H1_NO_P2
    unsigned short zc[8], qc[8], ic[8];
#pragma unroll
    for (int j = 0; j < 8; ++j) { const size_t gi = (size_t)(row0 + j) * 256 + ch; zc[j] = FH[gi]; qc[j] = QH[gi]; ic[j] = IH[gi]; }
#pragma unroll 1
    for (int s8 = 0; s8 < 8; ++s8) {
        unsigned kp[4], ip[4]; float kd8[8]; unsigned short i8[8];
        unsigned short zn[8], qn[8], in_[8];
        { const int sn = (s8 < 7 ? s8 + 1 : 7) * 8;
#pragma unroll
          for (int j = 0; j < 8; ++j) { const size_t gi = (size_t)(row0 + sn + j) * 256 + ch; zn[j] = FH[gi]; qn[j] = QH[gi]; in_[j] = IH[gi]; } }
#pragma unroll
        for (int j = 0; j < 8; ++j) {
            const int s = s8 * 8 + j; const size_t gi = (size_t)(row0 + s) * 256 + ch;
            const float z = bf2f(zc[j]), qv = bf2f(qc[j]); i8[j] = ic[j];
            const float ls = fminf(z, 0.f) - __logf(1.0f + __expf(-fabsf(z)));
            const float bb = l1m + ls, hi = fmaxf(loglb, bb), df = fabsf(loglb - bb);
            cum += hi + __logf(1.0f + __expf(-df));
            const float key = oml * __builtin_amdgcn_rcpf(1.0f + __expf(z));
            const float qs = qv * __builtin_amdgcn_rcpf(1.0f + __expf(-qv)) * 0.125f;
            const float av = qs * __expf(fminf(cum - ref, 80.f)), bv = key * __expf(fminf(ref - cum, 80.f)), qd = qs * __expf(cum);
            kd8[j] = key * __expf(last - cum);
#ifndef H1_NO_AB
            Am[s * 64 + lane] = (bf16)(cvtpk(av, 0.f) & 0xffffu); Bm[s * 64 + lane] = (bf16)(cvtpk(bv, 0.f) & 0xffffu);
#endif
#ifndef H1_NO_QD
            QDEC[gi] = (bf16)(cvtpk(qd, 0.f) & 0xffffu);
#endif
        }
#pragma unroll
        for (int j = 0; j < 4; ++j) { kp[j] = cvtpk(kd8[2 * j], kd8[2 * j + 1]); ip[j] = (unsigned)i8[2 * j] | ((unsigned)i8[2 * j + 1] << 16); }
        *(u32x4*)(KD + lane * 64 + s8 * 8) = (u32x4){kp[0], kp[1], kp[2], kp[3]};
        *(u32x4*)(IT + lane * 64 + s8 * 8) = (u32x4){ip[0], ip[1], ip[2], ip[3]};
#pragma unroll
        for (int j = 0; j < 8; ++j) { zc[j] = zn[j]; qc[j] = qn[j]; ic[j] = in_[j]; }
    }
#endif
    asm volatile("s_waitcnt lgkmcnt(0)" ::: "memory");
#ifndef H1_NO_MM
    bf16x8 itf[2][2][2];
#pragma unroll
    for (int mv = 0; mv < 2; ++mv)
#pragma unroll
        for (int ms = 0; ms < 2; ++ms)
#pragma unroll
            for (int st = 0; st < 2; ++st) { const bf16* p = IT + (32 * mv + r) * 64 + 32 * ms + 16 * st + 4 * h; const u32x2 x0 = *(const u32x2*)p, x1 = *(const u32x2*)(p + 8);
                itf[mv][ms][st] = __builtin_bit_cast(bf16x8, ((u32x4){x0.x, x0.y, x1.x, x1.y})); }
    float* alb = ALOC + (size_t)unit * 4096 + (4 * h) * 64 + r;
#pragma unroll
    for (int nk = 0; nk < 2; ++nk) {
        bf16x8 kdf[2][2];
#pragma unroll
        for (int ms = 0; ms < 2; ++ms)
#pragma unroll
            for (int st = 0; st < 2; ++st) { const bf16* p = KD + (32 * nk + r) * 64 + 32 * ms + 16 * st + 4 * h; const u32x2 x0 = *(const u32x2*)p, x1 = *(const u32x2*)(p + 8);
                kdf[ms][st] = __builtin_bit_cast(bf16x8, ((u32x4){x0.x, x0.y, x1.x, x1.y})); }
#pragma unroll
        for (int mv = 0; mv < 2; ++mv) {
            f32x16 acc = zero16();
#pragma unroll
            for (int ms = 0; ms < 2; ++ms)
#pragma unroll
                for (int st = 0; st < 2; ++st) acc = MFMA32(itf[mv][ms][st], kdf[ms][st], acc);
#pragma unroll
            for (int i = 0; i < 16; ++i) alb[(32 * mv + (i & 3) + 8 * (i >> 2)) * 64 + 32 * nk] = acc[i];
        }
    }
#pragma unroll
    for (int nt = 0; nt < 2; ++nt) {
        bf16x8 af[4];
#pragma unroll
        for (int ks = 0; ks < 4; ++ks) af[ks] = *(const bf16x8*)(Am + (32 * nt + r) * 64 + 16 * ks + 8 * h);
        f32x16 oi[2]; oi[0] = zero16(); oi[1] = zero16();
#pragma unroll
        for (int ms = 0; ms < 2; ++ms) {
            if (ms <= nt) {
                f32x16 sacc = zero16();
#pragma unroll
                for (int ks = 0; ks < 4; ++ks) { const bf16x8 bf_ = *(const bf16x8*)(Bm + (32 * ms + r) * 64 + 16 * ks + 8 * h); sacc = MFMA32(bf_, af[ks], sacc); }
                if (ms == nt) {
#pragma unroll
                    for (int i = 0; i < 16; ++i) if (crow(i, h) > r) sacc[i] = 0.f;
                }
#pragma unroll
                for (int st = 0; st < 2; ++st) { const bf16x8 pf = pack8(sacc, st); oi[0] = MFMA32(itf[0][ms][st], pf, oi[0]); oi[1] = MFMA32(itf[1][ms][st], pf, oi[1]); }
            }
        }
        const size_t orow = (size_t)(row0 + 32 * nt + r) * 256 + hh * 64;
#pragma unroll
        for (int mv = 0; mv < 2; ++mv)
#pragma unroll
            for (int gq = 0; gq < 4; ++gq) *(f32x4*)(OINTRA + orow + 32 * mv + 8 * gq + 4 * h) = (f32x4){oi[mv][4 * gq], oi[mv][4 * gq + 1], oi[mv][4 * gq + 2], oi[mv][4 * gq + 3]};
    }
#endif
    asm volatile("s_waitcnt lgkmcnt(0)" ::: "memory");
}

DI void phase_t(const Ctx& a, int L, unsigned char* lds, int gw, int NGW, int wave, int lane) {
    const int blk = gw >> 3, G = NGW >> 3;
    if (wave < 4) { for (int u = blk * 4 + wave; u < 1024; u += G * 4) h1_unit(a, L, u, lds + wave * 32768, lane); }
    else if (wave < 6) { for (int u = blk * 2 + (wave - 4); u < 512; u += G * 2) pool_unit(a, L, u, lane); }
    __syncthreads();
    if (L + 1 < DEPTH) { float* scr = (float*)(lds + wave * 16384); for (int it = gw; it < WC_ITEMS; it += NGW) wconv_item(a, L + 1, it, scr, lane); }
}

DI void attn_unit(const Ctx& a, int bh, int qb, unsigned char* lds, int tid, int wave, int lane) {
    asm volatile("" : "+v"(lane), "+v"(tid));
    const int r = lane & 31, h = lane >> 5, b = bh >> 3, hd = bh & 7, own = qb, nsel = own < 3 ? own : 3;
    const bf16* Q = (const bf16*)(a.ws + WS_R + R_Q); const bf16* Kb = (const bf16*)(a.ws + WS_R + R_K); const bf16* Vb = (const bf16*)(a.ws + WS_R + R_V);
    const float* kmp = (const float*)(a.ws + WS_KMP); bf16* Y = (bf16*)(a.ws + WS_R + R_Y);
    unsigned char* part = lds;
    unsigned short* llist = (unsigned short*)(lds + 104448);
    int* lcnt = (int*)(lds + 120832); int* itab = lcnt + 32;
    const size_t qbase = ((size_t)bh * SEQ + (size_t)qb * 256) * 64;
    if (own > 0) {
        if (tid < 32) lcnt[tid] = 0;
        float* km = (float*)(lds + 122880);
        for (int idx = tid; idx < own * 64; idx += NTHR) { const float* p0 = kmp + (size_t)((b * 32 + (idx >> 6)) * 2) * 512 + hd * 64 + (idx & 63); km[idx] = p0[0] + p0[512]; }
        __syncthreads();
        if (tid < 256) {
            float q[64];
            { const u32x4* qp = (const u32x4*)(Q + qbase + (size_t)tid * 64);
#pragma unroll
              for (int i = 0; i < 8; ++i) { const u32x4 w = qp[i];
                  q[8 * i + 0] = __uint_as_float(w.x << 16); q[8 * i + 1] = __uint_as_float(w.x & 0xffff0000u); q[8 * i + 2] = __uint_as_float(w.y << 16); q[8 * i + 3] = __uint_as_float(w.y & 0xffff0000u);
                  q[8 * i + 4] = __uint_as_float(w.z << 16); q[8 * i + 5] = __uint_as_float(w.z & 0xffff0000u); q[8 * i + 6] = __uint_as_float(w.w << 16); q[8 * i + 7] = __uint_as_float(w.w & 0xffff0000u); } }
            float g0 = -INFINITY, g1 = -INFINITY, g2 = -INFINITY; int i0 = 0, i1 = 0, i2 = 0;
            for (int j = 0; j < own; ++j) {
                const float* kj = km + j * 64;
                float g = 0.f;
#pragma unroll
                for (int d = 0; d < 64; d += 4) { const f32x4 x0 = *(const f32x4*)(kj + d);
                    g += q[d] * x0[0] + q[d + 1] * x0[1] + q[d + 2] * x0[2] + q[d + 3] * x0[3]; }
                if (g > g0) { g2 = g1; i2 = i1; g1 = g0; i1 = i0; g0 = g; i0 = j; }
                else if (g > g1) { g2 = g1; i2 = i1; g1 = g; i1 = j; }
                else if (g > g2) { g2 = g; i2 = j; }
            }
#pragma unroll
            for (int s = 0; s < 3; ++s) {
                if (s < nsel) { const int j = s == 0 ? i0 : (s == 1 ? i1 : i2); const int pos = atomicAdd(lcnt + j, 1); llist[j * 256 + pos] = (unsigned short)(tid | (s << 8)); }
            }
        }
        __syncthreads();
        if (tid == 0) { int n = 0; for (int j = 0; j < own; ++j) { const int ng = (lcnt[j] + 31) >> 5; for (int g = 0; g < ng; ++g) itab[n++] = j | (g << 8); } itab[64] = n; }
        __syncthreads();
        const int nitems = __builtin_amdgcn_readfirstlane(itab[64]);
        for (int it = wave; it < nitems; it += NWAVES) {
            const int ent = __builtin_amdgcn_readfirstlane(itab[it]); const int j = ent & 255, g = ent >> 8, n = __builtin_amdgcn_readfirstlane(lcnt[j]);
            const int idx = g * 32 + r; const bool valid = idx < n;
            const unsigned e = llist[j * 256 + (valid ? idx : 0)];
            const int qi = e & 255, slot = e >> 8;
            float mo, lo_; f32x16 ot[2];
            attn_core<false>(Q + qbase + (size_t)qi * 64, Kb + ((size_t)bh * 32 + j) * 16384, Vb + ((size_t)bh * 32 + j) * 16384, 8, r, h, mo, lo_, ot);
            if (valid) {
                unsigned char* rec = part + (qi * 3 + slot) * 136; const float inv = 1.0f / lo_;
#pragma unroll
                for (int md = 0; md < 2; ++md)
#pragma unroll
                    for (int gq = 0; gq < 4; ++gq) { u32x2 o; o.x = cvtpk(ot[md][4 * gq] * inv, ot[md][4 * gq + 1] * inv); o.y = cvtpk(ot[md][4 * gq + 2] * inv, ot[md][4 * gq + 3] * inv);
                        *(u32x2*)(rec + 2 * (32 * md + 8 * gq + 4 * h)) = o; }
                if (h == 0) { *(float*)(rec + 128) = mo; *(float*)(rec + 132) = lo_; }
            }
        }
        __syncthreads();
    }
    {
        const int ql = 32 * wave + r, t = qb * 256 + ql;
        float m0, l0; f32x16 ot[2];
        attn_core<true>(Q + qbase + (size_t)ql * 64, Kb + ((size_t)bh * 32 + qb) * 16384, Vb + ((size_t)bh * 32 + qb) * 16384, wave + 1, r, h, m0, l0, ot);
        float ms[3], ls[3]; float mx = m0;
#pragma unroll
        for (int s = 0; s < 3; ++s) { ms[s] = -INFINITY; ls[s] = 0.f; if (s < nsel) { const unsigned char* rec = part + (ql * 3 + s) * 136; ms[s] = *(const float*)(rec + 128); ls[s] = *(const float*)(rec + 132); mx = fmaxf(mx, ms[s]); } }
        const float w0 = __expf(m0 - mx); float den = w0 * l0;
#pragma unroll
        for (int md = 0; md < 2; ++md)
#pragma unroll
            for (int i = 0; i < 16; ++i) ot[md][i] *= w0;
#pragma unroll
        for (int s = 0; s < 3; ++s) {
            if (s < nsel) {
                const unsigned char* rec = part + (ql * 3 + s) * 136; const float ws_ = __expf(ms[s] - mx) * ls[s]; den += ws_;
#pragma unroll
                for (int md = 0; md < 2; ++md)
#pragma unroll
                    for (int gq = 0; gq < 4; ++gq) { const u32x2 w = *(const u32x2*)(rec + 2 * (32 * md + 8 * gq + 4 * h));
                        ot[md][4 * gq] += ws_ * __uint_as_float(w.x << 16); ot[md][4 * gq + 1] += ws_ * __uint_as_float(w.x & 0xffff0000u);
                        ot[md][4 * gq + 2] += ws_ * __uint_as_float(w.y << 16); ot[md][4 * gq + 3] += ws_ * __uint_as_float(w.y & 0xffff0000u); }
            }
        }
        float inv = 1.0f / den; const size_t yrow = (size_t)(b * SEQ + t) * 1024 + hd * 64;
#ifdef DBG_AMP_ATTN
        inv *= 64.f;
#endif
#pragma unroll
        for (int md = 0; md < 2; ++md)
#pragma unroll
            for (int gq = 0; gq < 4; ++gq) { u32x2 o; o.x = cvtpk(ot[md][4 * gq] * inv, ot[md][4 * gq + 1] * inv); o.y = cvtpk(ot[md][4 * gq + 2] * inv, ot[md][4 * gq + 3] * inv);
                *(u32x2*)(Y + yrow + 32 * md + 8 * gq + 4 * h) = o; }
    }
    __syncthreads();
}

DI void phase_a(const Ctx& a, int L, unsigned char* lds, int gw, int NGW, int tid, int wave, int lane) {
    if ((gw & 3) == 0 && (gw >> 2) < 512) {
        const int chunk = gw >> 2, bhh = chunk >> 6, e = (chunk & 63) * 64 + lane, k = e & 63;
        const float* ALOC = (const float*)(a.ws + WS_R + R_ALOC); const float* DEC = (const float*)(a.ws + WS_DEC); bf16* SP = (bf16*)(a.ws + WS_R + R_SP);
        float st = 0.f;
#pragma unroll 8
        for (int n = 0; n < 128; ++n) { const int item = bhh * 128 + n; const float av = ALOC[(size_t)item * 4096 + e], dv = DEC[item * 64 + k];
            SP[(size_t)item * 4096 + e] = (bf16)(cvtpk(st, 0.f) & 0xffffu); st = dv * st + av; }
    }
    const int G = NGW / NWAVES, blk = gw / NWAVES;
    for (int u = blk; u < 512; u += G) {
        const int v = u & 255, bh = v >> 4, qb = (u < 256) ? (v & 15) : 31 - (v & 15);
        attn_unit(a, bh, qb, lds, tid, wave, lane);
    }
}

DI void own_unit(const Ctx& a, int bhi, int qg, int lane) {
    asm volatile("" : "+v"(lane));
    const int r = lane & 31, h = lane >> 5, t0 = qg * 32, j = t0 >> 8, nkg = ((t0 & 255) >> 5) + 1, t = t0 + r;
    const int b = bhi >> 3, hd = bhi & 7; const size_t bh = (size_t)bhi;
    const bf16* Q = (const bf16*)(a.ws + WS_R + R_Q); const bf16* Kb = (const bf16*)(a.ws + WS_R + R_K); const bf16* Vb = (const bf16*)(a.ws + WS_R + R_V);
    const bf16* PO = (const bf16*)(a.ws + WS_R + R_PO); const float* PML = (const float*)(a.ws + WS_R + R_PML); bf16* Y = (bf16*)(a.ws + WS_R + R_Y);
    float m0, l0; f32x16 ot[2];
    attn_core<true>(Q + (bh * SEQ + t) * 64, Kb + (bh * 32 + j) * 16384, Vb + (bh * 32 + j) * 16384, nkg, r, h, m0, l0, ot);
#ifdef DBG_OWN_ONLY
    const int nsel = 0;
#else
    const int nsel = j < 3 ? j : 3;
#endif
    const size_t pi = (bh * SEQ + t) * 3;
    float ms[3], ls[3]; float mx = m0;
#pragma unroll
    for (int s = 0; s < 3; ++s) { ms[s] = -INFINITY; ls[s] = 0.f; if (s < nsel) { ms[s] = ld_sc1f(PML + (pi + s) * 2); ls[s] = ld_sc1f(PML + (pi + s) * 2 + 1); mx = fmaxf(mx, ms[s]); } }
    const float w0 = __expf(m0 - mx); float den = w0 * l0;
#pragma unroll
    for (int md = 0; md < 2; ++md)
#pragma unroll
        for (int i = 0; i < 16; ++i) ot[md][i] *= w0;
#pragma unroll
    for (int s = 0; s < 3; ++s) {
        if (s < nsel) {
            const float ws_ = __expf(ms[s] - mx) * ls[s]; den += ws_;
#pragma unroll
            for (int md = 0; md < 2; ++md)
#pragma unroll
                for (int gq = 0; gq < 4; ++gq) { const u32x2 w = *(const u32x2*)(PO + (pi + s) * 64 + 32 * md + 8 * gq + 4 * h);
                    ot[md][4 * gq] += ws_ * __uint_as_float(w.x << 16); ot[md][4 * gq + 1] += ws_ * __uint_as_float(w.x & 0xffff0000u);
                    ot[md][4 * gq + 2] += ws_ * __uint_as_float(w.y << 16); ot[md][4 * gq + 3] += ws_ * __uint_as_float(w.y & 0xffff0000u); }
        }
    }
    float inv = 1.0f / den; const size_t yrow = (size_t)(b * SEQ + t) * 1024 + hd * 64;
#ifdef DBG_ZERO_ATTN
    inv = 0.f;
#endif
#pragma unroll
    for (int md = 0; md < 2; ++md)
#pragma unroll
        for (int gq = 0; gq < 4; ++gq) { u32x2 o; o.x = cvtpk(ot[md][4 * gq] * inv, ot[md][4 * gq + 1] * inv); o.y = cvtpk(ot[md][4 * gq + 2] * inv, ot[md][4 * gq + 3] * inv);
            *(u32x2*)(Y + yrow + 32 * md + 8 * gq + 4 * h) = o; }
}

DI void h3_unit(const Ctx& a, int L, int unit, int lane) {
    asm volatile("" : "+v"(lane));
    const int b = unit >> 9, hh = (unit >> 7) & 3, n = unit & 127, r = lane & 31, h = lane >> 5;
    const int row0 = b * SEQ + n * 64;
    const bf16* SP = (const bf16*)(a.ws + WS_R + R_SP) + (size_t)unit * 4096; const bf16* QDEC = (const bf16*)(a.ws + WS_R + R_QDEC);
    const float* OINTRA = (const float*)(a.ws + WS_R + R_OINTRA); const bf16* GH = (const bf16*)(a.ws + WS_R + R_U5) + (size_t)4 * M * 256; bf16* Y = (bf16*)(a.ws + WS_R + R_Y);
    const float* on = a.in(I_HON) + L * 64;
    bf16x8 sf[2][4];
#pragma unroll
    for (int mv = 0; mv < 2; ++mv)
#pragma unroll
        for (int ks = 0; ks < 4; ++ks) sf[mv][ks] = *(const bf16x8*)(SP + (32 * mv + r) * 64 + 16 * ks + 8 * h);
#pragma unroll
    for (int nt = 0; nt < 2; ++nt) {
        const size_t trow = (size_t)(row0 + 32 * nt + r) * 256 + hh * 64;
        f32x16 o[2]; o[0] = zero16(); o[1] = zero16();
#pragma unroll
        for (int ks = 0; ks < 4; ++ks) { const bf16x8 qf = *(const bf16x8*)(QDEC + trow + 16 * ks + 8 * h); o[0] = MFMA32(sf[0][ks], qf, o[0]); o[1] = MFMA32(sf[1][ks], qf, o[1]); }
        float ss = 0.f;
#pragma unroll
        for (int mv = 0; mv < 2; ++mv)
#pragma unroll
            for (int gq = 0; gq < 4; ++gq) { const f32x4 x = *(const f32x4*)(OINTRA + trow + 32 * mv + 8 * gq + 4 * h);
#pragma unroll
                for (int i = 0; i < 4; ++i) { o[mv][4 * gq + i] += x[i]; ss += o[mv][4 * gq + i] * o[mv][4 * gq + i]; } }
        ss += __shfl_xor(ss, 32);
        float rn = rsqrtf(ss * (1.0f / 64.0f) + 1e-6f);
#ifdef DBG_ZERO_HGRN
        rn = 0.f;
#endif
#ifdef DBG_AMP_HGRN
        rn *= 16.f;
#endif
        const size_t yrow = (size_t)(row0 + 32 * nt + r) * 1024 + 768 + hh * 64;
#pragma unroll
        for (int mv = 0; mv < 2; ++mv)
#pragma unroll
            for (int gq = 0; gq < 4; ++gq) { const int v0 = 32 * mv + 8 * gq + 4 * h; const f32x4 gn = *(const f32x4*)(on + v0); const u32x2 gw_ = *(const u32x2*)(GH + trow + v0);
                const float g0 = __uint_as_float(gw_.x << 16), g1 = __uint_as_float(gw_.x & 0xffff0000u), g2 = __uint_as_float(gw_.y << 16), g3 = __uint_as_float(gw_.y & 0xffff0000u);
                u32x2 w; w.x = cvtpk(o[mv][4 * gq] * rn * gn[0] * pg8::silu_f(g0), o[mv][4 * gq + 1] * rn * gn[1] * pg8::silu_f(g1));
                w.y = cvtpk(o[mv][4 * gq + 2] * rn * gn[2] * pg8::silu_f(g2), o[mv][4 * gq + 3] * rn * gn[3] * pg8::silu_f(g3));
                *(u32x2*)(Y + yrow + v0) = w; }
    }
}

DI void phase_c(const Ctx& a, int L, int gw, int NGW, int lane) {
    for (int u = gw; u < 1024; u += NGW) h3_unit(a, L, u, lane);
}

#define LAS __attribute__((address_space(3)))
#define XB_TMO      128
#define XB_XCNT(j)  (256  + 64 * (j))
#define XB_XSUB(j)  (1280 + 64 * (j))
#define XB_XGEN(j)  (2304 + 64 * (j))
#define XB_TOP      3328
#define XB_TOPGEN   3392
#define XCD_BAR_WORDS 3456
#define XB_SPIN_CAP (1u << 18)

__device__ __forceinline__ unsigned xb_ld(unsigned* p)              { return __hip_atomic_load(p, __ATOMIC_RELAXED, __HIP_MEMORY_SCOPE_AGENT); }
__device__ __forceinline__ unsigned xb_add(unsigned* p, unsigned v) { return __hip_atomic_fetch_add(p, v, __ATOMIC_RELAXED, __HIP_MEMORY_SCOPE_AGENT); }
__device__ __forceinline__ unsigned xb_xcc_id() { return (unsigned)__builtin_amdgcn_s_getreg((3 << 11) | 20) & 0xFu; }
#define XB_SPIN(cond, bar) do { unsigned _sp = 0; while (cond) { __builtin_amdgcn_s_sleep(1); \
    if ((++_sp & 255u) == 0u) { if (xb_ld(&(bar)[XB_TMO])) break; if (_sp > XB_SPIN_CAP) { atomicAdd(&(bar)[XB_TMO], 1u); break; } } } } while (0)

struct XcdBarrier {
    unsigned* bar; unsigned x;
    volatile LAS unsigned* st;
};

__device__ __forceinline__ XcdBarrier xcd_barrier_post(unsigned* bar, volatile LAS unsigned* st) {
    XcdBarrier b; b.bar = bar; b.x = xb_xcc_id(); b.st = st;
    if (threadIdx.x == 0) (void)xb_add(&bar[XB_XCNT(b.x)], 1u);
    return b;
}
__device__ __forceinline__ void xcd_barrier_complete(unsigned* bar, unsigned x, unsigned& nloc, unsigned& nx) {
    const unsigned G = gridDim.x * gridDim.y * gridDim.z;
    unsigned sum, cnt, mine, sp = 0u;
    for (;;) {
        sum = 0u; cnt = 0u; mine = 0u;
#pragma unroll
        for (unsigned j = 0; j < 16; ++j) { const unsigned c = xb_ld(&bar[XB_XCNT(j)]); sum += c; cnt += (c > 0u) ? 1u : 0u; mine = (j == x) ? c : mine; }
        if (sum == G) break;
        __builtin_amdgcn_s_sleep(1);
        if ((++sp & 255u) == 0u) { if (xb_ld(&bar[XB_TMO])) break; if (sp > XB_SPIN_CAP) { atomicAdd(&bar[XB_TMO], 1u); break; } }
    }
    nloc = mine > 0u ? mine : 1u; nx = cnt > 0u ? cnt : 1u;
}

__device__ __forceinline__ void xcd_barrier(const XcdBarrier& b) {
    asm volatile("s_waitcnt vmcnt(0)" ::: "memory");
    __syncthreads();
    if (threadIdx.x == 0) {
        unsigned* bar = b.bar;
        __builtin_amdgcn_s_waitcnt(0);
        unsigned nloc = b.st[0], nx = b.st[1];
        if (nloc == 0u) { xcd_barrier_complete(bar, b.x, nloc, nx); b.st[0] = nloc; b.st[1] = nx; }
        const unsigned old = xb_add(&bar[XB_XSUB(b.x)], 1u);
        const unsigned gen = old / nloc;
        if (old + 1u == (gen + 1u) * nloc) {
            __builtin_amdgcn_fence(__ATOMIC_RELEASE, "agent");
            asm volatile("s_waitcnt vmcnt(0)" ::: "memory");
            const unsigned og = xb_add(&bar[XB_TOP], 1u);
            const unsigned tg = og / nx;
            if (og + 1u == (tg + 1u) * nx) xb_add(&bar[XB_TOPGEN], 1u);
            else XB_SPIN(xb_ld(&bar[XB_TOPGEN]) == tg, bar);
            __builtin_amdgcn_fence(__ATOMIC_ACQUIRE, "agent");
            xb_add(&bar[XB_XGEN(b.x)], 1u);
            asm volatile("s_waitcnt vmcnt(0)" ::: "memory");
        } else {
            XB_SPIN(xb_ld(&bar[XB_XGEN(b.x)]) == gen, bar);
            __builtin_amdgcn_fence(__ATOMIC_ACQUIRE, "agent");
            asm volatile("s_waitcnt vmcnt(0)" ::: "memory");
        }
    }
    __syncthreads();
}

template <int MASK> __global__ void __launch_bounds__(NTHR, 2) mk_fwd(Args args) {
    extern __shared__ __attribute__((aligned(16))) unsigned char lds[];
    const int G = gridDim.x, NGW = G * NWAVES;
    cg::grid_group grid = cg::this_grid();
    const int ph_lo = args.ph_lo, ph_hi = args.ph_hi;
    volatile LAS unsigned* bst = (volatile LAS unsigned*)((LAS unsigned char*)lds + 131072);
    if (threadIdx.x == 0) { bst[0] = 0u; bst[1] = 0u; }
    __syncthreads();
    XcdBarrier bar; bar.bar = nullptr; bar.x = 0; bar.st = bst;
    for (int ph = ph_lo; ph < ph_hi; ++ph) {
        if (ph > ph_lo) {
            if (ph == ph_lo + 1) {
                grid.sync();
                bar = xcd_barrier_post((unsigned*)(args.ws + WS_CTL + 65536), bst);
            } else { xcd_barrier(bar);
#ifdef DBG_DUP_BAR
                xcd_barrier(bar);
#endif
            }
        }
        int tid_v = threadIdx.x; asm volatile("" : "+v"(tid_v));
        const int tid = tid_v, lane = tid & 63, wave = __builtin_amdgcn_readfirstlane(tid >> 6), gw = blockIdx.x * NWAVES + wave;
        kptr_t kp = (kptr_t)__builtin_amdgcn_kernarg_segment_ptr();
        asm volatile("" : "+s"(kp));
        Ctx a; a.kp = kp; a.out = *(float* const __attribute__((address_space(4)))*)(kp + 144); a.ws = *(unsigned char* const __attribute__((address_space(4)))*)(kp + 152);
        unsigned char* ws = a.ws;
        float* stats = (float*)(ws + WS_STATS); bf16* xb = (bf16*)(ws + WS_XB); bf16* hid = (bf16*)(ws + WS_R + R_HID);
        if (ph == 0) {
if constexpr (MASK & 1) { phase_p0(a, lds, gw, NGW, wave, lane);
#ifdef DBG_DUP_P0
 __syncthreads(); phase_p0(a, lds, gw, NGW, wave, lane);
#endif
 }
 __syncthreads(); continue; }
        const int L = (ph - 1) / 9, sub = (ph - 1) % 9;
        unsigned char* wb = ws + WS_W + (size_t)(L & 1) * WSZ;
        if (sub == 0 || sub == 7) {
            pg8::Gemm g{xb, (const bf16*)(wb + (sub == 0 ? W_GU1 : W_GU2)), M, 2 * FF, D}; pg8::StaticOrder S; S.init(M, 2 * FF, G, (int)blockIdx.x);
            pg8::EpiSwiGLU E{hid, stats, FF};
            if constexpr (MASK & 2) pg8::gemm_phase<pg8::EpiSwiGLU, pg8::StaticOrder, PG8_ALIGN, PG8_SP2>((PG8_LAS unsigned char*)lds, g, S, E);
#if defined(DBG_DUP_G) && DBG_DUP_G == 1
            __syncthreads(); if constexpr (MASK & 2) pg8::gemm_phase<pg8::EpiSwiGLU, pg8::StaticOrder, PG8_ALIGN, PG8_SP2>((PG8_LAS unsigned char*)lds, g, S, E);
#endif
        } else if (sub == 1 || sub == 6 || sub == 8) {
            const bf16* A = sub == 6 ? (const bf16*)(ws + WS_R + R_Y) : hid; const int K = sub == 6 ? D : FF;
            const bf16* Bt = (const bf16*)(wb + (sub == 1 ? W_D1 : (sub == 6 ? W_OUT : W_D2)));
            pg8::Gemm g{A, Bt, M, D, K}; pg8::StaticOrder S; S.init(M, D, G, (int)blockIdx.x);
            pg8::EpiResid E{a.out, xb, stats, sub == 6 ? 1.0f : 0.5f};
            if constexpr (MASK & 4) pg8::gemm_phase<pg8::EpiResid, pg8::StaticOrder, PG8_ALIGN, PG8_SP2>((PG8_LAS unsigned char*)lds, g, S, E);
#if defined(DBG_DUP_G) && DBG_DUP_G == 2
            __syncthreads(); { pg8::EpiResid E0{a.out, xb, stats, 0.0f}; if constexpr (MASK & 4) pg8::gemm_phase<pg8::EpiResid, pg8::StaticOrder, PG8_ALIGN, PG8_SP2>((PG8_LAS unsigned char*)lds, g, S, E0); }
#endif
        } else if (sub == 2) {
            pg8::Gemm g{xb, (const bf16*)(wb + W_IN), M, INW, D}; pg8::StaticOrder S; S.init(M, INW, G, (int)blockIdx.x);
            pg8::EpiProj E{(bf16*)(ws + WS_R + R_Q), (bf16*)(ws + WS_R + R_K), (bf16*)(ws + WS_R + R_V), (bf16*)(ws + WS_R + R_U5), (float*)(ws + WS_KMP), stats,
                           (const float*)(ws + WS_ROPEC), (const float*)(ws + WS_ROPES), a.in(I_QN) + L * 64, a.in(I_KN) + L * 64};
            if constexpr (MASK & 8) pg8::gemm_phase<pg8::EpiProj, pg8::StaticOrder, PG8_ALIGN, PG8_SP2>((PG8_LAS unsigned char*)lds, g, S, E);
#if defined(DBG_DUP_G) && DBG_DUP_G == 3
            __syncthreads(); if constexpr (MASK & 8) pg8::gemm_phase<pg8::EpiProj, pg8::StaticOrder, PG8_ALIGN, PG8_SP2>((PG8_LAS unsigned char*)lds, g, S, E);
#endif
        } else if (sub == 3) {
if constexpr (MASK & 16) { phase_t(a, L, lds, gw, NGW, wave, lane);
#if defined(DBG_DUP_SUB) && DBG_DUP_SUB == 3
 __syncthreads(); phase_t(a, L, lds, gw, NGW, wave, lane);
#endif
 }
 __syncthreads(); }
        else if (sub == 4) {
if constexpr (MASK & 32) { phase_a(a, L, lds, gw, NGW, tid, wave, lane);
#if defined(DBG_DUP_SUB) && DBG_DUP_SUB == 4
 __syncthreads(); phase_a(a, L, lds, gw, NGW, tid, wave, lane);
#endif
 }
 __syncthreads(); }
        else {
if constexpr (MASK & 64) { phase_c(a, L, gw, NGW, lane);
#if defined(DBG_DUP_SUB) && DBG_DUP_SUB == 5
 __syncthreads(); phase_c(a, L, gw, NGW, lane);
#endif
 }
 __syncthreads(); }
    }
}

#ifndef MK_MULTI
#define MK_MULTI 0
#endif
#ifndef DBG_NPH
#define DBG_NPH (1 + 9 * DEPTH)
#endif
constexpr int N_PHASES = DBG_NPH;
static int phase_mask(int ph) { if (ph == 0) return 1; const int sub = (ph - 1) % 9; const int m[9] = {2, 4, 8, 16, 32, 64, 4, 2, 4}; return m[sub]; }
template <int MASK> static bool setup_one(int& per_cu) {
    if (hipFuncSetAttribute((const void*)mk_fwd<MASK>, hipFuncAttributeMaxDynamicSharedMemorySize, LDS_BYTES) != hipSuccess) return false;
    if (hipOccupancyMaxActiveBlocksPerMultiprocessor(&per_cu, (const void*)mk_fwd<MASK>, NTHR, LDS_BYTES) != hipSuccess) per_cu = 1;
    (void)hipGetLastError(); return true;
}
template <int MASK> static void launch_one(const Args& a, int grid, hipStream_t stream) { hipLaunchKernelGGL(mk_fwd<MASK>, dim3(grid), dim3(NTHR), LDS_BYTES, stream, a); }
extern "C" void kernel_launch(void* const* d_in, const int* in_sizes, int n_in, void* d_out, int out_size, void* d_ws, size_t ws_size, hipStream_t stream) {
    static int grid = 0;
    if (grid == 0) {
        if (n_in != 18 || in_sizes[0] != M * D || out_size != M * D || ws_size < WS_END) { fprintf(stderr, "kernel_launch: unexpected shapes / workspace (n_in %d, ws %zu < %zu)\n", n_in, ws_size, (size_t)WS_END); grid = -1; return; }
        int dev = 0, cus = 0, per_cu = 0; bool ok = true;
        (void)hipGetDevice(&dev); (void)hipDeviceGetAttribute(&cus, hipDeviceAttributeMultiprocessorCount, dev);
#if MK_MULTI
        ok = setup_one<1>(per_cu) && setup_one<2>(per_cu) && setup_one<4>(per_cu) && setup_one<8>(per_cu) && setup_one<16>(per_cu) && setup_one<32>(per_cu) && setup_one<64>(per_cu);
#else
        ok = setup_one<127>(per_cu);
#endif
        if (!ok) { fprintf(stderr, "kernel_launch: hipFuncSetAttribute failed\n"); grid = -1; return; }
        grid = cus;
    }
    if (grid < 0) return;
    Args a{};
    for (int i = 0; i < 18; ++i) a.in[i] = (const float*)d_in[i];
    a.out = (float*)d_out; a.ws = (unsigned char*)d_ws;
#if MK_MULTI
    for (int ph = 0; ph < N_PHASES; ++ph) { a.ph_lo = ph; a.ph_hi = ph + 1;
        switch (phase_mask(ph)) { case 1: launch_one<1>(a, grid, stream); break; case 2: launch_one<2>(a, grid, stream); break; case 4: launch_one<4>(a, grid, stream); break; case 8: launch_one<8>(a, grid, stream); break;
                                  case 16: launch_one<16>(a, grid, stream); break; case 32: launch_one<32>(a, grid, stream); break; default: launch_one<64>(a, grid, stream); break; } }
#else
    a.ph_lo = 0; a.ph_hi = N_PHASES;
    void* args[] = {&a};
    hipError_t e = hipLaunchCooperativeKernel((const void*)mk_fwd<127>, dim3(grid), dim3(NTHR), args, LDS_BYTES, stream);
    if (e != hipSuccess) fprintf(stderr, "cooperative launch failed: %s (grid %d)\n", hipGetErrorString(e), grid);
#endif
}
```

```cpp
#include <hip/hip_runtime.h>
#include <hip/hip_cooperative_groups.h>
#include <cstdio>
#include <cstdint>
namespace cg = cooperative_groups;
#define MK_MULTI 0
namespace pg8 {
#define PG8_LAS __attribute__((address_space(3)))
typedef unsigned short bf16_t;
typedef short bf16x8 __attribute__((ext_vector_type(8)));
typedef float f32x4 __attribute__((ext_vector_type(4)));
typedef unsigned u32x4 __attribute__((ext_vector_type(4)));
constexpr int BM = 256, BK = 64, HALF = 128, HTB = HALF * BK * 2  , STAGE_BYTES = 8 * HTB, NXCD = 8, WGM = 8;

__host__ __device__ __forceinline__ int lds_byte(int r, int c) { const int st = (r >> 4) * 2 + (c >> 5), rr = r & 15, cc = c & 31, ob = rr * 64 + cc * 2; return st * 1024 + (ob ^ (((ob >> 9) & 1) << 5)); }
__host__ __device__ __forceinline__ void stage_rc(int b, int& R, int& C) { const int st = b / 1024, sb = b % 1024, swz = sb ^ (((sb >> 9) & 1) << 5); R = (st >> 1) * 16 + swz / 64; C = (st & 1) * 32 + (swz % 64) / 2; }
__host__ __device__ __forceinline__ int perm32(int rho) { const int n = rho >> 4, i = rho & 15; return 8 * (i >> 2) + 4 * n + (i & 3); }

struct Unit { int pm, pn; };
struct Gemm { const bf16_t* A; const bf16_t* Bt; int M, N, K; };

struct StaticOrder {
    int nM, nN, nwg, G, c;
    __host__ __device__ void init(int M, int N, int G_, int c_) { nM = M / BM; nN = N / BM; nwg = nM * nN; G = G_; c = c_; }
    __host__ __device__ bool next(int i, Unit& u) const {
        const long L = (long)i * G + c; if (L >= nwg) return false;
        int wgid = (int)L; { const int q = nwg / NXCD, r = nwg % NXCD, xcd = wgid % NXCD, off = wgid / NXCD; wgid = (xcd < r ? xcd * (q + 1) : r * (q + 1) + (xcd - r) * q) + off; }
        const int nig = WGM * nN, gid = wgid / nig, fm = gid * WGM, gsz = (nM - fm) < WGM ? (nM - fm) : WGM;
        u.pm = fm + ((wgid % nig) % gsz); u.pn = (wgid % nig) / gsz; return true;
    }
    __device__ __forceinline__ void a_ready(const Unit&) const {}
    __device__ __forceinline__ void done(const Unit&) const {}
};

__device__ __forceinline__ unsigned cvt_pk_bf16(float lo, float hi) { unsigned r; asm volatile("v_cvt_pk_bf16_f32 %0, %1, %2" : "=v"(r) : "v"(lo), "v"(hi)); return r; }
typedef float f32x2 __attribute__((ext_vector_type(2)));
typedef unsigned u32x2 __attribute__((ext_vector_type(2)));
typedef __bf16 bf16x2_t __attribute__((ext_vector_type(2)));
__device__ __forceinline__ unsigned cvtpk(float lo, float hi) { f32x2 v = {lo, hi}; bf16x2_t b = __builtin_convertvector(v, bf16x2_t); return __builtin_bit_cast(unsigned, b); }
__device__ __forceinline__ float row_rstd(const float* stats, int row) {
    const f32x4* p = (const f32x4*)(stats + (size_t)row * 16);
    const f32x4 a = p[0], b = p[1], c = p[2], d = p[3];
    const float s = ((a[0] + a[1]) + (a[2] + a[3])) + ((b[0] + b[1]) + (b[2] + b[3])) + ((c[0] + c[1]) + (c[2] + c[3])) + ((d[0] + d[1]) + (d[2] + d[3]));
    return rsqrtf(s * (1.0f / 1024.0f) + 1e-6f);
}
__device__ __forceinline__ void row_rstd4(const float* stats, int row0, float (&rs)[4]) {
    f32x4 p[4][4];
#pragma unroll
    for (int m = 0; m < 4; ++m)
#pragma unroll
        for (int k = 0; k < 4; ++k) p[m][k] = *(const f32x4*)(stats + (size_t)(row0 + 16 * m) * 16 + 4 * k);
#pragma unroll
    for (int m = 0; m < 4; ++m) { const f32x4 a = p[m][0], b = p[m][1], c = p[m][2], d = p[m][3];
        const float s = ((a[0] + a[1]) + (a[2] + a[3])) + ((b[0] + b[1]) + (b[2] + b[3])) + ((c[0] + c[1]) + (c[2] + c[3])) + ((d[0] + d[1]) + (d[2] + d[3]));
        rs[m] = rsqrtf(s * (1.0f / 1024.0f) + 1e-6f); }
}
__device__ __forceinline__ float silu_f(float g) { return g * __builtin_amdgcn_rcpf(1.0f + __expf(-g)); }

struct EpiSwiGLU {
    static constexpr bool PERM = true, AFTER_DRAIN = false;
    bf16_t* H; const float* stats; int ldh;
    __device__ __forceinline__ void operator()(const f32x4 (&acc)[2][2][4][2], const Unit& u, int wr, int wc, int fr, int fq) const {
        asm volatile("" : "+v"(fr), "+v"(fq));
        const int row0 = u.pm * BM + wr * 64 + fr, col0 = u.pn * HALF + wc * 32 + 8 * fq;
#pragma unroll
        for (int ai = 0; ai < 2; ++ai) {
            float rs4[4]; row_rstd4(stats, row0 + ai * HALF, rs4);
#pragma unroll
            for (int m = 0; m < 4; ++m) {
                const int row = row0 + ai * HALF + m * 16;
                const float rs = rs4[m];
                float h[8];
#pragma unroll
                for (int n = 0; n < 2; ++n)
#pragma unroll
                    for (int i = 0; i < 4; ++i) { const float g = acc[ai][0][m][n][i] * rs, up = acc[ai][1][m][n][i] * rs; h[4 * n + i] = silu_f(g) * up; }
                u32x4 w; w.x = cvtpk(h[0], h[1]); w.y = cvtpk(h[2], h[3]); w.z = cvtpk(h[4], h[5]); w.w = cvtpk(h[6], h[7]);
                *(u32x4*)(H + (size_t)row * ldh + col0) = w;
            }
        }
    }
};

struct EpiResid {
    static constexpr bool PERM = true, AFTER_DRAIN = false;
    float* X; bf16_t* XB; float* stats; float scale;
    __device__ __forceinline__ void operator()(const f32x4 (&acc)[2][2][4][2], const Unit& u, int wr, int wc, int fr, int fq) const {
        asm volatile("" : "+v"(fr), "+v"(fq));
        const int row0 = u.pm * BM + wr * 64 + fr, col0 = u.pn * BM + wc * 32 + 8 * fq;
#pragma unroll
        for (int ai = 0; ai < 2; ++ai) {
            f32x4 xr[4][2][2];
#pragma unroll
            for (int m = 0; m < 4; ++m)
#pragma unroll
                for (int bj = 0; bj < 2; ++bj) { const float* xp = X + (size_t)(row0 + ai * HALF + m * 16) * 1024 + col0 + bj * HALF; xr[m][bj][0] = *(const f32x4*)xp; xr[m][bj][1] = *(const f32x4*)(xp + 4); }
#pragma unroll
            for (int m = 0; m < 4; ++m) {
                const int row = row0 + ai * HALF + m * 16; float ss = 0.f;
#pragma unroll
                for (int bj = 0; bj < 2; ++bj) {
                    float* xp = X + (size_t)row * 1024 + col0 + bj * HALF;
                    f32x4 x0 = xr[m][bj][0], x1 = xr[m][bj][1];
                    x0 = x0 + acc[ai][bj][m][0] * scale; x1 = x1 + acc[ai][bj][m][1] * scale;
                    *(f32x4*)xp = x0; *(f32x4*)(xp + 4) = x1;
                    ss += (x0[0] * x0[0] + x0[1] * x0[1]) + (x0[2] * x0[2] + x0[3] * x0[3]) + (x1[0] * x1[0] + x1[1] * x1[1]) + (x1[2] * x1[2] + x1[3] * x1[3]);
                    u32x4 w; w.x = cvtpk(x0[0], x0[1]); w.y = cvtpk(x0[2], x0[3]); w.z = cvtpk(x1[0], x1[1]); w.w = cvtpk(x1[2], x1[3]);
                    *(u32x4*)(XB + (size_t)row * 1024 + col0 + bj * HALF) = w;
                }
                ss += __shfl_xor(ss, 16); ss += __shfl_xor(ss, 32);
                if (fq == 0) stats[(size_t)row * 16 + u.pn * 4 + wc] = ss;
            }
        }
    }
};

struct EpiProj {
    static constexpr bool PERM = true, AFTER_DRAIN = false;
    bf16_t* Q; bf16_t* Kb; bf16_t* Vb; bf16_t* U5; float* kmp; const float* stats; const float* ropeC; const float* ropeS; const float* qn; const float* kn;
    __device__ __forceinline__ void operator()(const f32x4 (&acc)[2][2][4][2], const Unit& u, int wr, int wc, int fr, int fq) const {
        asm volatile("" : "+v"(fr), "+v"(fq));
        const int row0 = u.pm * BM + wr * 64 + fr;
        const int pn = u.pn;
        if (pn >= 6) {
            bf16_t* O = U5 + (size_t)(pn - 6) * (16384 * 256);
            const int col0 = wc * 32 + 8 * fq;
#pragma unroll
            for (int ai = 0; ai < 2; ++ai)
#pragma unroll
                for (int m = 0; m < 4; ++m) {
                    const int row = row0 + ai * HALF + m * 16; const float rs = row_rstd(stats, row);
#pragma unroll
                    for (int bj = 0; bj < 2; ++bj) {
                        const f32x4 v0 = acc[ai][bj][m][0] * rs, v1 = acc[ai][bj][m][1] * rs;
                        u32x4 w; w.x = cvtpk(v0[0], v0[1]); w.y = cvtpk(v0[2], v0[3]); w.z = cvtpk(v1[0], v1[1]); w.w = cvtpk(v1[2], v1[3]);
                        *(u32x4*)(O + (size_t)row * 256 + col0 + bj * HALF) = w;
                    }
                }
            return;
        }
        const int head = (pn & 1) * 4 + wc, b = u.pm >> 5, j = u.pm & 31;
        const size_t bh = (size_t)(b * 8 + head);
        if (pn >= 4) {
            bf16_t* vb = Vb + (bh * 32 + j) * 16384;
#pragma unroll
            for (int ai = 0; ai < 2; ++ai)
#pragma unroll
                for (int m = 0; m < 4; ++m) {
                    const int row = row0 + ai * HALF + m * 16; const float rs = row_rstd(stats, row);
                    const int kk = ai * HALF + wr * 64 + m * 16 + fr;
                    const int kg = kk >> 5, w = kk & 31, st = w >> 4, w16 = w & 15, hh = (w16 >> 2) & 1, jj = 4 * (w16 >> 3) + (w16 & 3);
#pragma unroll
                    for (int bj = 0; bj < 2; ++bj)
#pragma unroll
                        for (int n = 0; n < 2; ++n) {
                            const unsigned p0 = cvtpk(acc[ai][bj][m][n][0] * rs, acc[ai][bj][m][n][1] * rs), p1 = cvtpk(acc[ai][bj][m][n][2] * rs, acc[ai][bj][m][n][3] * rs);
#pragma unroll
                            for (int i = 0; i < 4; ++i) {
                                const int r = 8 * fq + 4 * n + i;
                                const unsigned pv = (i < 2) ? p0 : p1;
                                vb[((((kg * 2 + st) * 2 + bj) * 32 + r) * 2 + hh) * 8 + jj] = (bf16_t)((i & 1) ? (pv >> 16) : (pv & 0xffffu));
                            }
                        }
                }
            return;
        }
        const bool isk = pn >= 2;
        const float* gn = isk ? kn : qn;
        float ksum[16];
#pragma unroll
        for (int e = 0; e < 16; ++e) ksum[e] = 0.f;
#pragma unroll
        for (int ai = 0; ai < 2; ++ai)
#pragma unroll
            for (int m = 0; m < 4; ++m) {
                const int row = row0 + ai * HALF + m * 16; const float rs = row_rstd(stats, row);
                const int t = row & 8191, kk = t & 255;
                float v0[8], v1[8]; float ss = 0.f;
#pragma unroll
                for (int n = 0; n < 2; ++n)
#pragma unroll
                    for (int i = 0; i < 4; ++i) { v0[4 * n + i] = acc[ai][0][m][n][i] * rs; v1[4 * n + i] = acc[ai][1][m][n][i] * rs; ss += v0[4 * n + i] * v0[4 * n + i] + v1[4 * n + i] * v1[4 * n + i]; }
                ss += __shfl_xor(ss, 16); ss += __shfl_xor(ss, 32);
                const float rn = rsqrtf(ss * (1.0f / 64.0f) + 1e-6f);
                const f32x4 c0 = *(const f32x4*)(ropeC + t * 32 + 8 * fq), c1 = *(const f32x4*)(ropeC + t * 32 + 8 * fq + 4);
                const f32x4 s0 = *(const f32x4*)(ropeS + t * 32 + 8 * fq), s1 = *(const f32x4*)(ropeS + t * 32 + 8 * fq + 4);
                const f32x4 ga0 = *(const f32x4*)(gn + 8 * fq), ga1 = *(const f32x4*)(gn + 8 * fq + 4), gb0 = *(const f32x4*)(gn + 32 + 8 * fq), gb1 = *(const f32x4*)(gn + 36 + 8 * fq);
                float o0[8], o1[8];
#pragma unroll
                for (int e = 0; e < 8; ++e) {
                    const float x1 = v0[e] * rn * (e < 4 ? ga0[e & 3] : ga1[e & 3]), x2 = v1[e] * rn * (e < 4 ? gb0[e & 3] : gb1[e & 3]);
                    const float cs = e < 4 ? c0[e & 3] : c1[e & 3], sn = e < 4 ? s0[e & 3] : s1[e & 3];
                    o0[e] = x1 * cs - x2 * sn; o1[e] = x2 * cs + x1 * sn;
                }
                u32x4 w0, w1;
                w0.x = cvtpk(o0[0], o0[1]); w0.y = cvtpk(o0[2], o0[3]); w0.z = cvtpk(o0[4], o0[5]); w0.w = cvtpk(o0[6], o0[7]);
                w1.x = cvtpk(o1[0], o1[1]); w1.y = cvtpk(o1[2], o1[3]); w1.z = cvtpk(o1[4], o1[5]); w1.w = cvtpk(o1[6], o1[7]);
                if (!isk) {
                    bf16_t* qp = Q + (bh * 8192 + t) * 64 + 8 * fq;
                    *(u32x4*)qp = w0; *(u32x4*)(qp + 32) = w1;
                } else {
                    bf16_t* kb = Kb + (bh * 32 + j) * 16384;
                    const int kg = kk >> 5, r = kk & 31, hq = fq & 1, ksl = fq >> 1;
                    *(u32x4*)(kb + (((kg * 4 + ksl) * 32 + r) * 2 + hq) * 8) = w0;
                    *(u32x4*)(kb + (((kg * 4 + 2 + ksl) * 32 + r) * 2 + hq) * 8) = w1;
#pragma unroll
                    for (int e = 0; e < 8; ++e) { ksum[e] += o0[e]; ksum[8 + e] += o1[e]; }
                }
                asm volatile("" ::: "memory");
            }
        if (isk) {
#pragma unroll
            for (int e = 0; e < 16; ++e) { float s = ksum[e]; s += __shfl_xor(s, 1); s += __shfl_xor(s, 2); s += __shfl_xor(s, 4); s += __shfl_xor(s, 8); ksum[e] = s; }
            if (fr == 0) {
                float* kp = kmp + ((size_t)(u.pm * 2 + wr) * 512) + head * 64 + 8 * fq;
                *(f32x4*)kp = (f32x4){ksum[0], ksum[1], ksum[2], ksum[3]}; *(f32x4*)(kp + 4) = (f32x4){ksum[4], ksum[5], ksum[6], ksum[7]};
                *(f32x4*)(kp + 32) = (f32x4){ksum[8], ksum[9], ksum[10], ksum[11]}; *(f32x4*)(kp + 36) = (f32x4){ksum[12], ksum[13], ksum[14], ksum[15]};
            }
        }
    }
};

template <class Epi, class Sched, bool ALIGN_EPI = false, bool SP2 = false>
__device__ __forceinline__ void gemm_phase(PG8_LAS unsigned char* lds, const Gemm g, const Sched& S, const Epi& E) {
    int tid_v = threadIdx.x; asm volatile("" : "+v"(tid_v));
    const int tid = tid_v, wid = __builtin_amdgcn_readfirstlane(tid >> 6), lane = tid & 63, wr = wid >> 2, wc = wid & 3, fr = lane & 15, fq = lane >> 4;
    const int K = g.K, nt = K / BK;
    unsigned voffA[2], voffB[2];
#pragma unroll
    for (int i = 0; i < 2; ++i) { int R, C; stage_rc(tid * 16 + i * 8192, R, C); const int Rb = Epi::PERM ? ((R & ~31) + perm32(R & 31)) : R;
        voffA[i] = (unsigned)(R * K + C) * 2u; voffB[i] = (unsigned)(Rb * K + C) * 2u; }
    const size_t kstep = (size_t)(BK * 2);
    const size_t hstep = (size_t)HALF * K * 2;
    const size_t tstep = 2 * hstep;
    const unsigned ldsw = (unsigned)wid * 1024u;
    const int aoff = lds_byte(wr * 64 + fr, fq * 8), boff = lds_byte(wc * 32 + fr, fq * 8);
#define PG8_SA(b, h) (((b) * 2 + (h)) * HTB)
#define PG8_SB(b, h) ((4 + (b) * 2 + (h)) * HTB)
#define PG8_STAGE(bufoff, gbase, voff) do { _Pragma("unroll") for (int _i = 0; _i < 2; ++_i) \
        __builtin_amdgcn_global_load_lds((const unsigned*)((const char*)(gbase) + (voff)[_i]), (PG8_LAS unsigned*)(lds + (bufoff) + ldsw + _i * 8192), 16, 0, 0); } while (0)
#define PG8_LDA(dst, b, h) do { _Pragma("unroll") for (int m = 0; m < 4; ++m) _Pragma("unroll") for (int k = 0; k < 2; ++k) dst[m][k] = *(const PG8_LAS bf16x8*)(lds + PG8_SA(b, h) + aoff + m * 2048 + k * 1024); } while (0)
#define PG8_LDB(dst, b, h) do { _Pragma("unroll") for (int n = 0; n < 2; ++n) _Pragma("unroll") for (int k = 0; k < 2; ++k) dst[n][k] = *(const PG8_LAS bf16x8*)(lds + PG8_SB(b, h) + boff + n * 2048 + k * 1024); } while (0)
#define PG8_MMA(ai, bj, At, Bt) do { __builtin_amdgcn_s_setprio(1); _Pragma("unroll") for (int m = 0; m < 4; ++m) _Pragma("unroll") for (int n = 0; n < 2; ++n) _Pragma("unroll") for (int k = 0; k < 2; ++k) \
        acc[ai][bj][m][n] = __builtin_amdgcn_mfma_f32_16x16x32_bf16(Bt[n][k], At[m][k], acc[ai][bj][m][n], 0, 0, 0); __builtin_amdgcn_s_setprio(0); } while (0)
#define PG8_WAIT_V(n) asm volatile("s_waitcnt vmcnt(" #n ")" ::: "memory")
#define PG8_WAIT_L(n) asm volatile("s_waitcnt lgkmcnt(" #n ")" ::: "memory")
#define PG8_BAR __builtin_amdgcn_s_barrier()
#define PG8_SCHED __builtin_amdgcn_sched_barrier(0)
    Unit cur, nxt; int ui = 0;
    if (!S.next(0, cur)) return;
    f32x4 acc[2][2][4][2];
#pragma unroll
    for (int a = 0; a < 2; ++a)
#pragma unroll
        for (int b = 0; b < 2; ++b)
#pragma unroll
            for (int m = 0; m < 4; ++m)
#pragma unroll
                for (int n = 0; n < 2; ++n) acc[a][b][m][n] = (f32x4){0.f, 0.f, 0.f, 0.f};
    bf16x8 At[4][2], B0[2][2], B1[2][2];
    const char* cA = (const char*)g.A + (size_t)cur.pm * tstep; const char* cB = (const char*)g.Bt + (size_t)cur.pn * tstep;
    S.a_ready(cur);
    if constexpr (SP2) {
        PG8_STAGE(PG8_SB(0, 0), cB, voffB); PG8_STAGE(PG8_SB(0, 1), cB + hstep, voffB); PG8_STAGE(PG8_SA(0, 0), cA, voffA); PG8_STAGE(PG8_SA(0, 1), cA + hstep, voffA);
        if (wr == 1) PG8_BAR;
        PG8_WAIT_V(2); PG8_BAR;
        PG8_STAGE(PG8_SB(1, 0), cB + kstep, voffB); PG8_STAGE(PG8_SA(1, 0), cA + kstep, voffA); PG8_STAGE(PG8_SB(1, 1), cB + hstep + kstep, voffB);
        PG8_WAIT_V(6); PG8_BAR;
    } else {
        PG8_STAGE(PG8_SB(0, 0), cB, voffB); PG8_STAGE(PG8_SA(0, 0), cA, voffA); PG8_STAGE(PG8_SB(0, 1), cB + hstep, voffB); PG8_STAGE(PG8_SA(0, 1), cA + hstep, voffA);
        if (wr == 1) PG8_BAR;
        PG8_WAIT_V(4); PG8_BAR;
        PG8_STAGE(PG8_SB(1, 0), cB + kstep, voffB); PG8_STAGE(PG8_SA(1, 0), cA + kstep, voffA); PG8_STAGE(PG8_SB(1, 1), cB + hstep + kstep, voffB);
        PG8_WAIT_V(6); PG8_BAR;
    }
    for (;;) {
        const bool has_next = S.next(ui + 1, nxt);
        const char* nA = has_next ? (const char*)g.A + (size_t)nxt.pm * tstep : cA; const char* nB = has_next ? (const char*)g.Bt + (size_t)nxt.pn * tstep : cB;
        for (int t = 0; t < nt; t += 2) {
            const bool last = (t == nt - 2);
            const char* a1 = cA + (size_t)(t + 1) * kstep;
            const char* a2 = last ? nA : cA + (size_t)(t + 2) * kstep; const char* b2 = last ? nB : cB + (size_t)(t + 2) * kstep;
            const char* a3 = a2 + kstep; const char* b3 = b2 + kstep;
            if (last && has_next) S.a_ready(nxt);
            if constexpr (SP2) {
            PG8_LDB(B0, 0, 0); PG8_LDB(B1, 0, 1); PG8_SCHED; PG8_LDA(At, 0, 0); PG8_STAGE(PG8_SA(1, 1), a1 + hstep, voffA);
            PG8_WAIT_V(8); PG8_WAIT_L(0); PG8_BAR; PG8_MMA(0, 0, At, B0); PG8_MMA(0, 1, At, B1); PG8_BAR; PG8_SCHED;
            PG8_LDA(At, 0, 1); PG8_STAGE(PG8_SB(0, 0), b2, voffB); PG8_STAGE(PG8_SB(0, 1), b2 + hstep, voffB); PG8_STAGE(PG8_SA(0, 0), a2, voffA);
            PG8_WAIT_V(8); PG8_WAIT_L(0); PG8_BAR; PG8_MMA(1, 0, At, B0); PG8_MMA(1, 1, At, B1); PG8_BAR; PG8_SCHED;
            PG8_LDB(B0, 1, 0); PG8_LDB(B1, 1, 1); PG8_SCHED; PG8_LDA(At, 1, 0); PG8_STAGE(PG8_SA(0, 1), a2 + hstep, voffA);
            PG8_WAIT_V(8); PG8_WAIT_L(0); PG8_BAR; PG8_MMA(0, 0, At, B0); PG8_MMA(0, 1, At, B1); PG8_BAR; PG8_SCHED;
            PG8_LDA(At, 1, 1); PG8_STAGE(PG8_SB(1, 0), b3, voffB); PG8_STAGE(PG8_SB(1, 1), b3 + hstep, voffB); PG8_STAGE(PG8_SA(1, 0), a3, voffA);
            PG8_WAIT_V(8); PG8_WAIT_L(0); PG8_BAR; PG8_MMA(1, 0, At, B0); PG8_MMA(1, 1, At, B1); PG8_BAR; PG8_SCHED;
            } else {
            PG8_LDB(B0, 0, 0); PG8_SCHED; PG8_LDA(At, 0, 0); PG8_STAGE(PG8_SA(1, 1), a1 + hstep, voffA);
            PG8_WAIT_L(8); PG8_BAR; PG8_WAIT_L(0); PG8_MMA(0, 0, At, B0); PG8_BAR; PG8_SCHED;
            PG8_LDB(B1, 0, 1); PG8_STAGE(PG8_SB(0, 0), b2, voffB);
            PG8_BAR; PG8_WAIT_L(0); PG8_MMA(0, 1, At, B1); PG8_BAR;
            PG8_LDA(At, 0, 1); PG8_STAGE(PG8_SA(0, 0), a2, voffA);
            PG8_BAR; PG8_WAIT_L(0); PG8_MMA(1, 0, At, B0); PG8_BAR; PG8_SCHED;
            PG8_STAGE(PG8_SB(0, 1), b2 + hstep, voffB);
            PG8_WAIT_V(6); PG8_BAR; PG8_MMA(1, 1, At, B1); PG8_BAR;
            PG8_LDB(B0, 1, 0); PG8_SCHED; PG8_LDA(At, 1, 0); PG8_STAGE(PG8_SA(0, 1), a2 + hstep, voffA);
            PG8_WAIT_L(8); PG8_BAR; PG8_WAIT_L(0); PG8_MMA(0, 0, At, B0); PG8_BAR; PG8_SCHED;
            PG8_LDB(B1, 1, 1); PG8_STAGE(PG8_SB(1, 0), b3, voffB);
            PG8_BAR; PG8_WAIT_L(0); PG8_MMA(0, 1, At, B1); PG8_BAR;
            PG8_LDA(At, 1, 1); PG8_STAGE(PG8_SA(1, 0), a3, voffA);
            PG8_BAR; PG8_WAIT_L(0); PG8_MMA(1, 0, At, B0); PG8_BAR; PG8_SCHED;
            PG8_STAGE(PG8_SB(1, 1), b3 + hstep, voffB);
            PG8_WAIT_V(6); PG8_BAR; PG8_MMA(1, 1, At, B1); PG8_BAR;
            }
        }
        if constexpr (ALIGN_EPI) { if (wr == 0) PG8_BAR; }
        if constexpr (!Epi::AFTER_DRAIN) { E(acc, cur, wr, wc, fr, fq); S.done(cur); }
        if (!has_next) break;
#pragma unroll
        for (int a = 0; a < 2; ++a)
#pragma unroll
            for (int b = 0; b < 2; ++b)
#pragma unroll
                for (int m = 0; m < 4; ++m)
#pragma unroll
                    for (int n = 0; n < 2; ++n) acc[a][b][m][n] = (f32x4){0.f, 0.f, 0.f, 0.f};
        cur = nxt; cA = nA; cB = nB; ++ui;
        if constexpr (ALIGN_EPI) { if (wr == 1) PG8_BAR; }
    }
    PG8_WAIT_V(0);
    if constexpr (!ALIGN_EPI) { if (wr == 0) PG8_BAR; }
    PG8_BAR;
    if constexpr (Epi::AFTER_DRAIN) { E.fused(acc, cur, wr, wc, fr, fq, lds, wid, lane); S.done(cur); }
#undef PG8_SA
#undef PG8_SB
#undef PG8_STAGE
#undef PG8_LDA
#undef PG8_LDB
#undef PG8_MMA
#undef PG8_WAIT_V
#undef PG8_WAIT_L
#undef PG8_BAR
#undef PG8_SCHED
}
}

#ifndef PG8_SP2
#define PG8_SP2 true
#endif
#ifndef PG8_ALIGN
#define PG8_ALIGN true
#endif

#define DI __device__ __forceinline__
typedef unsigned short bf16;
typedef short bf16x8 __attribute__((ext_vector_type(8)));
typedef float f32x4 __attribute__((ext_vector_type(4)));
typedef float f32x16 __attribute__((ext_vector_type(16)));
typedef unsigned u32x4 __attribute__((ext_vector_type(4)));
typedef unsigned u32x2 __attribute__((ext_vector_type(2)));
#define MFMA32(a, b, c) __builtin_amdgcn_mfma_f32_32x32x16_bf16((a), (b), (c), 0, 0, 0)

constexpr int NWAVES = 8, NTHR = 512;
constexpr int M = 16384, D = 1024, FF = 2816, INW = 2816, SEQ = 8192, DEPTH = 4;
constexpr int LDS_BYTES = 147456;
constexpr size_t MiB = 1u << 20;
constexpr size_t WS_CTL = 0;
constexpr size_t WS_STATS = 1 * MiB;
constexpr size_t WS_KMP = 2 * MiB;
constexpr size_t WS_DEC = 2 * MiB + 512 * 1024;
constexpr size_t WS_ROPEC = 3 * MiB, WS_ROPES = 4 * MiB;
constexpr size_t WS_W = 5 * MiB, WSZ = 42467328;
constexpr size_t W_GU1 = 0, W_D1 = 11534336, W_IN = 17301504, W_OUT = 23068672, W_GU2 = 25165824, W_D2 = 36700160;
constexpr size_t WS_XB = 86 * MiB;
constexpr size_t WS_R = 118 * MiB;
constexpr size_t R_HID = 0;
constexpr size_t R_Q = 0, R_K = 16 * MiB, R_V = 32 * MiB, R_U5 = 48 * MiB  , R_Y = 88 * MiB, R_PO = 120 * MiB, R_PML = 168 * MiB,
                 R_LIST = 172 * MiB  , R_ALOC = 188 * MiB, R_OINTRA = 204 * MiB, R_QDEC = 220 * MiB, R_SP = 228 * MiB, R_END = 236 * MiB;
constexpr size_t WS_END = WS_R + R_END;

DI float bf2f(unsigned short b) { return __uint_as_float((unsigned)b << 16); }
DI unsigned cvtpk(float lo, float hi) { return pg8::cvtpk(lo, hi); }
DI float wave_sum(float v) {
#pragma unroll
    for (int o = 1; o < 64; o <<= 1) v += __shfl_xor(v, o);
    return v;
}
DI void st_sc1(unsigned* p, unsigned v) { __hip_atomic_store(p, v, __ATOMIC_RELAXED, __HIP_MEMORY_SCOPE_AGENT); }
DI unsigned ld_sc1(const unsigned* p) { return __hip_atomic_load(p, __ATOMIC_RELAXED, __HIP_MEMORY_SCOPE_AGENT); }
DI float ld_sc1f(const float* p) { return __uint_as_float(__hip_atomic_load((const unsigned*)p, __ATOMIC_RELAXED, __HIP_MEMORY_SCOPE_AGENT)); }
DI int crow(int reg, int h) { return (reg & 3) + 8 * (reg >> 2) + 4 * h; }
DI bf16x8 pack8(const f32x16& x, int s) {
    u32x4 p; p.x = cvtpk(x[8 * s], x[8 * s + 1]); p.y = cvtpk(x[8 * s + 2], x[8 * s + 3]); p.z = cvtpk(x[8 * s + 4], x[8 * s + 5]); p.w = cvtpk(x[8 * s + 6], x[8 * s + 7]);
    return __builtin_bit_cast(bf16x8, p);
}
DI f32x16 zero16() { f32x16 z;
#pragma unroll
    for (int i = 0; i < 16; ++i) z[i] = 0.f; return z; }

struct Args { const float* in[18]; float* out; unsigned char* ws; int ph_lo, ph_hi; };
typedef const float* cfp_t;
typedef const __attribute__((address_space(4))) unsigned char* kptr_t;
struct Ctx { kptr_t kp; unsigned char* ws; float* out;
    DI const float* in(int i) const { return *(const __attribute__((address_space(4))) cfp_t*)(kp + 8 * i); } };
enum { I_X = 0, I_F1N, I_F1G, I_F1U, I_F1D, I_MIXN, I_WIN, I_QN, I_KN, I_PW, I_PS, I_LB, I_HON, I_WOUT, I_F2N, I_F2G, I_F2U, I_F2D };

DI void wconv_tile(const float* W, int ld, int srccol, const float* gain, bf16* WT, int K, int nrow0, int k0, float* scr, int lane) {
    asm volatile("" : "+v"(lane));
    const int c4 = (lane & 7) * 4, kr = lane >> 3;
    f32x4 v[8]; float gv[8];
#pragma unroll
    for (int i = 0; i < 8; ++i) { v[i] = *(const f32x4*)(W + (size_t)(k0 + 8 * i + kr) * ld + srccol + c4); gv[i] = gain ? gain[k0 + 8 * i + kr] : 1.0f; }
#pragma unroll
    for (int i = 0; i < 8; ++i) { float* d = scr + (8 * i + kr) * 33 + c4; d[0] = v[i][0] * gv[i]; d[1] = v[i][1] * gv[i]; d[2] = v[i][2] * gv[i]; d[3] = v[i][3] * gv[i]; }
    asm volatile("s_waitcnt lgkmcnt(0)" ::: "memory");
    const int c = lane & 7;
#pragma unroll
    for (int j = 0; j < 4; ++j) { const int n = (lane >> 3) + 8 * j; const float* s = scr + (8 * c) * 33 + n;
        u32x4 o; o.x = cvtpk(s[0 * 33], s[1 * 33]); o.y = cvtpk(s[2 * 33], s[3 * 33]); o.z = cvtpk(s[4 * 33], s[5 * 33]); o.w = cvtpk(s[6 * 33], s[7 * 33]);
        *(u32x4*)(WT + (size_t)(nrow0 + n) * K + k0 + 8 * c) = o; }
    asm volatile("s_waitcnt lgkmcnt(0)" ::: "memory");
}
constexpr int WC_I0 = 2816, WC_I1 = 1408, WC_I2 = 1408, WC_I3 = 512, WC_I4 = 2816, WC_I5 = 1408, WC_ITEMS = WC_I0 + WC_I1 + WC_I2 + WC_I3 + WC_I4 + WC_I5;
DI void wconv_item(const Ctx& a, int L, int item, float* scr, int lane) {
    unsigned char* wb = a.ws + WS_W + (size_t)(L & 1) * WSZ;
    int r = item;
    if (r < WC_I0 || (r >= WC_I0 + WC_I1 + WC_I2 + WC_I3 && r < WC_I0 + WC_I1 + WC_I2 + WC_I3 + WC_I4)) {
        const bool second = r >= WC_I0; if (second) r -= WC_I0 + WC_I1 + WC_I2 + WC_I3;
        const int kb = r / 176, nb = r % 176, n0 = nb * 32, pn = n0 >> 8, c = n0 & 255, bj = c >> 7, col = 128 * pn + (c & 127);
        const float* src = a.in(second ? (bj ? I_F2U : I_F2G) : (bj ? I_F1U : I_F1G)) + (size_t)L * D * FF;
        const float* gain = a.in(second ? I_F2N : I_F1N) + L * D;
        wconv_tile(src, FF, col, gain, (bf16*)(wb + (second ? W_GU2 : W_GU1)), D, n0, kb * 64, scr, lane); return;
    }
    r -= WC_I0;
    if (r < WC_I1) { const int kb = r / 32, nb = r % 32; wconv_tile(a.in(I_F1D) + (size_t)L * FF * D, D, nb * 32, nullptr, (bf16*)(wb + W_D1), FF, nb * 32, kb * 64, scr, lane); return; }
    r -= WC_I1;
    if (r < WC_I2) { const int kb = r / 88, nb = r % 88, n0 = nb * 32, pn = n0 >> 8, c = n0 & 255;
        const int col = pn < 6 ? (pn >> 1) * 512 + 64 * ((pn & 1) * 4 + ((c >> 5) & 3)) + 32 * (c >> 7) : n0;
        wconv_tile(a.in(I_WIN) + (size_t)L * D * INW, INW, col, a.in(I_MIXN) + L * D, (bf16*)(wb + W_IN), D, n0, kb * 64, scr, lane); return; }
    r -= WC_I2;
    if (r < WC_I3) { const int kb = r / 32, nb = r % 32; wconv_tile(a.in(I_WOUT) + (size_t)L * D * D, D, nb * 32, nullptr, (bf16*)(wb + W_OUT), D, nb * 32, kb * 64, scr, lane); return; }
    r -= WC_I3 + WC_I4;
    { const int kb = r / 32, nb = r % 32; wconv_tile(a.in(I_F2D) + (size_t)L * FF * D, D, nb * 32, nullptr, (bf16*)(wb + W_D2), FF, nb * 32, kb * 64, scr, lane); }
}

DI void phase_p0(const Ctx& a, unsigned char* lds, int gw, int NGW, int wave, int lane) {
    const float* x = a.in(I_X); float* out = a.out; bf16* xb = (bf16*)(a.ws + WS_XB); float* stats = (float*)(a.ws + WS_STATS);
    for (int m0 = gw * 2; m0 < M; m0 += NGW * 2) {
        f32x4 v[2][4]; float sq[2];
#pragma unroll
        for (int k = 0; k < 2; ++k) { const f32x4* xr = (const f32x4*)(x + (size_t)(m0 + k) * D) + lane;
#pragma unroll
            for (int j = 0; j < 4; ++j) v[k][j] = xr[64 * j]; }
#pragma unroll
        for (int k = 0; k < 2; ++k) { float s = 0.f;
#pragma unroll
            for (int j = 0; j < 4; ++j) s += (v[k][j][0] * v[k][j][0] + v[k][j][1] * v[k][j][1]) + (v[k][j][2] * v[k][j][2] + v[k][j][3] * v[k][j][3]);
            sq[k] = wave_sum(s); }
#pragma unroll
        for (int k = 0; k < 2; ++k) { const int m = m0 + k;
            f32x4* orow = (f32x4*)(out + (size_t)m * D) + lane; u32x2* brow = (u32x2*)(xb + (size_t)m * D) + lane;
#pragma unroll
            for (int j = 0; j < 4; ++j) { orow[64 * j] = v[k][j]; u32x2 w; w.x = cvtpk(v[k][j][0], v[k][j][1]); w.y = cvtpk(v[k][j][2], v[k][j][3]); brow[64 * j] = w; }
            if (lane < 16) stats[(size_t)m * 16 + lane] = (lane == 0) ? sq[k] : 0.f; }
    }
    { unsigned* cz = (unsigned*)(a.ws + WS_CTL + 65536); for (int i = gw * 64 + lane; i < 3456; i += NGW * 64) cz[i] = 0u; }
    float* rc = (float*)(a.ws + WS_ROPEC); float* rs = (float*)(a.ws + WS_ROPES);
    for (int e = gw * 64 + lane; e < SEQ * 32; e += NGW * 64) {
        const int t = e >> 5, i = e & 31;
        double c = 0.15915494309189535;
        for (int k = 0; k < i; ++k) c *= 0.74989420933245582;
        const float chi = (float)c, clo = (float)(c - (double)chi), tf = (float)t;
        const float p = tf * chi, pe = fmaf(tf, chi, -p);
        float fr = __builtin_amdgcn_fractf(p) + (pe + tf * clo);
        rc[e] = __builtin_amdgcn_cosf(fr); rs[e] = __builtin_amdgcn_sinf(fr);
    }
    float* scr = (float*)(lds + wave * 16384);
    for (int it = gw; it < WC_ITEMS; it += NGW) wconv_item(a, 0, it, scr, lane);
}

template <bool DIAG>
DI void attn_core(const bf16* qrow, const bf16* kblk, const bf16* vblk, int nkg, int r, int h, float& m_out, float& l_out, f32x16 (&ot)[2]) {
    bf16x8 qf[4];
#pragma unroll
    for (int ks = 0; ks < 4; ++ks) qf[ks] = *(const bf16x8*)(qrow + 16 * ks + 8 * h);
    f32x16 st[8];
    const int lo = (r * 2 + h) * 8;
#pragma unroll
    for (int hf = 0; hf < 2; ++hf) {
        if (!DIAG || 4 * hf < nkg) {
            bf16x8 kf[16];
#pragma unroll
            for (int i = 0; i < 16; ++i) kf[i] = (!DIAG || 4 * hf + (i >> 2) < nkg) ? *(const bf16x8*)(kblk + ((4 * hf + (i >> 2)) * 4 + (i & 3)) * 512 + lo) : qf[0];
#pragma unroll
            for (int g = 0; g < 4; ++g) {
                const int kg = 4 * hf + g;
                f32x16 acc = zero16();
                if (!DIAG || kg < nkg) {
#pragma unroll
                    for (int ks = 0; ks < 4; ++ks) acc = MFMA32(kf[4 * g + ks], qf[ks], acc);
                    if (DIAG && kg == nkg - 1) {
#pragma unroll
                        for (int i = 0; i < 16; ++i) if (crow(i, h) > r) acc[i] = -INFINITY;
                    }
                } else {
#pragma unroll
                    for (int i = 0; i < 16; ++i) acc[i] = -INFINITY;
                }
                st[kg] = acc;
            }
        } else {
#pragma unroll
            for (int g = 0; g < 4; ++g)
#pragma unroll
                for (int i = 0; i < 16; ++i) st[4 * hf + g][i] = -INFINITY;
        }
    }
    float mx = -INFINITY;
#pragma unroll
    for (int kg = 0; kg < 8; ++kg)
#pragma unroll
        for (int i = 0; i < 16; ++i) mx = fmaxf(mx, st[kg][i]);
    mx = fmaxf(mx, __shfl_xor(mx, 32));
    const float c = 0.125f * 1.4426950408889634f; const float mc = mx * c;
    float l = 0.f;
#pragma unroll
    for (int kg = 0; kg < 8; ++kg)
#pragma unroll
        for (int i = 0; i < 16; ++i) { const float p = __builtin_amdgcn_exp2f(st[kg][i] * c - mc); st[kg][i] = p; l += p; }
    l += __shfl_xor(l, 32);
    ot[0] = zero16(); ot[1] = zero16();
#pragma unroll
    for (int pr = 0; pr < 4; ++pr) {
        if (!DIAG || 2 * pr < nkg) {
            bf16x8 vf[8];
#pragma unroll
            for (int i = 0; i < 8; ++i) vf[i] = (!DIAG || 2 * pr + (i >> 2) < nkg) ? *(const bf16x8*)(vblk + (((2 * pr + (i >> 2)) * 2 + ((i >> 1) & 1)) * 2 + (i & 1)) * 512 + lo) : qf[0];
#pragma unroll
            for (int g = 0; g < 2; ++g) {
                const int kg = 2 * pr + g;
                if (!DIAG || kg < nkg) {
#pragma unroll
                    for (int s2 = 0; s2 < 2; ++s2) { const bf16x8 pf = pack8(st[kg], s2); ot[0] = MFMA32(vf[4 * g + 2 * s2], pf, ot[0]); ot[1] = MFMA32(vf[4 * g + 2 * s2 + 1], pf, ot[1]); }
                }
            }
        }
    }
    m_out = mx * 0.125f; l_out = l;
}

DI void topk_unit(const Ctx& a, int L, int unit, int lane) {
    asm volatile("" : "+v"(lane));
    const int b = unit >> 10, hd = (unit >> 7) & 7, c = unit & 127, own = c >> 2;
    if (own == 0) return;
    const bf16* Q = (const bf16*)(a.ws + WS_R + R_Q); const float* kmp = (const float*)(a.ws + WS_KMP);
    unsigned* cnt = (unsigned*)(a.ws + WS_CTL) + L * 512; unsigned* lists = (unsigned*)(a.ws + WS_R + R_LIST);
    const int t = c * 64 + lane; const size_t bh = (size_t)(b * 8 + hd);
    float q[64];
    { const u32x4* qp = (const u32x4*)(Q + (bh * SEQ + t) * 64);
#pragma unroll
      for (int i = 0; i < 8; ++i) { const u32x4 w = qp[i];
          q[8 * i + 0] = __uint_as_float(w.x << 16); q[8 * i + 1] = __uint_as_float(w.x & 0xffff0000u); q[8 * i + 2] = __uint_as_float(w.y << 16); q[8 * i + 3] = __uint_as_float(w.y & 0xffff0000u);
          q[8 * i + 4] = __uint_as_float(w.z << 16); q[8 * i + 5] = __uint_as_float(w.z & 0xffff0000u); q[8 * i + 6] = __uint_as_float(w.w << 16); q[8 * i + 7] = __uint_as_float(w.w & 0xffff0000u); } }
    float g0 = -INFINITY, g1 = -INFINITY, g2 = -INFINITY; int i0 = 0, i1 = 0, i2 = 0;
    for (int j = 0; j < own; ++j) {
        const float* p0 = kmp + (size_t)((b * 32 + j) * 2) * 512 + hd * 64; const float* p1 = p0 + 512;
        float g = 0.f;
#pragma unroll
        for (int d = 0; d < 64; d += 4) { const f32x4 x0 = *(const f32x4*)(p0 + d), x1 = *(const f32x4*)(p1 + d);
            g += q[d] * (x0[0] + x1[0]) + q[d + 1] * (x0[1] + x1[1]) + q[d + 2] * (x0[2] + x1[2]) + q[d + 3] * (x0[3] + x1[3]); }
#ifdef DBG_FIXED_SEL
        g = -(float)j;
#endif
        if (g > g0) { g2 = g1; i2 = i1; g1 = g0; i1 = i0; g0 = g; i0 = j; }
        else if (g > g1) { g2 = g1; i2 = i1; g1 = g; i1 = j; }
        else if (g > g2) { g2 = g; i2 = j; }
    }
    const int nsel = own < 3 ? own : 3;
#pragma unroll
    for (int s = 0; s < 3; ++s) {
        if (s < nsel) { const int j = s == 0 ? i0 : (s == 1 ? i1 : i2); const int li = (int)bh * 32 + j;
            const unsigned pos = atomicAdd(cnt + li, 1u); st_sc1(lists + (size_t)li * 8192 + pos, (unsigned)(t | (s << 13))); }
    }
}

DI void pool_unit(const Ctx& a, int L, int unit, int lane) {
    asm volatile("" : "+v"(lane));
    const int tile = unit >> 2, g = unit & 3, w = 2 << g, r = lane & 31, h = lane >> 5;
    const bf16* U = (const bf16*)(a.ws + WS_R + R_U5); bf16* Y = (bf16*)(a.ws + WS_R + R_Y);
    const float* pw = a.in(I_PW) + (size_t)(L * 4 + g) * 4096; const float* ps = a.in(I_PS) + L * 256 + g * 64;
    const float* pwl = pw + (8 * h) * 64 + r;
    bf16x8 wf[2][4];
#pragma unroll
    for (int me = 0; me < 2; ++me)
#pragma unroll
        for (int ks = 0; ks < 4; ++ks) { float f[8];
#pragma unroll
            for (int j = 0; j < 8; ++j) f[j] = pwl[(16 * ks + j) * 64 + 32 * me];
            u32x4 p; p.x = cvtpk(f[0], f[1]); p.y = cvtpk(f[2], f[3]); p.z = cvtpk(f[4], f[5]); p.w = cvtpk(f[6], f[7]); wf[me][ks] = __builtin_bit_cast(bf16x8, p); }
#pragma unroll 1
    for (int nt = 0; nt < 4; ++nt) {
        const int m = tile * 128 + nt * 32 + r, tpos = m & (SEQ - 1);
        const int cntw = tpos + 1 < w ? tpos + 1 : w; const float invc = 1.0f / (float)cntw;
        f32x16 acc[2]; acc[0] = zero16(); acc[1] = zero16();
#pragma unroll
        for (int ks = 0; ks < 4; ++ks) {
            const bf16* up = U + (size_t)m * 256 + g * 64 + 16 * ks + 8 * h;
            float sum[8], self[8];
            { const u32x4 wv = *(const u32x4*)up;
              self[0] = __uint_as_float(wv.x << 16); self[1] = __uint_as_float(wv.x & 0xffff0000u); self[2] = __uint_as_float(wv.y << 16); self[3] = __uint_as_float(wv.y & 0xffff0000u);
              self[4] = __uint_as_float(wv.z << 16); self[5] = __uint_as_float(wv.z & 0xffff0000u); self[6] = __uint_as_float(wv.w << 16); self[7] = __uint_as_float(wv.w & 0xffff0000u); }
#pragma unroll
            for (int j = 0; j < 8; ++j) sum[j] = self[j];
            u32x4 rows[15];
#pragma unroll
            for (int i = 1; i < 16; ++i) { const bool ok = (i < w) && (i <= tpos); rows[i - 1] = *(const u32x4*)(up - (size_t)(ok ? i : 0) * 256); }
#pragma unroll
            for (int i = 1; i < 16; ++i) { const bool ok = (i < w) && (i <= tpos); const float kf = ok ? 1.f : 0.f; const u32x4 wv = rows[i - 1];
                sum[0] += kf * __uint_as_float(wv.x << 16); sum[1] += kf * __uint_as_float(wv.x & 0xffff0000u); sum[2] += kf * __uint_as_float(wv.y << 16); sum[3] += kf * __uint_as_float(wv.y & 0xffff0000u);
                sum[4] += kf * __uint_as_float(wv.z << 16); sum[5] += kf * __uint_as_float(wv.z & 0xffff0000u); sum[6] += kf * __uint_as_float(wv.w << 16); sum[7] += kf * __uint_as_float(wv.w & 0xffff0000u); }
            u32x4 p; p.x = cvtpk(sum[0] * invc - self[0], sum[1] * invc - self[1]); p.y = cvtpk(sum[2] * invc - self[2], sum[3] * invc - self[3]);
            p.z = cvtpk(sum[4] * invc - self[4], sum[5] * invc - self[5]); p.w = cvtpk(sum[6] * invc - self[6], sum[7] * invc - self[7]);
            const bf16x8 df = __builtin_bit_cast(bf16x8, p);
            acc[0] = MFMA32(wf[0][ks], df, acc[0]); acc[1] = MFMA32(wf[1][ks], df, acc[1]);
        }
#pragma unroll
        for (int me = 0; me < 2; ++me)
#pragma unroll
            for (int gq = 0; gq < 4; ++gq) { const int e0 = 32 * me + 8 * gq + 4 * h; const f32x4 sc = *(const f32x4*)(ps + e0);
                u32x2 o; o.x = cvtpk(acc[me][4 * gq] * sc[0], acc[me][4 * gq + 1] * sc[1]); o.y = cvtpk(acc[me][4 * gq + 2] * sc[2], acc[me][4 * gq + 3] * sc[3]);
                *(u32x2*)(Y + (size_t)m * 1024 + 512 + g * 64 + e0) = o; }
    }
}

DI void h1_unit(const Ctx& a, int L, int unit, unsigned char* sm, int lane) {
    asm volatile("" : "+v"(lane));
    const int b = unit >> 9, hh = (unit >> 7) & 3, n = unit & 127, r = lane & 31, h = lane >> 5;
    const int row0 = b * SEQ + n * 64, ch = hh * 64 + lane;
    const bf16* QH = (const bf16*)(a.ws + WS_R + R_U5) + (size_t)1 * M * 256; const bf16* FH = QH + (size_t)M * 256; const bf16* IH = FH + (size_t)M * 256;
    bf16* QDEC = (bf16*)(a.ws + WS_R + R_QDEC); float* ALOC = (float*)(a.ws + WS_R + R_ALOC); float* OINTRA = (float*)(a.ws + WS_R + R_OINTRA); float* DEC = (float*)(a.ws + WS_DEC);
    bf16* KD = (bf16*)sm; bf16* IT = (bf16*)(sm + 8192); bf16* Am = (bf16*)(sm + 16384); bf16* Bm = (bf16*)(sm + 24576);
#ifdef DBG_H1_CLEAR
    { u32x4* z4 = (u32x4*)sm;
#pragma unroll 4
      for (int i = 0; i < 32; ++i) z4[i * 64 + lane] = (u32x4){0u, 0u, 0u, 0u}; asm volatile("s_waitcnt lgkmcnt(0)" ::: "memory"); }
#endif
    float lb;
    { const float* lp = a.in(I_LB) + ch; const float x0 = lp[0], x1 = lp[256], x2 = lp[512], x3 = lp[768];
      const float mx = fmaxf(fmaxf(x0, x1), fmaxf(x2, x3)); const float e0 = __expf(x0 - mx), e1 = __expf(x1 - mx), e2 = __expf(x2 - mx), e3 = __expf(x3 - mx);
      const float inv = 1.0f / (e0 + e1 + e2 + e3); float acc = 0.f; if (L > 0) acc += e0; if (L > 1) acc += e1; if (L > 2) acc += e2; lb = acc * inv; }
    const float loglb = __logf(fmaxf(lb, 1e-20f)), l1m = __logf(1.0f - lb), oml = 1.0f - lb;
    float zr[64];
#pragma unroll
    for (int s = 0; s < 64; ++s) zr[s] = bf2f(FH[(size_t)(row0 + s) * 256 + ch]);
    float cum = 0.f, ref = 0.f;
#pragma unroll
    for (int s = 0; s < 64; ++s) {
        const float z = zr[s];
        const float ls = fminf(z, 0.f) - __logf(1.0f + __expf(-fabsf(z)));
        const float bb = l1m + ls, hi = fmaxf(loglb, bb), df = fabsf(loglb - bb);
        cum += hi + __logf(1.0f + __expf(-df));
        asm volatile("" : "+v"(cum));
        if (s == 31) ref = cum;
    }
    const float last = cum;
    DEC[unit * 64 + lane] = __expf(last);
    cum = 0.f;
#ifndef H1_NO_P2
    unsigned short zc[8], qc[8], ic[8];
#pragma unroll
    for (int j = 0; j < 8; ++j) { const size_t gi = (size_t)(row0 + j) * 256 + ch; zc[j] = FH[gi]; qc[j] = QH[gi]; ic[j] = IH[gi]; }
#pragma unroll 1
    for (int s8 = 0; s8 < 8; ++s8) {
        unsigned kp[4], ip[4]; float kd8[8]; unsigned short i8[8];
        unsigned short zn[8], qn[8], in_[8];
        { const int sn = (s8 < 7 ? s8 + 1 : 7) * 8;
#pragma unroll
          for (int j = 0; j < 8; ++j) { const size_t gi = (size_t)(row0 + sn + j) * 256 + ch; zn[j] = FH[gi]; qn[j] = QH[gi]; in_[j] = IH[gi]; } }
#pragma unroll
        for (int j = 0; j < 8; ++j) {
            const int s = s8 * 8 + j; const size_t gi = (size_t)(row0 + s) * 256 + ch;
            const float z = bf2f(zc[j]), qv = bf2f(qc[j]); i8[j] = ic[j];
            const float ls = fminf(z, 0.f) - __logf(1.0f + __expf(-fabsf(z)));
            const float bb = l1m + ls, hi = fmaxf(loglb, bb), df = fabsf(loglb - bb);
            cum += hi + __logf(1.0f + __expf(-df));
            const float key = oml * __builtin_amdgcn_rcpf(1.0f + __expf(z));
            const float qs = qv * __builtin_amdgcn_rcpf(1.0f + __expf(-qv)) * 0.125f;
            const float av = qs * __expf(fminf(cum - ref, 80.f)), bv = key * __expf(fminf(ref - cum, 80.f)), qd = qs * __expf(cum);
            kd8[j] = key * __expf(last - cum);
#ifndef H1_NO_AB
            Am[s * 64 + lane] = (bf16)(cvtpk(av, 0.f) & 0xffffu); Bm[s * 64 + lane] = (bf16)(cvtpk(bv, 0.f) & 0xffffu);
#endif
#ifndef H1_NO_QD
            QDEC[gi] = (bf16)(cvtpk(qd, 0.f) & 0xffffu);
#endif
        }
#pragma unroll
        for (int j = 0; j < 4; ++j) { kp[j] = cvtpk(kd8[2 * j], kd8[2 * j + 1]); ip[j] = (unsigned)i8[2 * j] | ((unsigned)i8[2 * j + 1] << 16); }
        *(u32x4*)(KD + lane * 64 + s8 * 8) = (u32x4){kp[0], kp[1], kp[2], kp[3]};
        *(u32x4*)(IT + lane * 64 + s8 * 8) = (u32x4){ip[0], ip[1], ip[2], ip[3]};
#pragma unroll
        for (int j = 0; j < 8; ++j) { zc[j] = zn[j]; qc[j] = qn[j]; ic[j] = in_[j]; }
    }
#endif
    asm volatile("s_waitcnt lgkmcnt(0)" ::: "memory");
#ifndef H1_NO_MM
    bf16x8 itf[2][2][2];
#pragma unroll
    for (int mv = 0; mv < 2; ++mv)
#pragma unroll
        for (int ms = 0; ms < 2; ++ms)
#pragma unroll
            for (int st = 0; st < 2; ++st) { const bf16* p = IT + (32 * mv + r) * 64 + 32 * ms + 16 * st + 4 * h; const u32x2 x0 = *(const u32x2*)p, x1 = *(const u32x2*)(p + 8);
                itf[mv][ms][st] = __builtin_bit_cast(bf16x8, ((u32x4){x0.x, x0.y, x1.x, x1.y})); }
    float* alb = ALOC + (size_t)unit * 4096 + (4 * h) * 64 + r;
#pragma unroll
    for (int nk = 0; nk < 2; ++nk) {
        bf16x8 kdf[2][2];
#pragma unroll
        for (int ms = 0; ms < 2; ++ms)
#pragma unroll
            for (int st = 0; st < 2; ++st) { const bf16* p = KD + (32 * nk + r) * 64 + 32 * ms + 16 * st + 4 * h; const u32x2 x0 = *(const u32x2*)p, x1 = *(const u32x2*)(p + 8);
                kdf[ms][st] = __builtin_bit_cast(bf16x8, ((u32x4){x0.x, x0.y, x1.x, x1.y})); }
#pragma unroll
        for (int mv = 0; mv < 2; ++mv) {
            f32x16 acc = zero16();
#pragma unroll
            for (int ms = 0; ms < 2; ++ms)
#pragma unroll
                for (int st = 0; st < 2; ++st) acc = MFMA32(itf[mv][ms][st], kdf[ms][st], acc);
#pragma unroll
            for (int i = 0; i < 16; ++i) alb[(32 * mv + (i & 3) + 8 * (i >> 2)) * 64 + 32 * nk] = acc[i];
        }
    }
#pragma unroll
    for (int nt = 0; nt < 2; ++nt) {
        bf16x8 af[4];
#pragma unroll
        for (int ks = 0; ks < 4; ++ks) af[ks] = *(const bf16x8*)(Am + (32 * nt + r) * 64 + 16 * ks + 8 * h);
        f32x16 oi[2]; oi[0] = zero16(); oi[1] = zero16();
#pragma unroll
        for (int ms = 0; ms < 2; ++ms) {
            if (ms <= nt) {
                f32x16 sacc = zero16();
#pragma unroll
                for (int ks = 0; ks < 4; ++ks) { const bf16x8 bf_ = *(const bf16x8*)(Bm + (32 * ms + r) * 64 + 16 * ks + 8 * h); sacc = MFMA32(bf_, af[ks], sacc); }
                if (ms == nt) {
#pragma unroll
                    for (int i = 0; i < 16; ++i) if (crow(i, h) > r) sacc[i] = 0.f;
                }
#pragma unroll
                for (int st = 0; st < 2; ++st) { const bf16x8 pf = pack8(sacc, st); oi[0] = MFMA32(itf[0][ms][st], pf, oi[0]); oi[1] = MFMA32(itf[1][ms][st], pf, oi[1]); }
            }
        }
        const size_t orow = (size_t)(row0 + 32 * nt + r) * 256 + hh * 64;
#pragma unroll
        for (int mv = 0; mv < 2; ++mv)
#pragma unroll
            for (int gq = 0; gq < 4; ++gq) *(f32x4*)(OINTRA + orow + 32 * mv + 8 * gq + 4 * h) = (f32x4){oi[mv][4 * gq], oi[mv][4 * gq + 1], oi[mv][4 * gq + 2], oi[mv][4 * gq + 3]};
    }
#endif
    asm volatile("s_waitcnt lgkmcnt(0)" ::: "memory");
}

DI void phase_t(const Ctx& a, int L, unsigned char* lds, int gw, int NGW, int wave, int lane, bool conv_here) {
    const int blk = gw >> 3, G = NGW >> 3;
    if (wave < 4) { for (int u = blk * 4 + wave; u < 1024; u += G * 4) h1_unit(a, L, u, lds + wave * 32768, lane); }
    else if (wave < 6) { for (int u = blk * 2 + (wave - 4); u < 512; u += G * 2) pool_unit(a, L, u, lane); }
    __syncthreads();
    if (conv_here && L + 1 < DEPTH) { float* scr = (float*)(lds + wave * 16384); for (int it = gw; it < WC_ITEMS; it += NGW) wconv_item(a, L + 1, it, scr, lane); }
}

DI void attn_unit(const Ctx& a, int bh, int qb, unsigned char* lds, int tid, int wave, int lane) {
    asm volatile("" : "+v"(lane), "+v"(tid));
    const int r = lane & 31, h = lane >> 5, b = bh >> 3, hd = bh & 7, own = qb, nsel = own < 3 ? own : 3;
    const bf16* Q = (const bf16*)(a.ws + WS_R + R_Q); const bf16* Kb = (const bf16*)(a.ws + WS_R + R_K); const bf16* Vb = (const bf16*)(a.ws + WS_R + R_V);
    const float* kmp = (const float*)(a.ws + WS_KMP); bf16* Y = (bf16*)(a.ws + WS_R + R_Y);
    unsigned char* part = lds;
    unsigned short* llist = (unsigned short*)(lds + 104448);
    int* lcnt = (int*)(lds + 120832); int* itab = lcnt + 32;
    const size_t qbase = ((size_t)bh * SEQ + (size_t)qb * 256) * 64;
    if (own > 0) {
        if (tid < 32) lcnt[tid] = 0;
        float* km = (float*)(lds + 122880);
        for (int idx = tid; idx < own * 64; idx += NTHR) { const float* p0 = kmp + (size_t)((b * 32 + (idx >> 6)) * 2) * 512 + hd * 64 + (idx & 63); km[idx] = p0[0] + p0[512]; }
        __syncthreads();
        if (tid < 256) {
            float q[64];
            { const u32x4* qp = (const u32x4*)(Q + qbase + (size_t)tid * 64);
#pragma unroll
              for (int i = 0; i < 8; ++i) { const u32x4 w = qp[i];
                  q[8 * i + 0] = __uint_as_float(w.x << 16); q[8 * i + 1] = __uint_as_float(w.x & 0xffff0000u); q[8 * i + 2] = __uint_as_float(w.y << 16); q[8 * i + 3] = __uint_as_float(w.y & 0xffff0000u);
                  q[8 * i + 4] = __uint_as_float(w.z << 16); q[8 * i + 5] = __uint_as_float(w.z & 0xffff0000u); q[8 * i + 6] = __uint_as_float(w.w << 16); q[8 * i + 7] = __uint_as_float(w.w & 0xffff0000u); } }
            float g0 = -INFINITY, g1 = -INFINITY, g2 = -INFINITY; int i0 = 0, i1 = 0, i2 = 0;
            for (int j = 0; j < own; ++j) {
                const float* kj = km + j * 64;
                float g = 0.f;
#pragma unroll
                for (int d = 0; d < 64; d += 4) { const f32x4 x0 = *(const f32x4*)(kj + d);
                    g += q[d] * x0[0] + q[d + 1] * x0[1] + q[d + 2] * x0[2] + q[d + 3] * x0[3]; }
                if (g > g0) { g2 = g1; i2 = i1; g1 = g0; i1 = i0; g0 = g; i0 = j; }
                else if (g > g1) { g2 = g1; i2 = i1; g1 = g; i1 = j; }
                else if (g > g2) { g2 = g; i2 = j; }
            }
#pragma unroll
            for (int s = 0; s < 3; ++s) {
                if (s < nsel) { const int j = s == 0 ? i0 : (s == 1 ? i1 : i2); const int pos = atomicAdd(lcnt + j, 1); llist[j * 256 + pos] = (unsigned short)(tid | (s << 8)); }
            }
        }
        __syncthreads();
        if (tid == 0) { int n = 0; for (int j = 0; j < own; ++j) { const int ng = (lcnt[j] + 31) >> 5; for (int g = 0; g < ng; ++g) itab[n++] = j | (g << 8); } itab[64] = n; }
        __syncthreads();
        const int nitems = __builtin_amdgcn_readfirstlane(itab[64]);
        for (int it = wave; it < nitems; it += NWAVES) {
            const int ent = __builtin_amdgcn_readfirstlane(itab[it]); const int j = ent & 255, g = ent >> 8, n = __builtin_amdgcn_readfirstlane(lcnt[j]);
            const int idx = g * 32 + r; const bool valid = idx < n;
            const unsigned e = llist[j * 256 + (valid ? idx : 0)];
            const int qi = e & 255, slot = e >> 8;
            float mo, lo_; f32x16 ot[2];
            attn_core<false>(Q + qbase + (size_t)qi * 64, Kb + ((size_t)bh * 32 + j) * 16384, Vb + ((size_t)bh * 32 + j) * 16384, 8, r, h, mo, lo_, ot);
            if (valid) {
                unsigned char* rec = part + (qi * 3 + slot) * 136; const float inv = 1.0f / lo_;
#pragma unroll
                for (int md = 0; md < 2; ++md)
#pragma unroll
                    for (int gq = 0; gq < 4; ++gq) { u32x2 o; o.x = cvtpk(ot[md][4 * gq] * inv, ot[md][4 * gq + 1] * inv); o.y = cvtpk(ot[md][4 * gq + 2] * inv, ot[md][4 * gq + 3] * inv);
                        *(u32x2*)(rec + 2 * (32 * md + 8 * gq + 4 * h)) = o; }
                if (h == 0) { *(float*)(rec + 128) = mo; *(float*)(rec + 132) = lo_; }
            }
        }
        __syncthreads();
    }
    {
        const int ql = 32 * wave + r, t = qb * 256 + ql;
        float m0, l0; f32x16 ot[2];
        attn_core<true>(Q + qbase + (size_t)ql * 64, Kb + ((size_t)bh * 32 + qb) * 16384, Vb + ((size_t)bh * 32 + qb) * 16384, wave + 1, r, h, m0, l0, ot);
        float ms[3], ls[3]; float mx = m0;
#pragma unroll
        for (int s = 0; s < 3; ++s) { ms[s] = -INFINITY; ls[s] = 0.f; if (s < nsel) { const unsigned char* rec = part + (ql * 3 + s) * 136; ms[s] = *(const float*)(rec + 128); ls[s] = *(const float*)(rec + 132); mx = fmaxf(mx, ms[s]); } }
        const float w0 = __expf(m0 - mx); float den = w0 * l0;
#pragma unroll
        for (int md = 0; md < 2; ++md)
#pragma unroll
            for (int i = 0; i < 16; ++i) ot[md][i] *= w0;
#pragma unroll
        for (int s = 0; s < 3; ++s) {
            if (s < nsel) {
                const unsigned char* rec = part + (ql * 3 + s) * 136; const float ws_ = __expf(ms[s] - mx) * ls[s]; den += ws_;
#pragma unroll
                for (int md = 0; md < 2; ++md)
#pragma unroll
                    for (int gq = 0; gq < 4; ++gq) { const u32x2 w = *(const u32x2*)(rec + 2 * (32 * md + 8 * gq + 4 * h));
                        ot[md][4 * gq] += ws_ * __uint_as_float(w.x << 16); ot[md][4 * gq + 1] += ws_ * __uint_as_float(w.x & 0xffff0000u);
                        ot[md][4 * gq + 2] += ws_ * __uint_as_float(w.y << 16); ot[md][4 * gq + 3] += ws_ * __uint_as_float(w.y & 0xffff0000u); }
            }
        }
        float inv = 1.0f / den; const size_t yrow = (size_t)(b * SEQ + t) * 1024 + hd * 64;
#ifdef DBG_AMP_ATTN
        inv *= 64.f;
#endif
#pragma unroll
        for (int md = 0; md < 2; ++md)
#pragma unroll
            for (int gq = 0; gq < 4; ++gq) { u32x2 o; o.x = cvtpk(ot[md][4 * gq] * inv, ot[md][4 * gq + 1] * inv); o.y = cvtpk(ot[md][4 * gq + 2] * inv, ot[md][4 * gq + 3] * inv);
                *(u32x2*)(Y + yrow + 32 * md + 8 * gq + 4 * h) = o; }
    }
    __syncthreads();
}

DI void phase_a(const Ctx& a, int L, unsigned char* lds, int gw, int NGW, int tid, int wave, int lane) {
    if ((gw & 3) == 0 && (gw >> 2) < 512) {
        const int chunk = gw >> 2, bhh = chunk >> 6, e = (chunk & 63) * 64 + lane, k = e & 63;
        const float* ALOC = (const float*)(a.ws + WS_R + R_ALOC); const float* DEC = (const float*)(a.ws + WS_DEC); bf16* SP = (bf16*)(a.ws + WS_R + R_SP);
        float st = 0.f;
#pragma unroll 32
        for (int n = 0; n < 128; ++n) { const int item = bhh * 128 + n; const float av = ALOC[(size_t)item * 4096 + e], dv = DEC[item * 64 + k];
            SP[(size_t)item * 4096 + e] = (bf16)(cvtpk(st, 0.f) & 0xffffu); st = dv * st + av; }
    }
    const int G = NGW / NWAVES, blk = gw / NWAVES;
    for (int u = blk; u < 512; u += G) {
        const int v = u & 255, bh = v >> 4, qb = (u < 256) ? (v & 15) : 31 - (v & 15);
        attn_unit(a, bh, qb, lds, tid, wave, lane);
    }
}

DI void own_unit(const Ctx& a, int bhi, int qg, int lane) {
    asm volatile("" : "+v"(lane));
    const int r = lane & 31, h = lane >> 5, t0 = qg * 32, j = t0 >> 8, nkg = ((t0 & 255) >> 5) + 1, t = t0 + r;
    const int b = bhi >> 3, hd = bhi & 7; const size_t bh = (size_t)bhi;
    const bf16* Q = (const bf16*)(a.ws + WS_R + R_Q); const bf16* Kb = (const bf16*)(a.ws + WS_R + R_K); const bf16* Vb = (const bf16*)(a.ws + WS_R + R_V);
    const bf16* PO = (const bf16*)(a.ws + WS_R + R_PO); const float* PML = (const float*)(a.ws + WS_R + R_PML); bf16* Y = (bf16*)(a.ws + WS_R + R_Y);
    float m0, l0; f32x16 ot[2];
    attn_core<true>(Q + (bh * SEQ + t) * 64, Kb + (bh * 32 + j) * 16384, Vb + (bh * 32 + j) * 16384, nkg, r, h, m0, l0, ot);
#ifdef DBG_OWN_ONLY
    const int nsel = 0;
#else
    const int nsel = j < 3 ? j : 3;
#endif
    const size_t pi = (bh * SEQ + t) * 3;
    float ms[3], ls[3]; float mx = m0;
#pragma unroll
    for (int s = 0; s < 3; ++s) { ms[s] = -INFINITY; ls[s] = 0.f; if (s < nsel) { ms[s] = ld_sc1f(PML + (pi + s) * 2); ls[s] = ld_sc1f(PML + (pi + s) * 2 + 1); mx = fmaxf(mx, ms[s]); } }
    const float w0 = __expf(m0 - mx); float den = w0 * l0;
#pragma unroll
    for (int md = 0; md < 2; ++md)
#pragma unroll
        for (int i = 0; i < 16; ++i) ot[md][i] *= w0;
#pragma unroll
    for (int s = 0; s < 3; ++s) {
        if (s < nsel) {
            const float ws_ = __expf(ms[s] - mx) * ls[s]; den += ws_;
#pragma unroll
            for (int md = 0; md < 2; ++md)
#pragma unroll
                for (int gq = 0; gq < 4; ++gq) { const u32x2 w = *(const u32x2*)(PO + (pi + s) * 64 + 32 * md + 8 * gq + 4 * h);
                    ot[md][4 * gq] += ws_ * __uint_as_float(w.x << 16); ot[md][4 * gq + 1] += ws_ * __uint_as_float(w.x & 0xffff0000u);
                    ot[md][4 * gq + 2] += ws_ * __uint_as_float(w.y << 16); ot[md][4 * gq + 3] += ws_ * __uint_as_float(w.y & 0xffff0000u); }
        }
    }
    float inv = 1.0f / den; const size_t yrow = (size_t)(b * SEQ + t) * 1024 + hd * 64;
#ifdef DBG_ZERO_ATTN
    inv = 0.f;
#endif
#pragma unroll
    for (int md = 0; md < 2; ++md)
#pragma unroll
        for (int gq = 0; gq < 4; ++gq) { u32x2 o; o.x = cvtpk(ot[md][4 * gq] * inv, ot[md][4 * gq + 1] * inv); o.y = cvtpk(ot[md][4 * gq + 2] * inv, ot[md][4 * gq + 3] * inv);
            *(u32x2*)(Y + yrow + 32 * md + 8 * gq + 4 * h) = o; }
}

DI void h3_unit(const Ctx& a, int L, int unit, int lane) {
    asm volatile("" : "+v"(lane));
    const int b = unit >> 9, hh = (unit >> 7) & 3, n = unit & 127, r = lane & 31, h = lane >> 5;
    const int row0 = b * SEQ + n * 64;
    const bf16* SP = (const bf16*)(a.ws + WS_R + R_SP) + (size_t)unit * 4096; const bf16* QDEC = (const bf16*)(a.ws + WS_R + R_QDEC);
    const float* OINTRA = (const float*)(a.ws + WS_R + R_OINTRA); const bf16* GH = (const bf16*)(a.ws + WS_R + R_U5) + (size_t)4 * M * 256; bf16* Y = (bf16*)(a.ws + WS_R + R_Y);
    const float* on = a.in(I_HON) + L * 64;
    bf16x8 sf[2][4];
#pragma unroll
    for (int mv = 0; mv < 2; ++mv)
#pragma unroll
        for (int ks = 0; ks < 4; ++ks) sf[mv][ks] = *(const bf16x8*)(SP + (32 * mv + r) * 64 + 16 * ks + 8 * h);
#pragma unroll
    for (int nt = 0; nt < 2; ++nt) {
        const size_t trow = (size_t)(row0 + 32 * nt + r) * 256 + hh * 64;
        f32x16 o[2]; o[0] = zero16(); o[1] = zero16();
#pragma unroll
        for (int ks = 0; ks < 4; ++ks) { const bf16x8 qf = *(const bf16x8*)(QDEC + trow + 16 * ks + 8 * h); o[0] = MFMA32(sf[0][ks], qf, o[0]); o[1] = MFMA32(sf[1][ks], qf, o[1]); }
        float ss = 0.f;
#pragma unroll
        for (int mv = 0; mv < 2; ++mv)
#pragma unroll
            for (int gq = 0; gq < 4; ++gq) { const f32x4 x = *(const f32x4*)(OINTRA + trow + 32 * mv + 8 * gq + 4 * h);
#pragma unroll
                for (int i = 0; i < 4; ++i) { o[mv][4 * gq + i] += x[i]; ss += o[mv][4 * gq + i] * o[mv][4 * gq + i]; } }
        ss += __shfl_xor(ss, 32);
        float rn = rsqrtf(ss * (1.0f / 64.0f) + 1e-6f);
#ifdef DBG_ZERO_HGRN
        rn = 0.f;
#endif
#ifdef DBG_AMP_HGRN
        rn *= 16.f;
#endif
        const size_t yrow = (size_t)(row0 + 32 * nt + r) * 1024 + 768 + hh * 64;
#pragma unroll
        for (int mv = 0; mv < 2; ++mv)
#pragma unroll
            for (int gq = 0; gq < 4; ++gq) { const int v0 = 32 * mv + 8 * gq + 4 * h; const f32x4 gn = *(const f32x4*)(on + v0); const u32x2 gw_ = *(const u32x2*)(GH + trow + v0);
                const float g0 = __uint_as_float(gw_.x << 16), g1 = __uint_as_float(gw_.x & 0xffff0000u), g2 = __uint_as_float(gw_.y << 16), g3 = __uint_as_float(gw_.y & 0xffff0000u);
                u32x2 w; w.x = cvtpk(o[mv][4 * gq] * rn * gn[0] * pg8::silu_f(g0), o[mv][4 * gq + 1] * rn * gn[1] * pg8::silu_f(g1));
                w.y = cvtpk(o[mv][4 * gq + 2] * rn * gn[2] * pg8::silu_f(g2), o[mv][4 * gq + 3] * rn * gn[3] * pg8::silu_f(g3));
                *(u32x2*)(Y + yrow + v0) = w; }
    }
}

DI void phase_c(const Ctx& a, int L, int gw, int NGW, int lane) {
    for (int u = gw; u < 1024; u += NGW) h3_unit(a, L, u, lane);
}

#define LAS __attribute__((address_space(3)))
#define XB_TMO      128
#define XB_XCNT(j)  (256  + 64 * (j))
#define XB_XSUB(j)  (1280 + 64 * (j))
#define XB_XGEN(j)  (2304 + 64 * (j))
#define XB_TOP      3328
#define XB_TOPGEN   3392
#define XCD_BAR_WORDS 3456
#define XB_SPIN_CAP (1u << 18)

__device__ __forceinline__ unsigned xb_ld(unsigned* p)              { return __hip_atomic_load(p, __ATOMIC_RELAXED, __HIP_MEMORY_SCOPE_AGENT); }
__device__ __forceinline__ unsigned xb_add(unsigned* p, unsigned v) { return __hip_atomic_fetch_add(p, v, __ATOMIC_RELAXED, __HIP_MEMORY_SCOPE_AGENT); }
__device__ __forceinline__ unsigned xb_xcc_id() { return (unsigned)__builtin_amdgcn_s_getreg((3 << 11) | 20) & 0xFu; }
#define XB_SPIN(cond, bar) do { unsigned _sp = 0; while (cond) { __builtin_amdgcn_s_sleep(1); \
    if ((++_sp & 255u) == 0u) { if (xb_ld(&(bar)[XB_TMO])) break; if (_sp > XB_SPIN_CAP) { atomicAdd(&(bar)[XB_TMO], 1u); break; } } } } while (0)

struct XcdBarrier {
    unsigned* bar; unsigned x;
    volatile LAS unsigned* st;
};

__device__ __forceinline__ XcdBarrier xcd_barrier_post(unsigned* bar, volatile LAS unsigned* st) {
    XcdBarrier b; b.bar = bar; b.x = xb_xcc_id(); b.st = st;
    if (threadIdx.x == 0) (void)xb_add(&bar[XB_XCNT(b.x)], 1u);
    return b;
}
__device__ __forceinline__ void xcd_barrier_complete(unsigned* bar, unsigned x, unsigned& nloc, unsigned& nx) {
    const unsigned G = gridDim.x * gridDim.y * gridDim.z;
    unsigned sum, cnt, mine, sp = 0u;
    for (;;) {
        sum = 0u; cnt = 0u; mine = 0u;
#pragma unroll
        for (unsigned j = 0; j < 16; ++j) { const unsigned c = xb_ld(&bar[XB_XCNT(j)]); sum += c; cnt += (c > 0u) ? 1u : 0u; mine = (j == x) ? c : mine; }
        if (sum == G) break;
        __builtin_amdgcn_s_sleep(1);
        if ((++sp & 255u) == 0u) { if (xb_ld(&bar[XB_TMO])) break; if (sp > XB_SPIN_CAP) { atomicAdd(&bar[XB_TMO], 1u); break; } }
    }
    nloc = mine > 0u ? mine : 1u; nx = cnt > 0u ? cnt : 1u;
}

__device__ __forceinline__ void xcd_barrier(const XcdBarrier& b) {
    asm volatile("s_waitcnt vmcnt(0)" ::: "memory");
    __syncthreads();
    if (threadIdx.x == 0) {
        unsigned* bar = b.bar;
        __builtin_amdgcn_s_waitcnt(0);
        unsigned nloc = b.st[0], nx = b.st[1];
        if (nloc == 0u) { xcd_barrier_complete(bar, b.x, nloc, nx); b.st[0] = nloc; b.st[1] = nx; }
        const unsigned old = xb_add(&bar[XB_XSUB(b.x)], 1u);
        const unsigned gen = old / nloc;
        if (old + 1u == (gen + 1u) * nloc) {
            __builtin_amdgcn_fence(__ATOMIC_RELEASE, "agent");
            asm volatile("s_waitcnt vmcnt(0)" ::: "memory");
            const unsigned og = xb_add(&bar[XB_TOP], 1u);
            const unsigned tg = og / nx;
            if (og + 1u == (tg + 1u) * nx) xb_add(&bar[XB_TOPGEN], 1u);
            else XB_SPIN(xb_ld(&bar[XB_TOPGEN]) == tg, bar);
            __builtin_amdgcn_fence(__ATOMIC_ACQUIRE, "agent");
            xb_add(&bar[XB_XGEN(b.x)], 1u);
            asm volatile("s_waitcnt vmcnt(0)" ::: "memory");
        } else {
            XB_SPIN(xb_ld(&bar[XB_XGEN(b.x)]) == gen, bar);
            __builtin_amdgcn_fence(__ATOMIC_ACQUIRE, "agent");
            asm volatile("s_waitcnt vmcnt(0)" ::: "memory");
        }
    }
    __syncthreads();
}

template <int MASK> __global__ void __launch_bounds__(NTHR, 2) mk_fwd(Args args) {
    extern __shared__ __attribute__((aligned(16))) unsigned char lds[];
    const int G = gridDim.x, NGW = G * NWAVES;
    cg::grid_group grid = cg::this_grid();
    const int ph_lo = args.ph_lo, ph_hi = args.ph_hi;
    volatile LAS unsigned* bst = (volatile LAS unsigned*)((LAS unsigned char*)lds + 131072);
    if (threadIdx.x == 0) { bst[0] = 0u; bst[1] = 0u; }
    __syncthreads();
    XcdBarrier bar; bar.bar = nullptr; bar.x = 0; bar.st = bst;
    for (int ph = ph_lo; ph < ph_hi; ++ph) {
        if (ph > ph_lo) {
            if (ph == ph_lo + 1) {
                grid.sync();
                bar = xcd_barrier_post((unsigned*)(args.ws + WS_CTL + 65536), bst);
            } else { xcd_barrier(bar);
#ifdef DBG_DUP_BAR
                xcd_barrier(bar);
#endif
            }
        }
        int tid_v = threadIdx.x; asm volatile("" : "+v"(tid_v));
        const int tid = tid_v, lane = tid & 63, wave = __builtin_amdgcn_readfirstlane(tid >> 6), gw = blockIdx.x * NWAVES + wave;
        kptr_t kp = (kptr_t)__builtin_amdgcn_kernarg_segment_ptr();
        asm volatile("" : "+s"(kp));
        Ctx a; a.kp = kp; a.out = *(float* const __attribute__((address_space(4)))*)(kp + 144); a.ws = *(unsigned char* const __attribute__((address_space(4)))*)(kp + 152);
        unsigned char* ws = a.ws;
        float* stats = (float*)(ws + WS_STATS); bf16* xb = (bf16*)(ws + WS_XB); bf16* hid = (bf16*)(ws + WS_R + R_HID);
        if (ph == 0) {
if constexpr (MASK & 1) { phase_p0(a, lds, gw, NGW, wave, lane);
#ifdef DBG_DUP_P0
 __syncthreads(); phase_p0(a, lds, gw, NGW, wave, lane);
#endif
 }
 __syncthreads(); continue; }
        const int L = (ph - 1) / 9, sub = (ph - 1) % 9;
        unsigned char* wb = ws + WS_W + (size_t)(L & 1) * WSZ;
        if (sub == 0 || sub == 7) {
            pg8::Gemm g{xb, (const bf16*)(wb + (sub == 0 ? W_GU1 : W_GU2)), M, 2 * FF, D}; pg8::StaticOrder S; S.init(M, 2 * FF, G, (int)blockIdx.x);
            pg8::EpiSwiGLU E{hid, stats, FF};
            if constexpr (MASK & 2) pg8::gemm_phase<pg8::EpiSwiGLU, pg8::StaticOrder, PG8_ALIGN, PG8_SP2>((PG8_LAS unsigned char*)lds, g, S, E);
            if constexpr ((MASK & 2) && (MASK & 16)) {
                if (G == 256 && L + 1 < DEPTH && blockIdx.x >= 128) {
                    __syncthreads();
                    float* scr = (float*)(lds + wave * 16384); const int half = sub == 7 ? 1 : 0;
                    for (int it = half * (WC_ITEMS / 2) + ((int)blockIdx.x - 128) * NWAVES + wave; it < (half + 1) * (WC_ITEMS / 2); it += 128 * NWAVES) wconv_item(a, L + 1, it, scr, lane);
                }
            }
#if defined(DBG_DUP_G) && DBG_DUP_G == 1
            __syncthreads(); if constexpr (MASK & 2) pg8::gemm_phase<pg8::EpiSwiGLU, pg8::StaticOrder, PG8_ALIGN, PG8_SP2>((PG8_LAS unsigned char*)lds, g, S, E);
#endif
        } else if (sub == 1 || sub == 6 || sub == 8) {
            const bf16* A = sub == 6 ? (const bf16*)(ws + WS_R + R_Y) : hid; const int K = sub == 6 ? D : FF;
            const bf16* Bt = (const bf16*)(wb + (sub == 1 ? W_D1 : (sub == 6 ? W_OUT : W_D2)));
            pg8::Gemm g{A, Bt, M, D, K}; pg8::StaticOrder S; S.init(M, D, G, (int)blockIdx.x);
            pg8::EpiResid E{a.out, xb, stats, sub == 6 ? 1.0f : 0.5f};
            if constexpr (MASK & 4) pg8::gemm_phase<pg8::EpiResid, pg8::StaticOrder, PG8_ALIGN, PG8_SP2>((PG8_LAS unsigned char*)lds, g, S, E);
#if defined(DBG_DUP_G) && DBG_DUP_G == 2
            __syncthreads(); { pg8::EpiResid E0{a.out, xb, stats, 0.0f}; if constexpr (MASK & 4) pg8::gemm_phase<pg8::EpiResid, pg8::StaticOrder, PG8_ALIGN, PG8_SP2>((PG8_LAS unsigned char*)lds, g, S, E0); }
#endif
        } else if (sub == 2) {
            pg8::Gemm g{xb, (const bf16*)(wb + W_IN), M, INW, D}; pg8::StaticOrder S; S.init(M, INW, G, (int)blockIdx.x);
            pg8::EpiProj E{(bf16*)(ws + WS_R + R_Q), (bf16*)(ws + WS_R + R_K), (bf16*)(ws + WS_R + R_V), (bf16*)(ws + WS_R + R_U5), (float*)(ws + WS_KMP), stats,
                           (const float*)(ws + WS_ROPEC), (const float*)(ws + WS_ROPES), a.in(I_QN) + L * 64, a.in(I_KN) + L * 64};
            if constexpr (MASK & 8) pg8::gemm_phase<pg8::EpiProj, pg8::StaticOrder, PG8_ALIGN, PG8_SP2>((PG8_LAS unsigned char*)lds, g, S, E);
#if defined(DBG_DUP_G) && DBG_DUP_G == 3
            __syncthreads(); if constexpr (MASK & 8) pg8::gemm_phase<pg8::EpiProj, pg8::StaticOrder, PG8_ALIGN, PG8_SP2>((PG8_LAS unsigned char*)lds, g, S, E);
#endif
        } else if (sub == 3) {
if constexpr (MASK & 16) { phase_t(a, L, lds, gw, NGW, wave, lane, !(MASK & 2) || G != 256);
#if defined(DBG_DUP_SUB) && DBG_DUP_SUB == 3
 __syncthreads(); phase_t(a, L, lds, gw, NGW, wave, lane, !(MASK & 2) || G != 256);
#endif
 }
 __syncthreads(); }
        else if (sub == 4) {
if constexpr (MASK & 32) { phase_a(a, L, lds, gw, NGW, tid, wave, lane);
#if defined(DBG_DUP_SUB) && DBG_DUP_SUB == 4
 __syncthreads(); phase_a(a, L, lds, gw, NGW, tid, wave, lane);
#endif
 }
 __syncthreads(); }
        else {
if constexpr (MASK & 64) { phase_c(a, L, gw, NGW, lane);
#if defined(DBG_DUP_SUB) && DBG_DUP_SUB == 5
 __syncthreads(); phase_c(a, L, gw, NGW, lane);
#endif
 }
 __syncthreads(); }
    }
}

#ifndef MK_MULTI
#define MK_MULTI 0
#endif
#ifndef DBG_NPH
#define DBG_NPH (1 + 9 * DEPTH)
#endif
constexpr int N_PHASES = DBG_NPH;
static int phase_mask(int ph) { if (ph == 0) return 1; const int sub = (ph - 1) % 9; const int m[9] = {2, 4, 8, 16, 32, 64, 4, 2, 4}; return m[sub]; }
template <int MASK> static bool setup_one(int& per_cu) {
    if (hipFuncSetAttribute((const void*)mk_fwd<MASK>, hipFuncAttributeMaxDynamicSharedMemorySize, LDS_BYTES) != hipSuccess) return false;
    if (hipOccupancyMaxActiveBlocksPerMultiprocessor(&per_cu, (const void*)mk_fwd<MASK>, NTHR, LDS_BYTES) != hipSuccess) per_cu = 1;
    (void)hipGetLastError(); return true;
}
template <int MASK> static void launch_one(const Args& a, int grid, hipStream_t stream) { hipLaunchKernelGGL(mk_fwd<MASK>, dim3(grid), dim3(NTHR), LDS_BYTES, stream, a); }
extern "C" void kernel_launch(void* const* d_in, const int* in_sizes, int n_in, void* d_out, int out_size, void* d_ws, size_t ws_size, hipStream_t stream) {
    static int grid = 0;
    if (grid == 0) {
        if (n_in != 18 || in_sizes[0] != M * D || out_size != M * D || ws_size < WS_END) { fprintf(stderr, "kernel_launch: unexpected shapes / workspace (n_in %d, ws %zu < %zu)\n", n_in, ws_size, (size_t)WS_END); grid = -1; return; }
        int dev = 0, cus = 0, per_cu = 0; bool ok = true;
        (void)hipGetDevice(&dev); (void)hipDeviceGetAttribute(&cus, hipDeviceAttributeMultiprocessorCount, dev);
#if MK_MULTI
        ok = setup_one<1>(per_cu) && setup_one<2>(per_cu) && setup_one<4>(per_cu) && setup_one<8>(per_cu) && setup_one<16>(per_cu) && setup_one<32>(per_cu) && setup_one<64>(per_cu);
#else
        ok = setup_one<127>(per_cu);
#endif
        if (!ok) { fprintf(stderr, "kernel_launch: hipFuncSetAttribute failed\n"); grid = -1; return; }
        grid = cus;
    }
    if (grid < 0) return;
    Args a{};
    for (int i = 0; i < 18; ++i) a.in[i] = (const float*)d_in[i];
    a.out = (float*)d_out; a.ws = (unsigned char*)d_ws;
#if MK_MULTI
    for (int ph = 0; ph < N_PHASES; ++ph) { a.ph_lo = ph; a.ph_hi = ph + 1;
        switch (phase_mask(ph)) { case 1: launch_one<1>(a, grid, stream); break; case 2: launch_one<2>(a, grid, stream); break; case 4: launch_one<4>(a, grid, stream); break; case 8: launch_one<8>(a, grid, stream); break;
                                  case 16: launch_one<16>(a, grid, stream); break; case 32: launch_one<32>(a, grid, stream); break; default: launch_one<64>(a, grid, stream); break; } }
#else
    a.ph_lo = 0; a.ph_hi = N_PHASES;
    void* args[] = {&a};
    hipError_t e = hipLaunchCooperativeKernel((const void*)mk_fwd<127>, dim3(grid), dim3(NTHR), args, LDS_BYTES, stream);
    if (e != hipSuccess) fprintf(stderr, "cooperative launch failed: %s (grid %d)\n", hipGetErrorString(e), grid);
#endif
}
```

```cpp
#include <hip/hip_runtime.h>
#include <hip/hip_cooperative_groups.h>
#include <cstdio>
#include <cstdint>
namespace cg = cooperative_groups;
#define MK_MULTI 0
namespace pg8 {
#define PG8_LAS __attribute__((address_space(3)))
typedef unsigned short bf16_t;
typedef short bf16x8 __attribute__((ext_vector_type(8)));
typedef float f32x4 __attribute__((ext_vector_type(4)));
typedef unsigned u32x4 __attribute__((ext_vector_type(4)));
constexpr int BM = 256, BK = 64, HALF = 128, HTB = HALF * BK * 2  , STAGE_BYTES = 8 * HTB, NXCD = 8, WGM = 8;

__host__ __device__ __forceinline__ int lds_byte(int r, int c) { const int st = (r >> 4) * 2 + (c >> 5), rr = r & 15, cc = c & 31, ob = rr * 64 + cc * 2; return st * 1024 + (ob ^ (((ob >> 9) & 1) << 5)); }
__host__ __device__ __forceinline__ void stage_rc(int b, int& R, int& C) { const int st = b / 1024, sb = b % 1024, swz = sb ^ (((sb >> 9) & 1) << 5); R = (st >> 1) * 16 + swz / 64; C = (st & 1) * 32 + (swz % 64) / 2; }
__host__ __device__ __forceinline__ int perm32(int rho) { const int n = rho >> 4, i = rho & 15; return 8 * (i >> 2) + 4 * n + (i & 3); }

struct Unit { int pm, pn; };
struct Gemm { const bf16_t* A; const bf16_t* Bt; int M, N, K; };

struct StaticOrder {
    int nM, nN, nwg, G, c;
    __host__ __device__ void init(int M, int N, int G_, int c_) { nM = M / BM; nN = N / BM; nwg = nM * nN; G = G_; c = c_; }
    __host__ __device__ bool next(int i, Unit& u) const {
        const long L = (long)i * G + c; if (L >= nwg) return false;
        int wgid = (int)L; { const int q = nwg / NXCD, r = nwg % NXCD, xcd = wgid % NXCD, off = wgid / NXCD; wgid = (xcd < r ? xcd * (q + 1) : r * (q + 1) + (xcd - r) * q) + off; }
        const int nig = WGM * nN, gid = wgid / nig, fm = gid * WGM, gsz = (nM - fm) < WGM ? (nM - fm) : WGM;
        u.pm = fm + ((wgid % nig) % gsz); u.pn = (wgid % nig) / gsz; return true;
    }
    __device__ __forceinline__ void a_ready(const Unit&) const {}
    __device__ __forceinline__ void done(const Unit&) const {}
};

__device__ __forceinline__ unsigned cvt_pk_bf16(float lo, float hi) { unsigned r; asm volatile("v_cvt_pk_bf16_f32 %0, %1, %2" : "=v"(r) : "v"(lo), "v"(hi)); return r; }
typedef float f32x2 __attribute__((ext_vector_type(2)));
typedef unsigned u32x2 __attribute__((ext_vector_type(2)));
typedef __bf16 bf16x2_t __attribute__((ext_vector_type(2)));
__device__ __forceinline__ unsigned cvtpk(float lo, float hi) { f32x2 v = {lo, hi}; bf16x2_t b = __builtin_convertvector(v, bf16x2_t); return __builtin_bit_cast(unsigned, b); }
__device__ __forceinline__ float row_rstd(const float* stats, int row) {
    const f32x4* p = (const f32x4*)(stats + (size_t)row * 16);
    const f32x4 a = p[0], b = p[1], c = p[2], d = p[3];
    const float s = ((a[0] + a[1]) + (a[2] + a[3])) + ((b[0] + b[1]) + (b[2] + b[3])) + ((c[0] + c[1]) + (c[2] + c[3])) + ((d[0] + d[1]) + (d[2] + d[3]));
    return rsqrtf(s * (1.0f / 1024.0f) + 1e-6f);
}
__device__ __forceinline__ void row_rstd4(const float* stats, int row0, float (&rs)[4]) {
    f32x4 p[4][4];
#pragma unroll
    for (int m = 0; m < 4; ++m)
#pragma unroll
        for (int k = 0; k < 4; ++k) p[m][k] = *(const f32x4*)(stats + (size_t)(row0 + 16 * m) * 16 + 4 * k);
#pragma unroll
    for (int m = 0; m < 4; ++m) { const f32x4 a = p[m][0], b = p[m][1], c = p[m][2], d = p[m][3];
        const float s = ((a[0] + a[1]) + (a[2] + a[3])) + ((b[0] + b[1]) + (b[2] + b[3])) + ((c[0] + c[1]) + (c[2] + c[3])) + ((d[0] + d[1]) + (d[2] + d[3]));
        rs[m] = rsqrtf(s * (1.0f / 1024.0f) + 1e-6f); }
}
__device__ __forceinline__ float silu_f(float g) { return g * __builtin_amdgcn_rcpf(1.0f + __expf(-g)); }

struct EpiSwiGLU {
    static constexpr bool PERM = true, AFTER_DRAIN = false;
    bf16_t* H; const float* stats; int ldh;
    __device__ __forceinline__ void operator()(const f32x4 (&acc)[2][2][4][2], const Unit& u, int wr, int wc, int fr, int fq) const {
        asm volatile("" : "+v"(fr), "+v"(fq));
        const int row0 = u.pm * BM + wr * 64 + fr, col0 = u.pn * HALF + wc * 32 + 8 * fq;
#pragma unroll
        for (int ai = 0; ai < 2; ++ai) {
            float rs4[4]; row_rstd4(stats, row0 + ai * HALF, rs4);
#pragma unroll
            for (int m = 0; m < 4; ++m) {
                const int row = row0 + ai * HALF + m * 16;
                const float rs = rs4[m];
                float h[8];
#pragma unroll
                for (int n = 0; n < 2; ++n)
#pragma unroll
                    for (int i = 0; i < 4; ++i) { const float g = acc[ai][0][m][n][i] * rs, up = acc[ai][1][m][n][i] * rs; h[4 * n + i] = silu_f(g) * up; }
                u32x4 w; w.x = cvtpk(h[0], h[1]); w.y = cvtpk(h[2], h[3]); w.z = cvtpk(h[4], h[5]); w.w = cvtpk(h[6], h[7]);
                *(u32x4*)(H + (size_t)row * ldh + col0) = w;
            }
        }
    }
};

struct EpiResid {
    static constexpr bool PERM = true, AFTER_DRAIN = false;
    const float* Xsrc; float* X; bf16_t* XB; float* stats; float scale;
    __device__ __forceinline__ void operator()(const f32x4 (&acc)[2][2][4][2], const Unit& u, int wr, int wc, int fr, int fq) const {
        asm volatile("" : "+v"(fr), "+v"(fq));
        const int row0 = u.pm * BM + wr * 64 + fr, col0 = u.pn * BM + wc * 32 + 8 * fq;
#pragma unroll
        for (int ai = 0; ai < 2; ++ai) {
            f32x4 xr[4][2][2];
#pragma unroll
            for (int m = 0; m < 4; ++m)
#pragma unroll
                for (int bj = 0; bj < 2; ++bj) { const float* xp = Xsrc + (size_t)(row0 + ai * HALF + m * 16) * 1024 + col0 + bj * HALF; xr[m][bj][0] = *(const f32x4*)xp; xr[m][bj][1] = *(const f32x4*)(xp + 4); }
#pragma unroll
            for (int m = 0; m < 4; ++m) {
                const int row = row0 + ai * HALF + m * 16; float ss = 0.f;
#pragma unroll
                for (int bj = 0; bj < 2; ++bj) {
                    float* xp = X + (size_t)row * 1024 + col0 + bj * HALF;
                    f32x4 x0 = xr[m][bj][0], x1 = xr[m][bj][1];
                    x0 = x0 + acc[ai][bj][m][0] * scale; x1 = x1 + acc[ai][bj][m][1] * scale;
                    *(f32x4*)xp = x0; *(f32x4*)(xp + 4) = x1;
                    ss += (x0[0] * x0[0] + x0[1] * x0[1]) + (x0[2] * x0[2] + x0[3] * x0[3]) + (x1[0] * x1[0] + x1[1] * x1[1]) + (x1[2] * x1[2] + x1[3] * x1[3]);
                    u32x4 w; w.x = cvtpk(x0[0], x0[1]); w.y = cvtpk(x0[2], x0[3]); w.z = cvtpk(x1[0], x1[1]); w.w = cvtpk(x1[2], x1[3]);
                    *(u32x4*)(XB + (size_t)row * 1024 + col0 + bj * HALF) = w;
                }
                ss += __shfl_xor(ss, 16); ss += __shfl_xor(ss, 32);
                if (fq == 0) stats[(size_t)row * 16 + u.pn * 4 + wc] = ss;
            }
        }
    }
};

struct EpiProj {
    static constexpr bool PERM = true, AFTER_DRAIN = false;
    bf16_t* Q; bf16_t* Kb; bf16_t* Vb; bf16_t* U5; float* kmp; const float* stats; const float* ropeC; const float* ropeS; const float* qn; const float* kn;
    __device__ __forceinline__ void operator()(const f32x4 (&acc)[2][2][4][2], const Unit& u, int wr, int wc, int fr, int fq) const {
        asm volatile("" : "+v"(fr), "+v"(fq));
        const int row0 = u.pm * BM + wr * 64 + fr;
        const int pn = u.pn;
        if (pn >= 6) {
            bf16_t* O = U5 + (size_t)(pn - 6) * (16384 * 256);
            const int col0 = wc * 32 + 8 * fq;
#pragma unroll
            for (int ai = 0; ai < 2; ++ai)
#pragma unroll
                for (int m = 0; m < 4; ++m) {
                    const int row = row0 + ai * HALF + m * 16; const float rs = row_rstd(stats, row);
#pragma unroll
                    for (int bj = 0; bj < 2; ++bj) {
                        const f32x4 v0 = acc[ai][bj][m][0] * rs, v1 = acc[ai][bj][m][1] * rs;
                        u32x4 w; w.x = cvtpk(v0[0], v0[1]); w.y = cvtpk(v0[2], v0[3]); w.z = cvtpk(v1[0], v1[1]); w.w = cvtpk(v1[2], v1[3]);
                        *(u32x4*)(O + (size_t)row * 256 + col0 + bj * HALF) = w;
                    }
                }
            return;
        }
        const int head = (pn & 1) * 4 + wc, b = u.pm >> 5, j = u.pm & 31;
        const size_t bh = (size_t)(b * 8 + head);
        if (pn >= 4) {
            bf16_t* vb = Vb + (bh * 32 + j) * 16384;
#pragma unroll
            for (int ai = 0; ai < 2; ++ai)
#pragma unroll
                for (int m = 0; m < 4; ++m) {
                    const int row = row0 + ai * HALF + m * 16; const float rs = row_rstd(stats, row);
                    const int kk = ai * HALF + wr * 64 + m * 16 + fr;
                    const int kg = kk >> 5, w = kk & 31, st = w >> 4, w16 = w & 15, hh = (w16 >> 2) & 1, jj = 4 * (w16 >> 3) + (w16 & 3);
#pragma unroll
                    for (int bj = 0; bj < 2; ++bj)
#pragma unroll
                        for (int n = 0; n < 2; ++n) {
                            const unsigned p0 = cvtpk(acc[ai][bj][m][n][0] * rs, acc[ai][bj][m][n][1] * rs), p1 = cvtpk(acc[ai][bj][m][n][2] * rs, acc[ai][bj][m][n][3] * rs);
#pragma unroll
                            for (int i = 0; i < 4; ++i) {
                                const int r = 8 * fq + 4 * n + i;
                                const unsigned pv = (i < 2) ? p0 : p1;
                                vb[((((kg * 2 + st) * 2 + bj) * 32 + r) * 2 + hh) * 8 + jj] = (bf16_t)((i & 1) ? (pv >> 16) : (pv & 0xffffu));
                            }
                        }
                }
            return;
        }
        const bool isk = pn >= 2;
        const float* gn = isk ? kn : qn;
        float ksum[16];
#pragma unroll
        for (int e = 0; e < 16; ++e) ksum[e] = 0.f;
#pragma unroll
        for (int ai = 0; ai < 2; ++ai)
#pragma unroll
            for (int m = 0; m < 4; ++m) {
                const int row = row0 + ai * HALF + m * 16; const float rs = row_rstd(stats, row);
                const int t = row & 8191, kk = t & 255;
                float v0[8], v1[8]; float ss = 0.f;
#pragma unroll
                for (int n = 0; n < 2; ++n)
#pragma unroll
                    for (int i = 0; i < 4; ++i) { v0[4 * n + i] = acc[ai][0][m][n][i] * rs; v1[4 * n + i] = acc[ai][1][m][n][i] * rs; ss += v0[4 * n + i] * v0[4 * n + i] + v1[4 * n + i] * v1[4 * n + i]; }
                ss += __shfl_xor(ss, 16); ss += __shfl_xor(ss, 32);
                const float rn = rsqrtf(ss * (1.0f / 64.0f) + 1e-6f);
                const f32x4 c0 = *(const f32x4*)(ropeC + t * 32 + 8 * fq), c1 = *(const f32x4*)(ropeC + t * 32 + 8 * fq + 4);
                const f32x4 s0 = *(const f32x4*)(ropeS + t * 32 + 8 * fq), s1 = *(const f32x4*)(ropeS + t * 32 + 8 * fq + 4);
                const f32x4 ga0 = *(const f32x4*)(gn + 8 * fq), ga1 = *(const f32x4*)(gn + 8 * fq + 4), gb0 = *(const f32x4*)(gn + 32 + 8 * fq), gb1 = *(const f32x4*)(gn + 36 + 8 * fq);
                float o0[8], o1[8];
#pragma unroll
                for (int e = 0; e < 8; ++e) {
                    const float x1 = v0[e] * rn * (e < 4 ? ga0[e & 3] : ga1[e & 3]), x2 = v1[e] * rn * (e < 4 ? gb0[e & 3] : gb1[e & 3]);
                    const float cs = e < 4 ? c0[e & 3] : c1[e & 3], sn = e < 4 ? s0[e & 3] : s1[e & 3];
                    o0[e] = x1 * cs - x2 * sn; o1[e] = x2 * cs + x1 * sn;
                }
                u32x4 w0, w1;
                w0.x = cvtpk(o0[0], o0[1]); w0.y = cvtpk(o0[2], o0[3]); w0.z = cvtpk(o0[4], o0[5]); w0.w = cvtpk(o0[6], o0[7]);
                w1.x = cvtpk(o1[0], o1[1]); w1.y = cvtpk(o1[2], o1[3]); w1.z = cvtpk(o1[4], o1[5]); w1.w = cvtpk(o1[6], o1[7]);
                if (!isk) {
                    bf16_t* qp = Q + (bh * 8192 + t) * 64 + 8 * fq;
                    *(u32x4*)qp = w0; *(u32x4*)(qp + 32) = w1;
                } else {
                    bf16_t* kb = Kb + (bh * 32 + j) * 16384;
                    const int kg = kk >> 5, r = kk & 31, hq = fq & 1, ksl = fq >> 1;
                    *(u32x4*)(kb + (((kg * 4 + ksl) * 32 + r) * 2 + hq) * 8) = w0;
                    *(u32x4*)(kb + (((kg * 4 + 2 + ksl) * 32 + r) * 2 + hq) * 8) = w1;
#pragma unroll
                    for (int e = 0; e < 8; ++e) { ksum[e] += o0[e]; ksum[8 + e] += o1[e]; }
                }
                asm volatile("" ::: "memory");
            }
        if (isk) {
#pragma unroll
            for (int e = 0; e < 16; ++e) { float s = ksum[e]; s += __shfl_xor(s, 1); s += __shfl_xor(s, 2); s += __shfl_xor(s, 4); s += __shfl_xor(s, 8); ksum[e] = s; }
            if (fr == 0) {
                float* kp = kmp + ((size_t)(u.pm * 2 + wr) * 512) + head * 64 + 8 * fq;
                *(f32x4*)kp = (f32x4){ksum[0], ksum[1], ksum[2], ksum[3]}; *(f32x4*)(kp + 4) = (f32x4){ksum[4], ksum[5], ksum[6], ksum[7]};
                *(f32x4*)(kp + 32) = (f32x4){ksum[8], ksum[9], ksum[10], ksum[11]}; *(f32x4*)(kp + 36) = (f32x4){ksum[12], ksum[13], ksum[14], ksum[15]};
            }
        }
    }
};

template <class Epi, class Sched, bool ALIGN_EPI = false, bool SP2 = false>
__device__ __forceinline__ void gemm_phase(PG8_LAS unsigned char* lds, const Gemm g, const Sched& S, const Epi& E) {
    int tid_v = threadIdx.x; asm volatile("" : "+v"(tid_v));
    const int tid = tid_v, wid = __builtin_amdgcn_readfirstlane(tid >> 6), lane = tid & 63, wr = wid >> 2, wc = wid & 3, fr = lane & 15, fq = lane >> 4;
    const int K = g.K, nt = K / BK;
    unsigned voffA[2], voffB[2];
#pragma unroll
    for (int i = 0; i < 2; ++i) { int R, C; stage_rc(tid * 16 + i * 8192, R, C); const int Rb = Epi::PERM ? ((R & ~31) + perm32(R & 31)) : R;
        voffA[i] = (unsigned)(R * K + C) * 2u; voffB[i] = (unsigned)(Rb * K + C) * 2u; }
    const size_t kstep = (size_t)(BK * 2);
    const size_t hstep = (size_t)HALF * K * 2;
    const size_t tstep = 2 * hstep;
    const unsigned ldsw = (unsigned)wid * 1024u;
    const int aoff = lds_byte(wr * 64 + fr, fq * 8), boff = lds_byte(wc * 32 + fr, fq * 8);
#define PG8_SA(b, h) (((b) * 2 + (h)) * HTB)
#define PG8_SB(b, h) ((4 + (b) * 2 + (h)) * HTB)
#define PG8_STAGE(bufoff, gbase, voff) do { _Pragma("unroll") for (int _i = 0; _i < 2; ++_i) \
        __builtin_amdgcn_global_load_lds((const unsigned*)((const char*)(gbase) + (voff)[_i]), (PG8_LAS unsigned*)(lds + (bufoff) + ldsw + _i * 8192), 16, 0, 0); } while (0)
#define PG8_LDA(dst, b, h) do { _Pragma("unroll") for (int m = 0; m < 4; ++m) _Pragma("unroll") for (int k = 0; k < 2; ++k) dst[m][k] = *(const PG8_LAS bf16x8*)(lds + PG8_SA(b, h) + aoff + m * 2048 + k * 1024); } while (0)
#define PG8_LDB(dst, b, h) do { _Pragma("unroll") for (int n = 0; n < 2; ++n) _Pragma("unroll") for (int k = 0; k < 2; ++k) dst[n][k] = *(const PG8_LAS bf16x8*)(lds + PG8_SB(b, h) + boff + n * 2048 + k * 1024); } while (0)
#define PG8_MMA(ai, bj, At, Bt) do { __builtin_amdgcn_s_setprio(1); _Pragma("unroll") for (int m = 0; m < 4; ++m) _Pragma("unroll") for (int n = 0; n < 2; ++n) _Pragma("unroll") for (int k = 0; k < 2; ++k) \
        acc[ai][bj][m][n] = __builtin_amdgcn_mfma_f32_16x16x32_bf16(Bt[n][k], At[m][k], acc[ai][bj][m][n], 0, 0, 0); __builtin_amdgcn_s_setprio(0); } while (0)
#define PG8_WAIT_V(n) asm volatile("s_waitcnt vmcnt(" #n ")" ::: "memory")
#define PG8_WAIT_L(n) asm volatile("s_waitcnt lgkmcnt(" #n ")" ::: "memory")
#define PG8_BAR __builtin_amdgcn_s_barrier()
#define PG8_SCHED __builtin_amdgcn_sched_barrier(0)
    Unit cur, nxt; int ui = 0;
    if (!S.next(0, cur)) return;
    f32x4 acc[2][2][4][2];
#pragma unroll
    for (int a = 0; a < 2; ++a)
#pragma unroll
        for (int b = 0; b < 2; ++b)
#pragma unroll
            for (int m = 0; m < 4; ++m)
#pragma unroll
                for (int n = 0; n < 2; ++n) acc[a][b][m][n] = (f32x4){0.f, 0.f, 0.f, 0.f};
    bf16x8 At[4][2], B0[2][2], B1[2][2];
    const char* cA = (const char*)g.A + (size_t)cur.pm * tstep; const char* cB = (const char*)g.Bt + (size_t)cur.pn * tstep;
    S.a_ready(cur);
    if constexpr (SP2) {
        PG8_STAGE(PG8_SB(0, 0), cB, voffB); PG8_STAGE(PG8_SB(0, 1), cB + hstep, voffB); PG8_STAGE(PG8_SA(0, 0), cA, voffA); PG8_STAGE(PG8_SA(0, 1), cA + hstep, voffA);
        if (wr == 1) PG8_BAR;
        PG8_WAIT_V(2); PG8_BAR;
        PG8_STAGE(PG8_SB(1, 0), cB + kstep, voffB); PG8_STAGE(PG8_SA(1, 0), cA + kstep, voffA); PG8_STAGE(PG8_SB(1, 1), cB + hstep + kstep, voffB);
        PG8_WAIT_V(6); PG8_BAR;
    } else {
        PG8_STAGE(PG8_SB(0, 0), cB, voffB); PG8_STAGE(PG8_SA(0, 0), cA, voffA); PG8_STAGE(PG8_SB(0, 1), cB + hstep, voffB); PG8_STAGE(PG8_SA(0, 1), cA + hstep, voffA);
        if (wr == 1) PG8_BAR;
        PG8_WAIT_V(4); PG8_BAR;
        PG8_STAGE(PG8_SB(1, 0), cB + kstep, voffB); PG8_STAGE(PG8_SA(1, 0), cA + kstep, voffA); PG8_STAGE(PG8_SB(1, 1), cB + hstep + kstep, voffB);
        PG8_WAIT_V(6); PG8_BAR;
    }
    for (;;) {
        const bool has_next = S.next(ui + 1, nxt);
        const char* nA = has_next ? (const char*)g.A + (size_t)nxt.pm * tstep : cA; const char* nB = has_next ? (const char*)g.Bt + (size_t)nxt.pn * tstep : cB;
        for (int t = 0; t < nt; t += 2) {
            const bool last = (t == nt - 2);
            const char* a1 = cA + (size_t)(t + 1) * kstep;
            const char* a2 = last ? nA : cA + (size_t)(t + 2) * kstep; const char* b2 = last ? nB : cB + (size_t)(t + 2) * kstep;
            const char* a3 = a2 + kstep; const char* b3 = b2 + kstep;
            if (last && has_next) S.a_ready(nxt);
            if constexpr (SP2) {
            PG8_LDB(B0, 0, 0); PG8_LDB(B1, 0, 1); PG8_SCHED; PG8_LDA(At, 0, 0); PG8_STAGE(PG8_SA(1, 1), a1 + hstep, voffA);
            PG8_WAIT_V(8); PG8_WAIT_L(0); PG8_BAR; PG8_MMA(0, 0, At, B0); PG8_MMA(0, 1, At, B1); PG8_BAR; PG8_SCHED;
            PG8_LDA(At, 0, 1); PG8_STAGE(PG8_SB(0, 0), b2, voffB); PG8_STAGE(PG8_SB(0, 1), b2 + hstep, voffB); PG8_STAGE(PG8_SA(0, 0), a2, voffA);
            PG8_WAIT_V(8); PG8_WAIT_L(0); PG8_BAR; PG8_MMA(1, 0, At, B0); PG8_MMA(1, 1, At, B1); PG8_BAR; PG8_SCHED;
            PG8_LDB(B0, 1, 0); PG8_LDB(B1, 1, 1); PG8_SCHED; PG8_LDA(At, 1, 0); PG8_STAGE(PG8_SA(0, 1), a2 + hstep, voffA);
            PG8_WAIT_V(8); PG8_WAIT_L(0); PG8_BAR; PG8_MMA(0, 0, At, B0); PG8_MMA(0, 1, At, B1); PG8_BAR; PG8_SCHED;
            PG8_LDA(At, 1, 1); PG8_STAGE(PG8_SB(1, 0), b3, voffB); PG8_STAGE(PG8_SB(1, 1), b3 + hstep, voffB); PG8_STAGE(PG8_SA(1, 0), a3, voffA);
            PG8_WAIT_V(8); PG8_WAIT_L(0); PG8_BAR; PG8_MMA(1, 0, At, B0); PG8_MMA(1, 1, At, B1); PG8_BAR; PG8_SCHED;
            } else {
            PG8_LDB(B0, 0, 0); PG8_SCHED; PG8_LDA(At, 0, 0); PG8_STAGE(PG8_SA(1, 1), a1 + hstep, voffA);
            PG8_WAIT_L(8); PG8_BAR; PG8_WAIT_L(0); PG8_MMA(0, 0, At, B0); PG8_BAR; PG8_SCHED;
            PG8_LDB(B1, 0, 1); PG8_STAGE(PG8_SB(0, 0), b2, voffB);
            PG8_BAR; PG8_WAIT_L(0); PG8_MMA(0, 1, At, B1); PG8_BAR;
            PG8_LDA(At, 0, 1); PG8_STAGE(PG8_SA(0, 0), a2, voffA);
            PG8_BAR; PG8_WAIT_L(0); PG8_MMA(1, 0, At, B0); PG8_BAR; PG8_SCHED;
            PG8_STAGE(PG8_SB(0, 1), b2 + hstep, voffB);
            PG8_WAIT_V(6); PG8_BAR; PG8_MMA(1, 1, At, B1); PG8_BAR;
            PG8_LDB(B0, 1, 0); PG8_SCHED; PG8_LDA(At, 1, 0); PG8_STAGE(PG8_SA(0, 1), a2 + hstep, voffA);
            PG8_WAIT_L(8); PG8_BAR; PG8_WAIT_L(0); PG8_MMA(0, 0, At, B0); PG8_BAR; PG8_SCHED;
            PG8_LDB(B1, 1, 1); PG8_STAGE(PG8_SB(1, 0), b3, voffB);
            PG8_BAR; PG8_WAIT_L(0); PG8_MMA(0, 1, At, B1); PG8_BAR;
            PG8_LDA(At, 1, 1); PG8_STAGE(PG8_SA(1, 0), a3, voffA);
            PG8_BAR; PG8_WAIT_L(0); PG8_MMA(1, 0, At, B0); PG8_BAR; PG8_SCHED;
            PG8_STAGE(PG8_SB(1, 1), b3 + hstep, voffB);
            PG8_WAIT_V(6); PG8_BAR; PG8_MMA(1, 1, At, B1); PG8_BAR;
            }
        }
        if constexpr (ALIGN_EPI) { if (wr == 0) PG8_BAR; }
        if constexpr (!Epi::AFTER_DRAIN) { E(acc, cur, wr, wc, fr, fq); S.done(cur); }
        if (!has_next) break;
#pragma unroll
        for (int a = 0; a < 2; ++a)
#pragma unroll
            for (int b = 0; b < 2; ++b)
#pragma unroll
                for (int m = 0; m < 4; ++m)
#pragma unroll
                    for (int n = 0; n < 2; ++n) acc[a][b][m][n] = (f32x4){0.f, 0.f, 0.f, 0.f};
        cur = nxt; cA = nA; cB = nB; ++ui;
        if constexpr (ALIGN_EPI) { if (wr == 1) PG8_BAR; }
    }
    PG8_WAIT_V(0);
    if constexpr (!ALIGN_EPI) { if (wr == 0) PG8_BAR; }
    PG8_BAR;
    if constexpr (Epi::AFTER_DRAIN) { E.fused(acc, cur, wr, wc, fr, fq, lds, wid, lane); S.done(cur); }
#undef PG8_SA
#undef PG8_SB
#undef PG8_STAGE
#undef PG8_LDA
#undef PG8_LDB
#undef PG8_MMA
#undef PG8_WAIT_V
#undef PG8_WAIT_L
#undef PG8_BAR
#undef PG8_SCHED
}
}

#ifndef PG8_SP2
#define PG8_SP2 true
#endif
#ifndef PG8_ALIGN
#define PG8_ALIGN true
#endif

#define DI __device__ __forceinline__
typedef unsigned short bf16;
typedef short bf16x8 __attribute__((ext_vector_type(8)));
typedef float f32x4 __attribute__((ext_vector_type(4)));
typedef float f32x16 __attribute__((ext_vector_type(16)));
typedef unsigned u32x4 __attribute__((ext_vector_type(4)));
typedef unsigned u32x2 __attribute__((ext_vector_type(2)));
#define MFMA32(a, b, c) __builtin_amdgcn_mfma_f32_32x32x16_bf16((a), (b), (c), 0, 0, 0)

constexpr int NWAVES = 8, NTHR = 512;
constexpr int M = 16384, D = 1024, FF = 2816, INW = 2816, SEQ = 8192, DEPTH = 4;
constexpr int LDS_BYTES = 147456;
constexpr size_t MiB = 1u << 20;
constexpr size_t WS_CTL = 0;
constexpr size_t WS_STATS = 1 * MiB;
constexpr size_t WS_KMP = 2 * MiB;
constexpr size_t WS_DEC = 2 * MiB + 512 * 1024;
constexpr size_t WS_ROPEC = 3 * MiB, WS_ROPES = 4 * MiB;
constexpr size_t WS_W = 5 * MiB, WSZ = 42467328;
constexpr size_t W_GU1 = 0, W_D1 = 11534336, W_IN = 17301504, W_OUT = 23068672, W_GU2 = 25165824, W_D2 = 36700160;
constexpr size_t WS_XB = 86 * MiB;
constexpr size_t WS_R = 118 * MiB;
constexpr size_t R_HID = 0;
constexpr size_t R_Q = 0, R_K = 16 * MiB, R_V = 32 * MiB, R_U5 = 48 * MiB  , R_Y = 88 * MiB, R_PO = 120 * MiB, R_PML = 168 * MiB,
                 R_LIST = 172 * MiB  , R_ALOC = 188 * MiB, R_OINTRA = 204 * MiB, R_QDEC = 220 * MiB, R_SP = 228 * MiB, R_END = 236 * MiB;
constexpr size_t WS_END = WS_R + R_END;

DI float bf2f(unsigned short b) { return __uint_as_float((unsigned)b << 16); }
DI unsigned cvtpk(float lo, float hi) { return pg8::cvtpk(lo, hi); }
DI float wave_sum(float v) {
#pragma unroll
    for (int o = 1; o < 64; o <<= 1) v += __shfl_xor(v, o);
    return v;
}
DI void st_sc1(unsigned* p, unsigned v) { __hip_atomic_store(p, v, __ATOMIC_RELAXED, __HIP_MEMORY_SCOPE_AGENT); }
DI unsigned ld_sc1(const unsigned* p) { return __hip_atomic_load(p, __ATOMIC_RELAXED, __HIP_MEMORY_SCOPE_AGENT); }
DI float ld_sc1f(const float* p) { return __uint_as_float(__hip_atomic_load((const unsigned*)p, __ATOMIC_RELAXED, __HIP_MEMORY_SCOPE_AGENT)); }
DI int crow(int reg, int h) { return (reg & 3) + 8 * (reg >> 2) + 4 * h; }
DI bf16x8 pack8(const f32x16& x, int s) {
    u32x4 p; p.x = cvtpk(x[8 * s], x[8 * s + 1]); p.y = cvtpk(x[8 * s + 2], x[8 * s + 3]); p.z = cvtpk(x[8 * s + 4], x[8 * s + 5]); p.w = cvtpk(x[8 * s + 6], x[8 * s + 7]);
    return __builtin_bit_cast(bf16x8, p);
}
DI f32x16 zero16() { f32x16 z;
#pragma unroll
    for (int i = 0; i < 16; ++i) z[i] = 0.f; return z; }

struct Args { const float* in[18]; float* out; unsigned char* ws; int ph_lo, ph_hi; };
typedef const float* cfp_t;
typedef const __attribute__((address_space(4))) unsigned char* kptr_t;
struct Ctx { kptr_t kp; unsigned char* ws; float* out;
    DI const float* in(int i) const { return *(const __attribute__((address_space(4))) cfp_t*)(kp + 8 * i); } };
enum { I_X = 0, I_F1N, I_F1G, I_F1U, I_F1D, I_MIXN, I_WIN, I_QN, I_KN, I_PW, I_PS, I_LB, I_HON, I_WOUT, I_F2N, I_F2G, I_F2U, I_F2D };

DI void wconv_tile(const float* W, int ld, int srccol, const float* gain, bf16* WT, int K, int nrow0, int k0, float* scr, int lane) {
    asm volatile("" : "+v"(lane));
    const int c4 = (lane & 7) * 4, kr = lane >> 3;
    f32x4 v[8]; float gv[8];
#pragma unroll
    for (int i = 0; i < 8; ++i) { v[i] = *(const f32x4*)(W + (size_t)(k0 + 8 * i + kr) * ld + srccol + c4); gv[i] = gain ? gain[k0 + 8 * i + kr] : 1.0f; }
#pragma unroll
    for (int i = 0; i < 8; ++i) { float* d = scr + (8 * i + kr) * 33 + c4; d[0] = v[i][0] * gv[i]; d[1] = v[i][1] * gv[i]; d[2] = v[i][2] * gv[i]; d[3] = v[i][3] * gv[i]; }
    asm volatile("s_waitcnt lgkmcnt(0)" ::: "memory");
    const int c = lane & 7;
#pragma unroll
    for (int j = 0; j < 4; ++j) { const int n = (lane >> 3) + 8 * j; const float* s = scr + (8 * c) * 33 + n;
        u32x4 o; o.x = cvtpk(s[0 * 33], s[1 * 33]); o.y = cvtpk(s[2 * 33], s[3 * 33]); o.z = cvtpk(s[4 * 33], s[5 * 33]); o.w = cvtpk(s[6 * 33], s[7 * 33]);
        *(u32x4*)(WT + (size_t)(nrow0 + n) * K + k0 + 8 * c) = o; }
    asm volatile("s_waitcnt lgkmcnt(0)" ::: "memory");
}
constexpr int WC_I0 = 2816, WC_I1 = 1408, WC_I2 = 1408, WC_I3 = 512, WC_I4 = 2816, WC_I5 = 1408, WC_ITEMS = WC_I0 + WC_I1 + WC_I2 + WC_I3 + WC_I4 + WC_I5;
DI void wconv_item(const Ctx& a, int L, int item, float* scr, int lane) {
    unsigned char* wb = a.ws + WS_W + (size_t)(L & 1) * WSZ;
    int r = item;
    if (r < WC_I0 || (r >= WC_I0 + WC_I1 + WC_I2 + WC_I3 && r < WC_I0 + WC_I1 + WC_I2 + WC_I3 + WC_I4)) {
        const bool second = r >= WC_I0; if (second) r -= WC_I0 + WC_I1 + WC_I2 + WC_I3;
        const int kb = r / 176, nb = r % 176, n0 = nb * 32, pn = n0 >> 8, c = n0 & 255, bj = c >> 7, col = 128 * pn + (c & 127);
        const float* src = a.in(second ? (bj ? I_F2U : I_F2G) : (bj ? I_F1U : I_F1G)) + (size_t)L * D * FF;
        const float* gain = a.in(second ? I_F2N : I_F1N) + L * D;
        wconv_tile(src, FF, col, gain, (bf16*)(wb + (second ? W_GU2 : W_GU1)), D, n0, kb * 64, scr, lane); return;
    }
    r -= WC_I0;
    if (r < WC_I1) { const int kb = r / 32, nb = r % 32; wconv_tile(a.in(I_F1D) + (size_t)L * FF * D, D, nb * 32, nullptr, (bf16*)(wb + W_D1), FF, nb * 32, kb * 64, scr, lane); return; }
    r -= WC_I1;
    if (r < WC_I2) { const int kb = r / 88, nb = r % 88, n0 = nb * 32, pn = n0 >> 8, c = n0 & 255;
        const int col = pn < 6 ? (pn >> 1) * 512 + 64 * ((pn & 1) * 4 + ((c >> 5) & 3)) + 32 * (c >> 7) : n0;
        wconv_tile(a.in(I_WIN) + (size_t)L * D * INW, INW, col, a.in(I_MIXN) + L * D, (bf16*)(wb + W_IN), D, n0, kb * 64, scr, lane); return; }
    r -= WC_I2;
    if (r < WC_I3) { const int kb = r / 32, nb = r % 32; wconv_tile(a.in(I_WOUT) + (size_t)L * D * D, D, nb * 32, nullptr, (bf16*)(wb + W_OUT), D, nb * 32, kb * 64, scr, lane); return; }
    r -= WC_I3 + WC_I4;
    { const int kb = r / 32, nb = r % 32; wconv_tile(a.in(I_F2D) + (size_t)L * FF * D, D, nb * 32, nullptr, (bf16*)(wb + W_D2), FF, nb * 32, kb * 64, scr, lane); }
}

DI void phase_p0(const Ctx& a, unsigned char* lds, int gw, int NGW, int wave, int lane) {
    const float* x = a.in(I_X); float* out = a.out; bf16* xb = (bf16*)(a.ws + WS_XB); float* stats = (float*)(a.ws + WS_STATS);
    for (int m0 = gw * 2; m0 < M; m0 += NGW * 2) {
        f32x4 v[2][4]; float sq[2];
#pragma unroll
        for (int k = 0; k < 2; ++k) { const f32x4* xr = (const f32x4*)(x + (size_t)(m0 + k) * D) + lane;
#pragma unroll
            for (int j = 0; j < 4; ++j) v[k][j] = xr[64 * j]; }
#pragma unroll
        for (int k = 0; k < 2; ++k) { float s = 0.f;
#pragma unroll
            for (int j = 0; j < 4; ++j) s += (v[k][j][0] * v[k][j][0] + v[k][j][1] * v[k][j][1]) + (v[k][j][2] * v[k][j][2] + v[k][j][3] * v[k][j][3]);
            sq[k] = wave_sum(s); }
#pragma unroll
        for (int k = 0; k < 2; ++k) { const int m = m0 + k;
            u32x2* brow = (u32x2*)(xb + (size_t)m * D) + lane;
#pragma unroll
            for (int j = 0; j < 4; ++j) { u32x2 w; w.x = cvtpk(v[k][j][0], v[k][j][1]); w.y = cvtpk(v[k][j][2], v[k][j][3]); brow[64 * j] = w; }
            if (lane < 16) stats[(size_t)m * 16 + lane] = (lane == 0) ? sq[k] : 0.f; }
    }
    { unsigned* cz = (unsigned*)(a.ws + WS_CTL + 65536); for (int i = gw * 64 + lane; i < 3456; i += NGW * 64) cz[i] = 0u; }
    float* rc = (float*)(a.ws + WS_ROPEC); float* rs = (float*)(a.ws + WS_ROPES);
    for (int e = gw * 64 + lane; e < SEQ * 32; e += NGW * 64) {
        const int t = e >> 5, i = e & 31;
        double c = 0.15915494309189535;
        for (int k = 0; k < i; ++k) c *= 0.74989420933245582;
        const float chi = (float)c, clo = (float)(c - (double)chi), tf = (float)t;
        const float p = tf * chi, pe = fmaf(tf, chi, -p);
        float fr = __builtin_amdgcn_fractf(p) + (pe + tf * clo);
        rc[e] = __builtin_amdgcn_cosf(fr); rs[e] = __builtin_amdgcn_sinf(fr);
    }
    float* scr = (float*)(lds + wave * 16384);
    for (int it = gw; it < WC_ITEMS; it += NGW) wconv_item(a, 0, it, scr, lane);
}

template <bool DIAG>
DI void attn_core(const bf16* qrow, const bf16* kblk, const bf16* vblk, int nkg, int r, int h, float& m_out, float& l_out, f32x16 (&ot)[2]) {
    bf16x8 qf[4];
#pragma unroll
    for (int ks = 0; ks < 4; ++ks) qf[ks] = *(const bf16x8*)(qrow + 16 * ks + 8 * h);
    f32x16 st[8];
    const int lo = (r * 2 + h) * 8;
#pragma unroll
    for (int hf = 0; hf < 2; ++hf) {
        if (!DIAG || 4 * hf < nkg) {
            bf16x8 kf[16];
#pragma unroll
            for (int i = 0; i < 16; ++i) kf[i] = (!DIAG || 4 * hf + (i >> 2) < nkg) ? *(const bf16x8*)(kblk + ((4 * hf + (i >> 2)) * 4 + (i & 3)) * 512 + lo) : qf[0];
#pragma unroll
            for (int g = 0; g < 4; ++g) {
                const int kg = 4 * hf + g;
                f32x16 acc = zero16();
                if (!DIAG || kg < nkg) {
#pragma unroll
                    for (int ks = 0; ks < 4; ++ks) acc = MFMA32(kf[4 * g + ks], qf[ks], acc);
                    if (DIAG && kg == nkg - 1) {
#pragma unroll
                        for (int i = 0; i < 16; ++i) if (crow(i, h) > r) acc[i] = -INFINITY;
                    }
                } else {
#pragma unroll
                    for (int i = 0; i < 16; ++i) acc[i] = -INFINITY;
                }
                st[kg] = acc;
            }
        } else {
#pragma unroll
            for (int g = 0; g < 4; ++g)
#pragma unroll
                for (int i = 0; i < 16; ++i) st[4 * hf + g][i] = -INFINITY;
        }
    }
    float mx = -INFINITY;
#pragma unroll
    for (int kg = 0; kg < 8; ++kg)
#pragma unroll
        for (int i = 0; i < 16; ++i) mx = fmaxf(mx, st[kg][i]);
    mx = fmaxf(mx, __shfl_xor(mx, 32));
    const float c = 0.125f * 1.4426950408889634f; const float mc = mx * c;
    float l = 0.f;
#pragma unroll
    for (int kg = 0; kg < 8; ++kg)
#pragma unroll
        for (int i = 0; i < 16; ++i) { const float p = __builtin_amdgcn_exp2f(st[kg][i] * c - mc); st[kg][i] = p; l += p; }
    l += __shfl_xor(l, 32);
    ot[0] = zero16(); ot[1] = zero16();
#pragma unroll
    for (int pr = 0; pr < 4; ++pr) {
        if (!DIAG || 2 * pr < nkg) {
            bf16x8 vf[8];
#pragma unroll
            for (int i = 0; i < 8; ++i) vf[i] = (!DIAG || 2 * pr + (i >> 2) < nkg) ? *(const bf16x8*)(vblk + (((2 * pr + (i >> 2)) * 2 + ((i >> 1) & 1)) * 2 + (i & 1)) * 512 + lo) : qf[0];
#pragma unroll
            for (int g = 0; g < 2; ++g) {
                const int kg = 2 * pr + g;
                if (!DIAG || kg < nkg) {
#pragma unroll
                    for (int s2 = 0; s2 < 2; ++s2) { const bf16x8 pf = pack8(st[kg], s2); ot[0] = MFMA32(vf[4 * g + 2 * s2], pf, ot[0]); ot[1] = MFMA32(vf[4 * g + 2 * s2 + 1], pf, ot[1]); }
                }
            }
        }
    }
    m_out = mx * 0.125f; l_out = l;
}

DI void topk_unit(const Ctx& a, int L, int unit, int lane) {
    asm volatile("" : "+v"(lane));
    const int b = unit >> 10, hd = (unit >> 7) & 7, c = unit & 127, own = c >> 2;
    if (own == 0) return;
    const bf16* Q = (const bf16*)(a.ws + WS_R + R_Q); const float* kmp = (const float*)(a.ws + WS_KMP);
    unsigned* cnt = (unsigned*)(a.ws + WS_CTL) + L * 512; unsigned* lists = (unsigned*)(a.ws + WS_R + R_LIST);
    const int t = c * 64 + lane; const size_t bh = (size_t)(b * 8 + hd);
    float q[64];
    { const u32x4* qp = (const u32x4*)(Q + (bh * SEQ + t) * 64);
#pragma unroll
      for (int i = 0; i < 8; ++i) { const u32x4 w = qp[i];
          q[8 * i + 0] = __uint_as_float(w.x << 16); q[8 * i + 1] = __uint_as_float(w.x & 0xffff0000u); q[8 * i + 2] = __uint_as_float(w.y << 16); q[8 * i + 3] = __uint_as_float(w.y & 0xffff0000u);
          q[8 * i + 4] = __uint_as_float(w.z << 16); q[8 * i + 5] = __uint_as_float(w.z & 0xffff0000u); q[8 * i + 6] = __uint_as_float(w.w << 16); q[8 * i + 7] = __uint_as_float(w.w & 0xffff0000u); } }
    float g0 = -INFINITY, g1 = -INFINITY, g2 = -INFINITY; int i0 = 0, i1 = 0, i2 = 0;
    for (int j = 0; j < own; ++j) {
        const float* p0 = kmp + (size_t)((b * 32 + j) * 2) * 512 + hd * 64; const float* p1 = p0 + 512;
        float g = 0.f;
#pragma unroll
        for (int d = 0; d < 64; d += 4) { const f32x4 x0 = *(const f32x4*)(p0 + d), x1 = *(const f32x4*)(p1 + d);
            g += q[d] * (x0[0] + x1[0]) + q[d + 1] * (x0[1] + x1[1]) + q[d + 2] * (x0[2] + x1[2]) + q[d + 3] * (x0[3] + x1[3]); }
#ifdef DBG_FIXED_SEL
        g = -(float)j;
#endif
        if (g > g0) { g2 = g1; i2 = i1; g1 = g0; i1 = i0; g0 = g; i0 = j; }
        else if (g > g1) { g2 = g1; i2 = i1; g1 = g; i1 = j; }
        else if (g > g2) { g2 = g; i2 = j; }
    }
    const int nsel = own < 3 ? own : 3;
#pragma unroll
    for (int s = 0; s < 3; ++s) {
        if (s < nsel) { const int j = s == 0 ? i0 : (s == 1 ? i1 : i2); const int li = (int)bh * 32 + j;
            const unsigned pos = atomicAdd(cnt + li, 1u); st_sc1(lists + (size_t)li * 8192 + pos, (unsigned)(t | (s << 13))); }
    }
}

DI void pool_unit(const Ctx& a, int L, int unit, int lane) {
    asm volatile("" : "+v"(lane));
    const int tile = unit >> 2, g = unit & 3, w = 2 << g, r = lane & 31, h = lane >> 5;
    const bf16* U = (const bf16*)(a.ws + WS_R + R_U5); bf16* Y = (bf16*)(a.ws + WS_R + R_Y);
    const float* pw = a.in(I_PW) + (size_t)(L * 4 + g) * 4096; const float* ps = a.in(I_PS) + L * 256 + g * 64;
    const float* pwl = pw + (8 * h) * 64 + r;
    bf16x8 wf[2][4];
#pragma unroll
    for (int me = 0; me < 2; ++me)
#pragma unroll
        for (int ks = 0; ks < 4; ++ks) { float f[8];
#pragma unroll
            for (int j = 0; j < 8; ++j) f[j] = pwl[(16 * ks + j) * 64 + 32 * me];
            u32x4 p; p.x = cvtpk(f[0], f[1]); p.y = cvtpk(f[2], f[3]); p.z = cvtpk(f[4], f[5]); p.w = cvtpk(f[6], f[7]); wf[me][ks] = __builtin_bit_cast(bf16x8, p); }
#pragma unroll 1
    for (int nt = 0; nt < 4; ++nt) {
        const int m = tile * 128 + nt * 32 + r, tpos = m & (SEQ - 1);
        const int cntw = tpos + 1 < w ? tpos + 1 : w; const float invc = 1.0f / (float)cntw;
        f32x16 acc[2]; acc[0] = zero16(); acc[1] = zero16();
#pragma unroll
        for (int ks = 0; ks < 4; ++ks) {
            const bf16* up = U + (size_t)m * 256 + g * 64 + 16 * ks + 8 * h;
            float sum[8], self[8];
            { const u32x4 wv = *(const u32x4*)up;
              self[0] = __uint_as_float(wv.x << 16); self[1] = __uint_as_float(wv.x & 0xffff0000u); self[2] = __uint_as_float(wv.y << 16); self[3] = __uint_as_float(wv.y & 0xffff0000u);
              self[4] = __uint_as_float(wv.z << 16); self[5] = __uint_as_float(wv.z & 0xffff0000u); self[6] = __uint_as_float(wv.w << 16); self[7] = __uint_as_float(wv.w & 0xffff0000u); }
#pragma unroll
            for (int j = 0; j < 8; ++j) sum[j] = self[j];
            u32x4 rows[15];
#pragma unroll
            for (int i = 1; i < 16; ++i) { const bool ok = (i < w) && (i <= tpos); rows[i - 1] = *(const u32x4*)(up - (size_t)(ok ? i : 0) * 256); }
#pragma unroll
            for (int i = 1; i < 16; ++i) { const bool ok = (i < w) && (i <= tpos); const float kf = ok ? 1.f : 0.f; const u32x4 wv = rows[i - 1];
                sum[0] += kf * __uint_as_float(wv.x << 16); sum[1] += kf * __uint_as_float(wv.x & 0xffff0000u); sum[2] += kf * __uint_as_float(wv.y << 16); sum[3] += kf * __uint_as_float(wv.y & 0xffff0000u);
                sum[4] += kf * __uint_as_float(wv.z << 16); sum[5] += kf * __uint_as_float(wv.z & 0xffff0000u); sum[6] += kf * __uint_as_float(wv.w << 16); sum[7] += kf * __uint_as_float(wv.w & 0xffff0000u); }
            u32x4 p; p.x = cvtpk(sum[0] * invc - self[0], sum[1] * invc - self[1]); p.y = cvtpk(sum[2] * invc - self[2], sum[3] * invc - self[3]);
            p.z = cvtpk(sum[4] * invc - self[4], sum[5] * invc - self[5]); p.w = cvtpk(sum[6] * invc - self[6], sum[7] * invc - self[7]);
            const bf16x8 df = __builtin_bit_cast(bf16x8, p);
            acc[0] = MFMA32(wf[0][ks], df, acc[0]); acc[1] = MFMA32(wf[1][ks], df, acc[1]);
        }
#pragma unroll
        for (int me = 0; me < 2; ++me)
#pragma unroll
            for (int gq = 0; gq < 4; ++gq) { const int e0 = 32 * me + 8 * gq + 4 * h; const f32x4 sc = *(const f32x4*)(ps + e0);
                u32x2 o; o.x = cvtpk(acc[me][4 * gq] * sc[0], acc[me][4 * gq + 1] * sc[1]); o.y = cvtpk(acc[me][4 * gq + 2] * sc[2], acc[me][4 * gq + 3] * sc[3]);
                *(u32x2*)(Y + (size_t)m * 1024 + 512 + g * 64 + e0) = o; }
    }
}

DI void h1_unit(const Ctx& a, int L, int unit, unsigned char* sm, int lane) {
    asm volatile("" : "+v"(lane));
    const int b = unit >> 9, hh = (unit >> 7) & 3, n = unit & 127, r = lane & 31, h = lane >> 5;
    const int row0 = b * SEQ + n * 64, ch = hh * 64 + lane;
    const bf16* QH = (const bf16*)(a.ws + WS_R + R_U5) + (size_t)1 * M * 256; const bf16* FH = QH + (size_t)M * 256; const bf16* IH = FH + (size_t)M * 256;
    bf16* QDEC = (bf16*)(a.ws + WS_R + R_QDEC); float* ALOC = (float*)(a.ws + WS_R + R_ALOC); float* OINTRA = (float*)(a.ws + WS_R + R_OINTRA); float* DEC = (float*)(a.ws + WS_DEC);
    bf16* KD = (bf16*)sm; bf16* IT = (bf16*)(sm + 8192); bf16* Am = (bf16*)(sm + 16384); bf16* Bm = (bf16*)(sm + 24576);
#ifdef DBG_H1_CLEAR
    { u32x4* z4 = (u32x4*)sm;
#pragma unroll 4
      for (int i = 0; i < 32; ++i) z4[i * 64 + lane] = (u32x4){0u, 0u, 0u, 0u}; asm volatile("s_waitcnt lgkmcnt(0)" ::: "memory"); }
#endif
    float lb;
    { const float* lp = a.in(I_LB) + ch; const float x0 = lp[0], x1 = lp[256], x2 = lp[512], x3 = lp[768];
      const float mx = fmaxf(fmaxf(x0, x1), fmaxf(x2, x3)); const float e0 = __expf(x0 - mx), e1 = __expf(x1 - mx), e2 = __expf(x2 - mx), e3 = __expf(x3 - mx);
      const float inv = 1.0f / (e0 + e1 + e2 + e3); float acc = 0.f; if (L > 0) acc += e0; if (L > 1) acc += e1; if (L > 2) acc += e2; lb = acc * inv; }
    const float loglb = __logf(fmaxf(lb, 1e-20f)), l1m = __logf(1.0f - lb), oml = 1.0f - lb;
    float zr[64];
#pragma unroll
    for (int s = 0; s < 64; ++s) zr[s] = bf2f(FH[(size_t)(row0 + s) * 256 + ch]);
    float cum = 0.f, ref = 0.f;
#pragma unroll
    for (int s = 0; s < 64; ++s) {
        const float z = zr[s];
        const float ls = fminf(z, 0.f) - __logf(1.0f + __expf(-fabsf(z)));
        const float bb = l1m + ls, hi = fmaxf(loglb, bb), df = fabsf(loglb - bb);
        cum += hi + __logf(1.0f + __expf(-df));
        asm volatile("" : "+v"(cum));
        if (s == 31) ref = cum;
    }
    const float last = cum;
    DEC[unit * 64 + lane] = __expf(last);
    cum = 0.f;
#ifndef H1_NO_P2
    unsigned short zc[8], qc[8], ic[8];
#pragma unroll
    for (int j = 0; j < 8; ++j) { const size_t gi = (size_t)(row0 + j) * 256 + ch; zc[j] = FH[gi]; qc[j] = QH[gi]; ic[j] = IH[gi]; }
#pragma unroll 1
    for (int s8 = 0; s8 < 8; ++s8) {
        unsigned kp[4], ip[4]; float kd8[8]; unsigned short i8[8];
        unsigned short zn[8], qn[8], in_[8];
        { const int sn = (s8 < 7 ? s8 + 1 : 7) * 8;
#pragma unroll
          for (int j = 0; j < 8; ++j) { const size_t gi = (size_t)(row0 + sn + j) * 256 + ch; zn[j] = FH[gi]; qn[j] = QH[gi]; in_[j] = IH[gi]; } }
#pragma unroll
        for (int j = 0; j < 8; ++j) {
            const int s = s8 * 8 + j; const size_t gi = (size_t)(row0 + s) * 256 + ch;
            const float z = bf2f(zc[j]), qv = bf2f(qc[j]); i8[j] = ic[j];
            const float ls = fminf(z, 0.f) - __logf(1.0f + __expf(-fabsf(z)));
            const float bb = l1m + ls, hi = fmaxf(loglb, bb), df = fabsf(loglb - bb);
            cum += hi + __logf(1.0f + __expf(-df));
            const float key = oml * __builtin_amdgcn_rcpf(1.0f + __expf(z));
            const float qs = qv * __builtin_amdgcn_rcpf(1.0f + __expf(-qv)) * 0.125f;
            const float av = qs * __expf(fminf(cum - ref, 80.f)), bv = key * __expf(fminf(ref - cum, 80.f)), qd = qs * __expf(cum);
            kd8[j] = key * __expf(last - cum);
#ifndef H1_NO_AB
            Am[s * 64 + lane] = (bf16)(cvtpk(av, 0.f) & 0xffffu); Bm[s * 64 + lane] = (bf16)(cvtpk(bv, 0.f) & 0xffffu);
#endif
#ifndef H1_NO_QD
            QDEC[gi] = (bf16)(cvtpk(qd, 0.f) & 0xffffu);
#endif
        }
#pragma unroll
        for (int j = 0; j < 4; ++j) { kp[j] = cvtpk(kd8[2 * j], kd8[2 * j + 1]); ip[j] = (unsigned)i8[2 * j] | ((unsigned)i8[2 * j + 1] << 16); }
        *(u32x4*)(KD + lane * 64 + s8 * 8) = (u32x4){kp[0], kp[1], kp[2], kp[3]};
        *(u32x4*)(IT + lane * 64 + s8 * 8) = (u32x4){ip[0], ip[1], ip[2], ip[3]};
#pragma unroll
        for (int j = 0; j < 8; ++j) { zc[j] = zn[j]; qc[j] = qn[j]; ic[j] = in_[j]; }
    }
#endif
    asm volatile("s_waitcnt lgkmcnt(0)" ::: "memory");
#ifndef H1_NO_MM
    bf16x8 itf[2][2][2];
#pragma unroll
    for (int mv = 0; mv < 2; ++mv)
#pragma unroll
        for (int ms = 0; ms < 2; ++ms)
#pragma unroll
            for (int st = 0; st < 2; ++st) { const bf16* p = IT + (32 * mv + r) * 64 + 32 * ms + 16 * st + 4 * h; const u32x2 x0 = *(const u32x2*)p, x1 = *(const u32x2*)(p + 8);
                itf[mv][ms][st] = __builtin_bit_cast(bf16x8, ((u32x4){x0.x, x0.y, x1.x, x1.y})); }
    float* alb = ALOC + (size_t)unit * 4096 + (4 * h) * 64 + r;
#pragma unroll
    for (int nk = 0; nk < 2; ++nk) {
        bf16x8 kdf[2][2];
#pragma unroll
        for (int ms = 0; ms < 2; ++ms)
#pragma unroll
            for (int st = 0; st < 2; ++st) { const bf16* p = KD + (32 * nk + r) * 64 + 32 * ms + 16 * st + 4 * h; const u32x2 x0 = *(const u32x2*)p, x1 = *(const u32x2*)(p + 8);
                kdf[ms][st] = __builtin_bit_cast(bf16x8, ((u32x4){x0.x, x0.y, x1.x, x1.y})); }
#pragma unroll
        for (int mv = 0; mv < 2; ++mv) {
            f32x16 acc = zero16();
#pragma unroll
            for (int ms = 0; ms < 2; ++ms)
#pragma unroll
                for (int st = 0; st < 2; ++st) acc = MFMA32(itf[mv][ms][st], kdf[ms][st], acc);
#pragma unroll
            for (int i = 0; i < 16; ++i) alb[(32 * mv + (i & 3) + 8 * (i >> 2)) * 64 + 32 * nk] = acc[i];
        }
    }
#pragma unroll
    for (int nt = 0; nt < 2; ++nt) {
        bf16x8 af[4];
#pragma unroll
        for (int ks = 0; ks < 4; ++ks) af[ks] = *(const bf16x8*)(Am + (32 * nt + r) * 64 + 16 * ks + 8 * h);
        f32x16 oi[2]; oi[0] = zero16(); oi[1] = zero16();
#pragma unroll
        for (int ms = 0; ms < 2; ++ms) {
            if (ms <= nt) {
                f32x16 sacc = zero16();
#pragma unroll
                for (int ks = 0; ks < 4; ++ks) { const bf16x8 bf_ = *(const bf16x8*)(Bm + (32 * ms + r) * 64 + 16 * ks + 8 * h); sacc = MFMA32(bf_, af[ks], sacc); }
                if (ms == nt) {
#pragma unroll
                    for (int i = 0; i < 16; ++i) if (crow(i, h) > r) sacc[i] = 0.f;
                }
#pragma unroll
                for (int st = 0; st < 2; ++st) { const bf16x8 pf = pack8(sacc, st); oi[0] = MFMA32(itf[0][ms][st], pf, oi[0]); oi[1] = MFMA32(itf[1][ms][st], pf, oi[1]); }
            }
        }
        const size_t orow = (size_t)(row0 + 32 * nt + r) * 256 + hh * 64;
#pragma unroll
        for (int mv = 0; mv < 2; ++mv)
#pragma unroll
            for (int gq = 0; gq < 4; ++gq) *(f32x4*)(OINTRA + orow + 32 * mv + 8 * gq + 4 * h) = (f32x4){oi[mv][4 * gq], oi[mv][4 * gq + 1], oi[mv][4 * gq + 2], oi[mv][4 * gq + 3]};
    }
#endif
    asm volatile("s_waitcnt lgkmcnt(0)" ::: "memory");
}

DI void phase_t(const Ctx& a, int L, unsigned char* lds, int gw, int NGW, int wave, int lane, bool conv_here) {
    const int blk = gw >> 3, G = NGW >> 3;
    if (wave < 4) { for (int u = blk * 4 + wave; u < 1024; u += G * 4) h1_unit(a, L, u, lds + wave * 32768, lane); }
    else if (wave < 6) { for (int u = blk * 2 + (wave - 4); u < 512; u += G * 2) pool_unit(a, L, u, lane); }
    __syncthreads();
    if (conv_here && L + 1 < DEPTH) { float* scr = (float*)(lds + wave * 16384); for (int it = gw; it < WC_ITEMS; it += NGW) wconv_item(a, L + 1, it, scr, lane); }
}

DI void attn_unit(const Ctx& a, int bh, int qb, unsigned char* lds, int tid, int wave, int lane) {
    asm volatile("" : "+v"(lane), "+v"(tid));
    const int r = lane & 31, h = lane >> 5, b = bh >> 3, hd = bh & 7, own = qb, nsel = own < 3 ? own : 3;
    const bf16* Q = (const bf16*)(a.ws + WS_R + R_Q); const bf16* Kb = (const bf16*)(a.ws + WS_R + R_K); const bf16* Vb = (const bf16*)(a.ws + WS_R + R_V);
    const float* kmp = (const float*)(a.ws + WS_KMP); bf16* Y = (bf16*)(a.ws + WS_R + R_Y);
    unsigned char* part = lds;
    unsigned short* llist = (unsigned short*)(lds + 104448);
    int* lcnt = (int*)(lds + 120832); int* itab = lcnt + 32;
    const size_t qbase = ((size_t)bh * SEQ + (size_t)qb * 256) * 64;
    if (own > 0) {
        if (tid < 32) lcnt[tid] = 0;
        float* km = (float*)(lds + 122880);
        for (int idx = tid; idx < own * 64; idx += NTHR) { const float* p0 = kmp + (size_t)((b * 32 + (idx >> 6)) * 2) * 512 + hd * 64 + (idx & 63); km[idx] = p0[0] + p0[512]; }
        __syncthreads();
        if (tid < 256) {
            float q[64];
            { const u32x4* qp = (const u32x4*)(Q + qbase + (size_t)tid * 64);
#pragma unroll
              for (int i = 0; i < 8; ++i) { const u32x4 w = qp[i];
                  q[8 * i + 0] = __uint_as_float(w.x << 16); q[8 * i + 1] = __uint_as_float(w.x & 0xffff0000u); q[8 * i + 2] = __uint_as_float(w.y << 16); q[8 * i + 3] = __uint_as_float(w.y & 0xffff0000u);
                  q[8 * i + 4] = __uint_as_float(w.z << 16); q[8 * i + 5] = __uint_as_float(w.z & 0xffff0000u); q[8 * i + 6] = __uint_as_float(w.w << 16); q[8 * i + 7] = __uint_as_float(w.w & 0xffff0000u); } }
            float g0 = -INFINITY, g1 = -INFINITY, g2 = -INFINITY; int i0 = 0, i1 = 0, i2 = 0;
            for (int j = 0; j < own; ++j) {
                const float* kj = km + j * 64;
                float g = 0.f;
#pragma unroll
                for (int d = 0; d < 64; d += 4) { const f32x4 x0 = *(const f32x4*)(kj + d);
                    g += q[d] * x0[0] + q[d + 1] * x0[1] + q[d + 2] * x0[2] + q[d + 3] * x0[3]; }
                if (g > g0) { g2 = g1; i2 = i1; g1 = g0; i1 = i0; g0 = g; i0 = j; }
                else if (g > g1) { g2 = g1; i2 = i1; g1 = g; i1 = j; }
                else if (g > g2) { g2 = g; i2 = j; }
            }
#pragma unroll
            for (int s = 0; s < 3; ++s) {
                if (s < nsel) { const int j = s == 0 ? i0 : (s == 1 ? i1 : i2); const int pos = atomicAdd(lcnt + j, 1); llist[j * 256 + pos] = (unsigned short)(tid | (s << 8)); }
            }
        }
        __syncthreads();
        if (tid == 0) { int n = 0; for (int j = 0; j < own; ++j) { const int ng = (lcnt[j] + 31) >> 5; for (int g = 0; g < ng; ++g) itab[n++] = j | (g << 8); } itab[64] = n; }
        __syncthreads();
        const int nitems = __builtin_amdgcn_readfirstlane(itab[64]);
        for (int it = wave; it < nitems; it += NWAVES) {
            const int ent = __builtin_amdgcn_readfirstlane(itab[it]); const int j = ent & 255, g = ent >> 8, n = __builtin_amdgcn_readfirstlane(lcnt[j]);
            const int idx = g * 32 + r; const bool valid = idx < n;
            const unsigned e = llist[j * 256 + (valid ? idx : 0)];
            const int qi = e & 255, slot = e >> 8;
            float mo, lo_; f32x16 ot[2];
            attn_core<false>(Q + qbase + (size_t)qi * 64, Kb + ((size_t)bh * 32 + j) * 16384, Vb + ((size_t)bh * 32 + j) * 16384, 8, r, h, mo, lo_, ot);
            if (valid) {
                unsigned char* rec = part + (qi * 3 + slot) * 136; const float inv = 1.0f / lo_;
#pragma unroll
                for (int md = 0; md < 2; ++md)
#pragma unroll
                    for (int gq = 0; gq < 4; ++gq) { u32x2 o; o.x = cvtpk(ot[md][4 * gq] * inv, ot[md][4 * gq + 1] * inv); o.y = cvtpk(ot[md][4 * gq + 2] * inv, ot[md][4 * gq + 3] * inv);
                        *(u32x2*)(rec + 2 * (32 * md + 8 * gq + 4 * h)) = o; }
                if (h == 0) { *(float*)(rec + 128) = mo; *(float*)(rec + 132) = lo_; }
            }
        }
        __syncthreads();
    }
    {
        const int ql = 32 * wave + r, t = qb * 256 + ql;
        float m0, l0; f32x16 ot[2];
        attn_core<true>(Q + qbase + (size_t)ql * 64, Kb + ((size_t)bh * 32 + qb) * 16384, Vb + ((size_t)bh * 32 + qb) * 16384, wave + 1, r, h, m0, l0, ot);
        float ms[3], ls[3]; float mx = m0;
#pragma unroll
        for (int s = 0; s < 3; ++s) { ms[s] = -INFINITY; ls[s] = 0.f; if (s < nsel) { const unsigned char* rec = part + (ql * 3 + s) * 136; ms[s] = *(const float*)(rec + 128); ls[s] = *(const float*)(rec + 132); mx = fmaxf(mx, ms[s]); } }
        const float w0 = __expf(m0 - mx); float den = w0 * l0;
#pragma unroll
        for (int md = 0; md < 2; ++md)
#pragma unroll
            for (int i = 0; i < 16; ++i) ot[md][i] *= w0;
#pragma unroll
        for (int s = 0; s < 3; ++s) {
            if (s < nsel) {
                const unsigned char* rec = part + (ql * 3 + s) * 136; const float ws_ = __expf(ms[s] - mx) * ls[s]; den += ws_;
#pragma unroll
                for (int md = 0; md < 2; ++md)
#pragma unroll
                    for (int gq = 0; gq < 4; ++gq) { const u32x2 w = *(const u32x2*)(rec + 2 * (32 * md + 8 * gq + 4 * h));
                        ot[md][4 * gq] += ws_ * __uint_as_float(w.x << 16); ot[md][4 * gq + 1] += ws_ * __uint_as_float(w.x & 0xffff0000u);
                        ot[md][4 * gq + 2] += ws_ * __uint_as_float(w.y << 16); ot[md][4 * gq + 3] += ws_ * __uint_as_float(w.y & 0xffff0000u); }
            }
        }
        float inv = 1.0f / den; const size_t yrow = (size_t)(b * SEQ + t) * 1024 + hd * 64;
#ifdef DBG_AMP_ATTN
        inv *= 64.f;
#endif
#pragma unroll
        for (int md = 0; md < 2; ++md)
#pragma unroll
            for (int gq = 0; gq < 4; ++gq) { u32x2 o; o.x = cvtpk(ot[md][4 * gq] * inv, ot[md][4 * gq + 1] * inv); o.y = cvtpk(ot[md][4 * gq + 2] * inv, ot[md][4 * gq + 3] * inv);
                *(u32x2*)(Y + yrow + 32 * md + 8 * gq + 4 * h) = o; }
    }
    __syncthreads();
}

DI void phase_a(const Ctx& a, int L, unsigned char* lds, int gw, int NGW, int tid, int wave, int lane) {
    if ((gw & 3) == 0 && (gw >> 2) < 512) {
        const int chunk = gw >> 2, bhh = chunk >> 6, e = (chunk & 63) * 64 + lane, k = e & 63;
        const float* ALOC = (const float*)(a.ws + WS_R + R_ALOC); const float* DEC = (const float*)(a.ws + WS_DEC); bf16* SP = (bf16*)(a.ws + WS_R + R_SP);
        float st = 0.f;
#pragma unroll 32
        for (int n = 0; n < 128; ++n) { const int item = bhh * 128 + n; const float av = ALOC[(size_t)item * 4096 + e], dv = DEC[item * 64 + k];
            SP[(size_t)item * 4096 + e] = (bf16)(cvtpk(st, 0.f) & 0xffffu); st = dv * st + av; }
    }
    const int G = NGW / NWAVES, blk = gw / NWAVES;
    for (int u = blk; u < 512; u += G) {
        const int v = u & 255, bh = v >> 4, qb = (u < 256) ? (v & 15) : 31 - (v & 15);
        attn_unit(a, bh, qb, lds, tid, wave, lane);
    }
}

DI void own_unit(const Ctx& a, int bhi, int qg, int lane) {
    asm volatile("" : "+v"(lane));
    const int r = lane & 31, h = lane >> 5, t0 = qg * 32, j = t0 >> 8, nkg = ((t0 & 255) >> 5) + 1, t = t0 + r;
    const int b = bhi >> 3, hd = bhi & 7; const size_t bh = (size_t)bhi;
    const bf16* Q = (const bf16*)(a.ws + WS_R + R_Q); const bf16* Kb = (const bf16*)(a.ws + WS_R + R_K); const bf16* Vb = (const bf16*)(a.ws + WS_R + R_V);
    const bf16* PO = (const bf16*)(a.ws + WS_R + R_PO); const float* PML = (const float*)(a.ws + WS_R + R_PML); bf16* Y = (bf16*)(a.ws + WS_R + R_Y);
    float m0, l0; f32x16 ot[2];
    attn_core<true>(Q + (bh * SEQ + t) * 64, Kb + (bh * 32 + j) * 16384, Vb + (bh * 32 + j) * 16384, nkg, r, h, m0, l0, ot);
#ifdef DBG_OWN_ONLY
    const int nsel = 0;
#else
    const int nsel = j < 3 ? j : 3;
#endif
    const size_t pi = (bh * SEQ + t) * 3;
    float ms[3], ls[3]; float mx = m0;
#pragma unroll
    for (int s = 0; s < 3; ++s) { ms[s] = -INFINITY; ls[s] = 0.f; if (s < nsel) { ms[s] = ld_sc1f(PML + (pi + s) * 2); ls[s] = ld_sc1f(PML + (pi + s) * 2 + 1); mx = fmaxf(mx, ms[s]); } }
    const float w0 = __expf(m0 - mx); float den = w0 * l0;
#pragma unroll
    for (int md = 0; md < 2; ++md)
#pragma unroll
        for (int i = 0; i < 16; ++i) ot[md][i] *= w0;
#pragma unroll
    for (int s = 0; s < 3; ++s) {
        if (s < nsel) {
            const float ws_ = __expf(ms[s] - mx) * ls[s]; den += ws_;
#pragma unroll
            for (int md = 0; md < 2; ++md)
#pragma unroll
                for (int gq = 0; gq < 4; ++gq) { const u32x2 w = *(const u32x2*)(PO + (pi + s) * 64 + 32 * md + 8 * gq + 4 * h);
                    ot[md][4 * gq] += ws_ * __uint_as_float(w.x << 16); ot[md][4 * gq + 1] += ws_ * __uint_as_float(w.x & 0xffff0000u);
                    ot[md][4 * gq + 2] += ws_ * __uint_as_float(w.y << 16); ot[md][4 * gq + 3] += ws_ * __uint_as_float(w.y & 0xffff0000u); }
        }
    }
    float inv = 1.0f / den; const size_t yrow = (size_t)(b * SEQ + t) * 1024 + hd * 64;
#ifdef DBG_ZERO_ATTN
    inv = 0.f;
#endif
#pragma unroll
    for (int md = 0; md < 2; ++md)
#pragma unroll
        for (int gq = 0; gq < 4; ++gq) { u32x2 o; o.x = cvtpk(ot[md][4 * gq] * inv, ot[md][4 * gq + 1] * inv); o.y = cvtpk(ot[md][4 * gq + 2] * inv, ot[md][4 * gq + 3] * inv);
            *(u32x2*)(Y + yrow + 32 * md + 8 * gq + 4 * h) = o; }
}

DI void h3_unit(const Ctx& a, int L, int unit2, int lane) {
    asm volatile("" : "+v"(lane));
    const int unit = unit2 >> 1, nt = unit2 & 1;
    const int b = unit >> 9, hh = (unit >> 7) & 3, n = unit & 127, r = lane & 31, h = lane >> 5;
    const int row0 = b * SEQ + n * 64;
    const bf16* SP = (const bf16*)(a.ws + WS_R + R_SP) + (size_t)unit * 4096; const bf16* QDEC = (const bf16*)(a.ws + WS_R + R_QDEC);
    const float* OINTRA = (const float*)(a.ws + WS_R + R_OINTRA); const bf16* GH = (const bf16*)(a.ws + WS_R + R_U5) + (size_t)4 * M * 256; bf16* Y = (bf16*)(a.ws + WS_R + R_Y);
    const float* on = a.in(I_HON) + L * 64;
    bf16x8 sf[2][4];
#pragma unroll
    for (int mv = 0; mv < 2; ++mv)
#pragma unroll
        for (int ks = 0; ks < 4; ++ks) sf[mv][ks] = *(const bf16x8*)(SP + (32 * mv + r) * 64 + 16 * ks + 8 * h);
    {
        const size_t trow = (size_t)(row0 + 32 * nt + r) * 256 + hh * 64;
        f32x16 o[2]; o[0] = zero16(); o[1] = zero16();
#pragma unroll
        for (int ks = 0; ks < 4; ++ks) { const bf16x8 qf = *(const bf16x8*)(QDEC + trow + 16 * ks + 8 * h); o[0] = MFMA32(sf[0][ks], qf, o[0]); o[1] = MFMA32(sf[1][ks], qf, o[1]); }
        float ss = 0.f;
#pragma unroll
        for (int mv = 0; mv < 2; ++mv)
#pragma unroll
            for (int gq = 0; gq < 4; ++gq) { const f32x4 x = *(const f32x4*)(OINTRA + trow + 32 * mv + 8 * gq + 4 * h);
#pragma unroll
                for (int i = 0; i < 4; ++i) { o[mv][4 * gq + i] += x[i]; ss += o[mv][4 * gq + i] * o[mv][4 * gq + i]; } }
        ss += __shfl_xor(ss, 32);
        float rn = rsqrtf(ss * (1.0f / 64.0f) + 1e-6f);
#ifdef DBG_ZERO_HGRN
        rn = 0.f;
#endif
#ifdef DBG_AMP_HGRN
        rn *= 16.f;
#endif
        const size_t yrow = (size_t)(row0 + 32 * nt + r) * 1024 + 768 + hh * 64;
#pragma unroll
        for (int mv = 0; mv < 2; ++mv)
#pragma unroll
            for (int gq = 0; gq < 4; ++gq) { const int v0 = 32 * mv + 8 * gq + 4 * h; const f32x4 gn = *(const f32x4*)(on + v0); const u32x2 gw_ = *(const u32x2*)(GH + trow + v0);
                const float g0 = __uint_as_float(gw_.x << 16), g1 = __uint_as_float(gw_.x & 0xffff0000u), g2 = __uint_as_float(gw_.y << 16), g3 = __uint_as_float(gw_.y & 0xffff0000u);
                u32x2 w; w.x = cvtpk(o[mv][4 * gq] * rn * gn[0] * pg8::silu_f(g0), o[mv][4 * gq + 1] * rn * gn[1] * pg8::silu_f(g1));
                w.y = cvtpk(o[mv][4 * gq + 2] * rn * gn[2] * pg8::silu_f(g2), o[mv][4 * gq + 3] * rn * gn[3] * pg8::silu_f(g3));
                *(u32x2*)(Y + yrow + v0) = w; }
    }
}

DI void phase_c(const Ctx& a, int L, int gw, int NGW, int lane) {
    for (int u = gw; u < 2048; u += NGW) h3_unit(a, L, u, lane);
}

#define LAS __attribute__((address_space(3)))
#define XB_TMO      128
#define XB_XCNT(j)  (256  + 64 * (j))
#define XB_XSUB(j)  (1280 + 64 * (j))
#define XB_XGEN(j)  (2304 + 64 * (j))
#define XB_TOP      3328
#define XB_TOPGEN   3392
#define XCD_BAR_WORDS 3456
#define XB_SPIN_CAP (1u << 18)

__device__ __forceinline__ unsigned xb_ld(unsigned* p)              { return __hip_atomic_load(p, __ATOMIC_RELAXED, __HIP_MEMORY_SCOPE_AGENT); }
__device__ __forceinline__ unsigned xb_add(unsigned* p, unsigned v) { return __hip_atomic_fetch_add(p, v, __ATOMIC_RELAXED, __HIP_MEMORY_SCOPE_AGENT); }
__device__ __forceinline__ unsigned xb_xcc_id() { return (unsigned)__builtin_amdgcn_s_getreg((3 << 11) | 20) & 0xFu; }
#define XB_SPIN(cond, bar) do { unsigned _sp = 0; while (cond) { __builtin_amdgcn_s_sleep(1); \
    if ((++_sp & 255u) == 0u) { if (xb_ld(&(bar)[XB_TMO])) break; if (_sp > XB_SPIN_CAP) { atomicAdd(&(bar)[XB_TMO], 1u); break; } } } } while (0)

struct XcdBarrier {
    unsigned* bar; unsigned x;
    volatile LAS unsigned* st;
};

__device__ __forceinline__ XcdBarrier xcd_barrier_post(unsigned* bar, volatile LAS unsigned* st) {
    XcdBarrier b; b.bar = bar; b.x = xb_xcc_id(); b.st = st;
    if (threadIdx.x == 0) (void)xb_add(&bar[XB_XCNT(b.x)], 1u);
    return b;
}
__device__ __forceinline__ void xcd_barrier_complete(unsigned* bar, unsigned x, unsigned& nloc, unsigned& nx) {
    const unsigned G = gridDim.x * gridDim.y * gridDim.z;
    unsigned sum, cnt, mine, sp = 0u;
    for (;;) {
        sum = 0u; cnt = 0u; mine = 0u;
#pragma unroll
        for (unsigned j = 0; j < 16; ++j) { const unsigned c = xb_ld(&bar[XB_XCNT(j)]); sum += c; cnt += (c > 0u) ? 1u : 0u; mine = (j == x) ? c : mine; }
        if (sum == G) break;
        __builtin_amdgcn_s_sleep(1);
        if ((++sp & 255u) == 0u) { if (xb_ld(&bar[XB_TMO])) break; if (sp > XB_SPIN_CAP) { atomicAdd(&bar[XB_TMO], 1u); break; } }
    }
    nloc = mine > 0u ? mine : 1u; nx = cnt > 0u ? cnt : 1u;
}

__device__ __forceinline__ void xcd_barrier(const XcdBarrier& b) {
    asm volatile("s_waitcnt vmcnt(0)" ::: "memory");
    __syncthreads();
    if (threadIdx.x == 0) {
        unsigned* bar = b.bar;
        __builtin_amdgcn_s_waitcnt(0);
        unsigned nloc = b.st[0], nx = b.st[1];
        if (nloc == 0u) { xcd_barrier_complete(bar, b.x, nloc, nx); b.st[0] = nloc; b.st[1] = nx; }
        const unsigned old = xb_add(&bar[XB_XSUB(b.x)], 1u);
        const unsigned gen = old / nloc;
        if (old + 1u == (gen + 1u) * nloc) {
            __builtin_amdgcn_fence(__ATOMIC_RELEASE, "agent");
            asm volatile("s_waitcnt vmcnt(0)" ::: "memory");
            const unsigned og = xb_add(&bar[XB_TOP], 1u);
            const unsigned tg = og / nx;
            if (og + 1u == (tg + 1u) * nx) xb_add(&bar[XB_TOPGEN], 1u);
            else XB_SPIN(xb_ld(&bar[XB_TOPGEN]) == tg, bar);
            __builtin_amdgcn_fence(__ATOMIC_ACQUIRE, "agent");
            xb_add(&bar[XB_XGEN(b.x)], 1u);
            asm volatile("s_waitcnt vmcnt(0)" ::: "memory");
        } else {
            XB_SPIN(xb_ld(&bar[XB_XGEN(b.x)]) == gen, bar);
            __builtin_amdgcn_fence(__ATOMIC_ACQUIRE, "agent");
            asm volatile("s_waitcnt vmcnt(0)" ::: "memory");
        }
    }
    __syncthreads();
}

template <int MASK> __global__ void __launch_bounds__(NTHR, 2) mk_fwd(Args args) {
    extern __shared__ __attribute__((aligned(16))) unsigned char lds[];
    const int G = gridDim.x, NGW = G * NWAVES;
    cg::grid_group grid = cg::this_grid();
    const int ph_lo = args.ph_lo, ph_hi = args.ph_hi;
    volatile LAS unsigned* bst = (volatile LAS unsigned*)((LAS unsigned char*)lds + 131072);
    if (threadIdx.x == 0) { bst[0] = 0u; bst[1] = 0u; }
    __syncthreads();
    XcdBarrier bar; bar.bar = nullptr; bar.x = 0; bar.st = bst;
    for (int ph = ph_lo; ph < ph_hi; ++ph) {
        if (ph > ph_lo) {
            if (ph == ph_lo + 1) {
                grid.sync();
                bar = xcd_barrier_post((unsigned*)(args.ws + WS_CTL + 65536), bst);
            } else { xcd_barrier(bar);
#ifdef DBG_DUP_BAR
                xcd_barrier(bar);
#endif
            }
        }
        int tid_v = threadIdx.x; asm volatile("" : "+v"(tid_v));
        const int tid = tid_v, lane = tid & 63, wave = __builtin_amdgcn_readfirstlane(tid >> 6), gw = blockIdx.x * NWAVES + wave;
        kptr_t kp = (kptr_t)__builtin_amdgcn_kernarg_segment_ptr();
        asm volatile("" : "+s"(kp));
        Ctx a; a.kp = kp; a.out = *(float* const __attribute__((address_space(4)))*)(kp + 144); a.ws = *(unsigned char* const __attribute__((address_space(4)))*)(kp + 152);
        unsigned char* ws = a.ws;
        float* stats = (float*)(ws + WS_STATS); bf16* xb = (bf16*)(ws + WS_XB); bf16* hid = (bf16*)(ws + WS_R + R_HID);
        if (ph == 0) {
if constexpr (MASK & 1) { phase_p0(a, lds, gw, NGW, wave, lane);
#ifdef DBG_DUP_P0
 __syncthreads(); phase_p0(a, lds, gw, NGW, wave, lane);
#endif
 }
 __syncthreads(); continue; }
        const int L = (ph - 1) / 9, sub = (ph - 1) % 9;
        unsigned char* wb = ws + WS_W + (size_t)(L & 1) * WSZ;
        if (sub == 0 || sub == 7) {
            pg8::Gemm g{xb, (const bf16*)(wb + (sub == 0 ? W_GU1 : W_GU2)), M, 2 * FF, D}; pg8::StaticOrder S; S.init(M, 2 * FF, G, (int)blockIdx.x);
            pg8::EpiSwiGLU E{hid, stats, FF};
            if constexpr (MASK & 2) pg8::gemm_phase<pg8::EpiSwiGLU, pg8::StaticOrder, PG8_ALIGN, PG8_SP2>((PG8_LAS unsigned char*)lds, g, S, E);
            if constexpr ((MASK & 2) && (MASK & 16)) {
                if (G == 256 && L + 1 < DEPTH && blockIdx.x >= 128) {
                    __syncthreads();
                    float* scr = (float*)(lds + wave * 16384); const int half = sub == 7 ? 1 : 0;
                    for (int it = half * (WC_ITEMS / 2) + ((int)blockIdx.x - 128) * NWAVES + wave; it < (half + 1) * (WC_ITEMS / 2); it += 128 * NWAVES) wconv_item(a, L + 1, it, scr, lane);
                }
            }
#if defined(DBG_DUP_G) && DBG_DUP_G == 1
            __syncthreads(); if constexpr (MASK & 2) pg8::gemm_phase<pg8::EpiSwiGLU, pg8::StaticOrder, PG8_ALIGN, PG8_SP2>((PG8_LAS unsigned char*)lds, g, S, E);
#endif
        } else if (sub == 1 || sub == 6 || sub == 8) {
            const bf16* A = sub == 6 ? (const bf16*)(ws + WS_R + R_Y) : hid; const int K = sub == 6 ? D : FF;
            const bf16* Bt = (const bf16*)(wb + (sub == 1 ? W_D1 : (sub == 6 ? W_OUT : W_D2)));
            pg8::Gemm g{A, Bt, M, D, K}; pg8::StaticOrder S; S.init(M, D, G, (int)blockIdx.x);
            pg8::EpiResid E{(L == 0 && sub == 1) ? a.in(I_X) : (const float*)a.out, a.out, xb, stats, sub == 6 ? 1.0f : 0.5f};
            if constexpr (MASK & 4) pg8::gemm_phase<pg8::EpiResid, pg8::StaticOrder, PG8_ALIGN, PG8_SP2>((PG8_LAS unsigned char*)lds, g, S, E);
#if defined(DBG_DUP_G) && DBG_DUP_G == 2
            __syncthreads(); { pg8::EpiResid E0{a.out, a.out, xb, stats, 0.0f}; if constexpr (MASK & 4) pg8::gemm_phase<pg8::EpiResid, pg8::StaticOrder, PG8_ALIGN, PG8_SP2>((PG8_LAS unsigned char*)lds, g, S, E0); }
#endif
        } else if (sub == 2) {
            pg8::Gemm g{xb, (const bf16*)(wb + W_IN), M, INW, D}; pg8::StaticOrder S; S.init(M, INW, G, (int)blockIdx.x);
            pg8::EpiProj E{(bf16*)(ws + WS_R + R_Q), (bf16*)(ws + WS_R + R_K), (bf16*)(ws + WS_R + R_V), (bf16*)(ws + WS_R + R_U5), (float*)(ws + WS_KMP), stats,
                           (const float*)(ws + WS_ROPEC), (const float*)(ws + WS_ROPES), a.in(I_QN) + L * 64, a.in(I_KN) + L * 64};
            if constexpr (MASK & 8) pg8::gemm_phase<pg8::EpiProj, pg8::StaticOrder, PG8_ALIGN, PG8_SP2>((PG8_LAS unsigned char*)lds, g, S, E);
#if defined(DBG_DUP_G) && DBG_DUP_G == 3
            __syncthreads(); if constexpr (MASK & 8) pg8::gemm_phase<pg8::EpiProj, pg8::StaticOrder, PG8_ALIGN, PG8_SP2>((PG8_LAS unsigned char*)lds, g, S, E);
#endif
        } else if (sub == 3) {
if constexpr (MASK & 16) { phase_t(a, L, lds, gw, NGW, wave, lane, !(MASK & 2) || G != 256);
#if defined(DBG_DUP_SUB) && DBG_DUP_SUB == 3
 __syncthreads(); phase_t(a, L, lds, gw, NGW, wave, lane, !(MASK & 2) || G != 256);
#endif
 }
 __syncthreads(); }
        else if (sub == 4) {
if constexpr (MASK & 32) { phase_a(a, L, lds, gw, NGW, tid, wave, lane);
#if defined(DBG_DUP_SUB) && DBG_DUP_SUB == 4
 __syncthreads(); phase_a(a, L, lds, gw, NGW, tid, wave, lane);
#endif
 }
 __syncthreads(); }
        else {
if constexpr (MASK & 64) { phase_c(a, L, gw, NGW, lane);
#if defined(DBG_DUP_SUB) && DBG_DUP_SUB == 5
 __syncthreads(); phase_c(a, L, gw, NGW, lane);
#endif
 }
 __syncthreads(); }
    }
}

#ifndef MK_MULTI
#define MK_MULTI 0
#endif
#ifndef DBG_NPH
#define DBG_NPH (1 + 9 * DEPTH)
#endif
constexpr int N_PHASES = DBG_NPH;
static int phase_mask(int ph) { if (ph == 0) return 1; const int sub = (ph - 1) % 9; const int m[9] = {2, 4, 8, 16, 32, 64, 4, 2, 4}; return m[sub]; }
template <int MASK> static bool setup_one(int& per_cu) {
    if (hipFuncSetAttribute((const void*)mk_fwd<MASK>, hipFuncAttributeMaxDynamicSharedMemorySize, LDS_BYTES) != hipSuccess) return false;
    if (hipOccupancyMaxActiveBlocksPerMultiprocessor(&per_cu, (const void*)mk_fwd<MASK>, NTHR, LDS_BYTES) != hipSuccess) per_cu = 1;
    (void)hipGetLastError(); return true;
}
template <int MASK> static void launch_one(const Args& a, int grid, hipStream_t stream) { hipLaunchKernelGGL(mk_fwd<MASK>, dim3(grid), dim3(NTHR), LDS_BYTES, stream, a); }
extern "C" void kernel_launch(void* const* d_in, const int* in_sizes, int n_in, void* d_out, int out_size, void* d_ws, size_t ws_size, hipStream_t stream) {
    static int grid = 0;
    if (grid == 0) {
        if (n_in != 18 || in_sizes[0] != M * D || out_size != M * D || ws_size < WS_END) { fprintf(stderr, "kernel_launch: unexpected shapes / workspace (n_in %d, ws %zu < %zu)\n", n_in, ws_size, (size_t)WS_END); grid = -1; return; }
        int dev = 0, cus = 0, per_cu = 0; bool ok = true;
        (void)hipGetDevice(&dev); (void)hipDeviceGetAttribute(&cus, hipDeviceAttributeMultiprocessorCount, dev);
#if MK_MULTI
        ok = setup_one<1>(per_cu) && setup_one<2>(per_cu) && setup_one<4>(per_cu) && setup_one<8>(per_cu) && setup_one<16>(per_cu) && setup_one<32>(per_cu) && setup_one<64>(per_cu);
#else
        ok = setup_one<127>(per_cu);
#endif
        if (!ok) { fprintf(stderr, "kernel_launch: hipFuncSetAttribute failed\n"); grid = -1; return; }
        grid = cus;
    }
    if (grid < 0) return;
    Args a{};
    for (int i = 0; i < 18; ++i) a.in[i] = (const float*)d_in[i];
    a.out = (float*)d_out; a.ws = (unsigned char*)d_ws;
#if MK_MULTI
    for (int ph = 0; ph < N_PHASES; ++ph) { a.ph_lo = ph; a.ph_hi = ph + 1;
        switch (phase_mask(ph)) { case 1: launch_one<1>(a, grid, stream); break; case 2: launch_one<2>(a, grid, stream); break; case 4: launch_one<4>(a, grid, stream); break; case 8: launch_one<8>(a, grid, stream); break;
                                  case 16: launch_one<16>(a, grid, stream); break; case 32: launch_one<32>(a, grid, stream); break; default: launch_one<64>(a, grid, stream); break; } }
#else
    a.ph_lo = 0; a.ph_hi = N_PHASES;
    void* args[] = {&a};
    hipError_t e = hipLaunchCooperativeKernel((const void*)mk_fwd<127>, dim3(grid), dim3(NTHR), args, LDS_BYTES, stream);
    if (e != hipSuccess) fprintf(stderr, "cooperative launch failed: %s (grid %d)\n", hipGetErrorString(e), grid);
#endif
}
```

```cpp
#include <hip/hip_runtime.h>
#include <hip/hip_cooperative_groups.h>
#include <cstdio>
#include <cstdint>
namespace cg = cooperative_groups;
#define MK_MULTI 0
namespace pg8 {
#define PG8_LAS __attribute__((address_space(3)))
typedef unsigned short bf16_t;
typedef short bf16x8 __attribute__((ext_vector_type(8)));
typedef float f32x4 __attribute__((ext_vector_type(4)));
typedef unsigned u32x4 __attribute__((ext_vector_type(4)));
constexpr int BM = 256, BK = 64, HALF = 128, HTB = HALF * BK * 2  , STAGE_BYTES = 8 * HTB, NXCD = 8, WGM = 8;

__host__ __device__ __forceinline__ int lds_byte(int r, int c) { const int st = (r >> 4) * 2 + (c >> 5), rr = r & 15, cc = c & 31, ob = rr * 64 + cc * 2; return st * 1024 + (ob ^ (((ob >> 9) & 1) << 5)); }
__host__ __device__ __forceinline__ void stage_rc(int b, int& R, int& C) { const int st = b / 1024, sb = b % 1024, swz = sb ^ (((sb >> 9) & 1) << 5); R = (st >> 1) * 16 + swz / 64; C = (st & 1) * 32 + (swz % 64) / 2; }
__host__ __device__ __forceinline__ int perm32(int rho) { const int n = rho >> 4, i = rho & 15; return 8 * (i >> 2) + 4 * n + (i & 3); }

struct Unit { int pm, pn; };
struct Gemm { const bf16_t* A; const bf16_t* Bt; int M, N, K; };

struct StaticOrder {
    int nM, nN, nwg, G, c;
    __host__ __device__ void init(int M, int N, int G_, int c_) { nM = M / BM; nN = N / BM; nwg = nM * nN; G = G_; c = c_; }
    __host__ __device__ bool next(int i, Unit& u) const {
        const long L = (long)i * G + c; if (L >= nwg) return false;
        int wgid = (int)L; { const int q = nwg / NXCD, r = nwg % NXCD, xcd = wgid % NXCD, off = wgid / NXCD; wgid = (xcd < r ? xcd * (q + 1) : r * (q + 1) + (xcd - r) * q) + off; }
        const int nig = WGM * nN, gid = wgid / nig, fm = gid * WGM, gsz = (nM - fm) < WGM ? (nM - fm) : WGM;
        u.pm = fm + ((wgid % nig) % gsz); u.pn = (wgid % nig) / gsz; return true;
    }
    __device__ __forceinline__ void a_ready(const Unit&) const {}
    __device__ __forceinline__ void done(const Unit&) const {}
};

__device__ __forceinline__ unsigned cvt_pk_bf16(float lo, float hi) { unsigned r; asm volatile("v_cvt_pk_bf16_f32 %0, %1, %2" : "=v"(r) : "v"(lo), "v"(hi)); return r; }
typedef float f32x2 __attribute__((ext_vector_type(2)));
typedef unsigned u32x2 __attribute__((ext_vector_type(2)));
typedef __bf16 bf16x2_t __attribute__((ext_vector_type(2)));
__device__ __forceinline__ unsigned cvtpk(float lo, float hi) { f32x2 v = {lo, hi}; bf16x2_t b = __builtin_convertvector(v, bf16x2_t); return __builtin_bit_cast(unsigned, b); }
__device__ __forceinline__ float row_rstd(const float* stats, int row) {
    const f32x4* p = (const f32x4*)(stats + (size_t)row * 16);
    const f32x4 a = p[0], b = p[1], c = p[2], d = p[3];
    const float s = ((a[0] + a[1]) + (a[2] + a[3])) + ((b[0] + b[1]) + (b[2] + b[3])) + ((c[0] + c[1]) + (c[2] + c[3])) + ((d[0] + d[1]) + (d[2] + d[3]));
    return rsqrtf(s * (1.0f / 1024.0f) + 1e-6f);
}
__device__ __forceinline__ void row_rstd4(const float* stats, int row0, float (&rs)[4]) {
    f32x4 p[4][4];
#pragma unroll
    for (int m = 0; m < 4; ++m)
#pragma unroll
        for (int k = 0; k < 4; ++k) p[m][k] = *(const f32x4*)(stats + (size_t)(row0 + 16 * m) * 16 + 4 * k);
#pragma unroll
    for (int m = 0; m < 4; ++m) { const f32x4 a = p[m][0], b = p[m][1], c = p[m][2], d = p[m][3];
        const float s = ((a[0] + a[1]) + (a[2] + a[3])) + ((b[0] + b[1]) + (b[2] + b[3])) + ((c[0] + c[1]) + (c[2] + c[3])) + ((d[0] + d[1]) + (d[2] + d[3]));
        rs[m] = rsqrtf(s * (1.0f / 1024.0f) + 1e-6f); }
}
__device__ __forceinline__ float silu_f(float g) { return g * __builtin_amdgcn_rcpf(1.0f + __expf(-g)); }

struct EpiSwiGLU {
    static constexpr bool PERM = true, AFTER_DRAIN = false;
    bf16_t* H; const float* stats; int ldh;
    __device__ __forceinline__ void operator()(const f32x4 (&acc)[2][2][4][2], const Unit& u, int wr, int wc, int fr, int fq) const {
        asm volatile("" : "+v"(fr), "+v"(fq));
        const int row0 = u.pm * BM + wr * 64 + fr, col0 = u.pn * HALF + wc * 32 + 8 * fq;
#pragma unroll
        for (int ai = 0; ai < 2; ++ai) {
            float rs4[4]; row_rstd4(stats, row0 + ai * HALF, rs4);
#pragma unroll
            for (int m = 0; m < 4; ++m) {
                const int row = row0 + ai * HALF + m * 16;
                const float rs = rs4[m];
                float h[8];
#pragma unroll
                for (int n = 0; n < 2; ++n)
#pragma unroll
                    for (int i = 0; i < 4; ++i) { const float g = acc[ai][0][m][n][i] * rs, up = acc[ai][1][m][n][i] * rs; h[4 * n + i] = silu_f(g) * up; }
                u32x4 w; w.x = cvtpk(h[0], h[1]); w.y = cvtpk(h[2], h[3]); w.z = cvtpk(h[4], h[5]); w.w = cvtpk(h[6], h[7]);
                *(u32x4*)(H + (size_t)row * ldh + col0) = w;
            }
        }
    }
};

struct EpiResid {
    static constexpr bool PERM = true, AFTER_DRAIN = false;
    const float* Xsrc; float* X; bf16_t* XB; float* stats; float scale;
    __device__ __forceinline__ void operator()(const f32x4 (&acc)[2][2][4][2], const Unit& u, int wr, int wc, int fr, int fq) const {
        asm volatile("" : "+v"(fr), "+v"(fq));
        const int row0 = u.pm * BM + wr * 64 + fr, col0 = u.pn * BM + wc * 32 + 8 * fq;
#pragma unroll
        for (int ai = 0; ai < 2; ++ai) {
            f32x4 xr[4][2][2];
#pragma unroll
            for (int m = 0; m < 4; ++m)
#pragma unroll
                for (int bj = 0; bj < 2; ++bj) { const float* xp = Xsrc + (size_t)(row0 + ai * HALF + m * 16) * 1024 + col0 + bj * HALF; xr[m][bj][0] = *(const f32x4*)xp; xr[m][bj][1] = *(const f32x4*)(xp + 4); }
#pragma unroll
            for (int m = 0; m < 4; ++m) {
                const int row = row0 + ai * HALF + m * 16; float ss = 0.f;
#pragma unroll
                for (int bj = 0; bj < 2; ++bj) {
                    float* xp = X + (size_t)row * 1024 + col0 + bj * HALF;
                    f32x4 x0 = xr[m][bj][0], x1 = xr[m][bj][1];
                    x0 = x0 + acc[ai][bj][m][0] * scale; x1 = x1 + acc[ai][bj][m][1] * scale;
                    *(f32x4*)xp = x0; *(f32x4*)(xp + 4) = x1;
                    ss += (x0[0] * x0[0] + x0[1] * x0[1]) + (x0[2] * x0[2] + x0[3] * x0[3]) + (x1[0] * x1[0] + x1[1] * x1[1]) + (x1[2] * x1[2] + x1[3] * x1[3]);
                    u32x4 w; w.x = cvtpk(x0[0], x0[1]); w.y = cvtpk(x0[2], x0[3]); w.z = cvtpk(x1[0], x1[1]); w.w = cvtpk(x1[2], x1[3]);
                    *(u32x4*)(XB + (size_t)row * 1024 + col0 + bj * HALF) = w;
                }
                ss += __shfl_xor(ss, 16); ss += __shfl_xor(ss, 32);
                if (fq == 0) stats[(size_t)row * 16 + u.pn * 4 + wc] = ss;
            }
        }
    }
};

struct EpiProj {
    static constexpr bool PERM = true, AFTER_DRAIN = false;
    bf16_t* Q; bf16_t* Kb; bf16_t* Vb; bf16_t* U5; float* kmp; const float* stats; const float* ropeC; const float* ropeS; const float* qn; const float* kn;
    __device__ __forceinline__ void operator()(const f32x4 (&acc)[2][2][4][2], const Unit& u, int wr, int wc, int fr, int fq) const {
        asm volatile("" : "+v"(fr), "+v"(fq));
        const int row0 = u.pm * BM + wr * 64 + fr;
        const int pn = u.pn;
        if (pn >= 6) {
            bf16_t* O = U5 + (size_t)(pn - 6) * (16384 * 256);
            const int col0 = wc * 32 + 8 * fq;
#pragma unroll
            for (int ai = 0; ai < 2; ++ai)
#pragma unroll
                for (int m = 0; m < 4; ++m) {
                    const int row = row0 + ai * HALF + m * 16; const float rs = row_rstd(stats, row);
#pragma unroll
                    for (int bj = 0; bj < 2; ++bj) {
                        const f32x4 v0 = acc[ai][bj][m][0] * rs, v1 = acc[ai][bj][m][1] * rs;
                        u32x4 w; w.x = cvtpk(v0[0], v0[1]); w.y = cvtpk(v0[2], v0[3]); w.z = cvtpk(v1[0], v1[1]); w.w = cvtpk(v1[2], v1[3]);
                        *(u32x4*)(O + (size_t)row * 256 + col0 + bj * HALF) = w;
                    }
                }
            return;
        }
        const int head = (pn & 1) * 4 + wc, b = u.pm >> 5, j = u.pm & 31;
        const size_t bh = (size_t)(b * 8 + head);
        if (pn >= 4) {
            bf16_t* vb = Vb + (bh * 32 + j) * 16384;
#pragma unroll
            for (int ai = 0; ai < 2; ++ai)
#pragma unroll
                for (int m = 0; m < 4; ++m) {
                    const int row = row0 + ai * HALF + m * 16; const float rs = row_rstd(stats, row);
                    const int kk = ai * HALF + wr * 64 + m * 16 + fr;
                    const int kg = kk >> 5, w = kk & 31, st = w >> 4, w16 = w & 15, hh = (w16 >> 2) & 1, jj = 4 * (w16 >> 3) + (w16 & 3);
#pragma unroll
                    for (int bj = 0; bj < 2; ++bj)
#pragma unroll
                        for (int n = 0; n < 2; ++n) {
                            const unsigned p0 = cvtpk(acc[ai][bj][m][n][0] * rs, acc[ai][bj][m][n][1] * rs), p1 = cvtpk(acc[ai][bj][m][n][2] * rs, acc[ai][bj][m][n][3] * rs);
#pragma unroll
                            for (int i = 0; i < 4; ++i) {
                                const int r = 8 * fq + 4 * n + i;
                                const unsigned pv = (i < 2) ? p0 : p1;
                                vb[((((kg * 2 + st) * 2 + bj) * 32 + r) * 2 + hh) * 8 + jj] = (bf16_t)((i & 1) ? (pv >> 16) : (pv & 0xffffu));
                            }
                        }
                }
            return;
        }
        const bool isk = pn >= 2;
        const float* gn = isk ? kn : qn;
        float ksum[16];
#pragma unroll
        for (int e = 0; e < 16; ++e) ksum[e] = 0.f;
#pragma unroll
        for (int ai = 0; ai < 2; ++ai)
#pragma unroll
            for (int m = 0; m < 4; ++m) {
                const int row = row0 + ai * HALF + m * 16; const float rs = row_rstd(stats, row);
                const int t = row & 8191, kk = t & 255;
                float v0[8], v1[8]; float ss = 0.f;
#pragma unroll
                for (int n = 0; n < 2; ++n)
#pragma unroll
                    for (int i = 0; i < 4; ++i) { v0[4 * n + i] = acc[ai][0][m][n][i] * rs; v1[4 * n + i] = acc[ai][1][m][n][i] * rs; ss += v0[4 * n + i] * v0[4 * n + i] + v1[4 * n + i] * v1[4 * n + i]; }
                ss += __shfl_xor(ss, 16); ss += __shfl_xor(ss, 32);
                const float rn = rsqrtf(ss * (1.0f / 64.0f) + 1e-6f);
                const f32x4 c0 = *(const f32x4*)(ropeC + t * 32 + 8 * fq), c1 = *(const f32x4*)(ropeC + t * 32 + 8 * fq + 4);
                const f32x4 s0 = *(const f32x4*)(ropeS + t * 32 + 8 * fq), s1 = *(const f32x4*)(ropeS + t * 32 + 8 * fq + 4);
                const f32x4 ga0 = *(const f32x4*)(gn + 8 * fq), ga1 = *(const f32x4*)(gn + 8 * fq + 4), gb0 = *(const f32x4*)(gn + 32 + 8 * fq), gb1 = *(const f32x4*)(gn + 36 + 8 * fq);
                float o0[8], o1[8];
#pragma unroll
                for (int e = 0; e < 8; ++e) {
                    const float x1 = v0[e] * rn * (e < 4 ? ga0[e & 3] : ga1[e & 3]), x2 = v1[e] * rn * (e < 4 ? gb0[e & 3] : gb1[e & 3]);
                    const float cs = e < 4 ? c0[e & 3] : c1[e & 3], sn = e < 4 ? s0[e & 3] : s1[e & 3];
                    o0[e] = x1 * cs - x2 * sn; o1[e] = x2 * cs + x1 * sn;
                }
                u32x4 w0, w1;
                w0.x = cvtpk(o0[0], o0[1]); w0.y = cvtpk(o0[2], o0[3]); w0.z = cvtpk(o0[4], o0[5]); w0.w = cvtpk(o0[6], o0[7]);
                w1.x = cvtpk(o1[0], o1[1]); w1.y = cvtpk(o1[2], o1[3]); w1.z = cvtpk(o1[4], o1[5]); w1.w = cvtpk(o1[6], o1[7]);
                if (!isk) {
                    bf16_t* qp = Q + (bh * 8192 + t) * 64 + 8 * fq;
                    *(u32x4*)qp = w0; *(u32x4*)(qp + 32) = w1;
                } else {
                    bf16_t* kb = Kb + (bh * 32 + j) * 16384;
                    const int kg = kk >> 5, r = kk & 31, hq = fq & 1, ksl = fq >> 1;
                    *(u32x4*)(kb + (((kg * 4 + ksl) * 32 + r) * 2 + hq) * 8) = w0;
                    *(u32x4*)(kb + (((kg * 4 + 2 + ksl) * 32 + r) * 2 + hq) * 8) = w1;
#pragma unroll
                    for (int e = 0; e < 8; ++e) { ksum[e] += o0[e]; ksum[8 + e] += o1[e]; }
                }
                asm volatile("" ::: "memory");
            }
        if (isk) {
#pragma unroll
            for (int e = 0; e < 16; ++e) { float s = ksum[e]; s += __shfl_xor(s, 1); s += __shfl_xor(s, 2); s += __shfl_xor(s, 4); s += __shfl_xor(s, 8); ksum[e] = s; }
            if (fr == 0) {
                float* kp = kmp + ((size_t)(u.pm * 2 + wr) * 512) + head * 64 + 8 * fq;
                *(f32x4*)kp = (f32x4){ksum[0], ksum[1], ksum[2], ksum[3]}; *(f32x4*)(kp + 4) = (f32x4){ksum[4], ksum[5], ksum[6], ksum[7]};
                *(f32x4*)(kp + 32) = (f32x4){ksum[8], ksum[9], ksum[10], ksum[11]}; *(f32x4*)(kp + 36) = (f32x4){ksum[12], ksum[13], ksum[14], ksum[15]};
            }
        }
    }
};

template <class Epi, class Sched, bool ALIGN_EPI = false, bool SP2 = false>
__device__ __forceinline__ void gemm_phase(PG8_LAS unsigned char* lds, const Gemm g, const Sched& S, const Epi& E) {
    int tid_v = threadIdx.x; asm volatile("" : "+v"(tid_v));
    const int tid = tid_v, wid = __builtin_amdgcn_readfirstlane(tid >> 6), lane = tid & 63, wr = wid >> 2, wc = wid & 3, fr = lane & 15, fq = lane >> 4;
    const int K = g.K, nt = K / BK;
    unsigned voffA[2], voffB[2];
#pragma unroll
    for (int i = 0; i < 2; ++i) { int R, C; stage_rc(tid * 16 + i * 8192, R, C); const int Rb = Epi::PERM ? ((R & ~31) + perm32(R & 31)) : R;
        voffA[i] = (unsigned)(R * K + C) * 2u; voffB[i] = (unsigned)(Rb * K + C) * 2u; }
    const size_t kstep = (size_t)(BK * 2);
    const size_t hstep = (size_t)HALF * K * 2;
    const size_t tstep = 2 * hstep;
    const unsigned ldsw = (unsigned)wid * 1024u;
    const int aoff = lds_byte(wr * 64 + fr, fq * 8), boff = lds_byte(wc * 32 + fr, fq * 8);
#define PG8_SA(b, h) (((b) * 2 + (h)) * HTB)
#define PG8_SB(b, h) ((4 + (b) * 2 + (h)) * HTB)
#define PG8_STAGE(bufoff, gbase, voff) do { _Pragma("unroll") for (int _i = 0; _i < 2; ++_i) \
        __builtin_amdgcn_global_load_lds((const unsigned*)((const char*)(gbase) + (voff)[_i]), (PG8_LAS unsigned*)(lds + (bufoff) + ldsw + _i * 8192), 16, 0, 0); } while (0)
#define PG8_LDA(dst, b, h) do { _Pragma("unroll") for (int m = 0; m < 4; ++m) _Pragma("unroll") for (int k = 0; k < 2; ++k) dst[m][k] = *(const PG8_LAS bf16x8*)(lds + PG8_SA(b, h) + aoff + m * 2048 + k * 1024); } while (0)
#define PG8_LDB(dst, b, h) do { _Pragma("unroll") for (int n = 0; n < 2; ++n) _Pragma("unroll") for (int k = 0; k < 2; ++k) dst[n][k] = *(const PG8_LAS bf16x8*)(lds + PG8_SB(b, h) + boff + n * 2048 + k * 1024); } while (0)
#define PG8_MMA(ai, bj, At, Bt) do { __builtin_amdgcn_s_setprio(1); _Pragma("unroll") for (int m = 0; m < 4; ++m) _Pragma("unroll") for (int n = 0; n < 2; ++n) _Pragma("unroll") for (int k = 0; k < 2; ++k) \
        acc[ai][bj][m][n] = __builtin_amdgcn_mfma_f32_16x16x32_bf16(Bt[n][k], At[m][k], acc[ai][bj][m][n], 0, 0, 0); __builtin_amdgcn_s_setprio(0); } while (0)
#define PG8_WAIT_V(n) asm volatile("s_waitcnt vmcnt(" #n ")" ::: "memory")
#define PG8_WAIT_L(n) asm volatile("s_waitcnt lgkmcnt(" #n ")" ::: "memory")
#define PG8_BAR __builtin_amdgcn_s_barrier()
#define PG8_SCHED __builtin_amdgcn_sched_barrier(0)
    Unit cur, nxt; int ui = 0;
    if (!S.next(0, cur)) return;
    f32x4 acc[2][2][4][2];
#pragma unroll
    for (int a = 0; a < 2; ++a)
#pragma unroll
        for (int b = 0; b < 2; ++b)
#pragma unroll
            for (int m = 0; m < 4; ++m)
#pragma unroll
                for (int n = 0; n < 2; ++n) acc[a][b][m][n] = (f32x4){0.f, 0.f, 0.f, 0.f};
    bf16x8 At[4][2], B0[2][2], B1[2][2];
    const char* cA = (const char*)g.A + (size_t)cur.pm * tstep; const char* cB = (const char*)g.Bt + (size_t)cur.pn * tstep;
    S.a_ready(cur);
    if constexpr (SP2) {
        PG8_STAGE(PG8_SB(0, 0), cB, voffB); PG8_STAGE(PG8_SB(0, 1), cB + hstep, voffB); PG8_STAGE(PG8_SA(0, 0), cA, voffA); PG8_STAGE(PG8_SA(0, 1), cA + hstep, voffA);
        if (wr == 1) PG8_BAR;
        PG8_WAIT_V(2); PG8_BAR;
        PG8_STAGE(PG8_SB(1, 0), cB + kstep, voffB); PG8_STAGE(PG8_SA(1, 0), cA + kstep, voffA); PG8_STAGE(PG8_SB(1, 1), cB + hstep + kstep, voffB);
        PG8_WAIT_V(6); PG8_BAR;
    } else {
        PG8_STAGE(PG8_SB(0, 0), cB, voffB); PG8_STAGE(PG8_SA(0, 0), cA, voffA); PG8_STAGE(PG8_SB(0, 1), cB + hstep, voffB); PG8_STAGE(PG8_SA(0, 1), cA + hstep, voffA);
        if (wr == 1) PG8_BAR;
        PG8_WAIT_V(4); PG8_BAR;
        PG8_STAGE(PG8_SB(1, 0), cB + kstep, voffB); PG8_STAGE(PG8_SA(1, 0), cA + kstep, voffA); PG8_STAGE(PG8_SB(1, 1), cB + hstep + kstep, voffB);
        PG8_WAIT_V(6); PG8_BAR;
    }
    for (;;) {
        const bool has_next = S.next(ui + 1, nxt);
        const char* nA = has_next ? (const char*)g.A + (size_t)nxt.pm * tstep : cA; const char* nB = has_next ? (const char*)g.Bt + (size_t)nxt.pn * tstep : cB;
        for (int t = 0; t < nt; t += 2) {
            const bool last = (t == nt - 2);
            const char* a1 = cA + (size_t)(t + 1) * kstep;
            const char* a2 = last ? nA : cA + (size_t)(t + 2) * kstep; const char* b2 = last ? nB : cB + (size_t)(t + 2) * kstep;
            const char* a3 = a2 + kstep; const char* b3 = b2 + kstep;
            if (last && has_next) S.a_ready(nxt);
            if constexpr (SP2) {
            PG8_LDB(B0, 0, 0); PG8_LDB(B1, 0, 1); PG8_SCHED; PG8_LDA(At, 0, 0); PG8_STAGE(PG8_SA(1, 1), a1 + hstep, voffA);
            PG8_WAIT_V(8); PG8_WAIT_L(0); PG8_BAR; PG8_MMA(0, 0, At, B0); PG8_MMA(0, 1, At, B1); PG8_BAR; PG8_SCHED;
            PG8_LDA(At, 0, 1); PG8_STAGE(PG8_SB(0, 0), b2, voffB); PG8_STAGE(PG8_SB(0, 1), b2 + hstep, voffB); PG8_STAGE(PG8_SA(0, 0), a2, voffA);
            PG8_WAIT_V(8); PG8_WAIT_L(0); PG8_BAR; PG8_MMA(1, 0, At, B0); PG8_MMA(1, 1, At, B1); PG8_BAR; PG8_SCHED;
            PG8_LDB(B0, 1, 0); PG8_LDB(B1, 1, 1); PG8_SCHED; PG8_LDA(At, 1, 0); PG8_STAGE(PG8_SA(0, 1), a2 + hstep, voffA);
            PG8_WAIT_V(8); PG8_WAIT_L(0); PG8_BAR; PG8_MMA(0, 0, At, B0); PG8_MMA(0, 1, At, B1); PG8_BAR; PG8_SCHED;
            PG8_LDA(At, 1, 1); PG8_STAGE(PG8_SB(1, 0), b3, voffB); PG8_STAGE(PG8_SB(1, 1), b3 + hstep, voffB); PG8_STAGE(PG8_SA(1, 0), a3, voffA);
            PG8_WAIT_V(8); PG8_WAIT_L(0); PG8_BAR; PG8_MMA(1, 0, At, B0); PG8_MMA(1, 1, At, B1); PG8_BAR; PG8_SCHED;
            } else {
            PG8_LDB(B0, 0, 0); PG8_SCHED; PG8_LDA(At, 0, 0); PG8_STAGE(PG8_SA(1, 1), a1 + hstep, voffA);
            PG8_WAIT_L(8); PG8_BAR; PG8_WAIT_L(0); PG8_MMA(0, 0, At, B0); PG8_BAR; PG8_SCHED;
            PG8_LDB(B1, 0, 1); PG8_STAGE(PG8_SB(0, 0), b2, voffB);
            PG8_BAR; PG8_WAIT_L(0); PG8_MMA(0, 1, At, B1); PG8_BAR;
            PG8_LDA(At, 0, 1); PG8_STAGE(PG8_SA(0, 0), a2, voffA);
            PG8_BAR; PG8_WAIT_L(0); PG8_MMA(1, 0, At, B0); PG8_BAR; PG8_SCHED;
            PG8_STAGE(PG8_SB(0, 1), b2 + hstep, voffB);
            PG8_WAIT_V(6); PG8_BAR; PG8_MMA(1, 1, At, B1); PG8_BAR;
            PG8_LDB(B0, 1, 0); PG8_SCHED; PG8_LDA(At, 1, 0); PG8_STAGE(PG8_SA(0, 1), a2 + hstep, voffA);
            PG8_WAIT_L(8); PG8_BAR; PG8_WAIT_L(0); PG8_MMA(0, 0, At, B0); PG8_BAR; PG8_SCHED;
            PG8_LDB(B1, 1, 1); PG8_STAGE(PG8_SB(1, 0), b3, voffB);
            PG8_BAR; PG8_WAIT_L(0); PG8_MMA(0, 1, At, B1); PG8_BAR;
            PG8_LDA(At, 1, 1); PG8_STAGE(PG8_SA(1, 0), a3, voffA);
            PG8_BAR; PG8_WAIT_L(0); PG8_MMA(1, 0, At, B0); PG8_BAR; PG8_SCHED;
            PG8_STAGE(PG8_SB(1, 1), b3 + hstep, voffB);
            PG8_WAIT_V(6); PG8_BAR; PG8_MMA(1, 1, At, B1); PG8_BAR;
            }
        }
        if constexpr (ALIGN_EPI) { if (wr == 0) PG8_BAR; }
        if constexpr (!Epi::AFTER_DRAIN) { E(acc, cur, wr, wc, fr, fq); S.done(cur); }
        if (!has_next) break;
#pragma unroll
        for (int a = 0; a < 2; ++a)
#pragma unroll
            for (int b = 0; b < 2; ++b)
#pragma unroll
                for (int m = 0; m < 4; ++m)
#pragma unroll
                    for (int n = 0; n < 2; ++n) acc[a][b][m][n] = (f32x4){0.f, 0.f, 0.f, 0.f};
        cur = nxt; cA = nA; cB = nB; ++ui;
        if constexpr (ALIGN_EPI) { if (wr == 1) PG8_BAR; }
    }
    PG8_WAIT_V(0);
    if constexpr (!ALIGN_EPI) { if (wr == 0) PG8_BAR; }
    PG8_BAR;
    if constexpr (Epi::AFTER_DRAIN) { E.fused(acc, cur, wr, wc, fr, fq, lds, wid, lane); S.done(cur); }
#undef PG8_SA
#undef PG8_SB
#undef PG8_STAGE
#undef PG8_LDA
#undef PG8_LDB
#undef PG8_MMA
#undef PG8_WAIT_V
#undef PG8_WAIT_L
#undef PG8_BAR
#undef PG8_SCHED
}
}

#ifndef PG8_SP2
#define PG8_SP2 true
#endif
#ifndef PG8_ALIGN
#define PG8_ALIGN true
#endif

#define DI __device__ __forceinline__
typedef unsigned short bf16;
typedef short bf16x8 __attribute__((ext_vector_type(8)));
typedef float f32x4 __attribute__((ext_vector_type(4)));
typedef float f32x16 __attribute__((ext_vector_type(16)));
typedef unsigned u32x4 __attribute__((ext_vector_type(4)));
typedef unsigned u32x2 __attribute__((ext_vector_type(2)));
#define MFMA32(a, b, c) __builtin_amdgcn_mfma_f32_32x32x16_bf16((a), (b), (c), 0, 0, 0)

constexpr int NWAVES = 8, NTHR = 512;
constexpr int M = 16384, D = 1024, FF = 2816, INW = 2816, SEQ = 8192, DEPTH = 4;
constexpr int LDS_BYTES = 147456;
constexpr size_t MiB = 1u << 20;
constexpr size_t WS_CTL = 0;
constexpr size_t WS_STATS = 1 * MiB;
constexpr size_t WS_KMP = 2 * MiB;
constexpr size_t WS_DEC = 2 * MiB + 512 * 1024;
constexpr size_t WS_ROPEC = 3 * MiB, WS_ROPES = 4 * MiB;
constexpr size_t WS_W = 5 * MiB, WSZ = 42467328;
constexpr size_t W_GU1 = 0, W_D1 = 11534336, W_IN = 17301504, W_OUT = 23068672, W_GU2 = 25165824, W_D2 = 36700160;
constexpr size_t WS_XB = 86 * MiB;
constexpr size_t WS_R = 118 * MiB;
constexpr size_t R_HID = 0;
constexpr size_t R_Q = 0, R_K = 16 * MiB, R_V = 32 * MiB, R_U5 = 48 * MiB  , R_Y = 88 * MiB, R_PO = 120 * MiB, R_PML = 168 * MiB,
                 R_LIST = 172 * MiB  , R_ALOC = 188 * MiB, R_OINTRA = 204 * MiB, R_QDEC = 220 * MiB, R_SP = 228 * MiB, R_END = 236 * MiB;
constexpr size_t WS_END = WS_R + R_END;

DI float bf2f(unsigned short b) { return __uint_as_float((unsigned)b << 16); }
DI unsigned cvtpk(float lo, float hi) { return pg8::cvtpk(lo, hi); }
DI float wave_sum(float v) {
#pragma unroll
    for (int o = 1; o < 64; o <<= 1) v += __shfl_xor(v, o);
    return v;
}
DI void st_sc1(unsigned* p, unsigned v) { __hip_atomic_store(p, v, __ATOMIC_RELAXED, __HIP_MEMORY_SCOPE_AGENT); }
DI unsigned ld_sc1(const unsigned* p) { return __hip_atomic_load(p, __ATOMIC_RELAXED, __HIP_MEMORY_SCOPE_AGENT); }
DI float ld_sc1f(const float* p) { return __uint_as_float(__hip_atomic_load((const unsigned*)p, __ATOMIC_RELAXED, __HIP_MEMORY_SCOPE_AGENT)); }
DI int crow(int reg, int h) { return (reg & 3) + 8 * (reg >> 2) + 4 * h; }
DI bf16x8 pack8(const f32x16& x, int s) {
    u32x4 p; p.x = cvtpk(x[8 * s], x[8 * s + 1]); p.y = cvtpk(x[8 * s + 2], x[8 * s + 3]); p.z = cvtpk(x[8 * s + 4], x[8 * s + 5]); p.w = cvtpk(x[8 * s + 6], x[8 * s + 7]);
    return __builtin_bit_cast(bf16x8, p);
}
DI f32x16 zero16() { f32x16 z;
#pragma unroll
    for (int i = 0; i < 16; ++i) z[i] = 0.f; return z; }

struct Args { const float* in[18]; float* out; unsigned char* ws; int ph_lo, ph_hi; };
typedef const float* cfp_t;
typedef const __attribute__((address_space(4))) unsigned char* kptr_t;
struct Ctx { kptr_t kp; unsigned char* ws; float* out;
    DI const float* in(int i) const { return *(const __attribute__((address_space(4))) cfp_t*)(kp + 8 * i); } };
enum { I_X = 0, I_F1N, I_F1G, I_F1U, I_F1D, I_MIXN, I_WIN, I_QN, I_KN, I_PW, I_PS, I_LB, I_HON, I_WOUT, I_F2N, I_F2G, I_F2U, I_F2D };

DI void wconv_tile(const float* W, int ld, int srccol, const float* gain, bf16* WT, int K, int nrow0, int k0, float* scr, int lane) {
    asm volatile("" : "+v"(lane));
    const int c4 = (lane & 7) * 4, kr = lane >> 3;
    f32x4 v[8]; float gv[8];
#pragma unroll
    for (int i = 0; i < 8; ++i) { v[i] = *(const f32x4*)(W + (size_t)(k0 + 8 * i + kr) * ld + srccol + c4); gv[i] = gain ? gain[k0 + 8 * i + kr] : 1.0f; }
#pragma unroll
    for (int i = 0; i < 8; ++i) { float* d = scr + (8 * i + kr) * 33 + c4; d[0] = v[i][0] * gv[i]; d[1] = v[i][1] * gv[i]; d[2] = v[i][2] * gv[i]; d[3] = v[i][3] * gv[i]; }
    asm volatile("s_waitcnt lgkmcnt(0)" ::: "memory");
    const int c = lane & 7;
#pragma unroll
    for (int j = 0; j < 4; ++j) { const int n = (lane >> 3) + 8 * j; const float* s = scr + (8 * c) * 33 + n;
        u32x4 o; o.x = cvtpk(s[0 * 33], s[1 * 33]); o.y = cvtpk(s[2 * 33], s[3 * 33]); o.z = cvtpk(s[4 * 33], s[5 * 33]); o.w = cvtpk(s[6 * 33], s[7 * 33]);
        *(u32x4*)(WT + (size_t)(nrow0 + n) * K + k0 + 8 * c) = o; }
    asm volatile("s_waitcnt lgkmcnt(0)" ::: "memory");
}
constexpr int WC_I0 = 2816, WC_I1 = 1408, WC_I2 = 1408, WC_I3 = 512, WC_I4 = 2816, WC_I5 = 1408, WC_ITEMS = WC_I0 + WC_I1 + WC_I2 + WC_I3 + WC_I4 + WC_I5;
DI void wconv_item(const Ctx& a, int L, int item, float* scr, int lane) {
    unsigned char* wb = a.ws + WS_W + (size_t)(L & 1) * WSZ;
    int r = item;
    if (r < WC_I0 || (r >= WC_I0 + WC_I1 + WC_I2 + WC_I3 && r < WC_I0 + WC_I1 + WC_I2 + WC_I3 + WC_I4)) {
        const bool second = r >= WC_I0; if (second) r -= WC_I0 + WC_I1 + WC_I2 + WC_I3;
        const int kb = r / 176, nb = r % 176, n0 = nb * 32, pn = n0 >> 8, c = n0 & 255, bj = c >> 7, col = 128 * pn + (c & 127);
        const float* src = a.in(second ? (bj ? I_F2U : I_F2G) : (bj ? I_F1U : I_F1G)) + (size_t)L * D * FF;
        const float* gain = a.in(second ? I_F2N : I_F1N) + L * D;
        wconv_tile(src, FF, col, gain, (bf16*)(wb + (second ? W_GU2 : W_GU1)), D, n0, kb * 64, scr, lane); return;
    }
    r -= WC_I0;
    if (r < WC_I1) { const int kb = r / 32, nb = r % 32; wconv_tile(a.in(I_F1D) + (size_t)L * FF * D, D, nb * 32, nullptr, (bf16*)(wb + W_D1), FF, nb * 32, kb * 64, scr, lane); return; }
    r -= WC_I1;
    if (r < WC_I2) { const int kb = r / 88, nb = r % 88, n0 = nb * 32, pn = n0 >> 8, c = n0 & 255;
        const int col = pn < 6 ? (pn >> 1) * 512 + 64 * ((pn & 1) * 4 + ((c >> 5) & 3)) + 32 * (c >> 7) : n0;
        wconv_tile(a.in(I_WIN) + (size_t)L * D * INW, INW, col, a.in(I_MIXN) + L * D, (bf16*)(wb + W_IN), D, n0, kb * 64, scr, lane); return; }
    r -= WC_I2;
    if (r < WC_I3) { const int kb = r / 32, nb = r % 32; wconv_tile(a.in(I_WOUT) + (size_t)L * D * D, D, nb * 32, nullptr, (bf16*)(wb + W_OUT), D, nb * 32, kb * 64, scr, lane); return; }
    r -= WC_I3 + WC_I4;
    { const int kb = r / 32, nb = r % 32; wconv_tile(a.in(I_F2D) + (size_t)L * FF * D, D, nb * 32, nullptr, (bf16*)(wb + W_D2), FF, nb * 32, kb * 64, scr, lane); }
}

DI void phase_p0(const Ctx& a, unsigned char* lds, int gw, int NGW, int wave, int lane) {
    const float* x = a.in(I_X); float* out = a.out; bf16* xb = (bf16*)(a.ws + WS_XB); float* stats = (float*)(a.ws + WS_STATS);
    for (int m0 = gw * 2; m0 < M; m0 += NGW * 2) {
        f32x4 v[2][4]; float sq[2];
#pragma unroll
        for (int k = 0; k < 2; ++k) { const f32x4* xr = (const f32x4*)(x + (size_t)(m0 + k) * D) + lane;
#pragma unroll
            for (int j = 0; j < 4; ++j) v[k][j] = xr[64 * j]; }
#pragma unroll
        for (int k = 0; k < 2; ++k) { float s = 0.f;
#pragma unroll
            for (int j = 0; j < 4; ++j) s += (v[k][j][0] * v[k][j][0] + v[k][j][1] * v[k][j][1]) + (v[k][j][2] * v[k][j][2] + v[k][j][3] * v[k][j][3]);
            sq[k] = wave_sum(s); }
#pragma unroll
        for (int k = 0; k < 2; ++k) { const int m = m0 + k;
            u32x2* brow = (u32x2*)(xb + (size_t)m * D) + lane;
#pragma unroll
            for (int j = 0; j < 4; ++j) { u32x2 w; w.x = cvtpk(v[k][j][0], v[k][j][1]); w.y = cvtpk(v[k][j][2], v[k][j][3]); brow[64 * j] = w; }
            if (lane < 16) stats[(size_t)m * 16 + lane] = (lane == 0) ? sq[k] : 0.f; }
    }
    { unsigned* cz = (unsigned*)(a.ws + WS_CTL + 65536); for (int i = gw * 64 + lane; i < 3456; i += NGW * 64) cz[i] = 0u; }
    float* rc = (float*)(a.ws + WS_ROPEC); float* rs = (float*)(a.ws + WS_ROPES);
    for (int e = gw * 64 + lane; e < SEQ * 32; e += NGW * 64) {
        const int t = e >> 5, i = e & 31;
        double c = 0.15915494309189535;
        for (int k = 0; k < i; ++k) c *= 0.74989420933245582;
        const float chi = (float)c, clo = (float)(c - (double)chi), tf = (float)t;
        const float p = tf * chi, pe = fmaf(tf, chi, -p);
        float fr = __builtin_amdgcn_fractf(p) + (pe + tf * clo);
        rc[e] = __builtin_amdgcn_cosf(fr); rs[e] = __builtin_amdgcn_sinf(fr);
    }
    float* scr = (float*)(lds + wave * 16384);
    for (int it = gw; it < WC_ITEMS; it += NGW) wconv_item(a, 0, it, scr, lane);
}

template <bool DIAG>
DI void attn_core(const bf16* qrow, const bf16* kblk, const bf16* vblk, int nkg, int r, int h, float& m_out, float& l_out, f32x16 (&ot)[2]) {
    bf16x8 qf[4];
#pragma unroll
    for (int ks = 0; ks < 4; ++ks) qf[ks] = *(const bf16x8*)(qrow + 16 * ks + 8 * h);
    f32x16 st[8];
    const int lo = (r * 2 + h) * 8;
#pragma unroll
    for (int hf = 0; hf < 2; ++hf) {
        if (!DIAG || 4 * hf < nkg) {
            bf16x8 kf[16];
#pragma unroll
            for (int i = 0; i < 16; ++i) kf[i] = (!DIAG || 4 * hf + (i >> 2) < nkg) ? *(const bf16x8*)(kblk + ((4 * hf + (i >> 2)) * 4 + (i & 3)) * 512 + lo) : qf[0];
#pragma unroll
            for (int g = 0; g < 4; ++g) {
                const int kg = 4 * hf + g;
                f32x16 acc = zero16();
                if (!DIAG || kg < nkg) {
#pragma unroll
                    for (int ks = 0; ks < 4; ++ks) acc = MFMA32(kf[4 * g + ks], qf[ks], acc);
                    if (DIAG && kg == nkg - 1) {
#pragma unroll
                        for (int i = 0; i < 16; ++i) if (crow(i, h) > r) acc[i] = -INFINITY;
                    }
                } else {
#pragma unroll
                    for (int i = 0; i < 16; ++i) acc[i] = -INFINITY;
                }
                st[kg] = acc;
            }
        } else {
#pragma unroll
            for (int g = 0; g < 4; ++g)
#pragma unroll
                for (int i = 0; i < 16; ++i) st[4 * hf + g][i] = -INFINITY;
        }
    }
    float mx = -INFINITY;
#pragma unroll
    for (int kg = 0; kg < 8; ++kg)
#pragma unroll
        for (int i = 0; i < 16; ++i) mx = fmaxf(mx, st[kg][i]);
    mx = fmaxf(mx, __shfl_xor(mx, 32));
    const float c = 0.125f * 1.4426950408889634f; const float mc = mx * c;
    float l = 0.f;
#pragma unroll
    for (int kg = 0; kg < 8; ++kg)
#pragma unroll
        for (int i = 0; i < 16; ++i) { const float p = __builtin_amdgcn_exp2f(st[kg][i] * c - mc); st[kg][i] = p; l += p; }
    l += __shfl_xor(l, 32);
    ot[0] = zero16(); ot[1] = zero16();
#pragma unroll
    for (int pr = 0; pr < 4; ++pr) {
        if (!DIAG || 2 * pr < nkg) {
            bf16x8 vf[8];
#pragma unroll
            for (int i = 0; i < 8; ++i) vf[i] = (!DIAG || 2 * pr + (i >> 2) < nkg) ? *(const bf16x8*)(vblk + (((2 * pr + (i >> 2)) * 2 + ((i >> 1) & 1)) * 2 + (i & 1)) * 512 + lo) : qf[0];
#pragma unroll
            for (int g = 0; g < 2; ++g) {
                const int kg = 2 * pr + g;
                if (!DIAG || kg < nkg) {
#pragma unroll
                    for (int s2 = 0; s2 < 2; ++s2) { const bf16x8 pf = pack8(st[kg], s2); ot[0] = MFMA32(vf[4 * g + 2 * s2], pf, ot[0]); ot[1] = MFMA32(vf[4 * g + 2 * s2 + 1], pf, ot[1]); }
                }
            }
        }
    }
    m_out = mx * 0.125f; l_out = l;
}

DI void topk_unit(const Ctx& a, int L, int unit, int lane) {
    asm volatile("" : "+v"(lane));
    const int b = unit >> 10, hd = (unit >> 7) & 7, c = unit & 127, own = c >> 2;
    if (own == 0) return;
    const bf16* Q = (const bf16*)(a.ws + WS_R + R_Q); const float* kmp = (const float*)(a.ws + WS_KMP);
    unsigned* cnt = (unsigned*)(a.ws + WS_CTL) + L * 512; unsigned* lists = (unsigned*)(a.ws + WS_R + R_LIST);
    const int t = c * 64 + lane; const size_t bh = (size_t)(b * 8 + hd);
    float q[64];
    { const u32x4* qp = (const u32x4*)(Q + (bh * SEQ + t) * 64);
#pragma unroll
      for (int i = 0; i < 8; ++i) { const u32x4 w = qp[i];
          q[8 * i + 0] = __uint_as_float(w.x << 16); q[8 * i + 1] = __uint_as_float(w.x & 0xffff0000u); q[8 * i + 2] = __uint_as_float(w.y << 16); q[8 * i + 3] = __uint_as_float(w.y & 0xffff0000u);
          q[8 * i + 4] = __uint_as_float(w.z << 16); q[8 * i + 5] = __uint_as_float(w.z & 0xffff0000u); q[8 * i + 6] = __uint_as_float(w.w << 16); q[8 * i + 7] = __uint_as_float(w.w & 0xffff0000u); } }
    float g0 = -INFINITY, g1 = -INFINITY, g2 = -INFINITY; int i0 = 0, i1 = 0, i2 = 0;
    for (int j = 0; j < own; ++j) {
        const float* p0 = kmp + (size_t)((b * 32 + j) * 2) * 512 + hd * 64; const float* p1 = p0 + 512;
        float g = 0.f;
#pragma unroll
        for (int d = 0; d < 64; d += 4) { const f32x4 x0 = *(const f32x4*)(p0 + d), x1 = *(const f32x4*)(p1 + d);
            g += q[d] * (x0[0] + x1[0]) + q[d + 1] * (x0[1] + x1[1]) + q[d + 2] * (x0[2] + x1[2]) + q[d + 3] * (x0[3] + x1[3]); }
#ifdef DBG_FIXED_SEL
        g = -(float)j;
#endif
        if (g > g0) { g2 = g1; i2 = i1; g1 = g0; i1 = i0; g0 = g; i0 = j; }
        else if (g > g1) { g2 = g1; i2 = i1; g1 = g; i1 = j; }
        else if (g > g2) { g2 = g; i2 = j; }
    }
    const int nsel = own < 3 ? own : 3;
#pragma unroll
    for (int s = 0; s < 3; ++s) {
        if (s < nsel) { const int j = s == 0 ? i0 : (s == 1 ? i1 : i2); const int li = (int)bh * 32 + j;
            const unsigned pos = atomicAdd(cnt + li, 1u); st_sc1(lists + (size_t)li * 8192 + pos, (unsigned)(t | (s << 13))); }
    }
}

DI void pool_unit(const Ctx& a, int L, int unit, int lane) {
    asm volatile("" : "+v"(lane));
    const int tile = unit >> 2, g = unit & 3, w = 2 << g, r = lane & 31, h = lane >> 5;
    const bf16* U = (const bf16*)(a.ws + WS_R + R_U5); bf16* Y = (bf16*)(a.ws + WS_R + R_Y);
    const float* pw = a.in(I_PW) + (size_t)(L * 4 + g) * 4096; const float* ps = a.in(I_PS) + L * 256 + g * 64;
    const float* pwl = pw + (8 * h) * 64 + r;
    bf16x8 wf[2][4];
#pragma unroll
    for (int me = 0; me < 2; ++me)
#pragma unroll
        for (int ks = 0; ks < 4; ++ks) { float f[8];
#pragma unroll
            for (int j = 0; j < 8; ++j) f[j] = pwl[(16 * ks + j) * 64 + 32 * me];
            u32x4 p; p.x = cvtpk(f[0], f[1]); p.y = cvtpk(f[2], f[3]); p.z = cvtpk(f[4], f[5]); p.w = cvtpk(f[6], f[7]); wf[me][ks] = __builtin_bit_cast(bf16x8, p); }
#pragma unroll 1
    for (int nt = 0; nt < 4; ++nt) {
        const int m = tile * 128 + nt * 32 + r, tpos = m & (SEQ - 1);
        const int cntw = tpos + 1 < w ? tpos + 1 : w; const float invc = 1.0f / (float)cntw;
        f32x16 acc[2]; acc[0] = zero16(); acc[1] = zero16();
#pragma unroll
        for (int ks = 0; ks < 4; ++ks) {
            const bf16* up = U + (size_t)m * 256 + g * 64 + 16 * ks + 8 * h;
            float sum[8], self[8];
            { const u32x4 wv = *(const u32x4*)up;
              self[0] = __uint_as_float(wv.x << 16); self[1] = __uint_as_float(wv.x & 0xffff0000u); self[2] = __uint_as_float(wv.y << 16); self[3] = __uint_as_float(wv.y & 0xffff0000u);
              self[4] = __uint_as_float(wv.z << 16); self[5] = __uint_as_float(wv.z & 0xffff0000u); self[6] = __uint_as_float(wv.w << 16); self[7] = __uint_as_float(wv.w & 0xffff0000u); }
#pragma unroll
            for (int j = 0; j < 8; ++j) sum[j] = self[j];
            u32x4 rows[15];
#pragma unroll
            for (int i = 1; i < 16; ++i) { const bool ok = (i < w) && (i <= tpos); rows[i - 1] = *(const u32x4*)(up - (size_t)(ok ? i : 0) * 256); }
#pragma unroll
            for (int i = 1; i < 16; ++i) { const bool ok = (i < w) && (i <= tpos); const float kf = ok ? 1.f : 0.f; const u32x4 wv = rows[i - 1];
                sum[0] += kf * __uint_as_float(wv.x << 16); sum[1] += kf * __uint_as_float(wv.x & 0xffff0000u); sum[2] += kf * __uint_as_float(wv.y << 16); sum[3] += kf * __uint_as_float(wv.y & 0xffff0000u);
                sum[4] += kf * __uint_as_float(wv.z << 16); sum[5] += kf * __uint_as_float(wv.z & 0xffff0000u); sum[6] += kf * __uint_as_float(wv.w << 16); sum[7] += kf * __uint_as_float(wv.w & 0xffff0000u); }
            u32x4 p; p.x = cvtpk(sum[0] * invc - self[0], sum[1] * invc - self[1]); p.y = cvtpk(sum[2] * invc - self[2], sum[3] * invc - self[3]);
            p.z = cvtpk(sum[4] * invc - self[4], sum[5] * invc - self[5]); p.w = cvtpk(sum[6] * invc - self[6], sum[7] * invc - self[7]);
            const bf16x8 df = __builtin_bit_cast(bf16x8, p);
            acc[0] = MFMA32(wf[0][ks], df, acc[0]); acc[1] = MFMA32(wf[1][ks], df, acc[1]);
        }
#pragma unroll
        for (int me = 0; me < 2; ++me)
#pragma unroll
            for (int gq = 0; gq < 4; ++gq) { const int e0 = 32 * me + 8 * gq + 4 * h; const f32x4 sc = *(const f32x4*)(ps + e0);
                u32x2 o; o.x = cvtpk(acc[me][4 * gq] * sc[0], acc[me][4 * gq + 1] * sc[1]); o.y = cvtpk(acc[me][4 * gq + 2] * sc[2], acc[me][4 * gq + 3] * sc[3]);
                *(u32x2*)(Y + (size_t)m * 1024 + 512 + g * 64 + e0) = o; }
    }
}

DI void h1_unit(const Ctx& a, int L, int unit, unsigned char* sm, int lane) {
    asm volatile("" : "+v"(lane));
    const int b = unit >> 9, hh = (unit >> 7) & 3, n = unit & 127, r = lane & 31, h = lane >> 5;
    const int row0 = b * SEQ + n * 64, ch = hh * 64 + lane;
    const bf16* QH = (const bf16*)(a.ws + WS_R + R_U5) + (size_t)1 * M * 256; const bf16* FH = QH + (size_t)M * 256; const bf16* IH = FH + (size_t)M * 256;
    bf16* QDEC = (bf16*)(a.ws + WS_R + R_QDEC); float* ALOC = (float*)(a.ws + WS_R + R_ALOC); float* OINTRA = (float*)(a.ws + WS_R + R_OINTRA); float* DEC = (float*)(a.ws + WS_DEC);
    bf16* KD = (bf16*)sm; bf16* IT = (bf16*)(sm + 8192); bf16* Am = (bf16*)(sm + 16384); bf16* Bm = (bf16*)(sm + 24576);
#ifdef DBG_H1_CLEAR
    { u32x4* z4 = (u32x4*)sm;
#pragma unroll 4
      for (int i = 0; i < 32; ++i) z4[i * 64 + lane] = (u32x4){0u, 0u, 0u, 0u}; asm volatile("s_waitcnt lgkmcnt(0)" ::: "memory"); }
#endif
    float lb;
    { const float* lp = a.in(I_LB) + ch; const float x0 = lp[0], x1 = lp[256], x2 = lp[512], x3 = lp[768];
      const float mx = fmaxf(fmaxf(x0, x1), fmaxf(x2, x3)); const float e0 = __expf(x0 - mx), e1 = __expf(x1 - mx), e2 = __expf(x2 - mx), e3 = __expf(x3 - mx);
      const float inv = 1.0f / (e0 + e1 + e2 + e3); float acc = 0.f; if (L > 0) acc += e0; if (L > 1) acc += e1; if (L > 2) acc += e2; lb = acc * inv; }
    const float loglb = __logf(fmaxf(lb, 1e-20f)), l1m = __logf(1.0f - lb), oml = 1.0f - lb;
    float zr[64];
#pragma unroll
    for (int s = 0; s < 64; ++s) zr[s] = bf2f(FH[(size_t)(row0 + s) * 256 + ch]);
    float cum = 0.f, ref = 0.f;
#pragma unroll
    for (int s = 0; s < 64; ++s) {
        const float z = zr[s];
        const float ls = fminf(z, 0.f) - __logf(1.0f + __expf(-fabsf(z)));
        const float bb = l1m + ls, hi = fmaxf(loglb, bb), df = fabsf(loglb - bb);
        cum += hi + __logf(1.0f + __expf(-df));
        asm volatile("" : "+v"(cum));
        if (s == 31) ref = cum;
    }
    const float last = cum;
    DEC[unit * 64 + lane] = __expf(last);
    cum = 0.f;
#ifndef H1_NO_P2
    unsigned short zc[8], qc[8], ic[8];
#pragma unroll
    for (int j = 0; j < 8; ++j) { const size_t gi = (size_t)(row0 + j) * 256 + ch; zc[j] = FH[gi]; qc[j] = QH[gi]; ic[j] = IH[gi]; }
#pragma unroll 1
    for (int s8 = 0; s8 < 8; ++s8) {
        unsigned kp[4], ip[4]; float kd8[8]; unsigned short i8[8];
        unsigned short zn[8], qn[8], in_[8];
        { const int sn = (s8 < 7 ? s8 + 1 : 7) * 8;
#pragma unroll
          for (int j = 0; j < 8; ++j) { const size_t gi = (size_t)(row0 + sn + j) * 256 + ch; zn[j] = FH[gi]; qn[j] = QH[gi]; in_[j] = IH[gi]; } }
#pragma unroll
        for (int j = 0; j < 8; ++j) {
            const int s = s8 * 8 + j; const size_t gi = (size_t)(row0 + s) * 256 + ch;
            const float z = bf2f(zc[j]), qv = bf2f(qc[j]); i8[j] = ic[j];
            const float ls = fminf(z, 0.f) - __logf(1.0f + __expf(-fabsf(z)));
            const float bb = l1m + ls, hi = fmaxf(loglb, bb), df = fabsf(loglb - bb);
            cum += hi + __logf(1.0f + __expf(-df));
            const float key = oml * __builtin_amdgcn_rcpf(1.0f + __expf(z));
            const float qs = qv * __builtin_amdgcn_rcpf(1.0f + __expf(-qv)) * 0.125f;
            const float av = qs * __expf(fminf(cum - ref, 80.f)), bv = key * __expf(fminf(ref - cum, 80.f)), qd = qs * __expf(cum);
            kd8[j] = key * __expf(last - cum);
#ifndef H1_NO_AB
            Am[s * 64 + lane] = (bf16)(cvtpk(av, 0.f) & 0xffffu); Bm[s * 64 + lane] = (bf16)(cvtpk(bv, 0.f) & 0xffffu);
#endif
#ifndef H1_NO_QD
            QDEC[gi] = (bf16)(cvtpk(qd, 0.f) & 0xffffu);
#endif
        }
#pragma unroll
        for (int j = 0; j < 4; ++j) { kp[j] = cvtpk(kd8[2 * j], kd8[2 * j + 1]); ip[j] = (unsigned)i8[2 * j] | ((unsigned)i8[2 * j + 1] << 16); }
        *(u32x4*)(KD + lane * 64 + s8 * 8) = (u32x4){kp[0], kp[1], kp[2], kp[3]};
        *(u32x4*)(IT + lane * 64 + s8 * 8) = (u32x4){ip[0], ip[1], ip[2], ip[3]};
#pragma unroll
        for (int j = 0; j < 8; ++j) { zc[j] = zn[j]; qc[j] = qn[j]; ic[j] = in_[j]; }
    }
#endif
    asm volatile("s_waitcnt lgkmcnt(0)" ::: "memory");
#ifndef H1_NO_MM
    bf16x8 itf[2][2][2];
#pragma unroll
    for (int mv = 0; mv < 2; ++mv)
#pragma unroll
        for (int ms = 0; ms < 2; ++ms)
#pragma unroll
            for (int st = 0; st < 2; ++st) { const bf16* p = IT + (32 * mv + r) * 64 + 32 * ms + 16 * st + 4 * h; const u32x2 x0 = *(const u32x2*)p, x1 = *(const u32x2*)(p + 8);
                itf[mv][ms][st] = __builtin_bit_cast(bf16x8, ((u32x4){x0.x, x0.y, x1.x, x1.y})); }
    float* alb = ALOC + (size_t)unit * 4096 + (4 * h) * 64 + r;
#pragma unroll
    for (int nk = 0; nk < 2; ++nk) {
        bf16x8 kdf[2][2];
#pragma unroll
        for (int ms = 0; ms < 2; ++ms)
#pragma unroll
            for (int st = 0; st < 2; ++st) { const bf16* p = KD + (32 * nk + r) * 64 + 32 * ms + 16 * st + 4 * h; const u32x2 x0 = *(const u32x2*)p, x1 = *(const u32x2*)(p + 8);
                kdf[ms][st] = __builtin_bit_cast(bf16x8, ((u32x4){x0.x, x0.y, x1.x, x1.y})); }
#pragma unroll
        for (int mv = 0; mv < 2; ++mv) {
            f32x16 acc = zero16();
#pragma unroll
            for (int ms = 0; ms < 2; ++ms)
#pragma unroll
                for (int st = 0; st < 2; ++st) acc = MFMA32(itf[mv][ms][st], kdf[ms][st], acc);
#pragma unroll
            for (int i = 0; i < 16; ++i) alb[(32 * mv + (i & 3) + 8 * (i >> 2)) * 64 + 32 * nk] = acc[i];
        }
    }
#pragma unroll
    for (int nt = 0; nt < 2; ++nt) {
        bf16x8 af[4];
#pragma unroll
        for (int ks = 0; ks < 4; ++ks) af[ks] = *(const bf16x8*)(Am + (32 * nt + r) * 64 + 16 * ks + 8 * h);
        f32x16 oi[2]; oi[0] = zero16(); oi[1] = zero16();
#pragma unroll
        for (int ms = 0; ms < 2; ++ms) {
            if (ms <= nt) {
                f32x16 sacc = zero16();
#pragma unroll
                for (int ks = 0; ks < 4; ++ks) { const bf16x8 bf_ = *(const bf16x8*)(Bm + (32 * ms + r) * 64 + 16 * ks + 8 * h); sacc = MFMA32(bf_, af[ks], sacc); }
                if (ms == nt) {
#pragma unroll
                    for (int i = 0; i < 16; ++i) if (crow(i, h) > r) sacc[i] = 0.f;
                }
#pragma unroll
                for (int st = 0; st < 2; ++st) { const bf16x8 pf = pack8(sacc, st); oi[0] = MFMA32(itf[0][ms][st], pf, oi[0]); oi[1] = MFMA32(itf[1][ms][st], pf, oi[1]); }
            }
        }
        const size_t orow = (size_t)(row0 + 32 * nt + r) * 256 + hh * 64;
#pragma unroll
        for (int mv = 0; mv < 2; ++mv)
#pragma unroll
            for (int gq = 0; gq < 4; ++gq) *(f32x4*)(OINTRA + orow + 32 * mv + 8 * gq + 4 * h) = (f32x4){oi[mv][4 * gq], oi[mv][4 * gq + 1], oi[mv][4 * gq + 2], oi[mv][4 * gq + 3]};
    }
#endif
    asm volatile("s_waitcnt lgkmcnt(0)" ::: "memory");
}

DI void phase_t(const Ctx& a, int L, unsigned char* lds, int gw, int NGW, int wave, int lane, bool conv_here) {
    const int blk = gw >> 3, G = NGW >> 3;
    if (wave < 4) { for (int u = blk * 4 + wave; u < 1024; u += G * 4) h1_unit(a, L, u, lds + wave * 32768, lane); }
    else if (wave < 6) { for (int u = blk * 2 + (wave - 4); u < 512; u += G * 2) pool_unit(a, L, u, lane); }
    __syncthreads();
    if (conv_here && L + 1 < DEPTH) { float* scr = (float*)(lds + wave * 16384); for (int it = gw; it < WC_ITEMS; it += NGW) wconv_item(a, L + 1, it, scr, lane); }
}

DI void attn_unit(const Ctx& a, int bh, int qb, unsigned char* lds, int tid, int wave, int lane) {
    asm volatile("" : "+v"(lane), "+v"(tid));
    const int r = lane & 31, h = lane >> 5, b = bh >> 3, hd = bh & 7, own = qb, nsel = own < 3 ? own : 3;
    const bf16* Q = (const bf16*)(a.ws + WS_R + R_Q); const bf16* Kb = (const bf16*)(a.ws + WS_R + R_K); const bf16* Vb = (const bf16*)(a.ws + WS_R + R_V);
    const float* kmp = (const float*)(a.ws + WS_KMP); bf16* Y = (bf16*)(a.ws + WS_R + R_Y);
    unsigned char* part = lds;
    unsigned short* llist = (unsigned short*)(lds + 104448);
    int* lcnt = (int*)(lds + 120832); int* itab = lcnt + 32;
    const size_t qbase = ((size_t)bh * SEQ + (size_t)qb * 256) * 64;
    if (own > 0) {
        if (tid < 32) lcnt[tid] = 0;
        float* km = (float*)(lds + 122880);
        for (int idx = tid; idx < own * 64; idx += NTHR) { const float* p0 = kmp + (size_t)((b * 32 + (idx >> 6)) * 2) * 512 + hd * 64 + (idx & 63); km[idx] = p0[0] + p0[512]; }
        __syncthreads();
        if (tid < 256) {
            float q[64];
            { const u32x4* qp = (const u32x4*)(Q + qbase + (size_t)tid * 64);
#pragma unroll
              for (int i = 0; i < 8; ++i) { const u32x4 w = qp[i];
                  q[8 * i + 0] = __uint_as_float(w.x << 16); q[8 * i + 1] = __uint_as_float(w.x & 0xffff0000u); q[8 * i + 2] = __uint_as_float(w.y << 16); q[8 * i + 3] = __uint_as_float(w.y & 0xffff0000u);
                  q[8 * i + 4] = __uint_as_float(w.z << 16); q[8 * i + 5] = __uint_as_float(w.z & 0xffff0000u); q[8 * i + 6] = __uint_as_float(w.w << 16); q[8 * i + 7] = __uint_as_float(w.w & 0xffff0000u); } }
            float g0 = -INFINITY, g1 = -INFINITY, g2 = -INFINITY; int i0 = 0, i1 = 0, i2 = 0;
            for (int j = 0; j < own; ++j) {
                const float* kj = km + j * 64;
                float g = 0.f;
#pragma unroll
                for (int d = 0; d < 64; d += 4) { const f32x4 x0 = *(const f32x4*)(kj + d);
                    g += q[d] * x0[0] + q[d + 1] * x0[1] + q[d + 2] * x0[2] + q[d + 3] * x0[3]; }
                if (g > g0) { g2 = g1; i2 = i1; g1 = g0; i1 = i0; g0 = g; i0 = j; }
                else if (g > g1) { g2 = g1; i2 = i1; g1 = g; i1 = j; }
                else if (g > g2) { g2 = g; i2 = j; }
            }
#pragma unroll
            for (int s = 0; s < 3; ++s) {
                if (s < nsel) { const int j = s == 0 ? i0 : (s == 1 ? i1 : i2); const int pos = atomicAdd(lcnt + j, 1); llist[j * 256 + pos] = (unsigned short)(tid | (s << 8)); }
            }
        }
        __syncthreads();
        if (tid == 0) { int n = 0; for (int j = 0; j < own; ++j) { const int ng = (lcnt[j] + 31) >> 5; for (int g = 0; g < ng; ++g) itab[n++] = j | (g << 8); } itab[64] = n; }
        __syncthreads();
        const int nitems = __builtin_amdgcn_readfirstlane(itab[64]);
        for (int it = wave; it < nitems; it += NWAVES) {
            const int ent = __builtin_amdgcn_readfirstlane(itab[it]); const int j = ent & 255, g = ent >> 8, n = __builtin_amdgcn_readfirstlane(lcnt[j]);
            const int idx = g * 32 + r; const bool valid = idx < n;
            const unsigned e = llist[j * 256 + (valid ? idx : 0)];
            const int qi = e & 255, slot = e >> 8;
            float mo, lo_; f32x16 ot[2];
            attn_core<false>(Q + qbase + (size_t)qi * 64, Kb + ((size_t)bh * 32 + j) * 16384, Vb + ((size_t)bh * 32 + j) * 16384, 8, r, h, mo, lo_, ot);
            if (valid) {
                unsigned char* rec = part + (qi * 3 + slot) * 136; const float inv = 1.0f / lo_;
#pragma unroll
                for (int md = 0; md < 2; ++md)
#pragma unroll
                    for (int gq = 0; gq < 4; ++gq) { u32x2 o; o.x = cvtpk(ot[md][4 * gq] * inv, ot[md][4 * gq + 1] * inv); o.y = cvtpk(ot[md][4 * gq + 2] * inv, ot[md][4 * gq + 3] * inv);
                        *(u32x2*)(rec + 2 * (32 * md + 8 * gq + 4 * h)) = o; }
                if (h == 0) { *(float*)(rec + 128) = mo; *(float*)(rec + 132) = lo_; }
            }
        }
        __syncthreads();
    }
    {
        const int ql = 32 * wave + r, t = qb * 256 + ql;
        float m0, l0; f32x16 ot[2];
        attn_core<true>(Q + qbase + (size_t)ql * 64, Kb + ((size_t)bh * 32 + qb) * 16384, Vb + ((size_t)bh * 32 + qb) * 16384, wave + 1, r, h, m0, l0, ot);
        float ms[3], ls[3]; float mx = m0;
#pragma unroll
        for (int s = 0; s < 3; ++s) { ms[s] = -INFINITY; ls[s] = 0.f; if (s < nsel) { const unsigned char* rec = part + (ql * 3 + s) * 136; ms[s] = *(const float*)(rec + 128); ls[s] = *(const float*)(rec + 132); mx = fmaxf(mx, ms[s]); } }
        const float w0 = __expf(m0 - mx); float den = w0 * l0;
#pragma unroll
        for (int md = 0; md < 2; ++md)
#pragma unroll
            for (int i = 0; i < 16; ++i) ot[md][i] *= w0;
#pragma unroll
        for (int s = 0; s < 3; ++s) {
            if (s < nsel) {
                const unsigned char* rec = part + (ql * 3 + s) * 136; const float ws_ = __expf(ms[s] - mx) * ls[s]; den += ws_;
#pragma unroll
                for (int md = 0; md < 2; ++md)
#pragma unroll
                    for (int gq = 0; gq < 4; ++gq) { const u32x2 w = *(const u32x2*)(rec + 2 * (32 * md + 8 * gq + 4 * h));
                        ot[md][4 * gq] += ws_ * __uint_as_float(w.x << 16); ot[md][4 * gq + 1] += ws_ * __uint_as_float(w.x & 0xffff0000u);
                        ot[md][4 * gq + 2] += ws_ * __uint_as_float(w.y << 16); ot[md][4 * gq + 3] += ws_ * __uint_as_float(w.y & 0xffff0000u); }
            }
        }
        float inv = 1.0f / den; const size_t yrow = (size_t)(b * SEQ + t) * 1024 + hd * 64;
#ifdef DBG_AMP_ATTN
        inv *= 64.f;
#endif
#pragma unroll
        for (int md = 0; md < 2; ++md)
#pragma unroll
            for (int gq = 0; gq < 4; ++gq) { u32x2 o; o.x = cvtpk(ot[md][4 * gq] * inv, ot[md][4 * gq + 1] * inv); o.y = cvtpk(ot[md][4 * gq + 2] * inv, ot[md][4 * gq + 3] * inv);
                *(u32x2*)(Y + yrow + 32 * md + 8 * gq + 4 * h) = o; }
    }
    __syncthreads();
}

DI void phase_a(const Ctx& a, int L, unsigned char* lds, int gw, int NGW, int tid, int wave, int lane) {
    if ((gw & 3) == 0 && (gw >> 2) < 512) {
        const int chunk = gw >> 2, bhh = chunk >> 6, e = (chunk & 63) * 64 + lane, k = e & 63;
        const float* ALOC = (const float*)(a.ws + WS_R + R_ALOC); const float* DEC = (const float*)(a.ws + WS_DEC); bf16* SP = (bf16*)(a.ws + WS_R + R_SP);
        float st = 0.f;
#pragma unroll 32
        for (int n = 0; n < 128; ++n) { const int item = bhh * 128 + n; const float av = ALOC[(size_t)item * 4096 + e], dv = DEC[item * 64 + k];
            SP[(size_t)item * 4096 + e] = (bf16)(cvtpk(st, 0.f) & 0xffffu); st = dv * st + av; }
    }
    const int G = NGW / NWAVES, blk = gw / NWAVES;
    if (G == 256) {
        const int xcd = blk & 7, i = blk >> 3;
        attn_unit(a, 2 * xcd, i, lds, tid, wave, lane);
        attn_unit(a, 2 * xcd + 1, 31 - i, lds, tid, wave, lane);
    } else {
        for (int u = blk; u < 512; u += G) {
            const int v = u & 255, bh = v >> 4, qb = (u < 256) ? (v & 15) : 31 - (v & 15);
            attn_unit(a, bh, qb, lds, tid, wave, lane);
        }
    }
}

DI void own_unit(const Ctx& a, int bhi, int qg, int lane) {
    asm volatile("" : "+v"(lane));
    const int r = lane & 31, h = lane >> 5, t0 = qg * 32, j = t0 >> 8, nkg = ((t0 & 255) >> 5) + 1, t = t0 + r;
    const int b = bhi >> 3, hd = bhi & 7; const size_t bh = (size_t)bhi;
    const bf16* Q = (const bf16*)(a.ws + WS_R + R_Q); const bf16* Kb = (const bf16*)(a.ws + WS_R + R_K); const bf16* Vb = (const bf16*)(a.ws + WS_R + R_V);
    const bf16* PO = (const bf16*)(a.ws + WS_R + R_PO); const float* PML = (const float*)(a.ws + WS_R + R_PML); bf16* Y = (bf16*)(a.ws + WS_R + R_Y);
    float m0, l0; f32x16 ot[2];
    attn_core<true>(Q + (bh * SEQ + t) * 64, Kb + (bh * 32 + j) * 16384, Vb + (bh * 32 + j) * 16384, nkg, r, h, m0, l0, ot);
#ifdef DBG_OWN_ONLY
    const int nsel = 0;
#else
    const int nsel = j < 3 ? j : 3;
#endif
    const size_t pi = (bh * SEQ + t) * 3;
    float ms[3], ls[3]; float mx = m0;
#pragma unroll
    for (int s = 0; s < 3; ++s) { ms[s] = -INFINITY; ls[s] = 0.f; if (s < nsel) { ms[s] = ld_sc1f(PML + (pi + s) * 2); ls[s] = ld_sc1f(PML + (pi + s) * 2 + 1); mx = fmaxf(mx, ms[s]); } }
    const float w0 = __expf(m0 - mx); float den = w0 * l0;
#pragma unroll
    for (int md = 0; md < 2; ++md)
#pragma unroll
        for (int i = 0; i < 16; ++i) ot[md][i] *= w0;
#pragma unroll
    for (int s = 0; s < 3; ++s) {
        if (s < nsel) {
            const float ws_ = __expf(ms[s] - mx) * ls[s]; den += ws_;
#pragma unroll
            for (int md = 0; md < 2; ++md)
#pragma unroll
                for (int gq = 0; gq < 4; ++gq) { const u32x2 w = *(const u32x2*)(PO + (pi + s) * 64 + 32 * md + 8 * gq + 4 * h);
                    ot[md][4 * gq] += ws_ * __uint_as_float(w.x << 16); ot[md][4 * gq + 1] += ws_ * __uint_as_float(w.x & 0xffff0000u);
                    ot[md][4 * gq + 2] += ws_ * __uint_as_float(w.y << 16); ot[md][4 * gq + 3] += ws_ * __uint_as_float(w.y & 0xffff0000u); }
        }
    }
    float inv = 1.0f / den; const size_t yrow = (size_t)(b * SEQ + t) * 1024 + hd * 64;
#ifdef DBG_ZERO_ATTN
    inv = 0.f;
#endif
#pragma unroll
    for (int md = 0; md < 2; ++md)
#pragma unroll
        for (int gq = 0; gq < 4; ++gq) { u32x2 o; o.x = cvtpk(ot[md][4 * gq] * inv, ot[md][4 * gq + 1] * inv); o.y = cvtpk(ot[md][4 * gq + 2] * inv, ot[md][4 * gq + 3] * inv);
            *(u32x2*)(Y + yrow + 32 * md + 8 * gq + 4 * h) = o; }
}

DI void h3_unit(const Ctx& a, int L, int unit2, int lane) {
    asm volatile("" : "+v"(lane));
    const int unit = unit2 >> 1, nt = unit2 & 1;
    const int b = unit >> 9, hh = (unit >> 7) & 3, n = unit & 127, r = lane & 31, h = lane >> 5;
    const int row0 = b * SEQ + n * 64;
    const bf16* SP = (const bf16*)(a.ws + WS_R + R_SP) + (size_t)unit * 4096; const bf16* QDEC = (const bf16*)(a.ws + WS_R + R_QDEC);
    const float* OINTRA = (const float*)(a.ws + WS_R + R_OINTRA); const bf16* GH = (const bf16*)(a.ws + WS_R + R_U5) + (size_t)4 * M * 256; bf16* Y = (bf16*)(a.ws + WS_R + R_Y);
    const float* on = a.in(I_HON) + L * 64;
    bf16x8 sf[2][4];
#pragma unroll
    for (int mv = 0; mv < 2; ++mv)
#pragma unroll
        for (int ks = 0; ks < 4; ++ks) sf[mv][ks] = *(const bf16x8*)(SP + (32 * mv + r) * 64 + 16 * ks + 8 * h);
    {
        const size_t trow = (size_t)(row0 + 32 * nt + r) * 256 + hh * 64;
        f32x16 o[2]; o[0] = zero16(); o[1] = zero16();
#pragma unroll
        for (int ks = 0; ks < 4; ++ks) { const bf16x8 qf = *(const bf16x8*)(QDEC + trow + 16 * ks + 8 * h); o[0] = MFMA32(sf[0][ks], qf, o[0]); o[1] = MFMA32(sf[1][ks], qf, o[1]); }
        float ss = 0.f;
#pragma unroll
        for (int mv = 0; mv < 2; ++mv)
#pragma unroll
            for (int gq = 0; gq < 4; ++gq) { const f32x4 x = *(const f32x4*)(OINTRA + trow + 32 * mv + 8 * gq + 4 * h);
#pragma unroll
                for (int i = 0; i < 4; ++i) { o[mv][4 * gq + i] += x[i]; ss += o[mv][4 * gq + i] * o[mv][4 * gq + i]; } }
        ss += __shfl_xor(ss, 32);
        float rn = rsqrtf(ss * (1.0f / 64.0f) + 1e-6f);
#ifdef DBG_ZERO_HGRN
        rn = 0.f;
#endif
#ifdef DBG_AMP_HGRN
        rn *= 16.f;
#endif
        const size_t yrow = (size_t)(row0 + 32 * nt + r) * 1024 + 768 + hh * 64;
#pragma unroll
        for (int mv = 0; mv < 2; ++mv)
#pragma unroll
            for (int gq = 0; gq < 4; ++gq) { const int v0 = 32 * mv + 8 * gq + 4 * h; const f32x4 gn = *(const f32x4*)(on + v0); const u32x2 gw_ = *(const u32x2*)(GH + trow + v0);
                const float g0 = __uint_as_float(gw_.x << 16), g1 = __uint_as_float(gw_.x & 0xffff0000u), g2 = __uint_as_float(gw_.y << 16), g3 = __uint_as_float(gw_.y & 0xffff0000u);
                u32x2 w; w.x = cvtpk(o[mv][4 * gq] * rn * gn[0] * pg8::silu_f(g0), o[mv][4 * gq + 1] * rn * gn[1] * pg8::silu_f(g1));
                w.y = cvtpk(o[mv][4 * gq + 2] * rn * gn[2] * pg8::silu_f(g2), o[mv][4 * gq + 3] * rn * gn[3] * pg8::silu_f(g3));
                *(u32x2*)(Y + yrow + v0) = w; }
    }
}

DI void phase_c(const Ctx& a, int L, int gw, int NGW, int lane) {
    for (int u = gw; u < 2048; u += NGW) h3_unit(a, L, u, lane);
}

#define LAS __attribute__((address_space(3)))
#define XB_TMO      128
#define XB_XCNT(j)  (256  + 64 * (j))
#define XB_XSUB(j)  (1280 + 64 * (j))
#define XB_XGEN(j)  (2304 + 64 * (j))
#define XB_TOP      3328
#define XB_TOPGEN   3392
#define XCD_BAR_WORDS 3456
#define XB_SPIN_CAP (1u << 18)

__device__ __forceinline__ unsigned xb_ld(unsigned* p)              { return __hip_atomic_load(p, __ATOMIC_RELAXED, __HIP_MEMORY_SCOPE_AGENT); }
__device__ __forceinline__ unsigned xb_add(unsigned* p, unsigned v) { return __hip_atomic_fetch_add(p, v, __ATOMIC_RELAXED, __HIP_MEMORY_SCOPE_AGENT); }
__device__ __forceinline__ unsigned xb_xcc_id() { return (unsigned)__builtin_amdgcn_s_getreg((3 << 11) | 20) & 0xFu; }
#define XB_SPIN(cond, bar) do { unsigned _sp = 0; while (cond) { __builtin_amdgcn_s_sleep(1); \
    if ((++_sp & 255u) == 0u) { if (xb_ld(&(bar)[XB_TMO])) break; if (_sp > XB_SPIN_CAP) { atomicAdd(&(bar)[XB_TMO], 1u); break; } } } } while (0)

struct XcdBarrier {
    unsigned* bar; unsigned x;
    volatile LAS unsigned* st;
};

__device__ __forceinline__ XcdBarrier xcd_barrier_post(unsigned* bar, volatile LAS unsigned* st) {
    XcdBarrier b; b.bar = bar; b.x = xb_xcc_id(); b.st = st;
    if (threadIdx.x == 0) (void)xb_add(&bar[XB_XCNT(b.x)], 1u);
    return b;
}
__device__ __forceinline__ void xcd_barrier_complete(unsigned* bar, unsigned x, unsigned& nloc, unsigned& nx) {
    const unsigned G = gridDim.x * gridDim.y * gridDim.z;
    unsigned sum, cnt, mine, sp = 0u;
    for (;;) {
        sum = 0u; cnt = 0u; mine = 0u;
#pragma unroll
        for (unsigned j = 0; j < 16; ++j) { const unsigned c = xb_ld(&bar[XB_XCNT(j)]); sum += c; cnt += (c > 0u) ? 1u : 0u; mine = (j == x) ? c : mine; }
        if (sum == G) break;
        __builtin_amdgcn_s_sleep(1);
        if ((++sp & 255u) == 0u) { if (xb_ld(&bar[XB_TMO])) break; if (sp > XB_SPIN_CAP) { atomicAdd(&bar[XB_TMO], 1u); break; } }
    }
    nloc = mine > 0u ? mine : 1u; nx = cnt > 0u ? cnt : 1u;
}

__device__ __forceinline__ void xcd_barrier(const XcdBarrier& b) {
    asm volatile("s_waitcnt vmcnt(0)" ::: "memory");
    __syncthreads();
    if (threadIdx.x == 0) {
        unsigned* bar = b.bar;
        __builtin_amdgcn_s_waitcnt(0);
        unsigned nloc = b.st[0], nx = b.st[1];
        if (nloc == 0u) { xcd_barrier_complete(bar, b.x, nloc, nx); b.st[0] = nloc; b.st[1] = nx; }
        const unsigned old = xb_add(&bar[XB_XSUB(b.x)], 1u);
        const unsigned gen = old / nloc;
        if (old + 1u == (gen + 1u) * nloc) {
            __builtin_amdgcn_fence(__ATOMIC_RELEASE, "agent");
            asm volatile("s_waitcnt vmcnt(0)" ::: "memory");
            const unsigned og = xb_add(&bar[XB_TOP], 1u);
            const unsigned tg = og / nx;
            if (og + 1u == (tg + 1u) * nx) xb_add(&bar[XB_TOPGEN], 1u);
            else XB_SPIN(xb_ld(&bar[XB_TOPGEN]) == tg, bar);
            __builtin_amdgcn_fence(__ATOMIC_ACQUIRE, "agent");
            xb_add(&bar[XB_XGEN(b.x)], 1u);
            asm volatile("s_waitcnt vmcnt(0)" ::: "memory");
        } else {
            XB_SPIN(xb_ld(&bar[XB_XGEN(b.x)]) == gen, bar);
            __builtin_amdgcn_fence(__ATOMIC_ACQUIRE, "agent");
            asm volatile("s_waitcnt vmcnt(0)" ::: "memory");
        }
    }
    __syncthreads();
}

template <int MASK> __global__ void __launch_bounds__(NTHR, 2) mk_fwd(Args args) {
    extern __shared__ __attribute__((aligned(16))) unsigned char lds[];
    const int G = gridDim.x, NGW = G * NWAVES;
    cg::grid_group grid = cg::this_grid();
    const int ph_lo = args.ph_lo, ph_hi = args.ph_hi;
    volatile LAS unsigned* bst = (volatile LAS unsigned*)((LAS unsigned char*)lds + 131072);
    if (threadIdx.x == 0) { bst[0] = 0u; bst[1] = 0u; }
    __syncthreads();
    XcdBarrier bar; bar.bar = nullptr; bar.x = 0; bar.st = bst;
    for (int ph = ph_lo; ph < ph_hi; ++ph) {
        if (ph > ph_lo) {
            if (ph == ph_lo + 1) {
                grid.sync();
                bar = xcd_barrier_post((unsigned*)(args.ws + WS_CTL + 65536), bst);
            } else { xcd_barrier(bar);
#ifdef DBG_DUP_BAR
                xcd_barrier(bar);
#endif
            }
        }
        int tid_v = threadIdx.x; asm volatile("" : "+v"(tid_v));
        const int tid = tid_v, lane = tid & 63, wave = __builtin_amdgcn_readfirstlane(tid >> 6), gw = blockIdx.x * NWAVES + wave;
        kptr_t kp = (kptr_t)__builtin_amdgcn_kernarg_segment_ptr();
        asm volatile("" : "+s"(kp));
        Ctx a; a.kp = kp; a.out = *(float* const __attribute__((address_space(4)))*)(kp + 144); a.ws = *(unsigned char* const __attribute__((address_space(4)))*)(kp + 152);
        unsigned char* ws = a.ws;
        float* stats = (float*)(ws + WS_STATS); bf16* xb = (bf16*)(ws + WS_XB); bf16* hid = (bf16*)(ws + WS_R + R_HID);
        if (ph == 0) {
if constexpr (MASK & 1) { phase_p0(a, lds, gw, NGW, wave, lane);
#ifdef DBG_DUP_P0
 __syncthreads(); phase_p0(a, lds, gw, NGW, wave, lane);
#endif
 }
 __syncthreads(); continue; }
        const int L = (ph - 1) / 9, sub = (ph - 1) % 9;
        unsigned char* wb = ws + WS_W + (size_t)(L & 1) * WSZ;
        if (sub == 0 || sub == 7) {
            pg8::Gemm g{xb, (const bf16*)(wb + (sub == 0 ? W_GU1 : W_GU2)), M, 2 * FF, D}; pg8::StaticOrder S; S.init(M, 2 * FF, G, (int)blockIdx.x);
            pg8::EpiSwiGLU E{hid, stats, FF};
            if constexpr (MASK & 2) pg8::gemm_phase<pg8::EpiSwiGLU, pg8::StaticOrder, PG8_ALIGN, PG8_SP2>((PG8_LAS unsigned char*)lds, g, S, E);
            if constexpr ((MASK & 2) && (MASK & 16)) {
                if (G == 256 && L + 1 < DEPTH && blockIdx.x >= 128) {
                    __syncthreads();
                    float* scr = (float*)(lds + wave * 16384); const int half = sub == 7 ? 1 : 0;
                    for (int it = half * (WC_ITEMS / 2) + ((int)blockIdx.x - 128) * NWAVES + wave; it < (half + 1) * (WC_ITEMS / 2); it += 128 * NWAVES) wconv_item(a, L + 1, it, scr, lane);
                }
            }
#if defined(DBG_DUP_G) && DBG_DUP_G == 1
            __syncthreads(); if constexpr (MASK & 2) pg8::gemm_phase<pg8::EpiSwiGLU, pg8::StaticOrder, PG8_ALIGN, PG8_SP2>((PG8_LAS unsigned char*)lds, g, S, E);
#endif
        } else if (sub == 1 || sub == 6 || sub == 8) {
            const bf16* A = sub == 6 ? (const bf16*)(ws + WS_R + R_Y) : hid; const int K = sub == 6 ? D : FF;
            const bf16* Bt = (const bf16*)(wb + (sub == 1 ? W_D1 : (sub == 6 ? W_OUT : W_D2)));
            pg8::Gemm g{A, Bt, M, D, K}; pg8::StaticOrder S; S.init(M, D, G, (int)blockIdx.x);
            pg8::EpiResid E{(L == 0 && sub == 1) ? a.in(I_X) : (const float*)a.out, a.out, xb, stats, sub == 6 ? 1.0f : 0.5f};
            if constexpr (MASK & 4) pg8::gemm_phase<pg8::EpiResid, pg8::StaticOrder, PG8_ALIGN, PG8_SP2>((PG8_LAS unsigned char*)lds, g, S, E);
#if defined(DBG_DUP_G) && DBG_DUP_G == 2
            __syncthreads(); { pg8::EpiResid E0{a.out, a.out, xb, stats, 0.0f}; if constexpr (MASK & 4) pg8::gemm_phase<pg8::EpiResid, pg8::StaticOrder, PG8_ALIGN, PG8_SP2>((PG8_LAS unsigned char*)lds, g, S, E0); }
#endif
        } else if (sub == 2) {
            pg8::Gemm g{xb, (const bf16*)(wb + W_IN), M, INW, D}; pg8::StaticOrder S; S.init(M, INW, G, (int)blockIdx.x);
            pg8::EpiProj E{(bf16*)(ws + WS_R + R_Q), (bf16*)(ws + WS_R + R_K), (bf16*)(ws + WS_R + R_V), (bf16*)(ws + WS_R + R_U5), (float*)(ws + WS_KMP), stats,
                           (const float*)(ws + WS_ROPEC), (const float*)(ws + WS_ROPES), a.in(I_QN) + L * 64, a.in(I_KN) + L * 64};
            if constexpr (MASK & 8) pg8::gemm_phase<pg8::EpiProj, pg8::StaticOrder, PG8_ALIGN, PG8_SP2>((PG8_LAS unsigned char*)lds, g, S, E);
#if defined(DBG_DUP_G) && DBG_DUP_G == 3
            __syncthreads(); if constexpr (MASK & 8) pg8::gemm_phase<pg8::EpiProj, pg8::StaticOrder, PG8_ALIGN, PG8_SP2>((PG8_LAS unsigned char*)lds, g, S, E);
#endif
        } else if (sub == 3) {
if constexpr (MASK & 16) { phase_t(a, L, lds, gw, NGW, wave, lane, !(MASK & 2) || G != 256);
#if defined(DBG_DUP_SUB) && DBG_DUP_SUB == 3
 __syncthreads(); phase_t(a, L, lds, gw, NGW, wave, lane, !(MASK & 2) || G != 256);
#endif
 }
 __syncthreads(); }
        else if (sub == 4) {
if constexpr (MASK & 32) { phase_a(a, L, lds, gw, NGW, tid, wave, lane);
#if defined(DBG_DUP_SUB) && DBG_DUP_SUB == 4
 __syncthreads(); phase_a(a, L, lds, gw, NGW, tid, wave, lane);
#endif
 }
 __syncthreads(); }
        else {
if constexpr (MASK & 64) { phase_c(a, L, gw, NGW, lane);
#if defined(DBG_DUP_SUB) && DBG_DUP_SUB == 5
 __syncthreads(); phase_c(a, L, gw, NGW, lane);
#endif
 }
 __syncthreads(); }
    }
}

#ifndef MK_MULTI
#define MK_MULTI 0
#endif
#ifndef DBG_NPH
#define DBG_NPH (1 + 9 * DEPTH)
#endif
constexpr int N_PHASES = DBG_NPH;
static int phase_mask(int ph) { if (ph == 0) return 1; const int sub = (ph - 1) % 9; const int m[9] = {2, 4, 8, 16, 32, 64, 4, 2, 4}; return m[sub]; }
template <int MASK> static bool setup_one(int& per_cu) {
    if (hipFuncSetAttribute((const void*)mk_fwd<MASK>, hipFuncAttributeMaxDynamicSharedMemorySize, LDS_BYTES) != hipSuccess) return false;
    if (hipOccupancyMaxActiveBlocksPerMultiprocessor(&per_cu, (const void*)mk_fwd<MASK>, NTHR, LDS_BYTES) != hipSuccess) per_cu = 1;
    (void)hipGetLastError(); return true;
}
template <int MASK> static void launch_one(const Args& a, int grid, hipStream_t stream) { hipLaunchKernelGGL(mk_fwd<MASK>, dim3(grid), dim3(NTHR), LDS_BYTES, stream, a); }
extern "C" void kernel_launch(void* const* d_in, const int* in_sizes, int n_in, void* d_out, int out_size, void* d_ws, size_t ws_size, hipStream_t stream) {
    static int grid = 0;
    if (grid == 0) {
        if (n_in != 18 || in_sizes[0] != M * D || out_size != M * D || ws_size < WS_END) { fprintf(stderr, "kernel_launch: unexpected shapes / workspace (n_in %d, ws %zu < %zu)\n", n_in, ws_size, (size_t)WS_END); grid = -1; return; }
        int dev = 0, cus = 0, per_cu = 0; bool ok = true;
        (void)hipGetDevice(&dev); (void)hipDeviceGetAttribute(&cus, hipDeviceAttributeMultiprocessorCount, dev);
#if MK_MULTI
        ok = setup_one<1>(per_cu) && setup_one<2>(per_cu) && setup_one<4>(per_cu) && setup_one<8>(per_cu) && setup_one<16>(per_cu) && setup_one<32>(per_cu) && setup_one<64>(per_cu);
#else
        ok = setup_one<127>(per_cu);
#endif
        if (!ok) { fprintf(stderr, "kernel_launch: hipFuncSetAttribute failed\n"); grid = -1; return; }
        grid = cus;
    }
    if (grid < 0) return;
    Args a{};
    for (int i = 0; i < 18; ++i) a.in[i] = (const float*)d_in[i];
    a.out = (float*)d_out; a.ws = (unsigned char*)d_ws;
#if MK_MULTI
    for (int ph = 0; ph < N_PHASES; ++ph) { a.ph_lo = ph; a.ph_hi = ph + 1;
        switch (phase_mask(ph)) { case 1: launch_one<1>(a, grid, stream); break; case 2: launch_one<2>(a, grid, stream); break; case 4: launch_one<4>(a, grid, stream); break; case 8: launch_one<8>(a, grid, stream); break;
                                  case 16: launch_one<16>(a, grid, stream); break; case 32: launch_one<32>(a, grid, stream); break; default: launch_one<64>(a, grid, stream); break; } }
#else
    a.ph_lo = 0; a.ph_hi = N_PHASES;
    void* args[] = {&a};
    hipError_t e = hipLaunchCooperativeKernel((const void*)mk_fwd<127>, dim3(grid), dim3(NTHR), args, LDS_BYTES, stream);
    if (e != hipSuccess) fprintf(stderr, "cooperative launch failed: %s (grid %d)\n", hipGetErrorString(e), grid);
#endif
}
```

```cpp
#include <hip/hip_runtime.h>
#include <hip/hip_cooperative_groups.h>
#include <cstdio>
#include <cstdint>
namespace cg = cooperative_groups;
#define MK_MULTI 0
namespace pg8 {
#define PG8_LAS __attribute__((address_space(3)))
typedef unsigned short bf16_t;
typedef short bf16x8 __attribute__((ext_vector_type(8)));
typedef float f32x4 __attribute__((ext_vector_type(4)));
typedef unsigned u32x4 __attribute__((ext_vector_type(4)));
constexpr int BM = 256, BK = 64, HALF = 128, HTB = HALF * BK * 2  , STAGE_BYTES = 8 * HTB, NXCD = 8, WGM = 8;

__host__ __device__ __forceinline__ int lds_byte(int r, int c) { const int st = (r >> 4) * 2 + (c >> 5), rr = r & 15, cc = c & 31, ob = rr * 64 + cc * 2; return st * 1024 + (ob ^ (((ob >> 9) & 1) << 5)); }
__host__ __device__ __forceinline__ void stage_rc(int b, int& R, int& C) { const int st = b / 1024, sb = b % 1024, swz = sb ^ (((sb >> 9) & 1) << 5); R = (st >> 1) * 16 + swz / 64; C = (st & 1) * 32 + (swz % 64) / 2; }
__host__ __device__ __forceinline__ int perm32(int rho) { const int n = rho >> 4, i = rho & 15; return 8 * (i >> 2) + 4 * n + (i & 3); }

struct Unit { int pm, pn; };
struct Gemm { const bf16_t* A; const bf16_t* Bt; int M, N, K; };

struct StaticOrder {
    int nM, nN, nwg, G, c;
    __host__ __device__ void init(int M, int N, int G_, int c_) { nM = M / BM; nN = N / BM; nwg = nM * nN; G = G_; c = c_; }
    __host__ __device__ bool next(int i, Unit& u) const {
        const long L = (long)i * G + c; if (L >= nwg) return false;
        int wgid = (int)L; { const int q = nwg / NXCD, r = nwg % NXCD, xcd = wgid % NXCD, off = wgid / NXCD; wgid = (xcd < r ? xcd * (q + 1) : r * (q + 1) + (xcd - r) * q) + off; }
        const int nig = WGM * nN, gid = wgid / nig, fm = gid * WGM, gsz = (nM - fm) < WGM ? (nM - fm) : WGM;
        u.pm = fm + ((wgid % nig) % gsz); u.pn = (wgid % nig) / gsz; return true;
    }
    __device__ __forceinline__ void a_ready(const Unit&) const {}
    __device__ __forceinline__ void done(const Unit&) const {}
};

__device__ __forceinline__ unsigned cvt_pk_bf16(float lo, float hi) { unsigned r; asm volatile("v_cvt_pk_bf16_f32 %0, %1, %2" : "=v"(r) : "v"(lo), "v"(hi)); return r; }
typedef float f32x2 __attribute__((ext_vector_type(2)));
typedef unsigned u32x2 __attribute__((ext_vector_type(2)));
typedef __bf16 bf16x2_t __attribute__((ext_vector_type(2)));
__device__ __forceinline__ unsigned cvtpk(float lo, float hi) { f32x2 v = {lo, hi}; bf16x2_t b = __builtin_convertvector(v, bf16x2_t); return __builtin_bit_cast(unsigned, b); }
__device__ __forceinline__ float row_rstd(const float* stats, int row) {
    const f32x4* p = (const f32x4*)(stats + (size_t)row * 16);
    const f32x4 a = p[0], b = p[1], c = p[2], d = p[3];
    const float s = ((a[0] + a[1]) + (a[2] + a[3])) + ((b[0] + b[1]) + (b[2] + b[3])) + ((c[0] + c[1]) + (c[2] + c[3])) + ((d[0] + d[1]) + (d[2] + d[3]));
    return rsqrtf(s * (1.0f / 1024.0f) + 1e-6f);
}
__device__ __forceinline__ void row_rstd4(const float* stats, int row0, float (&rs)[4]) {
    f32x4 p[4][4];
#pragma unroll
    for (int m = 0; m < 4; ++m)
#pragma unroll
        for (int k = 0; k < 4; ++k) p[m][k] = *(const f32x4*)(stats + (size_t)(row0 + 16 * m) * 16 + 4 * k);
#pragma unroll
    for (int m = 0; m < 4; ++m) { const f32x4 a = p[m][0], b = p[m][1], c = p[m][2], d = p[m][3];
        const float s = ((a[0] + a[1]) + (a[2] + a[3])) + ((b[0] + b[1]) + (b[2] + b[3])) + ((c[0] + c[1]) + (c[2] + c[3])) + ((d[0] + d[1]) + (d[2] + d[3]));
        rs[m] = rsqrtf(s * (1.0f / 1024.0f) + 1e-6f); }
}
__device__ __forceinline__ float silu_f(float g) { return g * __builtin_amdgcn_rcpf(1.0f + __expf(-g)); }

struct EpiSwiGLU {
    static constexpr bool PERM = true, AFTER_DRAIN = false;
    bf16_t* H; const float* stats; int ldh;
    __device__ __forceinline__ void operator()(const f32x4 (&acc)[2][2][4][2], const Unit& u, int wr, int wc, int fr, int fq) const {
        asm volatile("" : "+v"(fr), "+v"(fq));
        const int row0 = u.pm * BM + wr * 64 + fr, col0 = u.pn * HALF + wc * 32 + 8 * fq;
#pragma unroll
        for (int ai = 0; ai < 2; ++ai) {
            float rs4[4]; row_rstd4(stats, row0 + ai * HALF, rs4);
#pragma unroll
            for (int m = 0; m < 4; ++m) {
                const int row = row0 + ai * HALF + m * 16;
                const float rs = rs4[m];
                float h[8];
#pragma unroll
                for (int n = 0; n < 2; ++n)
#pragma unroll
                    for (int i = 0; i < 4; ++i) { const float g = acc[ai][0][m][n][i] * rs, up = acc[ai][1][m][n][i] * rs; h[4 * n + i] = silu_f(g) * up; }
                u32x4 w; w.x = cvtpk(h[0], h[1]); w.y = cvtpk(h[2], h[3]); w.z = cvtpk(h[4], h[5]); w.w = cvtpk(h[6], h[7]);
                *(u32x4*)(H + (size_t)row * ldh + col0) = w;
            }
        }
    }
};

struct EpiResid {
    static constexpr bool PERM = true, AFTER_DRAIN = false;
    const float* Xsrc; float* X; bf16_t* XB; float* stats; float scale;
    __device__ __forceinline__ void operator()(const f32x4 (&acc)[2][2][4][2], const Unit& u, int wr, int wc, int fr, int fq) const {
        asm volatile("" : "+v"(fr), "+v"(fq));
        const int row0 = u.pm * BM + wr * 64 + fr, col0 = u.pn * BM + wc * 32 + 8 * fq;
#pragma unroll
        for (int ai = 0; ai < 2; ++ai) {
            f32x4 xr[4][2][2];
#pragma unroll
            for (int m = 0; m < 4; ++m)
#pragma unroll
                for (int bj = 0; bj < 2; ++bj) { const float* xp = Xsrc + (size_t)(row0 + ai * HALF + m * 16) * 1024 + col0 + bj * HALF; xr[m][bj][0] = *(const f32x4*)xp; xr[m][bj][1] = *(const f32x4*)(xp + 4); }
#pragma unroll
            for (int m = 0; m < 4; ++m) {
                const int row = row0 + ai * HALF + m * 16; float ss = 0.f;
#pragma unroll
                for (int bj = 0; bj < 2; ++bj) {
                    float* xp = X + (size_t)row * 1024 + col0 + bj * HALF;
                    f32x4 x0 = xr[m][bj][0], x1 = xr[m][bj][1];
                    x0 = x0 + acc[ai][bj][m][0] * scale; x1 = x1 + acc[ai][bj][m][1] * scale;
                    *(f32x4*)xp = x0; *(f32x4*)(xp + 4) = x1;
                    ss += (x0[0] * x0[0] + x0[1] * x0[1]) + (x0[2] * x0[2] + x0[3] * x0[3]) + (x1[0] * x1[0] + x1[1] * x1[1]) + (x1[2] * x1[2] + x1[3] * x1[3]);
                    u32x4 w; w.x = cvtpk(x0[0], x0[1]); w.y = cvtpk(x0[2], x0[3]); w.z = cvtpk(x1[0], x1[1]); w.w = cvtpk(x1[2], x1[3]);
                    *(u32x4*)(XB + (size_t)row * 1024 + col0 + bj * HALF) = w;
                }
                ss += __shfl_xor(ss, 16); ss += __shfl_xor(ss, 32);
                if (fq == 0) stats[(size_t)row * 16 + u.pn * 4 + wc] = ss;
            }
        }
    }
};

struct EpiProj {
    static constexpr bool PERM = true, AFTER_DRAIN = false;
    bf16_t* Q; bf16_t* Kb; bf16_t* Vb; bf16_t* U5; float* kmp; const float* stats; const float* ropeC; const float* ropeS; const float* qn; const float* kn;
    __device__ __forceinline__ void operator()(const f32x4 (&acc)[2][2][4][2], const Unit& u, int wr, int wc, int fr, int fq) const {
        asm volatile("" : "+v"(fr), "+v"(fq));
        const int row0 = u.pm * BM + wr * 64 + fr;
        const int pn = u.pn;
        if (pn >= 6) {
            bf16_t* O = U5 + (size_t)(pn - 6) * (16384 * 256);
            const int col0 = wc * 32 + 8 * fq;
#pragma unroll
            for (int ai = 0; ai < 2; ++ai)
#pragma unroll
                for (int m = 0; m < 4; ++m) {
                    const int row = row0 + ai * HALF + m * 16; const float rs = row_rstd(stats, row);
#pragma unroll
                    for (int bj = 0; bj < 2; ++bj) {
                        const f32x4 v0 = acc[ai][bj][m][0] * rs, v1 = acc[ai][bj][m][1] * rs;
                        u32x4 w; w.x = cvtpk(v0[0], v0[1]); w.y = cvtpk(v0[2], v0[3]); w.z = cvtpk(v1[0], v1[1]); w.w = cvtpk(v1[2], v1[3]);
                        *(u32x4*)(O + (size_t)row * 256 + col0 + bj * HALF) = w;
                    }
                }
            return;
        }
        const int head = (pn & 1) * 4 + wc, b = u.pm >> 5, j = u.pm & 31;
        const size_t bh = (size_t)(b * 8 + head);
        if (pn >= 4) {
            bf16_t* vb = Vb + (bh * 32 + j) * 16384;
#pragma unroll
            for (int ai = 0; ai < 2; ++ai)
#pragma unroll
                for (int m = 0; m < 4; ++m) {
                    const int row = row0 + ai * HALF + m * 16; const float rs = row_rstd(stats, row);
                    const int kk = ai * HALF + wr * 64 + m * 16 + fr;
                    const int kg = kk >> 5, w = kk & 31, st = w >> 4, w16 = w & 15, hh = (w16 >> 2) & 1, jj = 4 * (w16 >> 3) + (w16 & 3);
#pragma unroll
                    for (int bj = 0; bj < 2; ++bj)
#pragma unroll
                        for (int n = 0; n < 2; ++n) {
                            const unsigned p0 = cvtpk(acc[ai][bj][m][n][0] * rs, acc[ai][bj][m][n][1] * rs), p1 = cvtpk(acc[ai][bj][m][n][2] * rs, acc[ai][bj][m][n][3] * rs);
#pragma unroll
                            for (int i = 0; i < 4; ++i) {
                                const int r = 8 * fq + 4 * n + i;
                                const unsigned pv = (i < 2) ? p0 : p1;
                                vb[((((kg * 2 + st) * 2 + bj) * 32 + r) * 2 + hh) * 8 + jj] = (bf16_t)((i & 1) ? (pv >> 16) : (pv & 0xffffu));
                            }
                        }
                }
            return;
        }
        const bool isk = pn >= 2;
        const float* gn = isk ? kn : qn;
        float ksum[16];
#pragma unroll
        for (int e = 0; e < 16; ++e) ksum[e] = 0.f;
#pragma unroll
        for (int ai = 0; ai < 2; ++ai)
#pragma unroll
            for (int m = 0; m < 4; ++m) {
                const int row = row0 + ai * HALF + m * 16; const float rs = row_rstd(stats, row);
                const int t = row & 8191, kk = t & 255;
                float v0[8], v1[8]; float ss = 0.f;
#pragma unroll
                for (int n = 0; n < 2; ++n)
#pragma unroll
                    for (int i = 0; i < 4; ++i) { v0[4 * n + i] = acc[ai][0][m][n][i] * rs; v1[4 * n + i] = acc[ai][1][m][n][i] * rs; ss += v0[4 * n + i] * v0[4 * n + i] + v1[4 * n + i] * v1[4 * n + i]; }
                ss += __shfl_xor(ss, 16); ss += __shfl_xor(ss, 32);
                const float rn = rsqrtf(ss * (1.0f / 64.0f) + 1e-6f);
                const f32x4 c0 = *(const f32x4*)(ropeC + t * 32 + 8 * fq), c1 = *(const f32x4*)(ropeC + t * 32 + 8 * fq + 4);
                const f32x4 s0 = *(const f32x4*)(ropeS + t * 32 + 8 * fq), s1 = *(const f32x4*)(ropeS + t * 32 + 8 * fq + 4);
                const f32x4 ga0 = *(const f32x4*)(gn + 8 * fq), ga1 = *(const f32x4*)(gn + 8 * fq + 4), gb0 = *(const f32x4*)(gn + 32 + 8 * fq), gb1 = *(const f32x4*)(gn + 36 + 8 * fq);
                float o0[8], o1[8];
#pragma unroll
                for (int e = 0; e < 8; ++e) {
                    const float x1 = v0[e] * rn * (e < 4 ? ga0[e & 3] : ga1[e & 3]), x2 = v1[e] * rn * (e < 4 ? gb0[e & 3] : gb1[e & 3]);
                    const float cs = e < 4 ? c0[e & 3] : c1[e & 3], sn = e < 4 ? s0[e & 3] : s1[e & 3];
                    o0[e] = x1 * cs - x2 * sn; o1[e] = x2 * cs + x1 * sn;
                }
                u32x4 w0, w1;
                w0.x = cvtpk(o0[0], o0[1]); w0.y = cvtpk(o0[2], o0[3]); w0.z = cvtpk(o0[4], o0[5]); w0.w = cvtpk(o0[6], o0[7]);
                w1.x = cvtpk(o1[0], o1[1]); w1.y = cvtpk(o1[2], o1[3]); w1.z = cvtpk(o1[4], o1[5]); w1.w = cvtpk(o1[6], o1[7]);
                if (!isk) {
                    bf16_t* qp = Q + (bh * 8192 + t) * 64 + 8 * fq;
                    *(u32x4*)qp = w0; *(u32x4*)(qp + 32) = w1;
                } else {
                    bf16_t* kb = Kb + (bh * 32 + j) * 16384;
                    const int kg = kk >> 5, r = kk & 31, hq = fq & 1, ksl = fq >> 1;
                    *(u32x4*)(kb + (((kg * 4 + ksl) * 32 + r) * 2 + hq) * 8) = w0;
                    *(u32x4*)(kb + (((kg * 4 + 2 + ksl) * 32 + r) * 2 + hq) * 8) = w1;
#pragma unroll
                    for (int e = 0; e < 8; ++e) { ksum[e] += o0[e]; ksum[8 + e] += o1[e]; }
                }
                asm volatile("" ::: "memory");
            }
        if (isk) {
#pragma unroll
            for (int e = 0; e < 16; ++e) { float s = ksum[e]; s += __shfl_xor(s, 1); s += __shfl_xor(s, 2); s += __shfl_xor(s, 4); s += __shfl_xor(s, 8); ksum[e] = s; }
            if (fr == 0) {
                float* kp = kmp + ((size_t)(u.pm * 2 + wr) * 512) + head * 64 + 8 * fq;
                *(f32x4*)kp = (f32x4){ksum[0], ksum[1], ksum[2], ksum[3]}; *(f32x4*)(kp + 4) = (f32x4){ksum[4], ksum[5], ksum[6], ksum[7]};
                *(f32x4*)(kp + 32) = (f32x4){ksum[8], ksum[9], ksum[10], ksum[11]}; *(f32x4*)(kp + 36) = (f32x4){ksum[12], ksum[13], ksum[14], ksum[15]};
            }
        }
    }
};

template <class Epi, class Sched, bool ALIGN_EPI = false, bool SP2 = false>
__device__ __forceinline__ void gemm_phase(PG8_LAS unsigned char* lds, const Gemm g, const Sched& S, const Epi& E) {
    int tid_v = threadIdx.x; asm volatile("" : "+v"(tid_v));
    const int tid = tid_v, wid = __builtin_amdgcn_readfirstlane(tid >> 6), lane = tid & 63, wr = wid >> 2, wc = wid & 3, fr = lane & 15, fq = lane >> 4;
    const int K = g.K, nt = K / BK;
    unsigned voffA[2], voffB[2];
#pragma unroll
    for (int i = 0; i < 2; ++i) { int R, C; stage_rc(tid * 16 + i * 8192, R, C); const int Rb = Epi::PERM ? ((R & ~31) + perm32(R & 31)) : R;
        voffA[i] = (unsigned)(R * K + C) * 2u; voffB[i] = (unsigned)(Rb * K + C) * 2u; }
    const size_t kstep = (size_t)(BK * 2);
    const size_t hstep = (size_t)HALF * K * 2;
    const size_t tstep = 2 * hstep;
    const unsigned ldsw = (unsigned)wid * 1024u;
    const int aoff = lds_byte(wr * 64 + fr, fq * 8), boff = lds_byte(wc * 32 + fr, fq * 8);
#define PG8_SA(b, h) (((b) * 2 + (h)) * HTB)
#define PG8_SB(b, h) ((4 + (b) * 2 + (h)) * HTB)
#define PG8_STAGE(bufoff, gbase, voff) do { _Pragma("unroll") for (int _i = 0; _i < 2; ++_i) \
        __builtin_amdgcn_global_load_lds((const unsigned*)((const char*)(gbase) + (voff)[_i]), (PG8_LAS unsigned*)(lds + (bufoff) + ldsw + _i * 8192), 16, 0, 0); } while (0)
#define PG8_LDA(dst, b, h) do { _Pragma("unroll") for (int m = 0; m < 4; ++m) _Pragma("unroll") for (int k = 0; k < 2; ++k) dst[m][k] = *(const PG8_LAS bf16x8*)(lds + PG8_SA(b, h) + aoff + m * 2048 + k * 1024); } while (0)
#define PG8_LDB(dst, b, h) do { _Pragma("unroll") for (int n = 0; n < 2; ++n) _Pragma("unroll") for (int k = 0; k < 2; ++k) dst[n][k] = *(const PG8_LAS bf16x8*)(lds + PG8_SB(b, h) + boff + n * 2048 + k * 1024); } while (0)
#define PG8_MMA(ai, bj, At, Bt) do { __builtin_amdgcn_s_setprio(1); _Pragma("unroll") for (int m = 0; m < 4; ++m) _Pragma("unroll") for (int n = 0; n < 2; ++n) _Pragma("unroll") for (int k = 0; k < 2; ++k) \
        acc[ai][bj][m][n] = __builtin_amdgcn_mfma_f32_16x16x32_bf16(Bt[n][k], At[m][k], acc[ai][bj][m][n], 0, 0, 0); __builtin_amdgcn_s_setprio(0); } while (0)
#define PG8_WAIT_V(n) asm volatile("s_waitcnt vmcnt(" #n ")" ::: "memory")
#define PG8_WAIT_L(n) asm volatile("s_waitcnt lgkmcnt(" #n ")" ::: "memory")
#define PG8_BAR __builtin_amdgcn_s_barrier()
#define PG8_SCHED __builtin_amdgcn_sched_barrier(0)
    Unit cur, nxt; int ui = 0;
    if (!S.next(0, cur)) return;
    f32x4 acc[2][2][4][2];
#pragma unroll
    for (int a = 0; a < 2; ++a)
#pragma unroll
        for (int b = 0; b < 2; ++b)
#pragma unroll
            for (int m = 0; m < 4; ++m)
#pragma unroll
                for (int n = 0; n < 2; ++n) acc[a][b][m][n] = (f32x4){0.f, 0.f, 0.f, 0.f};
    bf16x8 At[4][2], B0[2][2], B1[2][2];
    const char* cA = (const char*)g.A + (size_t)cur.pm * tstep; const char* cB = (const char*)g.Bt + (size_t)cur.pn * tstep;
    S.a_ready(cur);
    if constexpr (SP2) {
        PG8_STAGE(PG8_SB(0, 0), cB, voffB); PG8_STAGE(PG8_SB(0, 1), cB + hstep, voffB); PG8_STAGE(PG8_SA(0, 0), cA, voffA); PG8_STAGE(PG8_SA(0, 1), cA + hstep, voffA);
        if (wr == 1) PG8_BAR;
        PG8_WAIT_V(2); PG8_BAR;
        PG8_STAGE(PG8_SB(1, 0), cB + kstep, voffB); PG8_STAGE(PG8_SA(1, 0), cA + kstep, voffA); PG8_STAGE(PG8_SB(1, 1), cB + hstep + kstep, voffB);
        PG8_WAIT_V(6); PG8_BAR;
    } else {
        PG8_STAGE(PG8_SB(0, 0), cB, voffB); PG8_STAGE(PG8_SA(0, 0), cA, voffA); PG8_STAGE(PG8_SB(0, 1), cB + hstep, voffB); PG8_STAGE(PG8_SA(0, 1), cA + hstep, voffA);
        if (wr == 1) PG8_BAR;
        PG8_WAIT_V(4); PG8_BAR;
        PG8_STAGE(PG8_SB(1, 0), cB + kstep, voffB); PG8_STAGE(PG8_SA(1, 0), cA + kstep, voffA); PG8_STAGE(PG8_SB(1, 1), cB + hstep + kstep, voffB);
        PG8_WAIT_V(6); PG8_BAR;
    }
    for (;;) {
        const bool has_next = S.next(ui + 1, nxt);
        const char* nA = has_next ? (const char*)g.A + (size_t)nxt.pm * tstep : cA; const char* nB = has_next ? (const char*)g.Bt + (size_t)nxt.pn * tstep : cB;
        for (int t = 0; t < nt; t += 2) {
            const bool last = (t == nt - 2);
            const char* a1 = cA + (size_t)(t + 1) * kstep;
            const char* a2 = last ? nA : cA + (size_t)(t + 2) * kstep; const char* b2 = last ? nB : cB + (size_t)(t + 2) * kstep;
            const char* a3 = a2 + kstep; const char* b3 = b2 + kstep;
            if (last && has_next) S.a_ready(nxt);
            if constexpr (SP2) {
            PG8_LDB(B0, 0, 0); PG8_LDB(B1, 0, 1); PG8_SCHED; PG8_LDA(At, 0, 0); PG8_STAGE(PG8_SA(1, 1), a1 + hstep, voffA);
            PG8_WAIT_V(8); PG8_WAIT_L(0); PG8_BAR; PG8_MMA(0, 0, At, B0); PG8_MMA(0, 1, At, B1); PG8_BAR; PG8_SCHED;
            PG8_LDA(At, 0, 1); PG8_STAGE(PG8_SB(0, 0), b2, voffB); PG8_STAGE(PG8_SB(0, 1), b2 + hstep, voffB); PG8_STAGE(PG8_SA(0, 0), a2, voffA);
            PG8_WAIT_V(8); PG8_WAIT_L(0); PG8_BAR; PG8_MMA(1, 0, At, B0); PG8_MMA(1, 1, At, B1); PG8_BAR; PG8_SCHED;
            PG8_LDB(B0, 1, 0); PG8_LDB(B1, 1, 1); PG8_SCHED; PG8_LDA(At, 1, 0); PG8_STAGE(PG8_SA(0, 1), a2 + hstep, voffA);
            PG8_WAIT_V(8); PG8_WAIT_L(0); PG8_BAR; PG8_MMA(0, 0, At, B0); PG8_MMA(0, 1, At, B1); PG8_BAR; PG8_SCHED;
            PG8_LDA(At, 1, 1); PG8_STAGE(PG8_SB(1, 0), b3, voffB); PG8_STAGE(PG8_SB(1, 1), b3 + hstep, voffB); PG8_STAGE(PG8_SA(1, 0), a3, voffA);
            PG8_WAIT_V(8); PG8_WAIT_L(0); PG8_BAR; PG8_MMA(1, 0, At, B0); PG8_MMA(1, 1, At, B1); PG8_BAR; PG8_SCHED;
            } else {
            PG8_LDB(B0, 0, 0); PG8_SCHED; PG8_LDA(At, 0, 0); PG8_STAGE(PG8_SA(1, 1), a1 + hstep, voffA);
            PG8_WAIT_L(8); PG8_BAR; PG8_WAIT_L(0); PG8_MMA(0, 0, At, B0); PG8_BAR; PG8_SCHED;
            PG8_LDB(B1, 0, 1); PG8_STAGE(PG8_SB(0, 0), b2, voffB);
            PG8_BAR; PG8_WAIT_L(0); PG8_MMA(0, 1, At, B1); PG8_BAR;
            PG8_LDA(At, 0, 1); PG8_STAGE(PG8_SA(0, 0), a2, voffA);
            PG8_BAR; PG8_WAIT_L(0); PG8_MMA(1, 0, At, B0); PG8_BAR; PG8_SCHED;
            PG8_STAGE(PG8_SB(0, 1), b2 + hstep, voffB);
            PG8_WAIT_V(6); PG8_BAR; PG8_MMA(1, 1, At, B1); PG8_BAR;
            PG8_LDB(B0, 1, 0); PG8_SCHED; PG8_LDA(At, 1, 0); PG8_STAGE(PG8_SA(0, 1), a2 + hstep, voffA);
            PG8_WAIT_L(8); PG8_BAR; PG8_WAIT_L(0); PG8_MMA(0, 0, At, B0); PG8_BAR; PG8_SCHED;
            PG8_LDB(B1, 1, 1); PG8_STAGE(PG8_SB(1, 0), b3, voffB);
            PG8_BAR; PG8_WAIT_L(0); PG8_MMA(0, 1, At, B1); PG8_BAR;
            PG8_LDA(At, 1, 1); PG8_STAGE(PG8_SA(1, 0), a3, voffA);
            PG8_BAR; PG8_WAIT_L(0); PG8_MMA(1, 0, At, B0); PG8_BAR; PG8_SCHED;
            PG8_STAGE(PG8_SB(1, 1), b3 + hstep, voffB);
            PG8_WAIT_V(6); PG8_BAR; PG8_MMA(1, 1, At, B1); PG8_BAR;
            }
        }
        if constexpr (ALIGN_EPI) { if (wr == 0) PG8_BAR; }
        if constexpr (!Epi::AFTER_DRAIN) { E(acc, cur, wr, wc, fr, fq); S.done(cur); }
        if (!has_next) break;
#pragma unroll
        for (int a = 0; a < 2; ++a)
#pragma unroll
            for (int b = 0; b < 2; ++b)
#pragma unroll
                for (int m = 0; m < 4; ++m)
#pragma unroll
                    for (int n = 0; n < 2; ++n) acc[a][b][m][n] = (f32x4){0.f, 0.f, 0.f, 0.f};
        cur = nxt; cA = nA; cB = nB; ++ui;
        if constexpr (ALIGN_EPI) { if (wr == 1) PG8_BAR; }
    }
    PG8_WAIT_V(0);
    if constexpr (!ALIGN_EPI) { if (wr == 0) PG8_BAR; }
    PG8_BAR;
    if constexpr (Epi::AFTER_DRAIN) { E.fused(acc, cur, wr, wc, fr, fq, lds, wid, lane); S.done(cur); }
#undef PG8_SA
#undef PG8_SB
#undef PG8_STAGE
#undef PG8_LDA
#undef PG8_LDB
#undef PG8_MMA
#undef PG8_WAIT_V
#undef PG8_WAIT_L
#undef PG8_BAR
#undef PG8_SCHED
}
}

#ifndef PG8_SP2
#define PG8_SP2 true
#endif
#ifndef PG8_ALIGN
#define PG8_ALIGN true
#endif

#define DI __device__ __forceinline__
typedef unsigned short bf16;
typedef short bf16x8 __attribute__((ext_vector_type(8)));
typedef float f32x4 __attribute__((ext_vector_type(4)));
typedef float f32x16 __attribute__((ext_vector_type(16)));
typedef unsigned u32x4 __attribute__((ext_vector_type(4)));
typedef unsigned u32x2 __attribute__((ext_vector_type(2)));
#define MFMA32(a, b, c) __builtin_amdgcn_mfma_f32_32x32x16_bf16((a), (b), (c), 0, 0, 0)

constexpr int NWAVES = 8, NTHR = 512;
constexpr int M = 16384, D = 1024, FF = 2816, INW = 2816, SEQ = 8192, DEPTH = 4;
constexpr int LDS_BYTES = 147456;
constexpr size_t MiB = 1u << 20;
constexpr size_t WS_CTL = 0;
constexpr size_t WS_STATS = 1 * MiB;
constexpr size_t WS_KMP = 2 * MiB;
constexpr size_t WS_DEC = 2 * MiB + 512 * 1024;
constexpr size_t WS_ROPEC = 3 * MiB, WS_ROPES = 4 * MiB;
constexpr size_t WS_W = 5 * MiB, WSZ = 42467328;
constexpr size_t W_GU1 = 0, W_D1 = 11534336, W_IN = 17301504, W_OUT = 23068672, W_GU2 = 25165824, W_D2 = 36700160;
constexpr size_t WS_XB = 86 * MiB;
constexpr size_t WS_R = 118 * MiB;
constexpr size_t R_HID = 0;
constexpr size_t R_Q = 0, R_K = 16 * MiB, R_V = 32 * MiB, R_U5 = 48 * MiB  , R_Y = 88 * MiB, R_PO = 120 * MiB, R_PML = 168 * MiB,
                 R_LIST = 172 * MiB  , R_ALOC = 188 * MiB, R_OINTRA = 204 * MiB, R_QDEC = 220 * MiB, R_SP = 228 * MiB, R_END = 236 * MiB;
constexpr size_t WS_END = WS_R + R_END;

DI float bf2f(unsigned short b) { return __uint_as_float((unsigned)b << 16); }
DI unsigned cvtpk(float lo, float hi) { return pg8::cvtpk(lo, hi); }
DI float wave_sum(float v) {
#pragma unroll
    for (int o = 1; o < 64; o <<= 1) v += __shfl_xor(v, o);
    return v;
}
DI void st_sc1(unsigned* p, unsigned v) { __hip_atomic_store(p, v, __ATOMIC_RELAXED, __HIP_MEMORY_SCOPE_AGENT); }
DI unsigned ld_sc1(const unsigned* p) { return __hip_atomic_load(p, __ATOMIC_RELAXED, __HIP_MEMORY_SCOPE_AGENT); }
DI float ld_sc1f(const float* p) { return __uint_as_float(__hip_atomic_load((const unsigned*)p, __ATOMIC_RELAXED, __HIP_MEMORY_SCOPE_AGENT)); }
DI int crow(int reg, int h) { return (reg & 3) + 8 * (reg >> 2) + 4 * h; }
DI bf16x8 pack8(const f32x16& x, int s) {
    u32x4 p; p.x = cvtpk(x[8 * s], x[8 * s + 1]); p.y = cvtpk(x[8 * s + 2], x[8 * s + 3]); p.z = cvtpk(x[8 * s + 4], x[8 * s + 5]); p.w = cvtpk(x[8 * s + 6], x[8 * s + 7]);
    return __builtin_bit_cast(bf16x8, p);
}
DI f32x16 zero16() { f32x16 z;
#pragma unroll
    for (int i = 0; i < 16; ++i) z[i] = 0.f; return z; }

struct Args { const float* in[18]; float* out; unsigned char* ws; int ph_lo, ph_hi; };
typedef const float* cfp_t;
typedef const __attribute__((address_space(4))) unsigned char* kptr_t;
struct Ctx { kptr_t kp; unsigned char* ws; float* out;
    DI const float* in(int i) const { return *(const __attribute__((address_space(4))) cfp_t*)(kp + 8 * i); } };
enum { I_X = 0, I_F1N, I_F1G, I_F1U, I_F1D, I_MIXN, I_WIN, I_QN, I_KN, I_PW, I_PS, I_LB, I_HON, I_WOUT, I_F2N, I_F2G, I_F2U, I_F2D };

DI void wconv_tile(const float* W, int ld, int srccol, const float* gain, bf16* WT, int K, int nrow0, int k0, float* scr, int lane) {
    asm volatile("" : "+v"(lane));
    const int c4 = (lane & 7) * 4, kr = lane >> 3;
    f32x4 v[8]; float gv[8];
#pragma unroll
    for (int i = 0; i < 8; ++i) { v[i] = __builtin_nontemporal_load((const f32x4*)(W + (size_t)(k0 + 8 * i + kr) * ld + srccol + c4)); gv[i] = gain ? gain[k0 + 8 * i + kr] : 1.0f; }
#pragma unroll
    for (int i = 0; i < 8; ++i) { float* d = scr + (8 * i + kr) * 33 + c4; d[0] = v[i][0] * gv[i]; d[1] = v[i][1] * gv[i]; d[2] = v[i][2] * gv[i]; d[3] = v[i][3] * gv[i]; }
    asm volatile("s_waitcnt lgkmcnt(0)" ::: "memory");
    const int c = lane & 7;
#pragma unroll
    for (int j = 0; j < 4; ++j) { const int n = (lane >> 3) + 8 * j; const float* s = scr + (8 * c) * 33 + n;
        u32x4 o; o.x = cvtpk(s[0 * 33], s[1 * 33]); o.y = cvtpk(s[2 * 33], s[3 * 33]); o.z = cvtpk(s[4 * 33], s[5 * 33]); o.w = cvtpk(s[6 * 33], s[7 * 33]);
        *(u32x4*)(WT + (size_t)(nrow0 + n) * K + k0 + 8 * c) = o; }
    asm volatile("s_waitcnt lgkmcnt(0)" ::: "memory");
}
constexpr int WC_I0 = 2816, WC_I1 = 1408, WC_I2 = 1408, WC_I3 = 512, WC_I4 = 2816, WC_I5 = 1408, WC_ITEMS = WC_I0 + WC_I1 + WC_I2 + WC_I3 + WC_I4 + WC_I5;
DI void wconv_item(const Ctx& a, int L, int item, float* scr, int lane) {
    unsigned char* wb = a.ws + WS_W + (size_t)(L & 1) * WSZ;
    int r = item;
    if (r < WC_I0 || (r >= WC_I0 + WC_I1 + WC_I2 + WC_I3 && r < WC_I0 + WC_I1 + WC_I2 + WC_I3 + WC_I4)) {
        const bool second = r >= WC_I0; if (second) r -= WC_I0 + WC_I1 + WC_I2 + WC_I3;
        const int kb = r / 176, nb = r % 176, n0 = nb * 32, pn = n0 >> 8, c = n0 & 255, bj = c >> 7, col = 128 * pn + (c & 127);
        const float* src = a.in(second ? (bj ? I_F2U : I_F2G) : (bj ? I_F1U : I_F1G)) + (size_t)L * D * FF;
        const float* gain = a.in(second ? I_F2N : I_F1N) + L * D;
        wconv_tile(src, FF, col, gain, (bf16*)(wb + (second ? W_GU2 : W_GU1)), D, n0, kb * 64, scr, lane); return;
    }
    r -= WC_I0;
    if (r < WC_I1) { const int kb = r / 32, nb = r % 32; wconv_tile(a.in(I_F1D) + (size_t)L * FF * D, D, nb * 32, nullptr, (bf16*)(wb + W_D1), FF, nb * 32, kb * 64, scr, lane); return; }
    r -= WC_I1;
    if (r < WC_I2) { const int kb = r / 88, nb = r % 88, n0 = nb * 32, pn = n0 >> 8, c = n0 & 255;
        const int col = pn < 6 ? (pn >> 1) * 512 + 64 * ((pn & 1) * 4 + ((c >> 5) & 3)) + 32 * (c >> 7) : n0;
        wconv_tile(a.in(I_WIN) + (size_t)L * D * INW, INW, col, a.in(I_MIXN) + L * D, (bf16*)(wb + W_IN), D, n0, kb * 64, scr, lane); return; }
    r -= WC_I2;
    if (r < WC_I3) { const int kb = r / 32, nb = r % 32; wconv_tile(a.in(I_WOUT) + (size_t)L * D * D, D, nb * 32, nullptr, (bf16*)(wb + W_OUT), D, nb * 32, kb * 64, scr, lane); return; }
    r -= WC_I3 + WC_I4;
    { const int kb = r / 32, nb = r % 32; wconv_tile(a.in(I_F2D) + (size_t)L * FF * D, D, nb * 32, nullptr, (bf16*)(wb + W_D2), FF, nb * 32, kb * 64, scr, lane); }
}

DI void phase_p0(const Ctx& a, unsigned char* lds, int gw, int NGW, int wave, int lane) {
    const float* x = a.in(I_X); float* out = a.out; bf16* xb = (bf16*)(a.ws + WS_XB); float* stats = (float*)(a.ws + WS_STATS);
    for (int m0 = gw * 2; m0 < M; m0 += NGW * 2) {
        f32x4 v[2][4]; float sq[2];
#pragma unroll
        for (int k = 0; k < 2; ++k) { const f32x4* xr = (const f32x4*)(x + (size_t)(m0 + k) * D) + lane;
#pragma unroll
            for (int j = 0; j < 4; ++j) v[k][j] = __builtin_nontemporal_load(xr + 64 * j); }
#pragma unroll
        for (int k = 0; k < 2; ++k) { float s = 0.f;
#pragma unroll
            for (int j = 0; j < 4; ++j) s += (v[k][j][0] * v[k][j][0] + v[k][j][1] * v[k][j][1]) + (v[k][j][2] * v[k][j][2] + v[k][j][3] * v[k][j][3]);
            sq[k] = wave_sum(s); }
#pragma unroll
        for (int k = 0; k < 2; ++k) { const int m = m0 + k;
            u32x2* brow = (u32x2*)(xb + (size_t)m * D) + lane;
#pragma unroll
            for (int j = 0; j < 4; ++j) { u32x2 w; w.x = cvtpk(v[k][j][0], v[k][j][1]); w.y = cvtpk(v[k][j][2], v[k][j][3]); brow[64 * j] = w; }
            if (lane < 16) stats[(size_t)m * 16 + lane] = (lane == 0) ? sq[k] : 0.f; }
    }
    { unsigned* cz = (unsigned*)(a.ws + WS_CTL + 65536); for (int i = gw * 64 + lane; i < 3456; i += NGW * 64) cz[i] = 0u; }
    float* rc = (float*)(a.ws + WS_ROPEC); float* rs = (float*)(a.ws + WS_ROPES);
    for (int e = gw * 64 + lane; e < SEQ * 32; e += NGW * 64) {
        const int t = e >> 5, i = e & 31;
        double c = 0.15915494309189535;
        for (int k = 0; k < i; ++k) c *= 0.74989420933245582;
        const float chi = (float)c, clo = (float)(c - (double)chi), tf = (float)t;
        const float p = tf * chi, pe = fmaf(tf, chi, -p);
        float fr = __builtin_amdgcn_fractf(p) + (pe + tf * clo);
        rc[e] = __builtin_amdgcn_cosf(fr); rs[e] = __builtin_amdgcn_sinf(fr);
    }
    float* scr = (float*)(lds + wave * 16384);
    for (int it = gw; it < WC_ITEMS; it += NGW) wconv_item(a, 0, it, scr, lane);
}

template <bool DIAG>
DI void attn_core(const bf16* qrow, const bf16* kblk, const bf16* vblk, int nkg, int r, int h, float& m_out, float& l_out, f32x16 (&ot)[2]) {
    bf16x8 qf[4];
#pragma unroll
    for (int ks = 0; ks < 4; ++ks) qf[ks] = *(const bf16x8*)(qrow + 16 * ks + 8 * h);
    f32x16 st[8];
    const int lo = (r * 2 + h) * 8;
#pragma unroll
    for (int hf = 0; hf < 2; ++hf) {
        if (!DIAG || 4 * hf < nkg) {
            bf16x8 kf[16];
#pragma unroll
            for (int i = 0; i < 16; ++i) kf[i] = (!DIAG || 4 * hf + (i >> 2) < nkg) ? *(const bf16x8*)(kblk + ((4 * hf + (i >> 2)) * 4 + (i & 3)) * 512 + lo) : qf[0];
#pragma unroll
            for (int g = 0; g < 4; ++g) {
                const int kg = 4 * hf + g;
                f32x16 acc = zero16();
                if (!DIAG || kg < nkg) {
#pragma unroll
                    for (int ks = 0; ks < 4; ++ks) acc = MFMA32(kf[4 * g + ks], qf[ks], acc);
                    if (DIAG && kg == nkg - 1) {
#pragma unroll
                        for (int i = 0; i < 16; ++i) if (crow(i, h) > r) acc[i] = -INFINITY;
                    }
                } else {
#pragma unroll
                    for (int i = 0; i < 16; ++i) acc[i] = -INFINITY;
                }
                st[kg] = acc;
            }
        } else {
#pragma unroll
            for (int g = 0; g < 4; ++g)
#pragma unroll
                for (int i = 0; i < 16; ++i) st[4 * hf + g][i] = -INFINITY;
        }
    }
    float mx = -INFINITY;
#pragma unroll
    for (int kg = 0; kg < 8; ++kg)
#pragma unroll
        for (int i = 0; i < 16; ++i) mx = fmaxf(mx, st[kg][i]);
    mx = fmaxf(mx, __shfl_xor(mx, 32));
    const float c = 0.125f * 1.4426950408889634f; const float mc = mx * c;
    float l = 0.f;
#pragma unroll
    for (int kg = 0; kg < 8; ++kg)
#pragma unroll
        for (int i = 0; i < 16; ++i) { const float p = __builtin_amdgcn_exp2f(st[kg][i] * c - mc); st[kg][i] = p; l += p; }
    l += __shfl_xor(l, 32);
    ot[0] = zero16(); ot[1] = zero16();
#pragma unroll
    for (int pr = 0; pr < 4; ++pr) {
        if (!DIAG || 2 * pr < nkg) {
            bf16x8 vf[8];
#pragma unroll
            for (int i = 0; i < 8; ++i) vf[i] = (!DIAG || 2 * pr + (i >> 2) < nkg) ? *(const bf16x8*)(vblk + (((2 * pr + (i >> 2)) * 2 + ((i >> 1) & 1)) * 2 + (i & 1)) * 512 + lo) : qf[0];
#pragma unroll
            for (int g = 0; g < 2; ++g) {
                const int kg = 2 * pr + g;
                if (!DIAG || kg < nkg) {
#pragma unroll
                    for (int s2 = 0; s2 < 2; ++s2) { const bf16x8 pf = pack8(st[kg], s2); ot[0] = MFMA32(vf[4 * g + 2 * s2], pf, ot[0]); ot[1] = MFMA32(vf[4 * g + 2 * s2 + 1], pf, ot[1]); }
                }
            }
        }
    }
    m_out = mx * 0.125f; l_out = l;
}

DI void topk_unit(const Ctx& a, int L, int unit, int lane) {
    asm volatile("" : "+v"(lane));
    const int b = unit >> 10, hd = (unit >> 7) & 7, c = unit & 127, own = c >> 2;
    if (own == 0) return;
    const bf16* Q = (const bf16*)(a.ws + WS_R + R_Q); const float* kmp = (const float*)(a.ws + WS_KMP);
    unsigned* cnt = (unsigned*)(a.ws + WS_CTL) + L * 512; unsigned* lists = (unsigned*)(a.ws + WS_R + R_LIST);
    const int t = c * 64 + lane; const size_t bh = (size_t)(b * 8 + hd);
    float q[64];
    { const u32x4* qp = (const u32x4*)(Q + (bh * SEQ + t) * 64);
#pragma unroll
      for (int i = 0; i < 8; ++i) { const u32x4 w = qp[i];
          q[8 * i + 0] = __uint_as_float(w.x << 16); q[8 * i + 1] = __uint_as_float(w.x & 0xffff0000u); q[8 * i + 2] = __uint_as_float(w.y << 16); q[8 * i + 3] = __uint_as_float(w.y & 0xffff0000u);
          q[8 * i + 4] = __uint_as_float(w.z << 16); q[8 * i + 5] = __uint_as_float(w.z & 0xffff0000u); q[8 * i + 6] = __uint_as_float(w.w << 16); q[8 * i + 7] = __uint_as_float(w.w & 0xffff0000u); } }
    float g0 = -INFINITY, g1 = -INFINITY, g2 = -INFINITY; int i0 = 0, i1 = 0, i2 = 0;
    for (int j = 0; j < own; ++j) {
        const float* p0 = kmp + (size_t)((b * 32 + j) * 2) * 512 + hd * 64; const float* p1 = p0 + 512;
        float g = 0.f;
#pragma unroll
        for (int d = 0; d < 64; d += 4) { const f32x4 x0 = *(const f32x4*)(p0 + d), x1 = *(const f32x4*)(p1 + d);
            g += q[d] * (x0[0] + x1[0]) + q[d + 1] * (x0[1] + x1[1]) + q[d + 2] * (x0[2] + x1[2]) + q[d + 3] * (x0[3] + x1[3]); }
#ifdef DBG_FIXED_SEL
        g = -(float)j;
#endif
        if (g > g0) { g2 = g1; i2 = i1; g1 = g0; i1 = i0; g0 = g; i0 = j; }
        else if (g > g1) { g2 = g1; i2 = i1; g1 = g; i1 = j; }
        else if (g > g2) { g2 = g; i2 = j; }
    }
    const int nsel = own < 3 ? own : 3;
#pragma unroll
    for (int s = 0; s < 3; ++s) {
        if (s < nsel) { const int j = s == 0 ? i0 : (s == 1 ? i1 : i2); const int li = (int)bh * 32 + j;
            const unsigned pos = atomicAdd(cnt + li, 1u); st_sc1(lists + (size_t)li * 8192 + pos, (unsigned)(t | (s << 13))); }
    }
}

DI void pool_unit(const Ctx& a, int L, int unit, int lane) {
    asm volatile("" : "+v"(lane));
    const int tile = unit >> 2, g = unit & 3, w = 2 << g, r = lane & 31, h = lane >> 5;
    const bf16* U = (const bf16*)(a.ws + WS_R + R_U5); bf16* Y = (bf16*)(a.ws + WS_R + R_Y);
    const float* pw = a.in(I_PW) + (size_t)(L * 4 + g) * 4096; const float* ps = a.in(I_PS) + L * 256 + g * 64;
    const float* pwl = pw + (8 * h) * 64 + r;
    bf16x8 wf[2][4];
#pragma unroll
    for (int me = 0; me < 2; ++me)
#pragma unroll
        for (int ks = 0; ks < 4; ++ks) { float f[8];
#pragma unroll
            for (int j = 0; j < 8; ++j) f[j] = pwl[(16 * ks + j) * 64 + 32 * me];
            u32x4 p; p.x = cvtpk(f[0], f[1]); p.y = cvtpk(f[2], f[3]); p.z = cvtpk(f[4], f[5]); p.w = cvtpk(f[6], f[7]); wf[me][ks] = __builtin_bit_cast(bf16x8, p); }
#pragma unroll 1
    for (int nt = 0; nt < 4; ++nt) {
        const int m = tile * 128 + nt * 32 + r, tpos = m & (SEQ - 1);
        const int cntw = tpos + 1 < w ? tpos + 1 : w; const float invc = 1.0f / (float)cntw;
        f32x16 acc[2]; acc[0] = zero16(); acc[1] = zero16();
#pragma unroll
        for (int ks = 0; ks < 4; ++ks) {
            const bf16* up = U + (size_t)m * 256 + g * 64 + 16 * ks + 8 * h;
            float sum[8], self[8];
            { const u32x4 wv = *(const u32x4*)up;
              self[0] = __uint_as_float(wv.x << 16); self[1] = __uint_as_float(wv.x & 0xffff0000u); self[2] = __uint_as_float(wv.y << 16); self[3] = __uint_as_float(wv.y & 0xffff0000u);
              self[4] = __uint_as_float(wv.z << 16); self[5] = __uint_as_float(wv.z & 0xffff0000u); self[6] = __uint_as_float(wv.w << 16); self[7] = __uint_as_float(wv.w & 0xffff0000u); }
#pragma unroll
            for (int j = 0; j < 8; ++j) sum[j] = self[j];
            u32x4 rows[15];
#pragma unroll
            for (int i = 1; i < 16; ++i) { const bool ok = (i < w) && (i <= tpos); rows[i - 1] = *(const u32x4*)(up - (size_t)(ok ? i : 0) * 256); }
#pragma unroll
            for (int i = 1; i < 16; ++i) { const bool ok = (i < w) && (i <= tpos); const float kf = ok ? 1.f : 0.f; const u32x4 wv = rows[i - 1];
                sum[0] += kf * __uint_as_float(wv.x << 16); sum[1] += kf * __uint_as_float(wv.x & 0xffff0000u); sum[2] += kf * __uint_as_float(wv.y << 16); sum[3] += kf * __uint_as_float(wv.y & 0xffff0000u);
                sum[4] += kf * __uint_as_float(wv.z << 16); sum[5] += kf * __uint_as_float(wv.z & 0xffff0000u); sum[6] += kf * __uint_as_float(wv.w << 16); sum[7] += kf * __uint_as_float(wv.w & 0xffff0000u); }
            u32x4 p; p.x = cvtpk(sum[0] * invc - self[0], sum[1] * invc - self[1]); p.y = cvtpk(sum[2] * invc - self[2], sum[3] * invc - self[3]);
            p.z = cvtpk(sum[4] * invc - self[4], sum[5] * invc - self[5]); p.w = cvtpk(sum[6] * invc - self[6], sum[7] * invc - self[7]);
            const bf16x8 df = __builtin_bit_cast(bf16x8, p);
            acc[0] = MFMA32(wf[0][ks], df, acc[0]); acc[1] = MFMA32(wf[1][ks], df, acc[1]);
        }
#pragma unroll
        for (int me = 0; me < 2; ++me)
#pragma unroll
            for (int gq = 0; gq < 4; ++gq) { const int e0 = 32 * me + 8 * gq + 4 * h; const f32x4 sc = *(const f32x4*)(ps + e0);
                u32x2 o; o.x = cvtpk(acc[me][4 * gq] * sc[0], acc[me][4 * gq + 1] * sc[1]); o.y = cvtpk(acc[me][4 * gq + 2] * sc[2], acc[me][4 * gq + 3] * sc[3]);
                *(u32x2*)(Y + (size_t)m * 1024 + 512 + g * 64 + e0) = o; }
    }
}

DI void h1_unit(const Ctx& a, int L, int unit, unsigned char* sm, int lane) {
    asm volatile("" : "+v"(lane));
    const int b = unit >> 9, hh = (unit >> 7) & 3, n = unit & 127, r = lane & 31, h = lane >> 5;
    const int row0 = b * SEQ + n * 64, ch = hh * 64 + lane;
    const bf16* QH = (const bf16*)(a.ws + WS_R + R_U5) + (size_t)1 * M * 256; const bf16* FH = QH + (size_t)M * 256; const bf16* IH = FH + (size_t)M * 256;
    bf16* QDEC = (bf16*)(a.ws + WS_R + R_QDEC); float* ALOC = (float*)(a.ws + WS_R + R_ALOC); float* OINTRA = (float*)(a.ws + WS_R + R_OINTRA); float* DEC = (float*)(a.ws + WS_DEC);
    bf16* KD = (bf16*)sm; bf16* IT = (bf16*)(sm + 8192); bf16* Am = (bf16*)(sm + 16384); bf16* Bm = (bf16*)(sm + 24576);
#ifdef DBG_H1_CLEAR
    { u32x4* z4 = (u32x4*)sm;
#pragma unroll 4
      for (int i = 0; i < 32; ++i) z4[i * 64 + lane] = (u32x4){0u, 0u, 0u, 0u}; asm volatile("s_waitcnt lgkmcnt(0)" ::: "memory"); }
#endif
    float lb;
    { const float* lp = a.in(I_LB) + ch; const float x0 = lp[0], x1 = lp[256], x2 = lp[512], x3 = lp[768];
      const float mx = fmaxf(fmaxf(x0, x1), fmaxf(x2, x3)); const float e0 = __expf(x0 - mx), e1 = __expf(x1 - mx), e2 = __expf(x2 - mx), e3 = __expf(x3 - mx);
      const float inv = 1.0f / (e0 + e1 + e2 + e3); float acc = 0.f; if (L > 0) acc += e0; if (L > 1) acc += e1; if (L > 2) acc += e2; lb = acc * inv; }
    const float loglb = __logf(fmaxf(lb, 1e-20f)), l1m = __logf(1.0f - lb), oml = 1.0f - lb;
    float zr[64];
#pragma unroll
    for (int s = 0; s < 64; ++s) zr[s] = bf2f(FH[(size_t)(row0 + s) * 256 + ch]);
    float cum = 0.f, ref = 0.f;
#pragma unroll
    for (int s = 0; s < 64; ++s) {
        const float z = zr[s];
        const float ls = fminf(z, 0.f) - __logf(1.0f + __expf(-fabsf(z)));
        const float bb = l1m + ls, hi = fmaxf(loglb, bb), df = fabsf(loglb - bb);
        cum += hi + __logf(1.0f + __expf(-df));
        asm volatile("" : "+v"(cum));
        if (s == 31) ref = cum;
    }
    const float last = cum;
    DEC[unit * 64 + lane] = __expf(last);
    cum = 0.f;
#ifndef H1_NO_P2
    unsigned short zc[8], qc[8], ic[8];
#pragma unroll
    for (int j = 0; j < 8; ++j) { const size_t gi = (size_t)(row0 + j) * 256 + ch; zc[j] = FH[gi]; qc[j] = QH[gi]; ic[j] = IH[gi]; }
#pragma unroll 1
    for (int s8 = 0; s8 < 8; ++s8) {
        unsigned kp[4], ip[4]; float kd8[8]; unsigned short i8[8];
        unsigned short zn[8], qn[8], in_[8];
        { const int sn = (s8 < 7 ? s8 + 1 : 7) * 8;
#pragma unroll
          for (int j = 0; j < 8; ++j) { const size_t gi = (size_t)(row0 + sn + j) * 256 + ch; zn[j] = FH[gi]; qn[j] = QH[gi]; in_[j] = IH[gi]; } }
#pragma unroll
        for (int j = 0; j < 8; ++j) {
            const int s = s8 * 8 + j; const size_t gi = (size_t)(row0 + s) * 256 + ch;
            const float z = bf2f(zc[j]), qv = bf2f(qc[j]); i8[j] = ic[j];
            const float ls = fminf(z, 0.f) - __logf(1.0f + __expf(-fabsf(z)));
            const float bb = l1m + ls, hi = fmaxf(loglb, bb), df = fabsf(loglb - bb);
            cum += hi + __logf(1.0f + __expf(-df));
            const float key = oml * __builtin_amdgcn_rcpf(1.0f + __expf(z));
            const float qs = qv * __builtin_amdgcn_rcpf(1.0f + __expf(-qv)) * 0.125f;
            const float av = qs * __expf(fminf(cum - ref, 80.f)), bv = key * __expf(fminf(ref - cum, 80.f)), qd = qs * __expf(cum);
            kd8[j] = key * __expf(last - cum);
#ifndef H1_NO_AB
            Am[s * 64 + lane] = (bf16)(cvtpk(av, 0.f) & 0xffffu); Bm[s * 64 + lane] = (bf16)(cvtpk(bv, 0.f) & 0xffffu);
#endif
#ifndef H1_NO_QD
            QDEC[gi] = (bf16)(cvtpk(qd, 0.f) & 0xffffu);
#endif
        }
#pragma unroll
        for (int j = 0; j < 4; ++j) { kp[j] = cvtpk(kd8[2 * j], kd8[2 * j + 1]); ip[j] = (unsigned)i8[2 * j] | ((unsigned)i8[2 * j + 1] << 16); }
        *(u32x4*)(KD + lane * 64 + s8 * 8) = (u32x4){kp[0], kp[1], kp[2], kp[3]};
        *(u32x4*)(IT + lane * 64 + s8 * 8) = (u32x4){ip[0], ip[1], ip[2], ip[3]};
#pragma unroll
        for (int j = 0; j < 8; ++j) { zc[j] = zn[j]; qc[j] = qn[j]; ic[j] = in_[j]; }
    }
#endif
    asm volatile("s_waitcnt lgkmcnt(0)" ::: "memory");
#ifndef H1_NO_MM
    bf16x8 itf[2][2][2];
#pragma unroll
    for (int mv = 0; mv < 2; ++mv)
#pragma unroll
        for (int ms = 0; ms < 2; ++ms)
#pragma unroll
            for (int st = 0; st < 2; ++st) { const bf16* p = IT + (32 * mv + r) * 64 + 32 * ms + 16 * st + 4 * h; const u32x2 x0 = *(const u32x2*)p, x1 = *(const u32x2*)(p + 8);
                itf[mv][ms][st] = __builtin_bit_cast(bf16x8, ((u32x4){x0.x, x0.y, x1.x, x1.y})); }
    float* alb = ALOC + (size_t)unit * 4096 + (4 * h) * 64 + r;
#pragma unroll
    for (int nk = 0; nk < 2; ++nk) {
        bf16x8 kdf[2][2];
#pragma unroll
        for (int ms = 0; ms < 2; ++ms)
#pragma unroll
            for (int st = 0; st < 2; ++st) { const bf16* p = KD + (32 * nk + r) * 64 + 32 * ms + 16 * st + 4 * h; const u32x2 x0 = *(const u32x2*)p, x1 = *(const u32x2*)(p + 8);
                kdf[ms][st] = __builtin_bit_cast(bf16x8, ((u32x4){x0.x, x0.y, x1.x, x1.y})); }
#pragma unroll
        for (int mv = 0; mv < 2; ++mv) {
            f32x16 acc = zero16();
#pragma unroll
            for (int ms = 0; ms < 2; ++ms)
#pragma unroll
                for (int st = 0; st < 2; ++st) acc = MFMA32(itf[mv][ms][st], kdf[ms][st], acc);
#pragma unroll
            for (int i = 0; i < 16; ++i) alb[(32 * mv + (i & 3) + 8 * (i >> 2)) * 64 + 32 * nk] = acc[i];
        }
    }
#pragma unroll
    for (int nt = 0; nt < 2; ++nt) {
        bf16x8 af[4];
#pragma unroll
        for (int ks = 0; ks < 4; ++ks) af[ks] = *(const bf16x8*)(Am + (32 * nt + r) * 64 + 16 * ks + 8 * h);
        f32x16 oi[2]; oi[0] = zero16(); oi[1] = zero16();
#pragma unroll
        for (int ms = 0; ms < 2; ++ms) {
            if (ms <= nt) {
                f32x16 sacc = zero16();
#pragma unroll
                for (int ks = 0; ks < 4; ++ks) { const bf16x8 bf_ = *(const bf16x8*)(Bm + (32 * ms + r) * 64 + 16 * ks + 8 * h); sacc = MFMA32(bf_, af[ks], sacc); }
                if (ms == nt) {
#pragma unroll
                    for (int i = 0; i < 16; ++i) if (crow(i, h) > r) sacc[i] = 0.f;
                }
#pragma unroll
                for (int st = 0; st < 2; ++st) { const bf16x8 pf = pack8(sacc, st); oi[0] = MFMA32(itf[0][ms][st], pf, oi[0]); oi[1] = MFMA32(itf[1][ms][st], pf, oi[1]); }
            }
        }
        const size_t orow = (size_t)(row0 + 32 * nt + r) * 256 + hh * 64;
#pragma unroll
        for (int mv = 0; mv < 2; ++mv)
#pragma unroll
            for (int gq = 0; gq < 4; ++gq) *(f32x4*)(OINTRA + orow + 32 * mv + 8 * gq + 4 * h) = (f32x4){oi[mv][4 * gq], oi[mv][4 * gq + 1], oi[mv][4 * gq + 2], oi[mv][4 * gq + 3]};
    }
#endif
    asm volatile("s_waitcnt lgkmcnt(0)" ::: "memory");
}

DI void phase_t(const Ctx& a, int L, unsigned char* lds, int gw, int NGW, int wave, int lane, bool conv_here) {
    const int blk = gw >> 3, G = NGW >> 3;
    if (wave < 4) { for (int u = blk * 4 + wave; u < 1024; u += G * 4) h1_unit(a, L, u, lds + wave * 32768, lane); }
    else if (wave < 6) { for (int u = blk * 2 + (wave - 4); u < 512; u += G * 2) pool_unit(a, L, u, lane); }
    __syncthreads();
    if (conv_here && L + 1 < DEPTH) { float* scr = (float*)(lds + wave * 16384); for (int it = gw; it < WC_ITEMS; it += NGW) wconv_item(a, L + 1, it, scr, lane); }
}

DI void attn_unit(const Ctx& a, int bh, int qb, unsigned char* lds, int tid, int wave, int lane) {
    asm volatile("" : "+v"(lane), "+v"(tid));
    const int r = lane & 31, h = lane >> 5, b = bh >> 3, hd = bh & 7, own = qb, nsel = own < 3 ? own : 3;
    const bf16* Q = (const bf16*)(a.ws + WS_R + R_Q); const bf16* Kb = (const bf16*)(a.ws + WS_R + R_K); const bf16* Vb = (const bf16*)(a.ws + WS_R + R_V);
    const float* kmp = (const float*)(a.ws + WS_KMP); bf16* Y = (bf16*)(a.ws + WS_R + R_Y);
    unsigned char* part = lds;
    unsigned short* llist = (unsigned short*)(lds + 104448);
    int* lcnt = (int*)(lds + 120832); int* itab = lcnt + 32;
    const size_t qbase = ((size_t)bh * SEQ + (size_t)qb * 256) * 64;
    if (own > 0) {
        if (tid < 32) lcnt[tid] = 0;
        float* km = (float*)(lds + 122880);
        for (int idx = tid; idx < own * 64; idx += NTHR) { const float* p0 = kmp + (size_t)((b * 32 + (idx >> 6)) * 2) * 512 + hd * 64 + (idx & 63); km[idx] = p0[0] + p0[512]; }
        __syncthreads();
        if (tid < 256) {
            float q[64];
            { const u32x4* qp = (const u32x4*)(Q + qbase + (size_t)tid * 64);
#pragma unroll
              for (int i = 0; i < 8; ++i) { const u32x4 w = qp[i];
                  q[8 * i + 0] = __uint_as_float(w.x << 16); q[8 * i + 1] = __uint_as_float(w.x & 0xffff0000u); q[8 * i + 2] = __uint_as_float(w.y << 16); q[8 * i + 3] = __uint_as_float(w.y & 0xffff0000u);
                  q[8 * i + 4] = __uint_as_float(w.z << 16); q[8 * i + 5] = __uint_as_float(w.z & 0xffff0000u); q[8 * i + 6] = __uint_as_float(w.w << 16); q[8 * i + 7] = __uint_as_float(w.w & 0xffff0000u); } }
            float g0 = -INFINITY, g1 = -INFINITY, g2 = -INFINITY; int i0 = 0, i1 = 0, i2 = 0;
            for (int j = 0; j < own; ++j) {
                const float* kj = km + j * 64;
                float g = 0.f;
#pragma unroll
                for (int d = 0; d < 64; d += 4) { const f32x4 x0 = *(const f32x4*)(kj + d);
                    g += q[d] * x0[0] + q[d + 1] * x0[1] + q[d + 2] * x0[2] + q[d + 3] * x0[3]; }
                if (g > g0) { g2 = g1; i2 = i1; g1 = g0; i1 = i0; g0 = g; i0 = j; }
                else if (g > g1) { g2 = g1; i2 = i1; g1 = g; i1 = j; }
                else if (g > g2) { g2 = g; i2 = j; }
            }
#pragma unroll
            for (int s = 0; s < 3; ++s) {
                if (s < nsel) { const int j = s == 0 ? i0 : (s == 1 ? i1 : i2); const int pos = atomicAdd(lcnt + j, 1); llist[j * 256 + pos] = (unsigned short)(tid | (s << 8)); }
            }
        }
        __syncthreads();
        if (tid == 0) { int n = 0; for (int j = 0; j < own; ++j) { const int ng = (lcnt[j] + 31) >> 5; for (int g = 0; g < ng; ++g) itab[n++] = j | (g << 8); } itab[64] = n; }
        __syncthreads();
        const int nitems = __builtin_amdgcn_readfirstlane(itab[64]);
        for (int it = wave; it < nitems; it += NWAVES) {
            const int ent = __builtin_amdgcn_readfirstlane(itab[it]); const int j = ent & 255, g = ent >> 8, n = __builtin_amdgcn_readfirstlane(lcnt[j]);
            const int idx = g * 32 + r; const bool valid = idx < n;
            const unsigned e = llist[j * 256 + (valid ? idx : 0)];
            const int qi = e & 255, slot = e >> 8;
            float mo, lo_; f32x16 ot[2];
            attn_core<false>(Q + qbase + (size_t)qi * 64, Kb + ((size_t)bh * 32 + j) * 16384, Vb + ((size_t)bh * 32 + j) * 16384, 8, r, h, mo, lo_, ot);
            if (valid) {
                unsigned char* rec = part + (qi * 3 + slot) * 136; const float inv = 1.0f / lo_;
#pragma unroll
                for (int md = 0; md < 2; ++md)
#pragma unroll
                    for (int gq = 0; gq < 4; ++gq) { u32x2 o; o.x = cvtpk(ot[md][4 * gq] * inv, ot[md][4 * gq + 1] * inv); o.y = cvtpk(ot[md][4 * gq + 2] * inv, ot[md][4 * gq + 3] * inv);
                        *(u32x2*)(rec + 2 * (32 * md + 8 * gq + 4 * h)) = o; }
                if (h == 0) { *(float*)(rec + 128) = mo; *(float*)(rec + 132) = lo_; }
            }
        }
        __syncthreads();
    }
    {
        const int ql = 32 * wave + r, t = qb * 256 + ql;
        float m0, l0; f32x16 ot[2];
        attn_core<true>(Q + qbase + (size_t)ql * 64, Kb + ((size_t)bh * 32 + qb) * 16384, Vb + ((size_t)bh * 32 + qb) * 16384, wave + 1, r, h, m0, l0, ot);
        float ms[3], ls[3]; float mx = m0;
#pragma unroll
        for (int s = 0; s < 3; ++s) { ms[s] = -INFINITY; ls[s] = 0.f; if (s < nsel) { const unsigned char* rec = part + (ql * 3 + s) * 136; ms[s] = *(const float*)(rec + 128); ls[s] = *(const float*)(rec + 132); mx = fmaxf(mx, ms[s]); } }
        const float w0 = __expf(m0 - mx); float den = w0 * l0;
#pragma unroll
        for (int md = 0; md < 2; ++md)
#pragma unroll
            for (int i = 0; i < 16; ++i) ot[md][i] *= w0;
#pragma unroll
        for (int s = 0; s < 3; ++s) {
            if (s < nsel) {
                const unsigned char* rec = part + (ql * 3 + s) * 136; const float ws_ = __expf(ms[s] - mx) * ls[s]; den += ws_;
#pragma unroll
                for (int md = 0; md < 2; ++md)
#pragma unroll
                    for (int gq = 0; gq < 4; ++gq) { const u32x2 w = *(const u32x2*)(rec + 2 * (32 * md + 8 * gq + 4 * h));
                        ot[md][4 * gq] += ws_ * __uint_as_float(w.x << 16); ot[md][4 * gq + 1] += ws_ * __uint_as_float(w.x & 0xffff0000u);
                        ot[md][4 * gq + 2] += ws_ * __uint_as_float(w.y << 16); ot[md][4 * gq + 3] += ws_ * __uint_as_float(w.y & 0xffff0000u); }
            }
        }
        float inv = 1.0f / den; const size_t yrow = (size_t)(b * SEQ + t) * 1024 + hd * 64;
#ifdef DBG_AMP_ATTN
        inv *= 64.f;
#endif
#pragma unroll
        for (int md = 0; md < 2; ++md)
#pragma unroll
            for (int gq = 0; gq < 4; ++gq) { u32x2 o; o.x = cvtpk(ot[md][4 * gq] * inv, ot[md][4 * gq + 1] * inv); o.y = cvtpk(ot[md][4 * gq + 2] * inv, ot[md][4 * gq + 3] * inv);
                *(u32x2*)(Y + yrow + 32 * md + 8 * gq + 4 * h) = o; }
    }
    __syncthreads();
}

DI void phase_a(const Ctx& a, int L, unsigned char* lds, int gw, int NGW, int tid, int wave, int lane) {
    if ((gw & 3) == 0 && (gw >> 2) < 512) {
        const int chunk = gw >> 2, bhh = chunk >> 6, e = (chunk & 63) * 64 + lane, k = e & 63;
        const float* ALOC = (const float*)(a.ws + WS_R + R_ALOC); const float* DEC = (const float*)(a.ws + WS_DEC); bf16* SP = (bf16*)(a.ws + WS_R + R_SP);
        float st = 0.f;
#pragma unroll 32
        for (int n = 0; n < 128; ++n) { const int item = bhh * 128 + n; const float av = ALOC[(size_t)item * 4096 + e], dv = DEC[item * 64 + k];
            SP[(size_t)item * 4096 + e] = (bf16)(cvtpk(st, 0.f) & 0xffffu); st = dv * st + av; }
    }
    const int G = NGW / NWAVES, blk = gw / NWAVES;
    if (G == 256) {
        const int xcd = blk & 7, i = blk >> 3;
        attn_unit(a, 2 * xcd, i, lds, tid, wave, lane);
        attn_unit(a, 2 * xcd + 1, 31 - i, lds, tid, wave, lane);
    } else {
        for (int u = blk; u < 512; u += G) {
            const int v = u & 255, bh = v >> 4, qb = (u < 256) ? (v & 15) : 31 - (v & 15);
            attn_unit(a, bh, qb, lds, tid, wave, lane);
        }
    }
}

DI void own_unit(const Ctx& a, int bhi, int qg, int lane) {
    asm volatile("" : "+v"(lane));
    const int r = lane & 31, h = lane >> 5, t0 = qg * 32, j = t0 >> 8, nkg = ((t0 & 255) >> 5) + 1, t = t0 + r;
    const int b = bhi >> 3, hd = bhi & 7; const size_t bh = (size_t)bhi;
    const bf16* Q = (const bf16*)(a.ws + WS_R + R_Q); const bf16* Kb = (const bf16*)(a.ws + WS_R + R_K); const bf16* Vb = (const bf16*)(a.ws + WS_R + R_V);
    const bf16* PO = (const bf16*)(a.ws + WS_R + R_PO); const float* PML = (const float*)(a.ws + WS_R + R_PML); bf16* Y = (bf16*)(a.ws + WS_R + R_Y);
    float m0, l0; f32x16 ot[2];
    attn_core<true>(Q + (bh * SEQ + t) * 64, Kb + (bh * 32 + j) * 16384, Vb + (bh * 32 + j) * 16384, nkg, r, h, m0, l0, ot);
#ifdef DBG_OWN_ONLY
    const int nsel = 0;
#else
    const int nsel = j < 3 ? j : 3;
#endif
    const size_t pi = (bh * SEQ + t) * 3;
    float ms[3], ls[3]; float mx = m0;
#pragma unroll
    for (int s = 0; s < 3; ++s) { ms[s] = -INFINITY; ls[s] = 0.f; if (s < nsel) { ms[s] = ld_sc1f(PML + (pi + s) * 2); ls[s] = ld_sc1f(PML + (pi + s) * 2 + 1); mx = fmaxf(mx, ms[s]); } }
    const float w0 = __expf(m0 - mx); float den = w0 * l0;
#pragma unroll
    for (int md = 0; md < 2; ++md)
#pragma unroll
        for (int i = 0; i < 16; ++i) ot[md][i] *= w0;
#pragma unroll
    for (int s = 0; s < 3; ++s) {
        if (s < nsel) {
            const float ws_ = __expf(ms[s] - mx) * ls[s]; den += ws_;
#pragma unroll
            for (int md = 0; md < 2; ++md)
#pragma unroll
                for (int gq = 0; gq < 4; ++gq) { const u32x2 w = *(const u32x2*)(PO + (pi + s) * 64 + 32 * md + 8 * gq + 4 * h);
                    ot[md][4 * gq] += ws_ * __uint_as_float(w.x << 16); ot[md][4 * gq + 1] += ws_ * __uint_as_float(w.x & 0xffff0000u);
                    ot[md][4 * gq + 2] += ws_ * __uint_as_float(w.y << 16); ot[md][4 * gq + 3] += ws_ * __uint_as_float(w.y & 0xffff0000u); }
        }
    }
    float inv = 1.0f / den; const size_t yrow = (size_t)(b * SEQ + t) * 1024 + hd * 64;
#ifdef DBG_ZERO_ATTN
    inv = 0.f;
#endif
#pragma unroll
    for (int md = 0; md < 2; ++md)
#pragma unroll
        for (int gq = 0; gq < 4; ++gq) { u32x2 o; o.x = cvtpk(ot[md][4 * gq] * inv, ot[md][4 * gq + 1] * inv); o.y = cvtpk(ot[md][4 * gq + 2] * inv, ot[md][4 * gq + 3] * inv);
            *(u32x2*)(Y + yrow + 32 * md + 8 * gq + 4 * h) = o; }
}

DI void h3_unit(const Ctx& a, int L, int unit2, int lane) {
    asm volatile("" : "+v"(lane));
    const int unit = unit2 >> 1, nt = unit2 & 1;
    const int b = unit >> 9, hh = (unit >> 7) & 3, n = unit & 127, r = lane & 31, h = lane >> 5;
    const int row0 = b * SEQ + n * 64;
    const bf16* SP = (const bf16*)(a.ws + WS_R + R_SP) + (size_t)unit * 4096; const bf16* QDEC = (const bf16*)(a.ws + WS_R + R_QDEC);
    const float* OINTRA = (const float*)(a.ws + WS_R + R_OINTRA); const bf16* GH = (const bf16*)(a.ws + WS_R + R_U5) + (size_t)4 * M * 256; bf16* Y = (bf16*)(a.ws + WS_R + R_Y);
    const float* on = a.in(I_HON) + L * 64;
    bf16x8 sf[2][4];
#pragma unroll
    for (int mv = 0; mv < 2; ++mv)
#pragma unroll
        for (int ks = 0; ks < 4; ++ks) sf[mv][ks] = *(const bf16x8*)(SP + (32 * mv + r) * 64 + 16 * ks + 8 * h);
    {
        const size_t trow = (size_t)(row0 + 32 * nt + r) * 256 + hh * 64;
        f32x16 o[2]; o[0] = zero16(); o[1] = zero16();
#pragma unroll
        for (int ks = 0; ks < 4; ++ks) { const bf16x8 qf = *(const bf16x8*)(QDEC + trow + 16 * ks + 8 * h); o[0] = MFMA32(sf[0][ks], qf, o[0]); o[1] = MFMA32(sf[1][ks], qf, o[1]); }
        float ss = 0.f;
#pragma unroll
        for (int mv = 0; mv < 2; ++mv)
#pragma unroll
            for (int gq = 0; gq < 4; ++gq) { const f32x4 x = *(const f32x4*)(OINTRA + trow + 32 * mv + 8 * gq + 4 * h);
#pragma unroll
                for (int i = 0; i < 4; ++i) { o[mv][4 * gq + i] += x[i]; ss += o[mv][4 * gq + i] * o[mv][4 * gq + i]; } }
        ss += __shfl_xor(ss, 32);
        float rn = rsqrtf(ss * (1.0f / 64.0f) + 1e-6f);
#ifdef DBG_ZERO_HGRN
        rn = 0.f;
#endif
#ifdef DBG_AMP_HGRN
        rn *= 16.f;
#endif
        const size_t yrow = (size_t)(row0 + 32 * nt + r) * 1024 + 768 + hh * 64;
#pragma unroll
        for (int mv = 0; mv < 2; ++mv)
#pragma unroll
            for (int gq = 0; gq < 4; ++gq) { const int v0 = 32 * mv + 8 * gq + 4 * h; const f32x4 gn = *(const f32x4*)(on + v0); const u32x2 gw_ = *(const u32x2*)(GH + trow + v0);
                const float g0 = __uint_as_float(gw_.x << 16), g1 = __uint_as_float(gw_.x & 0xffff0000u), g2 = __uint_as_float(gw_.y << 16), g3 = __uint_as_float(gw_.y & 0xffff0000u);
                u32x2 w; w.x = cvtpk(o[mv][4 * gq] * rn * gn[0] * pg8::silu_f(g0), o[mv][4 * gq + 1] * rn * gn[1] * pg8::silu_f(g1));
                w.y = cvtpk(o[mv][4 * gq + 2] * rn * gn[2] * pg8::silu_f(g2), o[mv][4 * gq + 3] * rn * gn[3] * pg8::silu_f(g3));
                *(u32x2*)(Y + yrow + v0) = w; }
    }
}

DI void phase_c(const Ctx& a, int L, int gw, int NGW, int lane) {
    for (int u = gw; u < 2048; u += NGW) h3_unit(a, L, u, lane);
}

#define LAS __attribute__((address_space(3)))
#define XB_TMO      128
#define XB_XCNT(j)  (256  + 64 * (j))
#define XB_XSUB(j)  (1280 + 64 * (j))
#define XB_XGEN(j)  (2304 + 64 * (j))
#define XB_TOP      3328
#define XB_TOPGEN   3392
#define XCD_BAR_WORDS 3456
#define XB_SPIN_CAP (1u << 18)

__device__ __forceinline__ unsigned xb_ld(unsigned* p)              { return __hip_atomic_load(p, __ATOMIC_RELAXED, __HIP_MEMORY_SCOPE_AGENT); }
__device__ __forceinline__ unsigned xb_add(unsigned* p, unsigned v) { return __hip_atomic_fetch_add(p, v, __ATOMIC_RELAXED, __HIP_MEMORY_SCOPE_AGENT); }
__device__ __forceinline__ unsigned xb_xcc_id() { return (unsigned)__builtin_amdgcn_s_getreg((3 << 11) | 20) & 0xFu; }
#define XB_SPIN(cond, bar) do { unsigned _sp = 0; while (cond) { __builtin_amdgcn_s_sleep(1); \
    if ((++_sp & 255u) == 0u) { if (xb_ld(&(bar)[XB_TMO])) break; if (_sp > XB_SPIN_CAP) { atomicAdd(&(bar)[XB_TMO], 1u); break; } } } } while (0)

struct XcdBarrier {
    unsigned* bar; unsigned x;
    volatile LAS unsigned* st;
};

__device__ __forceinline__ XcdBarrier xcd_barrier_post(unsigned* bar, volatile LAS unsigned* st) {
    XcdBarrier b; b.bar = bar; b.x = xb_xcc_id(); b.st = st;
    if (threadIdx.x == 0) (void)xb_add(&bar[XB_XCNT(b.x)], 1u);
    return b;
}
__device__ __forceinline__ void xcd_barrier_complete(unsigned* bar, unsigned x, unsigned& nloc, unsigned& nx) {
    const unsigned G = gridDim.x * gridDim.y * gridDim.z;
    unsigned sum, cnt, mine, sp = 0u;
    for (;;) {
        sum = 0u; cnt = 0u; mine = 0u;
#pragma unroll
        for (unsigned j = 0; j < 16; ++j) { const unsigned c = xb_ld(&bar[XB_XCNT(j)]); sum += c; cnt += (c > 0u) ? 1u : 0u; mine = (j == x) ? c : mine; }
        if (sum == G) break;
        __builtin_amdgcn_s_sleep(1);
        if ((++sp & 255u) == 0u) { if (xb_ld(&bar[XB_TMO])) break; if (sp > XB_SPIN_CAP) { atomicAdd(&bar[XB_TMO], 1u); break; } }
    }
    nloc = mine > 0u ? mine : 1u; nx = cnt > 0u ? cnt : 1u;
}

__device__ __forceinline__ void xcd_barrier(const XcdBarrier& b) {
    asm volatile("s_waitcnt vmcnt(0)" ::: "memory");
    __syncthreads();
    if (threadIdx.x == 0) {
        unsigned* bar = b.bar;
        __builtin_amdgcn_s_waitcnt(0);
        unsigned nloc = b.st[0], nx = b.st[1];
        if (nloc == 0u) { xcd_barrier_complete(bar, b.x, nloc, nx); b.st[0] = nloc; b.st[1] = nx; }
        const unsigned old = xb_add(&bar[XB_XSUB(b.x)], 1u);
        const unsigned gen = old / nloc;
        if (old + 1u == (gen + 1u) * nloc) {
            __builtin_amdgcn_fence(__ATOMIC_RELEASE, "agent");
            asm volatile("s_waitcnt vmcnt(0)" ::: "memory");
            const unsigned og = xb_add(&bar[XB_TOP], 1u);
            const unsigned tg = og / nx;
            if (og + 1u == (tg + 1u) * nx) xb_add(&bar[XB_TOPGEN], 1u);
            else XB_SPIN(xb_ld(&bar[XB_TOPGEN]) == tg, bar);
            __builtin_amdgcn_fence(__ATOMIC_ACQUIRE, "agent");
            xb_add(&bar[XB_XGEN(b.x)], 1u);
            asm volatile("s_waitcnt vmcnt(0)" ::: "memory");
        } else {
            XB_SPIN(xb_ld(&bar[XB_XGEN(b.x)]) == gen, bar);
            __builtin_amdgcn_fence(__ATOMIC_ACQUIRE, "agent");
            asm volatile("s_waitcnt vmcnt(0)" ::: "memory");
        }
    }
    __syncthreads();
}

template <int MASK> __global__ void __launch_bounds__(NTHR, 2) mk_fwd(Args args) {
    extern __shared__ __attribute__((aligned(16))) unsigned char lds[];
    const int G = gridDim.x, NGW = G * NWAVES;
    cg::grid_group grid = cg::this_grid();
    const int ph_lo = args.ph_lo, ph_hi = args.ph_hi;
    volatile LAS unsigned* bst = (volatile LAS unsigned*)((LAS unsigned char*)lds + 131072);
    if (threadIdx.x == 0) { bst[0] = 0u; bst[1] = 0u; }
    __syncthreads();
    XcdBarrier bar; bar.bar = nullptr; bar.x = 0; bar.st = bst;
    for (int ph = ph_lo; ph < ph_hi; ++ph) {
        if (ph > ph_lo) {
            if (ph == ph_lo + 1) {
                grid.sync();
                bar = xcd_barrier_post((unsigned*)(args.ws + WS_CTL + 65536), bst);
            } else { xcd_barrier(bar);
#ifdef DBG_DUP_BAR
                xcd_barrier(bar);
#endif
            }
        }
        int tid_v = threadIdx.x; asm volatile("" : "+v"(tid_v));
        const int tid = tid_v, lane = tid & 63, wave = __builtin_amdgcn_readfirstlane(tid >> 6), gw = blockIdx.x * NWAVES + wave;
        kptr_t kp = (kptr_t)__builtin_amdgcn_kernarg_segment_ptr();
        asm volatile("" : "+s"(kp));
        Ctx a; a.kp = kp; a.out = *(float* const __attribute__((address_space(4)))*)(kp + 144); a.ws = *(unsigned char* const __attribute__((address_space(4)))*)(kp + 152);
        unsigned char* ws = a.ws;
        float* stats = (float*)(ws + WS_STATS); bf16* xb = (bf16*)(ws + WS_XB); bf16* hid = (bf16*)(ws + WS_R + R_HID);
        if (ph == 0) {
if constexpr (MASK & 1) { phase_p0(a, lds, gw, NGW, wave, lane);
#ifdef DBG_DUP_P0
 __syncthreads(); phase_p0(a, lds, gw, NGW, wave, lane);
#endif
 }
 __syncthreads(); continue; }
        const int L = (ph - 1) / 9, sub = (ph - 1) % 9;
        unsigned char* wb = ws + WS_W + (size_t)(L & 1) * WSZ;
        if (sub == 0 || sub == 7) {
            pg8::Gemm g{xb, (const bf16*)(wb + (sub == 0 ? W_GU1 : W_GU2)), M, 2 * FF, D}; pg8::StaticOrder S; S.init(M, 2 * FF, G, (int)blockIdx.x);
            pg8::EpiSwiGLU E{hid, stats, FF};
            if constexpr (MASK & 2) pg8::gemm_phase<pg8::EpiSwiGLU, pg8::StaticOrder, PG8_ALIGN, PG8_SP2>((PG8_LAS unsigned char*)lds, g, S, E);
            if constexpr ((MASK & 2) && (MASK & 16)) {
                if (G == 256 && L + 1 < DEPTH && blockIdx.x >= 128) {
                    __syncthreads();
                    float* scr = (float*)(lds + wave * 16384); const int half = sub == 7 ? 1 : 0;
                    for (int it = half * (WC_ITEMS / 2) + ((int)blockIdx.x - 128) * NWAVES + wave; it < (half + 1) * (WC_ITEMS / 2); it += 128 * NWAVES) wconv_item(a, L + 1, it, scr, lane);
                }
            }
#if defined(DBG_DUP_G) && DBG_DUP_G == 1
            __syncthreads(); if constexpr (MASK & 2) pg8::gemm_phase<pg8::EpiSwiGLU, pg8::StaticOrder, PG8_ALIGN, PG8_SP2>((PG8_LAS unsigned char*)lds, g, S, E);
#endif
        } else if (sub == 1 || sub == 6 || sub == 8) {
            const bf16* A = sub == 6 ? (const bf16*)(ws + WS_R + R_Y) : hid; const int K = sub == 6 ? D : FF;
            const bf16* Bt = (const bf16*)(wb + (sub == 1 ? W_D1 : (sub == 6 ? W_OUT : W_D2)));
            pg8::Gemm g{A, Bt, M, D, K}; pg8::StaticOrder S; S.init(M, D, G, (int)blockIdx.x);
            pg8::EpiResid E{(L == 0 && sub == 1) ? a.in(I_X) : (const float*)a.out, a.out, xb, stats, sub == 6 ? 1.0f : 0.5f};
            if constexpr (MASK & 4) pg8::gemm_phase<pg8::EpiResid, pg8::StaticOrder, PG8_ALIGN, PG8_SP2>((PG8_LAS unsigned char*)lds, g, S, E);
#if defined(DBG_DUP_G) && DBG_DUP_G == 2
            __syncthreads(); { pg8::EpiResid E0{a.out, a.out, xb, stats, 0.0f}; if constexpr (MASK & 4) pg8::gemm_phase<pg8::EpiResid, pg8::StaticOrder, PG8_ALIGN, PG8_SP2>((PG8_LAS unsigned char*)lds, g, S, E0); }
#endif
        } else if (sub == 2) {
            pg8::Gemm g{xb, (const bf16*)(wb + W_IN), M, INW, D}; pg8::StaticOrder S; S.init(M, INW, G, (int)blockIdx.x);
            pg8::EpiProj E{(bf16*)(ws + WS_R + R_Q), (bf16*)(ws + WS_R + R_K), (bf16*)(ws + WS_R + R_V), (bf16*)(ws + WS_R + R_U5), (float*)(ws + WS_KMP), stats,
                           (const float*)(ws + WS_ROPEC), (const float*)(ws + WS_ROPES), a.in(I_QN) + L * 64, a.in(I_KN) + L * 64};
            if constexpr (MASK & 8) pg8::gemm_phase<pg8::EpiProj, pg8::StaticOrder, PG8_ALIGN, PG8_SP2>((PG8_LAS unsigned char*)lds, g, S, E);
#if defined(DBG_DUP_G) && DBG_DUP_G == 3
            __syncthreads(); if constexpr (MASK & 8) pg8::gemm_phase<pg8::EpiProj, pg8::StaticOrder, PG8_ALIGN, PG8_SP2>((PG8_LAS unsigned char*)lds, g, S, E);
#endif
        } else if (sub == 3) {
if constexpr (MASK & 16) { phase_t(a, L, lds, gw, NGW, wave, lane, !(MASK & 2) || G != 256);
#if defined(DBG_DUP_SUB) && DBG_DUP_SUB == 3
 __syncthreads(); phase_t(a, L, lds, gw, NGW, wave, lane, !(MASK & 2) || G != 256);
#endif
 }
 __syncthreads(); }
        else if (sub == 4) {
if constexpr (MASK & 32) { phase_a(a, L, lds, gw, NGW, tid, wave, lane);
#if defined(DBG_DUP_SUB) && DBG_DUP_SUB == 4
 __syncthreads(); phase_a(a, L, lds, gw, NGW, tid, wave, lane);
#endif
 }
 __syncthreads(); }
        else {
if constexpr (MASK & 64) { phase_c(a, L, gw, NGW, lane);
#if defined(DBG_DUP_SUB) && DBG_DUP_SUB == 5
 __syncthreads(); phase_c(a, L, gw, NGW, lane);
#endif
 }
 __syncthreads(); }
    }
}

#ifndef MK_MULTI
#define MK_MULTI 0
#endif
#ifndef DBG_NPH
#define DBG_NPH (1 + 9 * DEPTH)
#endif
constexpr int N_PHASES = DBG_NPH;
static int phase_mask(int ph) { if (ph == 0) return 1; const int sub = (ph - 1) % 9; const int m[9] = {2, 4, 8, 16, 32, 64, 4, 2, 4}; return m[sub]; }
template <int MASK> static bool setup_one(int& per_cu) {
    if (hipFuncSetAttribute((const void*)mk_fwd<MASK>, hipFuncAttributeMaxDynamicSharedMemorySize, LDS_BYTES) != hipSuccess) return false;
    if (hipOccupancyMaxActiveBlocksPerMultiprocessor(&per_cu, (const void*)mk_fwd<MASK>, NTHR, LDS_BYTES) != hipSuccess) per_cu = 1;
    (void)hipGetLastError(); return true;
}
template <int MASK> static void launch_one(const Args& a, int grid, hipStream_t stream) { hipLaunchKernelGGL(mk_fwd<MASK>, dim3(grid), dim3(NTHR), LDS_BYTES, stream, a); }
extern "C" void kernel_launch(void* const* d_in, const int* in_sizes, int n_in, void* d_out, int out_size, void* d_ws, size_t ws_size, hipStream_t stream) {
    static int grid = 0;
    if (grid == 0) {
        if (n_in != 18 || in_sizes[0] != M * D || out_size != M * D || ws_size < WS_END) { fprintf(stderr, "kernel_launch: unexpected shapes / workspace (n_in %d, ws %zu < %zu)\n", n_in, ws_size, (size_t)WS_END); grid = -1; return; }
        int dev = 0, cus = 0, per_cu = 0; bool ok = true;
        (void)hipGetDevice(&dev); (void)hipDeviceGetAttribute(&cus, hipDeviceAttributeMultiprocessorCount, dev);
#if MK_MULTI
        ok = setup_one<1>(per_cu) && setup_one<2>(per_cu) && setup_one<4>(per_cu) && setup_one<8>(per_cu) && setup_one<16>(per_cu) && setup_one<32>(per_cu) && setup_one<64>(per_cu);
#else
        ok = setup_one<127>(per_cu);
#endif
        if (!ok) { fprintf(stderr, "kernel_launch: hipFuncSetAttribute failed\n"); grid = -1; return; }
        grid = cus;
    }
    if (grid < 0) return;
    Args a{};
    for (int i = 0; i < 18; ++i) a.in[i] = (const float*)d_in[i];
    a.out = (float*)d_out; a.ws = (unsigned char*)d_ws;
#if MK_MULTI
    for (int ph = 0; ph < N_PHASES; ++ph) { a.ph_lo = ph; a.ph_hi = ph + 1;
        switch (phase_mask(ph)) { case 1: launch_one<1>(a, grid, stream); break; case 2: launch_one<2>(a, grid, stream); break; case 4: launch_one<4>(a, grid, stream); break; case 8: launch_one<8>(a, grid, stream); break;
                                  case 16: launch_one<16>(a, grid, stream); break; case 32: launch_one<32>(a, grid, stream); break; default: launch_one<64>(a, grid, stream); break; } }
#else
    a.ph_lo = 0; a.ph_hi = N_PHASES;
    void* args[] = {&a};
    hipError_t e = hipLaunchCooperativeKernel((const void*)mk_fwd<127>, dim3(grid), dim3(NTHR), args, LDS_BYTES, stream);
    if (e != hipSuccess) fprintf(stderr, "cooperative launch failed: %s (grid %d)\n", hipGetErrorString(e), grid);
#endif
}
```
